# Optimizing an MI355X kernel written in HIP

```python
import jax, jax.numpy as jnp
from jax import lax
import numpy as np

D_MODEL = 1024
BATCH = 4
SEQ = 8192
DEPTH = 1
DEC_BATCH = 8
DEC_SEQ = 16
PAST_LEN = 4096

CHUNK = 64
EPS = 1e-6
LRU_WIDTH = D_MODEL // 2
LRU_BLOCKS = 8
LRU_BLOCK_W = LRU_WIDTH // LRU_BLOCKS
CONV_W = 4
LRU_C = 8.0
N_HEADS = 8
N_KV_HEADS = 2
HEAD_DIM = 64
ATTN_WIDTH = N_HEADS * HEAD_DIM
N_IDX_HEADS = 8
IDX_DIM = 64
TOPK_MAX = 256
Q_BLOCK = 128
ROPE_THETA = 10000.0
D_FF = ((8 * D_MODEL // 3 + 255) // 256) * 256
PROJ_SIZES = (LRU_WIDTH, LRU_WIDTH, N_HEADS * HEAD_DIM, N_KV_HEADS * HEAD_DIM,
              N_KV_HEADS * HEAD_DIM, N_IDX_HEADS * IDX_DIM, IDX_DIM, N_IDX_HEADS)
D_IN = sum(PROJ_SIZES)

kernel_name = "hymba_rglru_dsa_streaming_step"


def rmsnorm(x, g):
    xf = x.astype(jnp.float32)
    y = xf * lax.rsqrt(jnp.mean(xf * xf, axis=-1, keepdims=True) + EPS)
    return (y * g.astype(jnp.float32)).astype(x.dtype)


def rope(x, pos):
    half = x.shape[-1] // 2
    inv = ROPE_THETA ** (-jnp.arange(half, dtype=jnp.float32) / half)
    ang = pos.astype(jnp.float32)[:, None] * inv[None, :]
    cos = jnp.cos(ang)[None, :, None, :]
    sin = jnp.sin(ang)[None, :, None, :]
    xf = x.astype(jnp.float32)
    x1, x2 = xf[..., :half], xf[..., half:]
    return jnp.concatenate([x1 * cos - x2 * sin, x2 * cos + x1 * sin], axis=-1).astype(x.dtype)


def causal_conv(xr, prev, w, b):
    T = xr.shape[1]
    xpad = jnp.concatenate([prev.astype(xr.dtype), xr], axis=1)
    y = b
    for j in range(CONV_W):
        y = y + xpad[:, j:j + T] * w[j]
    return y, xpad[:, -(CONV_W - 1):]


def _lin_combine(c1, c2):
    a1, b1 = c1
    a2, b2 = c2
    return a1 * a2, a2 * b1 + b2


def rglru(x, pos, h_prev, w_rg, b_rg, w_ig, b_ig, lru_lambda):
    B, T, W = x.shape
    xf = x.astype(jnp.float32)
    xb = xf.reshape(B, T, LRU_BLOCKS, LRU_BLOCK_W)
    r = jax.nn.sigmoid(jnp.einsum('btni,nij->btnj', xb, w_rg.astype(jnp.float32)) + b_rg.astype(jnp.float32)).reshape(B, T, W)
    i = jax.nn.sigmoid(jnp.einsum('btni,nij->btnj', xb, w_ig.astype(jnp.float32)) + b_ig.astype(jnp.float32)).reshape(B, T, W)
    log_a = -LRU_C * r * jax.nn.softplus(-lru_lambda.astype(jnp.float32))
    a = jnp.exp(log_a)
    mult = jnp.where((pos == 0)[None, :, None], 1.0, jnp.sqrt(-jnp.expm1(2.0 * log_a)))
    bterm = mult * i * xf
    a_cum, b_cum = lax.associative_scan(_lin_combine, (a, bterm), axis=1)
    h = a_cum * h_prev.astype(jnp.float32)[:, None, :] + b_cum
    return h, h[:, -1]


def dsa_block(q, qi, wi, q_pos, k, v, ki, k_pos, topk):
    B, Tq = q.shape[:2]
    sc = jnp.einsum('bthd,bsd->bths', qi.astype(jnp.float32), ki.astype(jnp.float32))
    idx_score = jnp.einsum('bths,bth->bts', jax.nn.relu(sc), wi.astype(jnp.float32))
    adm = (q_pos[:, None] // CHUNK) >= (k_pos[None, :] // CHUNK)
    idx_score = jnp.where(adm[None], idx_score, -jnp.inf)
    vals, sel = lax.top_k(idx_score, topk)
    valid = jnp.isfinite(vals)
    gather = jax.vmap(lambda arr, ix: arr[ix])
    ks = gather(k, sel)
    vs = gather(v, sel)
    qg = q.reshape(B, Tq, N_KV_HEADS, N_HEADS // N_KV_HEADS, HEAD_DIM)
    s = jnp.einsum('bthgd,btkhd->bthgk', qg.astype(jnp.float32), ks.astype(jnp.float32)) * (HEAD_DIM ** -0.5)
    s = jnp.where(valid[:, :, None, None, :], s, -jnp.inf)
    p = jax.nn.softmax(s, axis=-1)
    o = jnp.einsum('bthgk,btkhd->bthgd', p, vs.astype(jnp.float32))
    return o.reshape(B, Tq, N_HEADS * HEAD_DIM).astype(q.dtype)


def dsa_attend(q, qi, wi, q_pos, k, v, ki, k_pos, topk):
    B, T = q.shape[:2]
    if T > Q_BLOCK and T % Q_BLOCK == 0:
        nb = T // Q_BLOCK

        def split_blocks(arr):
            return jnp.moveaxis(arr.reshape((B, nb, Q_BLOCK) + arr.shape[2:]), 1, 0)

        def one(args):
            qb, qib, wib, pb = args
            return dsa_block(qb, qib, wib, pb, k, v, ki, k_pos, topk)

        out = lax.map(one, (split_blocks(q), split_blocks(qi), split_blocks(wi), q_pos.reshape(nb, Q_BLOCK)))
        return jnp.moveaxis(out, 0, 1).reshape(B, T, N_HEADS * HEAD_DIM)
    return dsa_block(q, qi, wi, q_pos, k, v, ki, k_pos, topk)


def layer(x, pos, conv_prev, h_prev, k_past, v_past, ki_past,
          norm_mix, w_in, conv_w, conv_b, w_rg, b_rg, w_ig, b_ig, lru_lambda,
          q_norm, k_norm, w_out, norm_ffn, w_ffn_in, w_ffn_out):
    B, T, _ = x.shape
    h = rmsnorm(x, norm_mix)
    proj = h @ w_in
    parts = []
    off = 0
    for size in PROJ_SIZES:
        parts.append(proj[..., off:off + size])
        off += size
    xr, gate, q, k, v, qi, ki, wi = parts
    xc, conv_new = causal_conv(xr, conv_prev, conv_w, conv_b)
    hs, h_last = rglru(xc, pos, h_prev, w_rg, b_rg, w_ig, b_ig, lru_lambda)
    y_a = hs.astype(x.dtype) * jax.nn.gelu(gate)
    q = rope(rmsnorm(q.reshape(B, T, N_HEADS, HEAD_DIM), q_norm), pos)
    k = rope(rmsnorm(k.reshape(B, T, N_KV_HEADS, HEAD_DIM), k_norm), pos)
    v = v.reshape(B, T, N_KV_HEADS, HEAD_DIM)
    qi = rope(qi.reshape(B, T, N_IDX_HEADS, IDX_DIM), pos)
    ki = rope(ki.reshape(B, T, 1, IDX_DIM), pos)[:, :, 0]
    wi = wi * (N_IDX_HEADS ** -0.5 * IDX_DIM ** -0.5)
    if k_past is None:
        k_all, v_all, ki_all, k_pos = k, v, ki, pos
    else:
        P = k_past.shape[1]
        k_all = jnp.concatenate([k_past.astype(k.dtype), k], axis=1)
        v_all = jnp.concatenate([v_past.astype(v.dtype), v], axis=1)
        ki_all = jnp.concatenate([ki_past.astype(ki.dtype), ki], axis=1)
        k_pos = jnp.concatenate([jnp.arange(P, dtype=jnp.int32), pos])
    topk = min(TOPK_MAX, k_all.shape[1] // 4)
    y_b = dsa_attend(q, qi, wi, pos, k_all, v_all, ki_all, k_pos, topk)
    x = x + jnp.concatenate([y_a, y_b], axis=-1) @ w_out
    hf = rmsnorm(x, norm_ffn)
    gu = hf @ w_ffn_in
    x = x + (jax.nn.silu(gu[..., :D_FF]) * gu[..., D_FF:]) @ w_ffn_out
    return x, k, v, ki, h_last.astype(x.dtype), conv_new


def setup_inputs(seed: int = 0) -> dict:
    key = jax.random.key(seed)
    ks = jax.random.split(key, 24)
    f32 = jnp.float32
    nrm = lambda kk, shape, s: jax.random.normal(kk, shape, f32) * s
    a8 = jax.random.uniform(ks[10], (LRU_WIDTH,), f32, 0.9, 0.999)
    a_base = a8 ** (1.0 / LRU_C)
    return {
        "x_prompt": nrm(ks[0], (BATCH, SEQ, D_MODEL), 1.0),
        "x_sample": nrm(ks[1], (DEC_BATCH, DEC_SEQ, D_MODEL), 1.0),
        "cache_k": nrm(ks[2], (DEC_BATCH, PAST_LEN, N_KV_HEADS, HEAD_DIM), 1.0),
        "cache_v": nrm(ks[3], (DEC_BATCH, PAST_LEN, N_KV_HEADS, HEAD_DIM), 1.0),
        "cache_kidx": nrm(ks[4], (DEC_BATCH, PAST_LEN, IDX_DIM), 1.0),
        "state_h": nrm(ks[5], (DEC_BATCH, LRU_WIDTH), 0.5),
        "state_conv": nrm(ks[6], (DEC_BATCH, CONV_W - 1, LRU_WIDTH), 1.0),
        "norm_mix": 1.0 + nrm(ks[7], (D_MODEL,), 0.01),
        "w_in": nrm(ks[8], (D_MODEL, D_IN), D_MODEL ** -0.5),
        "conv_w": nrm(ks[9], (CONV_W, LRU_WIDTH), CONV_W ** -0.5),
        "conv_b": nrm(ks[11], (LRU_WIDTH,), 0.01),
        "w_rg": nrm(ks[12], (LRU_BLOCKS, LRU_BLOCK_W, LRU_BLOCK_W), LRU_BLOCK_W ** -0.5),
        "b_rg": nrm(ks[13], (LRU_BLOCKS, LRU_BLOCK_W), 0.01),
        "w_ig": nrm(ks[14], (LRU_BLOCKS, LRU_BLOCK_W, LRU_BLOCK_W), LRU_BLOCK_W ** -0.5),
        "b_ig": nrm(ks[15], (LRU_BLOCKS, LRU_BLOCK_W), 0.01),
        "lru_lambda": jnp.log(a_base) - jnp.log1p(-a_base),
        "q_norm": 1.0 + nrm(ks[16], (HEAD_DIM,), 0.01),
        "k_norm": 1.0 + nrm(ks[17], (HEAD_DIM,), 0.01),
        "w_out": nrm(ks[18], (LRU_WIDTH + ATTN_WIDTH, D_MODEL), (LRU_WIDTH + ATTN_WIDTH) ** -0.5),
        "norm_ffn": 1.0 + nrm(ks[19], (D_MODEL,), 0.01),
        "w_ffn_in": nrm(ks[20], (D_MODEL, 2 * D_FF), D_MODEL ** -0.5),
        "w_ffn_out": nrm(ks[21], (D_FF, D_MODEL), D_FF ** -0.5),
    }


def reference(x_prompt, x_sample, cache_k, cache_v, cache_kidx, state_h, state_conv,
              norm_mix, w_in, conv_w, conv_b, w_rg, b_rg, w_ig, b_ig, lru_lambda,
              q_norm, k_norm, w_out, norm_ffn, w_ffn_in, w_ffn_out):
    weights = (norm_mix, w_in, conv_w, conv_b, w_rg, b_rg, w_ig, b_ig, lru_lambda,
               q_norm, k_norm, w_out, norm_ffn, w_ffn_in, w_ffn_out)
    Bp, Tp, _ = x_prompt.shape
    Bs, Ts, _ = x_sample.shape
    P = cache_k.shape[1]
    pos_p = jnp.arange(Tp, dtype=jnp.int32)
    pos_s = P + jnp.arange(Ts, dtype=jnp.int32)
    yp = x_prompt
    conv0 = jnp.zeros((Bp, CONV_W - 1, LRU_WIDTH), x_prompt.dtype)
    h0 = jnp.zeros((Bp, LRU_WIDTH), x_prompt.dtype)
    ys = x_sample
    for _ in range(DEPTH):
        yp, k_p, v_p, ki_p, h_p, conv_p = layer(yp, pos_p, conv0, h0, None, None, None, *weights)
        ys, k_s, v_s, ki_s, h_s, conv_s = layer(ys, pos_s, state_conv, state_h, cache_k, cache_v, cache_kidx, *weights)
    return (yp, ys, k_p, v_p, ki_p, h_p, conv_p, k_s, v_s, ki_s, h_s, conv_s)
```

```cpp
#include <hip/hip_runtime.h>
#include <hip/hip_cooperative_groups.h>
#include <cstdio>
#include <cstdint>
#include <cmath>
namespace cg = cooperative_groups;
namespace pg8 {
#define PG8_LAS __attribute__((address_space(3)))
typedef unsigned short bf16_t;
typedef short bf16x8 __attribute__((ext_vector_type(8)));
typedef float f32x4 __attribute__((ext_vector_type(4)));
typedef unsigned u32x4 __attribute__((ext_vector_type(4)));
constexpr int BM = 256, BK = 64, HALF = 128, HTB = HALF * BK * 2  , STAGE_BYTES = 8 * HTB, NXCD = 8, WGM = 8;

__host__ __device__ __forceinline__ int lds_byte(int r, int c) { const int st = (r >> 4) * 2 + (c >> 5), rr = r & 15, cc = c & 31, ob = rr * 64 + cc * 2; return st * 1024 + (ob ^ (((ob >> 9) & 1) << 5)); }
__host__ __device__ __forceinline__ void stage_rc(int b, int& R, int& C) { const int st = b / 1024, sb = b % 1024, swz = sb ^ (((sb >> 9) & 1) << 5); R = (st >> 1) * 16 + swz / 64; C = (st & 1) * 32 + (swz % 64) / 2; }
__host__ __device__ __forceinline__ int perm32(int rho) { const int n = rho >> 4, i = rho & 15; return 8 * (i >> 2) + 4 * n + (i & 3); }

struct Unit { int pm, pn; };
struct Gemm { const bf16_t* A; const bf16_t* Bt; int M, N, K; };

struct StaticOrder {
    int nM, nN, nwg, G, c;
    __host__ __device__ void init(int M, int N, int G_, int c_) { nM = M / BM; nN = N / BM; nwg = nM * nN; G = G_; c = c_; }
    __host__ __device__ bool next(int i, Unit& u) const {
        const long L = (long)i * G + c; if (L >= nwg) return false;
        int wgid = (int)L; { const int q = nwg / NXCD, r = nwg % NXCD, xcd = wgid % NXCD, off = wgid / NXCD; wgid = (xcd < r ? xcd * (q + 1) : r * (q + 1) + (xcd - r) * q) + off; }
        const int nig = WGM * nN, gid = wgid / nig, fm = gid * WGM, gsz = (nM - fm) < WGM ? (nM - fm) : WGM;
        u.pm = fm + ((wgid % nig) % gsz); u.pn = (wgid % nig) / gsz; return true;
    }
    __device__ __forceinline__ void a_ready(const Unit&) const {}
    __device__ __forceinline__ void done(const Unit&) const {}
};
__device__ __forceinline__ unsigned cvt_pk_bf16(float lo, float hi) { unsigned r; asm volatile("v_cvt_pk_bf16_f32 %0, %1, %2" : "=v"(r) : "v"(lo), "v"(hi)); return r; }
template <class Epi, class Sched, bool ALIGN_EPI = false, bool SP2 = false>
__device__ __forceinline__ void gemm_phase(PG8_LAS unsigned char* lds, const Gemm g, const Sched& S, const Epi& E) {
    const int tid = threadIdx.x, wid = __builtin_amdgcn_readfirstlane(tid >> 6), lane = tid & 63, wr = wid >> 2, wc = wid & 3, fr = lane & 15, fq = lane >> 4;
    const int K = g.K, nt = K / BK;
    unsigned voffA[2], voffB[2];
#pragma unroll
    for (int i = 0; i < 2; ++i) { int R, C; stage_rc(tid * 16 + i * 8192, R, C); const int Rb = Epi::PERM ? ((R & ~31) + perm32(R & 31)) : R;
        voffA[i] = (unsigned)(R * K + C) * 2u; voffB[i] = (unsigned)(Rb * K + C) * 2u; }
    const size_t kstep = (size_t)(BK * 2);
    const size_t hstep = (size_t)HALF * K * 2;
    const size_t tstep = 2 * hstep;
    const unsigned ldsw = (unsigned)wid * 1024u;
    const int aoff = lds_byte(wr * 64 + fr, fq * 8), boff = lds_byte(wc * 32 + fr, fq * 8);
#define PG8_SA(b, h) (((b) * 2 + (h)) * HTB)
#define PG8_SB(b, h) ((4 + (b) * 2 + (h)) * HTB)
#define PG8_STAGE(bufoff, gbase, voff) do { _Pragma("unroll") for (int _i = 0; _i < 2; ++_i) \
        __builtin_amdgcn_global_load_lds((const unsigned*)((const char*)(gbase) + (voff)[_i]), (PG8_LAS unsigned*)(lds + (bufoff) + ldsw + _i * 8192), 16, 0, 0); } while (0)
#define PG8_LDA(dst, b, h) do { _Pragma("unroll") for (int m = 0; m < 4; ++m) _Pragma("unroll") for (int k = 0; k < 2; ++k) dst[m][k] = *(const PG8_LAS bf16x8*)(lds + PG8_SA(b, h) + aoff + m * 2048 + k * 1024); } while (0)
#define PG8_LDB(dst, b, h) do { _Pragma("unroll") for (int n = 0; n < 2; ++n) _Pragma("unroll") for (int k = 0; k < 2; ++k) dst[n][k] = *(const PG8_LAS bf16x8*)(lds + PG8_SB(b, h) + boff + n * 2048 + k * 1024); } while (0)
#define PG8_MMA(ai, bj, At, Bt) do { __builtin_amdgcn_s_setprio(1); _Pragma("unroll") for (int m = 0; m < 4; ++m) _Pragma("unroll") for (int n = 0; n < 2; ++n) _Pragma("unroll") for (int k = 0; k < 2; ++k) \
        acc[ai][bj][m][n] = __builtin_amdgcn_mfma_f32_16x16x32_bf16(Bt[n][k], At[m][k], acc[ai][bj][m][n], 0, 0, 0); __builtin_amdgcn_s_setprio(0); } while (0)
#define PG8_WAIT_V(n) asm volatile("s_waitcnt vmcnt(" #n ")" ::: "memory")
#define PG8_WAIT_L(n) asm volatile("s_waitcnt lgkmcnt(" #n ")" ::: "memory")
#define PG8_BAR __builtin_amdgcn_s_barrier()
#define PG8_SCHED __builtin_amdgcn_sched_barrier(0)
    Unit cur, nxt; int ui = 0;
    if (!S.next(0, cur)) return;
    f32x4 acc[2][2][4][2];
#pragma unroll
    for (int a = 0; a < 2; ++a)
#pragma unroll
        for (int b = 0; b < 2; ++b)
#pragma unroll
            for (int m = 0; m < 4; ++m)
#pragma unroll
                for (int n = 0; n < 2; ++n) acc[a][b][m][n] = (f32x4){0.f, 0.f, 0.f, 0.f};
    bf16x8 At[4][2], B0[2][2], B1[2][2];
    const char* cA = (const char*)g.A + (size_t)cur.pm * tstep; const char* cB = (const char*)g.Bt + (size_t)cur.pn * tstep;
    S.a_ready(cur);
    if constexpr (SP2) {
        PG8_STAGE(PG8_SB(0, 0), cB, voffB); PG8_STAGE(PG8_SB(0, 1), cB + hstep, voffB); PG8_STAGE(PG8_SA(0, 0), cA, voffA); PG8_STAGE(PG8_SA(0, 1), cA + hstep, voffA);
        if (wr == 1) PG8_BAR;
        PG8_WAIT_V(2); PG8_BAR;
        PG8_STAGE(PG8_SB(1, 0), cB + kstep, voffB); PG8_STAGE(PG8_SA(1, 0), cA + kstep, voffA); PG8_STAGE(PG8_SB(1, 1), cB + hstep + kstep, voffB);
        PG8_WAIT_V(6); PG8_BAR;
    } else {
        PG8_STAGE(PG8_SB(0, 0), cB, voffB); PG8_STAGE(PG8_SA(0, 0), cA, voffA); PG8_STAGE(PG8_SB(0, 1), cB + hstep, voffB); PG8_STAGE(PG8_SA(0, 1), cA + hstep, voffA);
        if (wr == 1) PG8_BAR;
        PG8_WAIT_V(4); PG8_BAR;
        PG8_STAGE(PG8_SB(1, 0), cB + kstep, voffB); PG8_STAGE(PG8_SA(1, 0), cA + kstep, voffA); PG8_STAGE(PG8_SB(1, 1), cB + hstep + kstep, voffB);
        PG8_WAIT_V(6); PG8_BAR;
    }
    for (;;) {
        const bool has_next = S.next(ui + 1, nxt);
        const char* nA = has_next ? (const char*)g.A + (size_t)nxt.pm * tstep : cA; const char* nB = has_next ? (const char*)g.Bt + (size_t)nxt.pn * tstep : cB;
        for (int t = 0; t < nt; t += 2) {
            const bool last = (t == nt - 2);
            const char* a1 = cA + (size_t)(t + 1) * kstep;
            const char* a2 = last ? nA : cA + (size_t)(t + 2) * kstep; const char* b2 = last ? nB : cB + (size_t)(t + 2) * kstep;
            const char* a3 = a2 + kstep; const char* b3 = b2 + kstep;
            if (last && has_next) S.a_ready(nxt);
            if constexpr (SP2) {
            PG8_LDB(B0, 0, 0); PG8_LDB(B1, 0, 1); PG8_SCHED; PG8_LDA(At, 0, 0); PG8_STAGE(PG8_SA(1, 1), a1 + hstep, voffA);
            PG8_WAIT_V(8); PG8_WAIT_L(0); PG8_BAR; PG8_MMA(0, 0, At, B0); PG8_MMA(0, 1, At, B1); PG8_BAR; PG8_SCHED;
            PG8_LDA(At, 0, 1); PG8_STAGE(PG8_SB(0, 0), b2, voffB); PG8_STAGE(PG8_SB(0, 1), b2 + hstep, voffB); PG8_STAGE(PG8_SA(0, 0), a2, voffA);
            PG8_WAIT_V(8); PG8_WAIT_L(0); PG8_BAR; PG8_MMA(1, 0, At, B0); PG8_MMA(1, 1, At, B1); PG8_BAR; PG8_SCHED;
            PG8_LDB(B0, 1, 0); PG8_LDB(B1, 1, 1); PG8_SCHED; PG8_LDA(At, 1, 0); PG8_STAGE(PG8_SA(0, 1), a2 + hstep, voffA);
            PG8_WAIT_V(8); PG8_WAIT_L(0); PG8_BAR; PG8_MMA(0, 0, At, B0); PG8_MMA(0, 1, At, B1); PG8_BAR; PG8_SCHED;
            PG8_LDA(At, 1, 1); PG8_STAGE(PG8_SB(1, 0), b3, voffB); PG8_STAGE(PG8_SB(1, 1), b3 + hstep, voffB); PG8_STAGE(PG8_SA(1, 0), a3, voffA);
            PG8_WAIT_V(8); PG8_WAIT_L(0); PG8_BAR; PG8_MMA(1, 0, At, B0); PG8_MMA(1, 1, At, B1); PG8_BAR; PG8_SCHED;
            } else {
            PG8_LDB(B0, 0, 0); PG8_SCHED; PG8_LDA(At, 0, 0); PG8_STAGE(PG8_SA(1, 1), a1 + hstep, voffA);
            PG8_WAIT_L(8); PG8_BAR; PG8_WAIT_L(0); PG8_MMA(0, 0, At, B0); PG8_BAR; PG8_SCHED;
            PG8_LDB(B1, 0, 1); PG8_STAGE(PG8_SB(0, 0), b2, voffB);
            PG8_BAR; PG8_WAIT_L(0); PG8_MMA(0, 1, At, B1); PG8_BAR;
            PG8_LDA(At, 0, 1); PG8_STAGE(PG8_SA(0, 0), a2, voffA);
            PG8_BAR; PG8_WAIT_L(0); PG8_MMA(1, 0, At, B0); PG8_BAR; PG8_SCHED;
            PG8_STAGE(PG8_SB(0, 1), b2 + hstep, voffB);
            PG8_WAIT_V(6); PG8_BAR; PG8_MMA(1, 1, At, B1); PG8_BAR;
            PG8_LDB(B0, 1, 0); PG8_SCHED; PG8_LDA(At, 1, 0); PG8_STAGE(PG8_SA(0, 1), a2 + hstep, voffA);
            PG8_WAIT_L(8); PG8_BAR; PG8_WAIT_L(0); PG8_MMA(0, 0, At, B0); PG8_BAR; PG8_SCHED;
            PG8_LDB(B1, 1, 1); PG8_STAGE(PG8_SB(1, 0), b3, voffB);
            PG8_BAR; PG8_WAIT_L(0); PG8_MMA(0, 1, At, B1); PG8_BAR;
            PG8_LDA(At, 1, 1); PG8_STAGE(PG8_SA(1, 0), a3, voffA);
            PG8_BAR; PG8_WAIT_L(0); PG8_MMA(1, 0, At, B0); PG8_BAR; PG8_SCHED;
            PG8_STAGE(PG8_SB(1, 1), b3 + hstep, voffB);
            PG8_WAIT_V(6); PG8_BAR; PG8_MMA(1, 1, At, B1); PG8_BAR;
            }
        }
        if constexpr (ALIGN_EPI) { if (wr == 0) PG8_BAR; }
        if constexpr (!Epi::AFTER_DRAIN) { E(acc, cur, wr, wc, fr, fq); S.done(cur); }
        if (!has_next) break;
#pragma unroll
        for (int a = 0; a < 2; ++a)
#pragma unroll
            for (int b = 0; b < 2; ++b)
#pragma unroll
                for (int m = 0; m < 4; ++m)
#pragma unroll
                    for (int n = 0; n < 2; ++n) acc[a][b][m][n] = (f32x4){0.f, 0.f, 0.f, 0.f};
        cur = nxt; cA = nA; cB = nB; ++ui;
        if constexpr (ALIGN_EPI) { if (wr == 1) PG8_BAR; }
    }
    PG8_WAIT_V(0);
    if constexpr (!ALIGN_EPI) { if (wr == 0) PG8_BAR; }
    PG8_BAR;
    if constexpr (Epi::AFTER_DRAIN) { E.fused(acc, cur, wr, wc, fr, fq, lds, wid, lane); S.done(cur); }
#undef PG8_SA
#undef PG8_SB
#undef PG8_STAGE
#undef PG8_LDA
#undef PG8_LDB
#undef PG8_MMA
#undef PG8_WAIT_V
#undef PG8_WAIT_L
#undef PG8_BAR
#undef PG8_SCHED
}
}

constexpr int D = 1024, NB = 4, SEQ = 8192, DB = 8, DT = 16, PAST = 4096;
constexpr int MP = NB * SEQ;
constexpr int MS = DB * DT;
constexpr int MR = MP + MS;
constexpr int M = 33024;
constexpr int LW = 512, NLB = 8, LBW = 64;
constexpr int KVW = 128;
constexpr int DIN = 2376, NIN = 2560;
constexpr int DFF = 2816;
constexpr int SKEYS = PAST + DT;
constexpr float EPS = 1e-6f;
constexpr float WI_SCALE = 0.044194173824159216f;

constexpr size_t O_YP = 0;
constexpr size_t O_YS = O_YP + (size_t)MP * D;
constexpr size_t O_KP = O_YS + (size_t)MS * D;
constexpr size_t O_VP = O_KP + (size_t)MP * KVW;
constexpr size_t O_KIP = O_VP + (size_t)MP * KVW;
constexpr size_t O_HP = O_KIP + (size_t)MP * 64;
constexpr size_t O_CP = O_HP + (size_t)NB * LW;
constexpr size_t O_KS = O_CP + (size_t)NB * 3 * LW;
constexpr size_t O_VS = O_KS + (size_t)MS * KVW;
constexpr size_t O_KIS = O_VS + (size_t)MS * KVW;
constexpr size_t O_HS = O_KIS + (size_t)MS * 64;
constexpr size_t O_CS = O_HS + (size_t)DB * LW;
constexpr size_t O_END = O_CS + (size_t)DB * 3 * LW;
static_assert(O_END == 44236800, "output size");

constexpr size_t al256(size_t x) { return (x + 255) & ~(size_t)255; }
constexpr size_t WS_CTL = 0, CTL_BYTES = 1u << 20;
constexpr size_t WS_WIN = WS_CTL + CTL_BYTES;
constexpr size_t WS_WOUT = WS_WIN + al256((size_t)NIN * D * 2);
constexpr size_t WS_WFI = WS_WOUT + al256((size_t)D * D * 2);
constexpr size_t WS_WFO = WS_WFI + al256((size_t)2 * DFF * D * 2);
constexpr size_t WS_WG = WS_WFO + al256((size_t)D * DFF * 2);
constexpr size_t WS_RCOS = WS_WG + al256((size_t)2 * 8 * 64 * 64 * 2);
constexpr size_t WS_RSIN = WS_RCOS + al256((size_t)8192 * 32 * 4);
constexpr size_t WS_SP = WS_RSIN + al256((size_t)8192 * 32 * 4);
constexpr size_t WS_RSTD = WS_SP + al256(512 * 4);
constexpr size_t WS_SSQ = WS_RSTD + al256((size_t)M * 4);
constexpr size_t WS_WI = WS_SSQ + al256((size_t)M * 4);
constexpr size_t WS_AGG = WS_WI + al256((size_t)M * 8 * 4);
constexpr size_t WS_XB = WS_AGG + al256((size_t)12 * 64 * 512 * 8);
constexpr size_t WS_YC = WS_XB + al256((size_t)M * D * 2);
constexpr size_t WS_KB = WS_YC + al256((size_t)M * D * 2);
constexpr size_t WS_VB = WS_KB + al256((size_t)MP * KVW * 2);
constexpr size_t WS_KIB = WS_VB + al256((size_t)MP * KVW * 2);
constexpr size_t WS_KS = WS_KIB + al256((size_t)MP * 64 * 2);
constexpr size_t WS_VS = WS_KS + al256((size_t)DB * SKEYS * KVW * 2);
constexpr size_t WS_KIS = WS_VS + al256((size_t)DB * SKEYS * KVW * 2);
constexpr size_t WS_R1 = WS_KIS + al256((size_t)DB * SKEYS * 64 * 2);
constexpr size_t WS_XR = WS_R1;
constexpr size_t WS_GG = WS_XR + al256((size_t)M * LW * 2);
constexpr size_t WS_Q = WS_GG + al256((size_t)M * LW * 2);
constexpr size_t WS_QI = WS_Q + al256((size_t)M * LW * 2);
constexpr size_t WS_ACUM = WS_QI + al256((size_t)M * LW * 2);
constexpr size_t WS_BCUM = WS_ACUM + al256((size_t)M * LW * 4);
constexpr size_t WS_R1_END = WS_BCUM + al256((size_t)M * LW * 4);
constexpr size_t WS_H = WS_R1;
static_assert(WS_H + (size_t)M * DFF * 2 <= WS_R1_END, "H overlay fits");
constexpr size_t WS_END = WS_R1_END;

constexpr int LDS_BYTES = 147456;

#define LAS __attribute__((address_space(3)))
typedef unsigned short bf16;
typedef float f32x4 __attribute__((ext_vector_type(4)));
typedef float f32x2 __attribute__((ext_vector_type(2)));
typedef unsigned u32x4 __attribute__((ext_vector_type(4)));
typedef unsigned u32x2 __attribute__((ext_vector_type(2)));
typedef short bf16x8 __attribute__((ext_vector_type(8)));

__device__ __forceinline__ unsigned f2bf(float f) { unsigned u = __builtin_bit_cast(unsigned, f); return (u + 0x7fffu + ((u >> 16) & 1u)) >> 16; }
__device__ __forceinline__ unsigned pk2(float lo, float hi) { return f2bf(lo) | (f2bf(hi) << 16); }
__device__ __forceinline__ float bf2f(unsigned b) { return __builtin_bit_cast(float, b << 16); }
__device__ __forceinline__ float bflo(unsigned w) { return __builtin_bit_cast(float, w << 16); }
__device__ __forceinline__ float bfhi(unsigned w) { return __builtin_bit_cast(float, w & 0xffff0000u); }
__device__ __forceinline__ void store_bf16x8(bf16* p, f32x4 lo, f32x4 hi) {
    u32x4 w; w.x = pg8::cvt_pk_bf16(lo[0], lo[1]); w.y = pg8::cvt_pk_bf16(lo[2], lo[3]); w.z = pg8::cvt_pk_bf16(hi[0], hi[1]); w.w = pg8::cvt_pk_bf16(hi[2], hi[3]);
    *(u32x4*)p = w;
}
__device__ __forceinline__ float gelu_tanh(float x) {
    const float u = 0.7978845608028654f * (x + 0.044715f * x * x * x);
    const float e = __expf(2.0f * u);
    const float th = 1.0f - 2.0f / (e + 1.0f);
    return 0.5f * x * (1.0f + th);
}
__device__ __forceinline__ float sigmoidf_(float x) { return 1.0f / (1.0f + __expf(-x)); }

struct EpiInProj {
    static constexpr bool PERM = false, AFTER_DRAIN = false;
    const float* rstd; const float* rcos; const float* rsin; const float* gq; const float* gk;
    bf16* XR; bf16* GG; bf16* Q; bf16* QI; bf16* KB; bf16* VB; bf16* KIB; bf16* KS; bf16* VS; bf16* KIS; float* WI; float* out;

    template <bool NORM> __device__ __forceinline__ void head_rope(f32x4 (&v)[2][2], const float* g, int pos, int fq) const {
        if (NORM) {
            float ss = 0.f;
#pragma unroll
            for (int bj = 0; bj < 2; ++bj)
#pragma unroll
                for (int n = 0; n < 2; ++n) ss += (v[bj][n][0] * v[bj][n][0] + v[bj][n][1] * v[bj][n][1]) + (v[bj][n][2] * v[bj][n][2] + v[bj][n][3] * v[bj][n][3]);
            ss += __shfl_xor(ss, 16); ss += __shfl_xor(ss, 32);
            const float inv = rsqrtf(ss * (1.0f / 64.0f) + EPS);
#pragma unroll
            for (int bj = 0; bj < 2; ++bj)
#pragma unroll
                for (int n = 0; n < 2; ++n) { const f32x4 g4 = *(const f32x4*)(g + 32 * bj + 8 * fq + 4 * n); v[bj][n] = v[bj][n] * inv * g4; }
        }
#pragma unroll
        for (int n = 0; n < 2; ++n) {
            const f32x4 c4 = *(const f32x4*)(rcos + pos * 32 + 8 * fq + 4 * n), s4 = *(const f32x4*)(rsin + pos * 32 + 8 * fq + 4 * n);
            const f32x4 x1 = v[0][n], x2 = v[1][n];
            v[0][n] = x1 * c4 - x2 * s4; v[1][n] = x2 * c4 + x1 * s4;
        }
    }
    __device__ __forceinline__ void operator()(const f32x4 (&acc)[2][2][4][2], const pg8::Unit& u, int wr, int wc, int fr, int fq) const {
        const int pn = u.pn;
#pragma unroll
        for (int ai = 0; ai < 2; ++ai) {
            const int rbase = u.pm * 256 + ai * 128;
            if (rbase >= MR) continue;
            const bool samp = rbase >= MP;
#pragma unroll
            for (int m = 0; m < 4; ++m) {
                const int r = rbase + wr * 64 + m * 16 + fr;
                int sb, t, pos;
                if (!samp) { sb = r >> 13; t = r & 8191; pos = t; } else { const int rs = r - MP; sb = rs >> 4; t = rs & 15; pos = PAST + t; }
                const float rsd = rstd[r];
                f32x4 v[2][2];
#pragma unroll
                for (int bj = 0; bj < 2; ++bj)
#pragma unroll
                    for (int n = 0; n < 2; ++n) v[bj][n] = acc[ai][bj][m][n] * rsd;
                if (pn < 2) {
#pragma unroll
                    for (int bj = 0; bj < 2; ++bj) {
                        const int c = 256 * pn + 64 * wc + 32 * bj + 8 * fq;
                        store_bf16x8(XR + (size_t)r * LW + c, v[bj][0], v[bj][1]);
                        const int tl = samp ? DT - 3 : SEQ - 3;
                        if (t >= tl) {
                            float* o = samp ? out + O_CS + ((size_t)(sb * 3 + (t - tl))) * LW + c : out + O_CP + ((size_t)(sb * 3 + (t - tl))) * LW + c;
                            *(f32x4*)o = v[bj][0]; *(f32x4*)(o + 4) = v[bj][1];
                        }
                    }
                } else if (pn < 4) {
#pragma unroll
                    for (int bj = 0; bj < 2; ++bj) {
                        const int c = 256 * (pn - 2) + 64 * wc + 32 * bj + 8 * fq;
                        f32x4 a = v[bj][0], b = v[bj][1];
#pragma unroll
                        for (int j = 0; j < 4; ++j) { a[j] = gelu_tanh(a[j]); b[j] = gelu_tanh(b[j]); }
                        store_bf16x8(GG + (size_t)r * LW + c, a, b);
                    }
                } else if (pn < 6) {
                    head_rope<true>(v, gq, pos, fq);
                    const int head = 4 * (pn - 4) + wc;
#pragma unroll
                    for (int bj = 0; bj < 2; ++bj) store_bf16x8(Q + (size_t)r * 512 + head * 64 + 32 * bj + 8 * fq, v[bj][0], v[bj][1]);
                } else if (pn == 6) {
                    if (wc < 2) head_rope<true>(v, gk, pos, fq);
                    const int hh = wc & 1;
                    float* of; bf16* ob;
                    if (wc < 2) { of = samp ? out + O_KS + (size_t)(r - MP) * KVW : out + O_KP + (size_t)r * KVW; ob = samp ? KS + ((size_t)sb * SKEYS + PAST + t) * KVW : KB + (size_t)r * KVW; }
                    else        { of = samp ? out + O_VS + (size_t)(r - MP) * KVW : out + O_VP + (size_t)r * KVW; ob = samp ? VS + ((size_t)sb * SKEYS + PAST + t) * KVW : VB + (size_t)r * KVW; }
#pragma unroll
                    for (int bj = 0; bj < 2; ++bj) {
                        const int c = hh * 64 + 32 * bj + 8 * fq;
                        *(f32x4*)(of + c) = v[bj][0]; *(f32x4*)(of + c + 4) = v[bj][1];
                        store_bf16x8(ob + c, v[bj][0], v[bj][1]);
                    }
                } else if (pn < 9) {
                    head_rope<false>(v, nullptr, pos, fq);
                    const int head = 4 * (pn - 7) + wc;
#pragma unroll
                    for (int bj = 0; bj < 2; ++bj) store_bf16x8(QI + (size_t)r * 512 + head * 64 + 32 * bj + 8 * fq, v[bj][0], v[bj][1]);
                } else {
                    if (wc == 0) {
                        head_rope<false>(v, nullptr, pos, fq);
                        float* of = samp ? out + O_KIS + (size_t)(r - MP) * 64 : out + O_KIP + (size_t)r * 64;
                        bf16* ob = samp ? KIS + ((size_t)sb * SKEYS + PAST + t) * 64 : KIB + (size_t)r * 64;
#pragma unroll
                        for (int bj = 0; bj < 2; ++bj) {
                            const int c = 32 * bj + 8 * fq;
                            *(f32x4*)(of + c) = v[bj][0]; *(f32x4*)(of + c + 4) = v[bj][1];
                            store_bf16x8(ob + c, v[bj][0], v[bj][1]);
                        }
                    } else if (wc == 1) {
                        if (fq == 0) { *(f32x4*)(WI + (size_t)r * 8) = v[0][0] * WI_SCALE; *(f32x4*)(WI + (size_t)r * 8 + 4) = v[0][1] * WI_SCALE; }
                    }
                }
            }
        }
    }
};

struct EpiOutProj {
    static constexpr bool PERM = false, AFTER_DRAIN = false;
    const float* xp; const float* xs; float* out; bf16* XB2; float* ssq;
    __device__ __forceinline__ void operator()(const f32x4 (&acc)[2][2][4][2], const pg8::Unit& u, int wr, int wc, int fr, int fq) const {
        const int col0 = u.pn * 256 + wc * 32 + 4 * fq;
#pragma unroll
        for (int ai = 0; ai < 2; ++ai) {
            const int rbase = u.pm * 256 + ai * 128;
            if (rbase >= MR) continue;
            const bool samp = rbase >= MP;
#pragma unroll
            for (int m = 0; m < 4; ++m) {
                const int r = rbase + wr * 64 + m * 16 + fr;
                const float* xrow = samp ? xs + (size_t)(r - MP) * D : xp + (size_t)r * D;
                float* yrow = samp ? out + O_YS + (size_t)(r - MP) * D : out + O_YP + (size_t)r * D;
                float ss = 0.f;
#pragma unroll
                for (int bj = 0; bj < 2; ++bj)
#pragma unroll
                    for (int n = 0; n < 2; ++n) {
                        const int c = col0 + bj * 128 + n * 16;
                        const f32x4 y = *(const f32x4*)(xrow + c) + acc[ai][bj][m][n];
                        *(f32x4*)(yrow + c) = y;
                        ss += (y[0] * y[0] + y[1] * y[1]) + (y[2] * y[2] + y[3] * y[3]);
                        u32x2 w; w.x = pg8::cvt_pk_bf16(y[0], y[1]); w.y = pg8::cvt_pk_bf16(y[2], y[3]);
                        *(u32x2*)(XB2 + (size_t)r * D + c) = w;
                    }
                ss += __shfl_xor(ss, 16); ss += __shfl_xor(ss, 32);
                if (fq == 0) atomicAdd(ssq + r, ss);
            }
        }
    }
};

struct EpiFfnIn {
    static constexpr bool PERM = false, AFTER_DRAIN = false;
    const float* ssq; bf16* H;
    __device__ __forceinline__ void operator()(const f32x4 (&acc)[2][2][4][2], const pg8::Unit& u, int wr, int wc, int fr, int fq) const {
        const int c = 128 * u.pn + 32 * wc + 8 * fq;
#pragma unroll
        for (int ai = 0; ai < 2; ++ai) {
            const int rbase = u.pm * 256 + ai * 128;
            if (rbase >= MR) continue;
#pragma unroll
            for (int m = 0; m < 4; ++m) {
                const int r = rbase + wr * 64 + m * 16 + fr;
                const float rs2 = rsqrtf(ssq[r] * (1.0f / 1024.0f) + EPS);
                f32x4 h[2];
#pragma unroll
                for (int n = 0; n < 2; ++n) {
                    const f32x4 g = acc[ai][0][m][n] * rs2, up = acc[ai][1][m][n] * rs2;
#pragma unroll
                    for (int j = 0; j < 4; ++j) h[n][j] = g[j] * sigmoidf_(g[j]) * up[j];
                }
                store_bf16x8(H + (size_t)r * DFF + c, h[0], h[1]);
            }
        }
    }
};

struct EpiFfnOut {
    static constexpr bool PERM = false, AFTER_DRAIN = false;
    float* out;
    __device__ __forceinline__ void operator()(const f32x4 (&acc)[2][2][4][2], const pg8::Unit& u, int wr, int wc, int fr, int fq) const {
        const int col0 = u.pn * 256 + wc * 32 + 4 * fq;
#pragma unroll
        for (int ai = 0; ai < 2; ++ai) {
            const int rbase = u.pm * 256 + ai * 128;
            if (rbase >= MR) continue;
            const bool samp = rbase >= MP;
#pragma unroll
            for (int m = 0; m < 4; ++m) {
                const int r = rbase + wr * 64 + m * 16 + fr;
                float* yrow = samp ? out + O_YS + (size_t)(r - MP) * D : out + O_YP + (size_t)r * D;
#pragma unroll
                for (int bj = 0; bj < 2; ++bj)
#pragma unroll
                    for (int n = 0; n < 2; ++n) { const int c = col0 + bj * 128 + n * 16; *(f32x4*)(yrow + c) = *(const f32x4*)(yrow + c) + acc[ai][bj][m][n]; }
            }
        }
    }
};

struct Params {
    const float* in[22];
    float* out;
    unsigned char* ws;
    double invf[32];
    int ph_lo, ph_hi;
};
enum { I_XP = 0, I_XS, I_CK, I_CV, I_CKI, I_SH, I_SC, I_NM, I_WIN, I_CW, I_CB, I_WRG, I_BRG, I_WIG, I_BIG, I_LAM, I_QN, I_KN, I_WOUT, I_NF, I_WFI, I_WFO };

struct Frame { LAS unsigned char* lds; int tid, lane, wave, G, bid; };

__device__ __forceinline__ float wave_sum(float v) {
#pragma unroll
    for (int o = 1; o < 64; o <<= 1) v += __shfl_xor(v, o);
    return v;
}

__device__ __forceinline__ void transpose_item(const float* W, int K, int N, int nvalid, const float* gain, bf16* WT, int k0, int row0, int lcol0, bool perm, LAS float* scr, int lane) {
#pragma unroll 8
    for (int i = 0; i < 32; ++i) {
        const int kk = 2 * i + (lane >> 5), col = lcol0 + (lane & 31);
        float v = 0.f;
        if (col < nvalid) { v = W[(size_t)(k0 + kk) * N + col]; if (gain) v *= gain[k0 + kk]; }
        scr[kk * 33 + (lane & 31)] = v;
    }
    asm volatile("s_waitcnt lgkmcnt(0)" ::: "memory");
    const int c = lane & 7;
#pragma unroll
    for (int j = 0; j < 4; ++j) {
        const int n = (lane >> 3) + 8 * j, src = perm ? pg8::perm32(n) : n;
        const LAS float* s = scr + (8 * c) * 33 + src;
        u32x4 o; o.x = pk2(s[0 * 33], s[1 * 33]); o.y = pk2(s[2 * 33], s[3 * 33]); o.z = pk2(s[4 * 33], s[5 * 33]); o.w = pk2(s[6 * 33], s[7 * 33]);
        *(u32x4*)(WT + (size_t)(row0 + n) * K + k0 + 8 * c) = o;
    }
    asm volatile("s_waitcnt lgkmcnt(0)" ::: "memory");
}

__device__ __forceinline__ void phase0(const Params& p, Frame& F) {
    unsigned char* ws = p.ws;
    LAS float* scr = (LAS float*)(F.lds + F.wave * 16384);
    const int gw = F.bid * 8 + F.wave, NGW = F.G * 8;
    constexpr int I_IN = 16 * (NIN / 32), I_OUT = 16 * (D / 32), I_FI = 16 * (2 * DFF / 32), I_FO = (DFF / 64) * (D / 32);
    constexpr int NITEMS = I_IN + I_OUT + I_FI + I_FO;
    for (int it = gw; it < NITEMS; it += NGW) {
        int r = it;
        if (r < I_IN) { const int kb = r / (NIN / 32), g = r % (NIN / 32), pn = g >> 3, sub = g & 7, bj = sub >> 2, wc = sub & 3;
            transpose_item(p.in[I_WIN], D, DIN, DIN, p.in[I_NM], (bf16*)(ws + WS_WIN), 64 * kb, 32 * g, 256 * pn + 64 * wc + 32 * bj, true, scr, F.lane); continue; }
        r -= I_IN;
        if (r < I_OUT) { const int kb = r / (D / 32), g = r % (D / 32);
            transpose_item(p.in[I_WOUT], D, D, D, nullptr, (bf16*)(ws + WS_WOUT), 64 * kb, 32 * g, 32 * g, false, scr, F.lane); continue; }
        r -= I_OUT;
        if (r < I_FI) { const int kb = r / (2 * DFF / 32), g = r % (2 * DFF / 32), pn = g >> 3, sub = g & 7, bj = sub >> 2, wc = sub & 3;
            transpose_item(p.in[I_WFI], D, 2 * DFF, 2 * DFF, p.in[I_NF], (bf16*)(ws + WS_WFI), 64 * kb, 32 * g, (bj ? DFF : 0) + 128 * pn + 32 * wc, true, scr, F.lane); continue; }
        r -= I_FI;
        { const int kb = r / (D / 32), g = r % (D / 32);
            transpose_item(p.in[I_WFO], DFF, D, D, nullptr, (bf16*)(ws + WS_WFO), 64 * kb, 32 * g, 32 * g, false, scr, F.lane); }
    }
    {
        bf16* XB = (bf16*)(ws + WS_XB); float* rstd = (float*)(ws + WS_RSTD);
        for (int m = gw; m < M; m += NGW) {
            unsigned long long* o8 = (unsigned long long*)(XB + (size_t)m * D) + F.lane;
            if (m >= MR) {
#pragma unroll
                for (int j = 0; j < 4; ++j) o8[64 * j] = 0ull;
                if (F.lane == 0) rstd[m] = 0.f;
                continue;
            }
            const float* xrow = (m < MP) ? p.in[I_XP] + (size_t)m * D : p.in[I_XS] + (size_t)(m - MP) * D;
            const f32x4* xr = (const f32x4*)xrow + F.lane;
            f32x4 v[4]; float s = 0.f;
#pragma unroll
            for (int j = 0; j < 4; ++j) { v[j] = xr[64 * j]; s += (v[j][0] * v[j][0] + v[j][1] * v[j][1]) + (v[j][2] * v[j][2] + v[j][3] * v[j][3]); }
            s = wave_sum(s);
            if (F.lane == 0) rstd[m] = rsqrtf(s * (1.0f / D) + EPS);
#pragma unroll
            for (int j = 0; j < 4; ++j) o8[64 * j] = (unsigned long long)pk2(v[j][0], v[j][1]) | ((unsigned long long)pk2(v[j][2], v[j][3]) << 32);
        }
    }
    const size_t gt = (size_t)F.bid * 512 + F.tid, GS = (size_t)F.G * 512;
    {
        bf16* KS = (bf16*)(ws + WS_KS); bf16* VS = (bf16*)(ws + WS_VS); bf16* KIS = (bf16*)(ws + WS_KIS);
        constexpr size_t NKV8 = (size_t)DB * PAST * KVW / 8, NKI8 = (size_t)DB * PAST * 64 / 8;
        for (size_t i = gt; i < 2 * NKV8 + NKI8; i += GS) {
            const float* src; bf16* dst; size_t e;
            if (i < NKV8) { e = i * 8; const size_t b = e / ((size_t)PAST * KVW), rem = e % ((size_t)PAST * KVW); src = p.in[I_CK] + e; dst = KS + b * SKEYS * KVW + rem; }
            else if (i < 2 * NKV8) { e = (i - NKV8) * 8; const size_t b = e / ((size_t)PAST * KVW), rem = e % ((size_t)PAST * KVW); src = p.in[I_CV] + e; dst = VS + b * SKEYS * KVW + rem; }
            else { e = (i - 2 * NKV8) * 8; const size_t b = e / ((size_t)PAST * 64), rem = e % ((size_t)PAST * 64); src = p.in[I_CKI] + e; dst = KIS + b * SKEYS * 64 + rem; }
            const f32x4 a = *(const f32x4*)src, b4 = *(const f32x4*)(src + 4);
            u32x4 w; w.x = pk2(a[0], a[1]); w.y = pk2(a[2], a[3]); w.z = pk2(b4[0], b4[1]); w.w = pk2(b4[2], b4[3]);
            *(u32x4*)dst = w;
        }
    }
    {
        float* rc = (float*)(ws + WS_RCOS); float* rsn = (float*)(ws + WS_RSIN);
        for (size_t i = gt; i < (size_t)8192 * 32; i += GS) {
            const int pos = (int)(i >> 5), fi = (int)(i & 31);
            const double ang = (double)pos * p.invf[fi];
            const double kq = rint(ang * 0.63661977236758134308);
            double r = fma(-kq, 1.57079632679489655800e+00, ang); r = fma(-kq, 6.12323399573676603587e-17, r);
            const double r2 = r * r;
            double sn = -1.0 / 1307674368000.0; sn = sn * r2 + 1.0 / 6227020800.0; sn = sn * r2 - 1.0 / 39916800.0; sn = sn * r2 + 1.0 / 362880.0; sn = sn * r2 - 1.0 / 5040.0; sn = sn * r2 + 1.0 / 120.0; sn = sn * r2 - 1.0 / 6.0; sn = sn * r2 + 1.0; sn *= r;
            double cs = 1.0 / 20922789888000.0; cs = cs * r2 - 1.0 / 87178291200.0; cs = cs * r2 + 1.0 / 479001600.0; cs = cs * r2 - 1.0 / 3628800.0; cs = cs * r2 + 1.0 / 40320.0; cs = cs * r2 - 1.0 / 720.0; cs = cs * r2 + 1.0 / 24.0; cs = cs * r2 - 0.5; cs = cs * r2 + 1.0;
            const int q = (int)((long long)kq & 3);
            const double sv = (q == 0) ? sn : (q == 1) ? cs : (q == 2) ? -sn : -cs;
            const double cv = (q == 0) ? cs : (q == 1) ? -sn : (q == 2) ? -cs : sn;
            rc[i] = (float)cv; rsn[i] = (float)sv;
        }
    }
    {
        float* ssq = (float*)(ws + WS_SSQ);
        for (size_t i = gt; i < (size_t)M; i += GS) ssq[i] = 0.f;
        float* sp = (float*)(ws + WS_SP);
        for (size_t i = gt; i < 512; i += GS) sp[i] = log1pf(__expf(-p.in[I_LAM][i]));
        bf16* WG = (bf16*)(ws + WS_WG);
        for (size_t i = gt; i < (size_t)2 * 8 * 64 * 64; i += GS) {
            const int ii = (int)(i & 63), j = (int)((i >> 6) & 63), nb = (int)((i >> 12) & 7), gsel = (int)(i >> 15);
            const float* W = gsel ? p.in[I_WIG] : p.in[I_WRG];
            WG[i] = (bf16)f2bf(W[(nb * 64 + ii) * 64 + j]);
        }
    }
}

constexpr int S_XS = 0, S_XC = 34816, S_XCB = S_XC + 32768, S_BT = S_XCB + 18432, S_AGS = S_BT + 32768;
static_assert(S_AGS + 4096 <= 131072, "scan LDS map");
__device__ __forceinline__ void scan_local_unit(const Params& p, Frame& F, int sbi  , int nb, int sg) {
    unsigned char* ws = p.ws;
    const bool samp = sbi >= NB; const int b = samp ? sbi - NB : sbi;
    const int T = samp ? DT : 128, t0 = samp ? 0 : sg * 128;
    const size_t r0 = samp ? (size_t)MP + b * DT : (size_t)b * SEQ + t0;
    const bf16* XR = (const bf16*)(ws + WS_XR);
    LAS float* xs = (LAS float*)(F.lds + S_XS); LAS float* xc = (LAS float*)(F.lds + S_XC); LAS bf16* xcb = (LAS bf16*)(F.lds + S_XCB);
    LAS float* bt = (LAS float*)(F.lds + S_BT); LAS float* av = xs; LAS f32x2* ags = (LAS f32x2*)(F.lds + S_AGS);
    const int tid = F.tid;
    for (int idx = tid; idx < (T + 3) * 64; idx += 512) {
        const int tt = idx >> 6, c = idx & 63, t = t0 - 3 + tt;
        float v;
        if (t >= 0) v = bf2f(XR[(r0 + tt - 3) * LW + nb * 64 + c]);
        else v = samp ? p.in[I_SC][((size_t)b * 3 + tt) * LW + nb * 64 + c] : 0.f;
        xs[tt * 64 + c] = v;
    }
    __syncthreads();
    {
        const int c = tid & 63; const int ch = nb * 64 + c;
        const float cb = p.in[I_CB][ch], w0 = p.in[I_CW][ch], w1 = p.in[I_CW][LW + ch], w2 = p.in[I_CW][2 * LW + ch], w3 = p.in[I_CW][3 * LW + ch];
        for (int t = tid >> 6; t < T; t += 8) {
            const float v = cb + w0 * xs[t * 64 + c] + w1 * xs[(t + 1) * 64 + c] + w2 * xs[(t + 2) * 64 + c] + w3 * xs[(t + 3) * 64 + c];
            xc[t * 64 + c] = v; xcb[t * 72 + c] = (bf16)f2bf(v);
        }
    }
    __syncthreads();
    if (F.wave * 16 < T) {
        const int row = F.lane & 15, kq = F.lane >> 4;
        const bf16x8 A0 = *(const LAS bf16x8*)(xcb + (F.wave * 16 + row) * 72 + 8 * kq), A1 = *(const LAS bf16x8*)(xcb + (F.wave * 16 + row) * 72 + 32 + 8 * kq);
        const bf16* WG = (const bf16*)(ws + WS_WG); const float* sp = (const float*)(ws + WS_SP);
#pragma unroll
        for (int jt = 0; jt < 4; ++jt) {
            const int j = 16 * jt + row, ch = nb * 64 + j;
            const bf16* wr_ = WG + ((size_t)(0 * 8 + nb) * 64 + j) * 64; const bf16* wi_ = WG + ((size_t)(1 * 8 + nb) * 64 + j) * 64;
            f32x4 ar = {0.f, 0.f, 0.f, 0.f}, ai = {0.f, 0.f, 0.f, 0.f};
            ar = __builtin_amdgcn_mfma_f32_16x16x32_bf16(A0, *(const bf16x8*)(wr_ + 8 * kq), ar, 0, 0, 0);
            ar = __builtin_amdgcn_mfma_f32_16x16x32_bf16(A1, *(const bf16x8*)(wr_ + 32 + 8 * kq), ar, 0, 0, 0);
            ai = __builtin_amdgcn_mfma_f32_16x16x32_bf16(A0, *(const bf16x8*)(wi_ + 8 * kq), ai, 0, 0, 0);
            ai = __builtin_amdgcn_mfma_f32_16x16x32_bf16(A1, *(const bf16x8*)(wi_ + 32 + 8 * kq), ai, 0, 0, 0);
            const float brg = p.in[I_BRG][ch], big = p.in[I_BIG][ch], spv = sp[ch];
#pragma unroll
            for (int ii = 0; ii < 4; ++ii) {
                const int t = F.wave * 16 + 4 * kq + ii;
                const float rg = sigmoidf_(ar[ii] + brg), ig = sigmoidf_(ai[ii] + big);
                const float la = -8.0f * rg * spv;
                const float a = __expf(la);
                const float mult = (!samp && (t0 + t) == 0) ? 1.0f : sqrtf(-expm1f(2.0f * la));
                av[t * 64 + j] = a; bt[t * 64 + j] = mult * ig * xc[t * 64 + j];
            }
        }
    }
    __syncthreads();
    const int c = tid & 63, sub = tid >> 6; const bool act = sub * 16 < T;
    if (act) {
        float Ac = 1.f, Bc = 0.f;
        for (int t = sub * 16; t < sub * 16 + 16; ++t) { const float a = av[t * 64 + c], bb = bt[t * 64 + c]; Bc = a * Bc + bb; Ac = Ac * a; av[t * 64 + c] = Ac; bt[t * 64 + c] = Bc; }
        ags[sub * 64 + c] = (f32x2){Ac, Bc};
    }
    __syncthreads();
    if (act) {
        float Ap = 1.f, Bp = 0.f;
        for (int s2 = 0; s2 < sub; ++s2) { const f32x2 g = ags[s2 * 64 + c]; Bp = g.x * Bp + g.y; Ap = Ap * g.x; }
        float* ACUM = (float*)(ws + WS_ACUM); float* BCUM = (float*)(ws + WS_BCUM);
        float ac = 0.f, bc = 0.f;
        for (int t = sub * 16; t < sub * 16 + 16; ++t) {
            const float al = av[t * 64 + c]; ac = al * Ap; bc = al * Bp + bt[t * 64 + c];
            ACUM[(r0 + t) * LW + nb * 64 + c] = ac; BCUM[(r0 + t) * LW + nb * 64 + c] = bc;
        }
        if (sub * 16 + 16 == T) ((f32x2*)(ws + WS_AGG))[((size_t)sbi * 64 + sg) * LW + nb * 64 + c] = (f32x2){ac, bc};
    }
    __syncthreads();
}

__device__ __forceinline__ void scan_apply_unit(const Params& p, Frame& F, int sbi, int sg) {
    unsigned char* ws = p.ws;
    const bool samp = sbi >= NB; const int b = samp ? sbi - NB : sbi;
    const int T = samp ? DT : 128;
    const size_t r0 = samp ? (size_t)MP + b * DT : (size_t)b * SEQ + sg * 128;
    const int ch = F.tid;
    float h = samp ? p.in[I_SH][b * LW + ch] : 0.f;
    const f32x2* AGG = (const f32x2*)(ws + WS_AGG) + (size_t)sbi * 64 * LW + ch;
    for (int s2 = 0; s2 < sg; ++s2) { const f32x2 g = AGG[(size_t)s2 * LW]; h = g.x * h + g.y; }
    const float* ACUM = (const float*)(ws + WS_ACUM) + r0 * LW + ch; const float* BCUM = (const float*)(ws + WS_BCUM) + r0 * LW + ch;
    const bf16* GG = (const bf16*)(ws + WS_GG) + r0 * LW + ch; bf16* YC = (bf16*)(ws + WS_YC) + r0 * D + ch;
    float ht = 0.f;
#pragma unroll 8
    for (int t = 0; t < T; ++t) {
        ht = ACUM[(size_t)t * LW] * h + BCUM[(size_t)t * LW];
        YC[(size_t)t * D] = (bf16)f2bf(ht * bf2f(GG[(size_t)t * LW]));
    }
    if (samp) p.out[O_HS + b * LW + ch] = ht;
    else if (sg == 63) p.out[O_HP + b * LW + ch] = ht;
}

constexpr int A_CAND = 0, A_CNT = 131072, A_THR = 131072 + 128, CAP = 1024;
__device__ __forceinline__ unsigned pack_key(float s, int key) {
    unsigned u = __float_as_uint(s);
    u = (u & 0x80000000u) ? ~u : (u | 0x80000000u);
    return (u & 0xFFFFE000u) | (unsigned)(8191 - key);
}
__device__ __forceinline__ unsigned select256(LAS unsigned* cq, int n, int lane) {
    unsigned e[16];
#pragma unroll
    for (int i = 0; i < 16; ++i) { const int idx = i * 64 + lane; e[i] = idx < n ? cq[idx] : 0u; }
    unsigned T = 0u;
    for (int bit = 31; bit >= 0; --bit) {
        const unsigned c = T | (1u << bit); int cnt = 0;
#pragma unroll
        for (int i = 0; i < 16; ++i) cnt += __popcll(__ballot(e[i] >= c));
        if (cnt >= 256) T = c;
    }
    asm volatile("s_waitcnt lgkmcnt(0)" ::: "memory");
    int base = 0;
#pragma unroll
    for (int i = 0; i < 16; ++i) {
        const bool keep = e[i] >= T; const unsigned long long mk = __ballot(keep);
        const int pos = base + (int)__builtin_amdgcn_mbcnt_hi((unsigned)(mk >> 32), __builtin_amdgcn_mbcnt_lo((unsigned)mk, 0u));
        if (keep) cq[pos] = e[i];
        base += __popcll(mk);
    }
    return T;
}

__device__ __forceinline__ void attn_unit(const Params& p, Frame& F, size_t q0row, int nq, int L, const bf16* KI, const bf16* Kb, const bf16* Vb) {
    unsigned char* ws = p.ws;
    const bf16* QI = (const bf16*)(ws + WS_QI); const bf16* Qb = (const bf16*)(ws + WS_Q); const float* WI = (const float*)(ws + WS_WI); bf16* YC = (bf16*)(ws + WS_YC);
    LAS unsigned* cand = (LAS unsigned*)(F.lds + A_CAND); LAS unsigned* cntp = (LAS unsigned*)(F.lds + A_CNT); LAS unsigned* thrp = (LAS unsigned*)(F.lds + A_THR);
    const int lane = F.lane, wid = F.wave, qc = lane & 15, kq = lane >> 4;
    if (F.tid < 32) { cntp[F.tid] = 0u; thrp[F.tid] = 0u; }
    const int nsub = nq >> 4, nslots = (nsub == 2) ? 4 : 8, slot = (nsub == 2) ? (wid & 3) : wid, sub = (nsub == 2) ? (wid >> 2) : 0;
    const int ql = sub * 16 + qc;
    bf16x8 Bq[8][2]; float sinf_[8];
    {
        const size_t qrow = q0row + ql;
#pragma unroll
        for (int h = 0; h < 8; ++h) {
            const float w = WI[qrow * 8 + h];
            sinf_[h] = (w < 0.f) ? -INFINITY : INFINITY;
#pragma unroll
            for (int s = 0; s < 2; ++s) {
                const u32x4 raw = *(const u32x4*)(QI + qrow * 512 + h * 64 + 32 * s + 8 * kq);
                u32x4 o; o.x = pk2(bflo(raw.x) * w, bfhi(raw.x) * w); o.y = pk2(bflo(raw.y) * w, bfhi(raw.y) * w); o.z = pk2(bflo(raw.z) * w, bfhi(raw.z) * w); o.w = pk2(bflo(raw.w) * w, bfhi(raw.w) * w);
                Bq[h][s] = __builtin_bit_cast(bf16x8, o);
            }
        }
    }
    __syncthreads();
    const int ngroups = (L + 63) >> 6, nrounds = (ngroups + nslots - 1) / nslots;
    const unsigned limit = (unsigned)(CAP - nslots * 64);
    for (int it = 0; it < nrounds; ++it) {
        const int gi = it * nslots + slot;
        if (gi < ngroups) {
            unsigned pk[16];
#pragma unroll
            for (int tl = 0; tl < 4; ++tl) {
                const int keybase = gi * 64 + tl * 16; int arow = keybase + qc; arow = arow < L ? arow : L - 1;
                const bf16x8 A0 = *(const bf16x8*)(KI + (size_t)arow * 64 + 8 * kq), A1 = *(const bf16x8*)(KI + (size_t)arow * 64 + 32 + 8 * kq);
                f32x4 sc = {0.f, 0.f, 0.f, 0.f};
#pragma unroll
                for (int h = 0; h < 8; ++h) {
                    f32x4 acc = {0.f, 0.f, 0.f, 0.f};
                    acc = __builtin_amdgcn_mfma_f32_16x16x32_bf16(A0, Bq[h][0], acc, 0, 0, 0);
                    acc = __builtin_amdgcn_mfma_f32_16x16x32_bf16(A1, Bq[h][1], acc, 0, 0, 0);
#pragma unroll
                    for (int i = 0; i < 4; ++i) sc[i] += __builtin_amdgcn_fmed3f(acc[i], 0.f, sinf_[h]);
                }
#pragma unroll
                for (int i = 0; i < 4; ++i) { const int key = keybase + 4 * kq + i; pk[tl * 4 + i] = key < L ? pack_key(sc[i], key) : 0u; }
            }
            const unsigned thr = thrp[ql];
            int n = 0;
#pragma unroll
            for (int j = 0; j < 16; ++j) n += (pk[j] > thr) ? 1 : 0;
            if (n) {
                unsigned base = __hip_atomic_fetch_add(cntp + ql, (unsigned)n, __ATOMIC_RELAXED, __HIP_MEMORY_SCOPE_WORKGROUP);
                LAS unsigned* cq = cand + ql * CAP;
#pragma unroll
                for (int j = 0; j < 16; ++j) if (pk[j] > thr) cq[base++] = pk[j];
            }
        }
        __syncthreads();
#pragma unroll 1
        for (int i2 = 0; i2 < 4; ++i2) {
            const int qq = wid * 4 + i2;
            if (qq < nq) {
                const unsigned n = (unsigned)__builtin_amdgcn_readfirstlane((int)cntp[qq]);
                if (n > limit) { const unsigned T = select256(cand + qq * CAP, (int)n, lane); if (lane == 0) { cntp[qq] = 256u; thrp[qq] = T; } }
            }
        }
        __syncthreads();
    }
    const int wb = wid * 16384;
    LAS unsigned short* idx16 = (LAS unsigned short*)(F.lds + wb);
    LAS float* linv = (LAS float*)(F.lds + wb + 2048);
    LAS int* nsl = (LAS int*)(F.lds + wb + 2048 + 64);
    LAS float* P = (LAS float*)(F.lds + wb + 4096);
    {
        unsigned ee[4][4]; int ns[4];
#pragma unroll
        for (int i2 = 0; i2 < 4; ++i2) {
            const int qq = wid * 4 + i2; int n = 0;
            if (qq < nq) {
                n = __builtin_amdgcn_readfirstlane((int)cntp[qq]);
                if (n > 256) { select256(cand + qq * CAP, n, lane); n = 256; }
            }
            ns[i2] = n;
        }
        asm volatile("s_waitcnt lgkmcnt(0)" ::: "memory");
#pragma unroll
        for (int i2 = 0; i2 < 4; ++i2)
#pragma unroll
            for (int m2 = 0; m2 < 4; ++m2) { const int k = lane + 64 * m2; ee[i2][m2] = (k < ns[i2]) ? cand[(wid * 4 + i2) * CAP + k] : 8191u; }
        asm volatile("s_waitcnt lgkmcnt(0)" ::: "memory");
#pragma unroll
        for (int i2 = 0; i2 < 4; ++i2) {
#pragma unroll
            for (int m2 = 0; m2 < 4; ++m2) idx16[i2 * 256 + lane + 64 * m2] = (unsigned short)(8191u - (ee[i2][m2] & 8191u));
            if (lane == 0) nsl[i2] = ns[i2];
        }
        asm volatile("s_waitcnt lgkmcnt(0)" ::: "memory");
    }
#pragma unroll 1
    for (int i2 = 0; i2 < 4; ++i2) {
        const int n = __builtin_amdgcn_readfirstlane(nsl[i2]);
        if (n == 0) continue;
        const size_t qrow = q0row + wid * 4 + i2;
        const int h = lane & 15;
        bf16x8 Bh[4];
#pragma unroll
        for (int s = 0; s < 4; ++s) {
            const bool v = (h < 8) && ((h >> 2) == (s >> 1));
            u32x4 raw = {0u, 0u, 0u, 0u};
            if (v) raw = *(const u32x4*)(Qb + qrow * 512 + h * 64 + 32 * (s & 1) + 8 * kq);
            Bh[s] = __builtin_bit_cast(bf16x8, raw);
        }
        float mx = -INFINITY;
#pragma unroll 2
        for (int tl = 0; tl < 16; ++tl) {
            const int idx = idx16[i2 * 256 + tl * 16 + qc];
            const bf16* kr = Kb + (size_t)idx * KVW + 8 * kq;
            f32x4 acc = {0.f, 0.f, 0.f, 0.f};
#pragma unroll
            for (int s = 0; s < 4; ++s) acc = __builtin_amdgcn_mfma_f32_16x16x32_bf16(*(const bf16x8*)(kr + 32 * s), Bh[s], acc, 0, 0, 0);
#pragma unroll
            for (int ii = 0; ii < 4; ++ii) {
                const int key = tl * 16 + 4 * kq + ii; const float sv = key < n ? acc[ii] * 0.125f : -INFINITY;
                mx = fmaxf(mx, sv);
                if (h < 8) P[key * 8 + h] = sv;
            }
        }
        mx = fmaxf(mx, __shfl_xor(mx, 16)); mx = fmaxf(mx, __shfl_xor(mx, 32));
        asm volatile("s_waitcnt lgkmcnt(0)" ::: "memory");
        float sum = 0.f;
        if (h < 8) {
#pragma unroll 4
            for (int tl = 0; tl < 16; ++tl)
#pragma unroll
                for (int ii = 0; ii < 4; ++ii) { const int key = tl * 16 + 4 * kq + ii; const float pv = __expf(P[key * 8 + h] - mx); P[key * 8 + h] = pv; sum += pv; }
        }
        sum += __shfl_xor(sum, 16); sum += __shfl_xor(sum, 32);
        if (h < 8 && kq == 0) linv[h] = 1.0f / sum;
        asm volatile("s_waitcnt lgkmcnt(0)" ::: "memory");
        const int g = lane >> 5;
        float o[4][2] = {{0.f, 0.f}, {0.f, 0.f}, {0.f, 0.f}, {0.f, 0.f}};
#pragma unroll 4
        for (int k = 0; k < n; ++k) {
            const int idx = idx16[i2 * 256 + k];
            const unsigned vv = *(const unsigned*)(Vb + (size_t)idx * KVW + 2 * lane);
            const f32x4 p4 = *(const LAS f32x4*)(P + k * 8 + 4 * g);
            const float lo = bflo(vv), hi = bfhi(vv);
#pragma unroll
            for (int hh = 0; hh < 4; ++hh) { o[hh][0] += p4[hh] * lo; o[hh][1] += p4[hh] * hi; }
        }
#pragma unroll
        for (int hh = 0; hh < 4; ++hh) {
            const int head = 4 * g + hh; const float rl = linv[head];
            *(unsigned*)(YC + qrow * D + 512 + head * 64 + 2 * (lane & 31)) = pk2(o[hh][0] * rl, o[hh][1] * rl);
        }
        asm volatile("s_waitcnt lgkmcnt(0)" ::: "memory");
    }
    __syncthreads();
}

__device__ __forceinline__ void phase3(const Params& p, Frame& F) {
    unsigned char* ws = p.ws;
    for (int u = F.bid; u < 256 + DB; u += F.G) { if (u < 256) scan_apply_unit(p, F, u >> 6, u & 63); else scan_apply_unit(p, F, NB + (u - 256), 0); }
    for (int k = 0;; ++k) {
        const int u = k * F.G + ((k & 1) ? F.G - 1 - F.bid : F.bid);
        if (k * F.G >= 1024) break;
        if (u >= 1024) continue;
        const int chunk = 127 - (u >> 3), b = (u & 7) >> 1, half = u & 1;
        const size_t q0row = (size_t)b * SEQ + chunk * 64 + half * 32;
        attn_unit(p, F, q0row, 32, 64 * (chunk + 1), (const bf16*)(ws + WS_KIB) + (size_t)b * SEQ * 64, (const bf16*)(ws + WS_KB) + (size_t)b * SEQ * KVW, (const bf16*)(ws + WS_VB) + (size_t)b * SEQ * KVW);
    }
    for (int s = F.bid; s < DB; s += F.G)
        attn_unit(p, F, (size_t)MP + s * DT, 16, SKEYS, (const bf16*)(ws + WS_KIS) + (size_t)s * SKEYS * 64, (const bf16*)(ws + WS_KS) + (size_t)s * SKEYS * KVW, (const bf16*)(ws + WS_VS) + (size_t)s * SKEYS * KVW);
}

__global__ void __launch_bounds__(512, 2) fwd_kernel(Params p) {
    extern __shared__ __attribute__((aligned(16))) unsigned char lds_raw[];
    Frame F; F.lds = (LAS unsigned char*)lds_raw; F.tid = threadIdx.x; F.lane = F.tid & 63; F.wave = __builtin_amdgcn_readfirstlane(F.tid >> 6); F.G = gridDim.x; F.bid = blockIdx.x;
    unsigned char* ws = p.ws;
    const int lo = p.ph_lo, hi = p.ph_hi;
#define IN(k) (lo <= (k) && (k) < hi)
#ifndef SKIPMASK
#define SKIPMASK 0
#endif
#define SKIP(k) ((SKIPMASK >> (k)) & 1)
#define SEAM(k) do { if (IN(k) && IN((k) + 1)) { cg::this_grid().sync(); } } while (0)
    if (IN(0) && !SKIP(0)) phase0(p, F);
    SEAM(0);
    if (IN(1) && !SKIP(1)) {
        pg8::Gemm g{(const pg8::bf16_t*)(ws + WS_XB), (const pg8::bf16_t*)(ws + WS_WIN), M, NIN, D};
        pg8::StaticOrder S; S.init(M, NIN, F.G, F.bid);
        EpiInProj E{(const float*)(ws + WS_RSTD), (const float*)(ws + WS_RCOS), (const float*)(ws + WS_RSIN), p.in[I_QN], p.in[I_KN],
                    (bf16*)(ws + WS_XR), (bf16*)(ws + WS_GG), (bf16*)(ws + WS_Q), (bf16*)(ws + WS_QI), (bf16*)(ws + WS_KB), (bf16*)(ws + WS_VB), (bf16*)(ws + WS_KIB),
                    (bf16*)(ws + WS_KS), (bf16*)(ws + WS_VS), (bf16*)(ws + WS_KIS), (float*)(ws + WS_WI), p.out};
        pg8::gemm_phase<EpiInProj, pg8::StaticOrder, true, true>(F.lds, g, S, E);
    }
    SEAM(1);
    if (IN(2) && !SKIP(2)) {
        for (int u = F.bid; u < 2048 + 64; u += F.G) {
            if (u < 2048) scan_local_unit(p, F, u >> 9, u & 7, (u & 511) >> 3);
            else scan_local_unit(p, F, NB + ((u - 2048) >> 3), (u - 2048) & 7, 0);
        }
    }
    SEAM(2);
    if (IN(3) && !SKIP(3)) phase3(p, F);
    SEAM(3);
    if (IN(4) && !SKIP(4)) {
        pg8::Gemm g{(const pg8::bf16_t*)(ws + WS_YC), (const pg8::bf16_t*)(ws + WS_WOUT), M, D, D};
        pg8::StaticOrder S; S.init(M, D, F.G, F.bid);
        EpiOutProj E{p.in[I_XP], p.in[I_XS], p.out, (bf16*)(ws + WS_XB), (float*)(ws + WS_SSQ)};
        pg8::gemm_phase<EpiOutProj, pg8::StaticOrder, true, true>(F.lds, g, S, E);
    }
    SEAM(4);
    if (IN(5) && !SKIP(5)) {
        pg8::Gemm g{(const pg8::bf16_t*)(ws + WS_XB), (const pg8::bf16_t*)(ws + WS_WFI), M, 2 * DFF, D};
        pg8::StaticOrder S; S.init(M, 2 * DFF, F.G, F.bid);
        EpiFfnIn E{(const float*)(ws + WS_SSQ), (bf16*)(ws + WS_H)};
        pg8::gemm_phase<EpiFfnIn, pg8::StaticOrder, true, true>(F.lds, g, S, E);
    }
    SEAM(5);
    if (IN(6) && !SKIP(6)) {
        pg8::Gemm g{(const pg8::bf16_t*)(ws + WS_H), (const pg8::bf16_t*)(ws + WS_WFO), M, D, DFF};
        pg8::StaticOrder S; S.init(M, D, F.G, F.bid);
        EpiFfnOut E{p.out};
        pg8::gemm_phase<EpiFfnOut, pg8::StaticOrder, true, true>(F.lds, g, S, E);
    }
#undef IN
#undef SEAM
}

#ifndef N_LAUNCHES
#define N_LAUNCHES 7
#endif
constexpr int NPHASE = 7;
extern "C" void kernel_launch(void* const* d_in, const int* in_sizes, int n_in, void* d_out, int out_size, void* d_ws, size_t ws_size, hipStream_t stream) {
    static int grid = 0;
    if (grid == 0) {
        if (n_in != 22 || out_size != (int)O_END || ws_size < WS_END) { fprintf(stderr, "kernel_launch: unexpected shapes: n_in %d out %d ws %zu (need %zu)\n", n_in, out_size, ws_size, (size_t)WS_END); grid = -1; return; }
        int dev = 0, cus = 0, per_cu = 0;
        if (hipGetDevice(&dev) != hipSuccess || hipDeviceGetAttribute(&cus, hipDeviceAttributeMultiprocessorCount, dev) != hipSuccess) { grid = -1; return; }
        if (hipFuncSetAttribute((const void*)fwd_kernel, hipFuncAttributeMaxDynamicSharedMemorySize, LDS_BYTES) != hipSuccess) { fprintf(stderr, "kernel_launch: hipFuncSetAttribute failed\n"); grid = -1; return; }
        if (hipOccupancyMaxActiveBlocksPerMultiprocessor(&per_cu, (const void*)fwd_kernel, 512, LDS_BYTES) != hipSuccess || per_cu < 1) { fprintf(stderr, "kernel_launch: occupancy query says %d blocks/CU\n", per_cu); per_cu = 1; }
        (void)hipGetLastError();
        grid = cus;
    }
    if (grid < 0) return;
    Params p{};
    for (int i = 0; i < 22; ++i) p.in[i] = (const float*)d_in[i];
    p.out = (float*)d_out; p.ws = (unsigned char*)d_ws;
    for (int i = 0; i < 32; ++i) p.invf[i] = pow(10000.0, -(double)i / 32.0);
    if (N_LAUNCHES == 1) {
        p.ph_lo = 0; p.ph_hi = NPHASE;
        void* args[] = {&p};
        hipError_t e = hipLaunchCooperativeKernel((const void*)fwd_kernel, dim3(grid), dim3(512), args, LDS_BYTES, stream);
        if (e != hipSuccess) fprintf(stderr, "kernel_launch: cooperative launch failed: %s (grid %d)\n", hipGetErrorString(e), grid);
    } else {
        for (int k = 0; k < NPHASE; ++k) { p.ph_lo = k; p.ph_hi = k + 1; hipLaunchKernelGGL(fwd_kernel, dim3(grid), dim3(512), LDS_BYTES, stream, p); }
    }
}
```

```cpp
#include <hip/hip_runtime.h>
#include <hip/hip_cooperative_groups.h>
#include <cstdio>
#include <cstdint>
#include <cmath>
namespace cg = cooperative_groups;
namespace pg8 {
#define PG8_LAS __attribute__((address_space(3)))
typedef unsigned short bf16_t;
typedef short bf16x8 __attribute__((ext_vector_type(8)));
typedef float f32x4 __attribute__((ext_vector_type(4)));
typedef unsigned u32x4 __attribute__((ext_vector_type(4)));
constexpr int BM = 256, BK = 64, HALF = 128, HTB = HALF * BK * 2  , STAGE_BYTES = 8 * HTB, NXCD = 8, WGM = 8;

__host__ __device__ __forceinline__ int lds_byte(int r, int c) { const int st = (r >> 4) * 2 + (c >> 5), rr = r & 15, cc = c & 31, ob = rr * 64 + cc * 2; return st * 1024 + (ob ^ (((ob >> 9) & 1) << 5)); }
__host__ __device__ __forceinline__ void stage_rc(int b, int& R, int& C) { const int st = b / 1024, sb = b % 1024, swz = sb ^ (((sb >> 9) & 1) << 5); R = (st >> 1) * 16 + swz / 64; C = (st & 1) * 32 + (swz % 64) / 2; }
__host__ __device__ __forceinline__ int perm32(int rho) { const int n = rho >> 4, i = rho & 15; return 8 * (i >> 2) + 4 * n + (i & 3); }

struct Unit { int pm, pn; };
struct Gemm { const bf16_t* A; const bf16_t* Bt; int M, N, K; };

struct StaticOrder {
    int nM, nN, nwg, G, c;
    __host__ __device__ void init(int M, int N, int G_, int c_) { nM = M / BM; nN = N / BM; nwg = nM * nN; G = G_; c = c_; }
    __host__ __device__ bool next(int i, Unit& u) const {
        const long L = (long)i * G + c; if (L >= nwg) return false;
        int wgid = (int)L; { const int q = nwg / NXCD, r = nwg % NXCD, xcd = wgid % NXCD, off = wgid / NXCD; wgid = (xcd < r ? xcd * (q + 1) : r * (q + 1) + (xcd - r) * q) + off; }
        const int nig = WGM * nN, gid = wgid / nig, fm = gid * WGM, gsz = (nM - fm) < WGM ? (nM - fm) : WGM;
        u.pm = fm + ((wgid % nig) % gsz); u.pn = (wgid % nig) / gsz; return true;
    }
    __device__ __forceinline__ void a_ready(const Unit&) const {}
    __device__ __forceinline__ void done(const Unit&) const {}
};
__device__ __forceinline__ unsigned cvt_pk_bf16(float lo, float hi) { unsigned r; asm volatile("v_cvt_pk_bf16_f32 %0, %1, %2" : "=v"(r) : "v"(lo), "v"(hi)); return r; }
template <class Epi, class Sched, bool ALIGN_EPI = false, bool SP2 = false>
__device__ __forceinline__ void gemm_phase(PG8_LAS unsigned char* lds, const Gemm g, const Sched& S, const Epi& E) {
    const int tid = threadIdx.x, wid = __builtin_amdgcn_readfirstlane(tid >> 6), lane = tid & 63, wr = wid >> 2, wc = wid & 3, fr = lane & 15, fq = lane >> 4;
    const int K = g.K, nt = K / BK;
    unsigned voffA[2], voffB[2];
#pragma unroll
    for (int i = 0; i < 2; ++i) { int R, C; stage_rc(tid * 16 + i * 8192, R, C); const int Rb = Epi::PERM ? ((R & ~31) + perm32(R & 31)) : R;
        voffA[i] = (unsigned)(R * K + C) * 2u; voffB[i] = (unsigned)(Rb * K + C) * 2u; }
    const size_t kstep = (size_t)(BK * 2);
    const size_t hstep = (size_t)HALF * K * 2;
    const size_t tstep = 2 * hstep;
    const unsigned ldsw = (unsigned)wid * 1024u;
    const int aoff = lds_byte(wr * 64 + fr, fq * 8), boff = lds_byte(wc * 32 + fr, fq * 8);
#define PG8_SA(b, h) (((b) * 2 + (h)) * HTB)
#define PG8_SB(b, h) ((4 + (b) * 2 + (h)) * HTB)
#define PG8_STAGE(bufoff, gbase, voff) do { _Pragma("unroll") for (int _i = 0; _i < 2; ++_i) \
        __builtin_amdgcn_global_load_lds((const unsigned*)((const char*)(gbase) + (voff)[_i]), (PG8_LAS unsigned*)(lds + (bufoff) + ldsw + _i * 8192), 16, 0, 0); } while (0)
#define PG8_LDA(dst, b, h) do { _Pragma("unroll") for (int m = 0; m < 4; ++m) _Pragma("unroll") for (int k = 0; k < 2; ++k) dst[m][k] = *(const PG8_LAS bf16x8*)(lds + PG8_SA(b, h) + aoff + m * 2048 + k * 1024); } while (0)
#define PG8_LDB(dst, b, h) do { _Pragma("unroll") for (int n = 0; n < 2; ++n) _Pragma("unroll") for (int k = 0; k < 2; ++k) dst[n][k] = *(const PG8_LAS bf16x8*)(lds + PG8_SB(b, h) + boff + n * 2048 + k * 1024); } while (0)
#define PG8_MMA(ai, bj, At, Bt) do { __builtin_amdgcn_s_setprio(1); _Pragma("unroll") for (int m = 0; m < 4; ++m) _Pragma("unroll") for (int n = 0; n < 2; ++n) _Pragma("unroll") for (int k = 0; k < 2; ++k) \
        acc[ai][bj][m][n] = __builtin_amdgcn_mfma_f32_16x16x32_bf16(Bt[n][k], At[m][k], acc[ai][bj][m][n], 0, 0, 0); __builtin_amdgcn_s_setprio(0); } while (0)
#define PG8_WAIT_V(n) asm volatile("s_waitcnt vmcnt(" #n ")" ::: "memory")
#define PG8_WAIT_L(n) asm volatile("s_waitcnt lgkmcnt(" #n ")" ::: "memory")
#define PG8_BAR __builtin_amdgcn_s_barrier()
#define PG8_SCHED __builtin_amdgcn_sched_barrier(0)
    Unit cur, nxt; int ui = 0;
    if (!S.next(0, cur)) return;
    f32x4 acc[2][2][4][2];
#pragma unroll
    for (int a = 0; a < 2; ++a)
#pragma unroll
        for (int b = 0; b < 2; ++b)
#pragma unroll
            for (int m = 0; m < 4; ++m)
#pragma unroll
                for (int n = 0; n < 2; ++n) acc[a][b][m][n] = (f32x4){0.f, 0.f, 0.f, 0.f};
    bf16x8 At[4][2], B0[2][2], B1[2][2];
    const char* cA = (const char*)g.A + (size_t)cur.pm * tstep; const char* cB = (const char*)g.Bt + (size_t)cur.pn * tstep;
    S.a_ready(cur);
    if constexpr (SP2) {
        PG8_STAGE(PG8_SB(0, 0), cB, voffB); PG8_STAGE(PG8_SB(0, 1), cB + hstep, voffB); PG8_STAGE(PG8_SA(0, 0), cA, voffA); PG8_STAGE(PG8_SA(0, 1), cA + hstep, voffA);
        if (wr == 1) PG8_BAR;
        PG8_WAIT_V(2); PG8_BAR;
        PG8_STAGE(PG8_SB(1, 0), cB + kstep, voffB); PG8_STAGE(PG8_SA(1, 0), cA + kstep, voffA); PG8_STAGE(PG8_SB(1, 1), cB + hstep + kstep, voffB);
        PG8_WAIT_V(6); PG8_BAR;
    } else {
        PG8_STAGE(PG8_SB(0, 0), cB, voffB); PG8_STAGE(PG8_SA(0, 0), cA, voffA); PG8_STAGE(PG8_SB(0, 1), cB + hstep, voffB); PG8_STAGE(PG8_SA(0, 1), cA + hstep, voffA);
        if (wr == 1) PG8_BAR;
        PG8_WAIT_V(4); PG8_BAR;
        PG8_STAGE(PG8_SB(1, 0), cB + kstep, voffB); PG8_STAGE(PG8_SA(1, 0), cA + kstep, voffA); PG8_STAGE(PG8_SB(1, 1), cB + hstep + kstep, voffB);
        PG8_WAIT_V(6); PG8_BAR;
    }
    for (;;) {
        const bool has_next = S.next(ui + 1, nxt);
        const char* nA = has_next ? (const char*)g.A + (size_t)nxt.pm * tstep : cA; const char* nB = has_next ? (const char*)g.Bt + (size_t)nxt.pn * tstep : cB;
        for (int t = 0; t < nt; t += 2) {
            const bool last = (t == nt - 2);
            const char* a1 = cA + (size_t)(t + 1) * kstep;
            const char* a2 = last ? nA : cA + (size_t)(t + 2) * kstep; const char* b2 = last ? nB : cB + (size_t)(t + 2) * kstep;
            const char* a3 = a2 + kstep; const char* b3 = b2 + kstep;
            if (last && has_next) S.a_ready(nxt);
            if constexpr (SP2) {
            PG8_LDB(B0, 0, 0); PG8_LDB(B1, 0, 1); PG8_SCHED; PG8_LDA(At, 0, 0); PG8_STAGE(PG8_SA(1, 1), a1 + hstep, voffA);
            PG8_WAIT_V(8); PG8_WAIT_L(0); PG8_BAR; PG8_MMA(0, 0, At, B0); PG8_MMA(0, 1, At, B1); PG8_BAR; PG8_SCHED;
            PG8_LDA(At, 0, 1); PG8_STAGE(PG8_SB(0, 0), b2, voffB); PG8_STAGE(PG8_SB(0, 1), b2 + hstep, voffB); PG8_STAGE(PG8_SA(0, 0), a2, voffA);
            PG8_WAIT_V(8); PG8_WAIT_L(0); PG8_BAR; PG8_MMA(1, 0, At, B0); PG8_MMA(1, 1, At, B1); PG8_BAR; PG8_SCHED;
            PG8_LDB(B0, 1, 0); PG8_LDB(B1, 1, 1); PG8_SCHED; PG8_LDA(At, 1, 0); PG8_STAGE(PG8_SA(0, 1), a2 + hstep, voffA);
            PG8_WAIT_V(8); PG8_WAIT_L(0); PG8_BAR; PG8_MMA(0, 0, At, B0); PG8_MMA(0, 1, At, B1); PG8_BAR; PG8_SCHED;
            PG8_LDA(At, 1, 1); PG8_STAGE(PG8_SB(1, 0), b3, voffB); PG8_STAGE(PG8_SB(1, 1), b3 + hstep, voffB); PG8_STAGE(PG8_SA(1, 0), a3, voffA);
            PG8_WAIT_V(8); PG8_WAIT_L(0); PG8_BAR; PG8_MMA(1, 0, At, B0); PG8_MMA(1, 1, At, B1); PG8_BAR; PG8_SCHED;
            } else {
            PG8_LDB(B0, 0, 0); PG8_SCHED; PG8_LDA(At, 0, 0); PG8_STAGE(PG8_SA(1, 1), a1 + hstep, voffA);
            PG8_WAIT_L(8); PG8_BAR; PG8_WAIT_L(0); PG8_MMA(0, 0, At, B0); PG8_BAR; PG8_SCHED;
            PG8_LDB(B1, 0, 1); PG8_STAGE(PG8_SB(0, 0), b2, voffB);
            PG8_BAR; PG8_WAIT_L(0); PG8_MMA(0, 1, At, B1); PG8_BAR;
            PG8_LDA(At, 0, 1); PG8_STAGE(PG8_SA(0, 0), a2, voffA);
            PG8_BAR; PG8_WAIT_L(0); PG8_MMA(1, 0, At, B0); PG8_BAR; PG8_SCHED;
            PG8_STAGE(PG8_SB(0, 1), b2 + hstep, voffB);
            PG8_WAIT_V(6); PG8_BAR; PG8_MMA(1, 1, At, B1); PG8_BAR;
            PG8_LDB(B0, 1, 0); PG8_SCHED; PG8_LDA(At, 1, 0); PG8_STAGE(PG8_SA(0, 1), a2 + hstep, voffA);
            PG8_WAIT_L(8); PG8_BAR; PG8_WAIT_L(0); PG8_MMA(0, 0, At, B0); PG8_BAR; PG8_SCHED;
            PG8_LDB(B1, 1, 1); PG8_STAGE(PG8_SB(1, 0), b3, voffB);
            PG8_BAR; PG8_WAIT_L(0); PG8_MMA(0, 1, At, B1); PG8_BAR;
            PG8_LDA(At, 1, 1); PG8_STAGE(PG8_SA(1, 0), a3, voffA);
            PG8_BAR; PG8_WAIT_L(0); PG8_MMA(1, 0, At, B0); PG8_BAR; PG8_SCHED;
            PG8_STAGE(PG8_SB(1, 1), b3 + hstep, voffB);
            PG8_WAIT_V(6); PG8_BAR; PG8_MMA(1, 1, At, B1); PG8_BAR;
            }
        }
        if constexpr (ALIGN_EPI) { if (wr == 0) PG8_BAR; }
        if constexpr (!Epi::AFTER_DRAIN) { E(acc, cur, wr, wc, fr, fq); S.done(cur); }
        if (!has_next) break;
#pragma unroll
        for (int a = 0; a < 2; ++a)
#pragma unroll
            for (int b = 0; b < 2; ++b)
#pragma unroll
                for (int m = 0; m < 4; ++m)
#pragma unroll
                    for (int n = 0; n < 2; ++n) acc[a][b][m][n] = (f32x4){0.f, 0.f, 0.f, 0.f};
        cur = nxt; cA = nA; cB = nB; ++ui;
        if constexpr (ALIGN_EPI) { if (wr == 1) PG8_BAR; }
    }
    PG8_WAIT_V(0);
    if constexpr (!ALIGN_EPI) { if (wr == 0) PG8_BAR; }
    PG8_BAR;
    if constexpr (Epi::AFTER_DRAIN) { E.fused(acc, cur, wr, wc, fr, fq, lds, wid, lane); S.done(cur); }
#undef PG8_SA
#undef PG8_SB
#undef PG8_STAGE
#undef PG8_LDA
#undef PG8_LDB
#undef PG8_MMA
#undef PG8_WAIT_V
#undef PG8_WAIT_L
#undef PG8_BAR
#undef PG8_SCHED
}
}

constexpr int D = 1024, NB = 4, SEQ = 8192, DB = 8, DT = 16, PAST = 4096;
constexpr int MP = NB * SEQ;
constexpr int MS = DB * DT;
constexpr int MR = MP + MS;
constexpr int M = 33024;
constexpr int LW = 512, NLB = 8, LBW = 64;
constexpr int KVW = 128;
constexpr int DIN = 2376, NIN = 2560;
constexpr int DFF = 2816;
constexpr int SKEYS = PAST + DT;
constexpr float EPS = 1e-6f;
constexpr float WI_SCALE = 0.044194173824159216f;

constexpr size_t O_YP = 0;
constexpr size_t O_YS = O_YP + (size_t)MP * D;
constexpr size_t O_KP = O_YS + (size_t)MS * D;
constexpr size_t O_VP = O_KP + (size_t)MP * KVW;
constexpr size_t O_KIP = O_VP + (size_t)MP * KVW;
constexpr size_t O_HP = O_KIP + (size_t)MP * 64;
constexpr size_t O_CP = O_HP + (size_t)NB * LW;
constexpr size_t O_KS = O_CP + (size_t)NB * 3 * LW;
constexpr size_t O_VS = O_KS + (size_t)MS * KVW;
constexpr size_t O_KIS = O_VS + (size_t)MS * KVW;
constexpr size_t O_HS = O_KIS + (size_t)MS * 64;
constexpr size_t O_CS = O_HS + (size_t)DB * LW;
constexpr size_t O_END = O_CS + (size_t)DB * 3 * LW;
static_assert(O_END == 44236800, "output size");

constexpr size_t al256(size_t x) { return (x + 255) & ~(size_t)255; }
constexpr size_t WS_CTL = 0, CTL_BYTES = 1u << 20;
constexpr size_t WS_WIN = WS_CTL + CTL_BYTES;
constexpr size_t WS_WOUT = WS_WIN + al256((size_t)NIN * D * 2);
constexpr size_t WS_WFI = WS_WOUT + al256((size_t)D * D * 2);
constexpr size_t WS_WFO = WS_WFI + al256((size_t)2 * DFF * D * 2);
constexpr size_t WS_WG = WS_WFO + al256((size_t)D * DFF * 2);
constexpr size_t WS_RCOS = WS_WG + al256((size_t)2 * 8 * 64 * 64 * 2);
constexpr size_t WS_RSIN = WS_RCOS + al256((size_t)8192 * 32 * 4);
constexpr size_t WS_SP = WS_RSIN + al256((size_t)8192 * 32 * 4);
constexpr size_t WS_RSTD = WS_SP + al256(512 * 4);
constexpr size_t WS_SSQ = WS_RSTD + al256((size_t)M * 4);
constexpr size_t WS_WI = WS_SSQ + al256((size_t)M * 4);
constexpr size_t WS_AGG = WS_WI + al256((size_t)M * 8 * 4);
constexpr size_t WS_XB = WS_AGG + al256((size_t)12 * 64 * 512 * 8);
constexpr size_t WS_YC = WS_XB + al256((size_t)M * D * 2);
constexpr size_t WS_KB = WS_YC + al256((size_t)M * D * 2);
constexpr size_t WS_VB = WS_KB + al256((size_t)MP * KVW * 2);
constexpr size_t WS_KIB = WS_VB + al256((size_t)MP * KVW * 2);
constexpr size_t WS_KS = WS_KIB + al256((size_t)MP * 64 * 2);
constexpr size_t WS_VS = WS_KS + al256((size_t)DB * SKEYS * KVW * 2);
constexpr size_t WS_KIS = WS_VS + al256((size_t)DB * SKEYS * KVW * 2);
constexpr size_t WS_R1 = WS_KIS + al256((size_t)DB * SKEYS * 64 * 2);
constexpr size_t WS_XR = WS_R1;
constexpr size_t WS_GG = WS_XR + al256((size_t)M * LW * 2);
constexpr size_t WS_Q = WS_GG + al256((size_t)M * LW * 2);
constexpr size_t WS_QI = WS_Q + al256((size_t)M * LW * 2);
constexpr size_t WS_ACUM = WS_QI + al256((size_t)M * LW * 2);
constexpr size_t WS_BCUM = WS_ACUM + al256((size_t)M * LW * 4);
constexpr size_t WS_R1_END = WS_BCUM + al256((size_t)M * LW * 4);
constexpr size_t WS_H = WS_R1;
static_assert(WS_H + (size_t)M * DFF * 2 <= WS_R1_END, "H overlay fits");
constexpr size_t WS_END = WS_R1_END;

constexpr int LDS_BYTES = 147456;

#define LAS __attribute__((address_space(3)))
typedef unsigned short bf16;
typedef float f32x4 __attribute__((ext_vector_type(4)));
typedef float f32x2 __attribute__((ext_vector_type(2)));
typedef unsigned u32x4 __attribute__((ext_vector_type(4)));
typedef unsigned u32x2 __attribute__((ext_vector_type(2)));
typedef short bf16x8 __attribute__((ext_vector_type(8)));

__device__ __forceinline__ unsigned f2bf(float f) { unsigned u = __builtin_bit_cast(unsigned, f); return (u + 0x7fffu + ((u >> 16) & 1u)) >> 16; }
__device__ __forceinline__ unsigned pk2(float lo, float hi) { return f2bf(lo) | (f2bf(hi) << 16); }
__device__ __forceinline__ float bf2f(unsigned b) { return __builtin_bit_cast(float, b << 16); }
__device__ __forceinline__ float bflo(unsigned w) { return __builtin_bit_cast(float, w << 16); }
__device__ __forceinline__ float bfhi(unsigned w) { return __builtin_bit_cast(float, w & 0xffff0000u); }
__device__ __forceinline__ void store_bf16x8(bf16* p, f32x4 lo, f32x4 hi) {
    u32x4 w; w.x = pg8::cvt_pk_bf16(lo[0], lo[1]); w.y = pg8::cvt_pk_bf16(lo[2], lo[3]); w.z = pg8::cvt_pk_bf16(hi[0], hi[1]); w.w = pg8::cvt_pk_bf16(hi[2], hi[3]);
    *(u32x4*)p = w;
}
__device__ __forceinline__ float gelu_tanh(float x) {
    const float u = 0.7978845608028654f * (x + 0.044715f * x * x * x);
    const float e = __expf(2.0f * u);
    const float th = 1.0f - 2.0f / (e + 1.0f);
    return 0.5f * x * (1.0f + th);
}
__device__ __forceinline__ float sigmoidf_(float x) { return 1.0f / (1.0f + __expf(-x)); }

struct EpiInProj {
    static constexpr bool PERM = false, AFTER_DRAIN = false;
    const float* rstd; const float* rcos; const float* rsin; const float* gq; const float* gk;
    bf16* XR; bf16* GG; bf16* Q; bf16* QI; bf16* KB; bf16* VB; bf16* KIB; bf16* KS; bf16* VS; bf16* KIS; float* WI; float* out;

    template <bool NORM> __device__ __forceinline__ void head_rope(f32x4 (&v)[2][2], const float* g, int pos, int fq) const {
        if (NORM) {
            float ss = 0.f;
#pragma unroll
            for (int bj = 0; bj < 2; ++bj)
#pragma unroll
                for (int n = 0; n < 2; ++n) ss += (v[bj][n][0] * v[bj][n][0] + v[bj][n][1] * v[bj][n][1]) + (v[bj][n][2] * v[bj][n][2] + v[bj][n][3] * v[bj][n][3]);
            ss += __shfl_xor(ss, 16); ss += __shfl_xor(ss, 32);
            const float inv = rsqrtf(ss * (1.0f / 64.0f) + EPS);
#pragma unroll
            for (int bj = 0; bj < 2; ++bj)
#pragma unroll
                for (int n = 0; n < 2; ++n) { const f32x4 g4 = *(const f32x4*)(g + 32 * bj + 8 * fq + 4 * n); v[bj][n] = v[bj][n] * inv * g4; }
        }
#pragma unroll
        for (int n = 0; n < 2; ++n) {
            const f32x4 c4 = *(const f32x4*)(rcos + pos * 32 + 8 * fq + 4 * n), s4 = *(const f32x4*)(rsin + pos * 32 + 8 * fq + 4 * n);
            const f32x4 x1 = v[0][n], x2 = v[1][n];
            v[0][n] = x1 * c4 - x2 * s4; v[1][n] = x2 * c4 + x1 * s4;
        }
    }
    __device__ __forceinline__ void operator()(const f32x4 (&acc)[2][2][4][2], const pg8::Unit& u, int wr, int wc, int fr, int fq) const {
        const int pn = u.pn;
#pragma unroll
        for (int ai = 0; ai < 2; ++ai) {
            const int rbase = u.pm * 256 + ai * 128;
            if (rbase >= MR) continue;
            const bool samp = rbase >= MP;
#pragma unroll
            for (int m = 0; m < 4; ++m) {
                const int r = rbase + wr * 64 + m * 16 + fr;
                int sb, t, pos;
                if (!samp) { sb = r >> 13; t = r & 8191; pos = t; } else { const int rs = r - MP; sb = rs >> 4; t = rs & 15; pos = PAST + t; }
                const float rsd = rstd[r];
                f32x4 v[2][2];
#pragma unroll
                for (int bj = 0; bj < 2; ++bj)
#pragma unroll
                    for (int n = 0; n < 2; ++n) v[bj][n] = acc[ai][bj][m][n] * rsd;
                if (pn < 2) {
#pragma unroll
                    for (int bj = 0; bj < 2; ++bj) {
                        const int c = 256 * pn + 64 * wc + 32 * bj + 8 * fq;
                        store_bf16x8(XR + (size_t)r * LW + c, v[bj][0], v[bj][1]);
                        const int tl = samp ? DT - 3 : SEQ - 3;
                        if (t >= tl) {
                            float* o = samp ? out + O_CS + ((size_t)(sb * 3 + (t - tl))) * LW + c : out + O_CP + ((size_t)(sb * 3 + (t - tl))) * LW + c;
                            *(f32x4*)o = v[bj][0]; *(f32x4*)(o + 4) = v[bj][1];
                        }
                    }
                } else if (pn < 4) {
#pragma unroll
                    for (int bj = 0; bj < 2; ++bj) {
                        const int c = 256 * (pn - 2) + 64 * wc + 32 * bj + 8 * fq;
                        f32x4 a = v[bj][0], b = v[bj][1];
#pragma unroll
                        for (int j = 0; j < 4; ++j) { a[j] = gelu_tanh(a[j]); b[j] = gelu_tanh(b[j]); }
                        store_bf16x8(GG + (size_t)r * LW + c, a, b);
                    }
                } else if (pn < 6) {
                    head_rope<true>(v, gq, pos, fq);
                    const int head = 4 * (pn - 4) + wc;
#pragma unroll
                    for (int bj = 0; bj < 2; ++bj) store_bf16x8(Q + (size_t)r * 512 + head * 64 + 32 * bj + 8 * fq, v[bj][0], v[bj][1]);
                } else if (pn == 6) {
                    if (wc < 2) head_rope<true>(v, gk, pos, fq);
                    const int hh = wc & 1;
                    float* of; bf16* ob;
                    if (wc < 2) { of = samp ? out + O_KS + (size_t)(r - MP) * KVW : out + O_KP + (size_t)r * KVW; ob = samp ? KS + ((size_t)sb * SKEYS + PAST + t) * KVW : KB + (size_t)r * KVW; }
                    else        { of = samp ? out + O_VS + (size_t)(r - MP) * KVW : out + O_VP + (size_t)r * KVW; ob = samp ? VS + ((size_t)sb * SKEYS + PAST + t) * KVW : VB + (size_t)r * KVW; }
#pragma unroll
                    for (int bj = 0; bj < 2; ++bj) {
                        const int c = hh * 64 + 32 * bj + 8 * fq;
                        *(f32x4*)(of + c) = v[bj][0]; *(f32x4*)(of + c + 4) = v[bj][1];
                        store_bf16x8(ob + c, v[bj][0], v[bj][1]);
                    }
                } else if (pn < 9) {
                    head_rope<false>(v, nullptr, pos, fq);
                    const int head = 4 * (pn - 7) + wc;
#pragma unroll
                    for (int bj = 0; bj < 2; ++bj) store_bf16x8(QI + (size_t)r * 512 + head * 64 + 32 * bj + 8 * fq, v[bj][0], v[bj][1]);
                } else {
                    if (wc == 0) {
                        head_rope<false>(v, nullptr, pos, fq);
                        float* of = samp ? out + O_KIS + (size_t)(r - MP) * 64 : out + O_KIP + (size_t)r * 64;
                        bf16* ob = samp ? KIS + ((size_t)sb * SKEYS + PAST + t) * 64 : KIB + (size_t)r * 64;
#pragma unroll
                        for (int bj = 0; bj < 2; ++bj) {
                            const int c = 32 * bj + 8 * fq;
                            *(f32x4*)(of + c) = v[bj][0]; *(f32x4*)(of + c + 4) = v[bj][1];
                            store_bf16x8(ob + c, v[bj][0], v[bj][1]);
                        }
                    } else if (wc == 1) {
                        if (fq == 0) { *(f32x4*)(WI + (size_t)r * 8) = v[0][0] * WI_SCALE; *(f32x4*)(WI + (size_t)r * 8 + 4) = v[0][1] * WI_SCALE; }
                    }
                }
            }
        }
    }
};

struct EpiOutProj {
    static constexpr bool PERM = false, AFTER_DRAIN = false;
    const float* xp; const float* xs; float* out; bf16* XB2; float* ssq;
    __device__ __forceinline__ void operator()(const f32x4 (&acc)[2][2][4][2], const pg8::Unit& u, int wr, int wc, int fr, int fq) const {
        const int col0 = u.pn * 256 + wc * 32 + 4 * fq;
#pragma unroll
        for (int ai = 0; ai < 2; ++ai) {
            const int rbase = u.pm * 256 + ai * 128;
            if (rbase >= MR) continue;
            const bool samp = rbase >= MP;
#pragma unroll
            for (int m = 0; m < 4; ++m) {
                const int r = rbase + wr * 64 + m * 16 + fr;
                const float* xrow = samp ? xs + (size_t)(r - MP) * D : xp + (size_t)r * D;
                float* yrow = samp ? out + O_YS + (size_t)(r - MP) * D : out + O_YP + (size_t)r * D;
                float ss = 0.f;
#pragma unroll
                for (int bj = 0; bj < 2; ++bj)
#pragma unroll
                    for (int n = 0; n < 2; ++n) {
                        const int c = col0 + bj * 128 + n * 16;
                        const f32x4 y = *(const f32x4*)(xrow + c) + acc[ai][bj][m][n];
                        *(f32x4*)(yrow + c) = y;
                        ss += (y[0] * y[0] + y[1] * y[1]) + (y[2] * y[2] + y[3] * y[3]);
                        u32x2 w; w.x = pg8::cvt_pk_bf16(y[0], y[1]); w.y = pg8::cvt_pk_bf16(y[2], y[3]);
                        *(u32x2*)(XB2 + (size_t)r * D + c) = w;
                    }
                ss += __shfl_xor(ss, 16); ss += __shfl_xor(ss, 32);
                if (fq == 0) atomicAdd(ssq + r, ss);
            }
        }
    }
};

struct EpiFfnIn {
    static constexpr bool PERM = false, AFTER_DRAIN = false;
    const float* ssq; bf16* H;
    __device__ __forceinline__ void operator()(const f32x4 (&acc)[2][2][4][2], const pg8::Unit& u, int wr, int wc, int fr, int fq) const {
        const int c = 128 * u.pn + 32 * wc + 8 * fq;
#pragma unroll
        for (int ai = 0; ai < 2; ++ai) {
            const int rbase = u.pm * 256 + ai * 128;
            if (rbase >= MR) continue;
#pragma unroll
            for (int m = 0; m < 4; ++m) {
                const int r = rbase + wr * 64 + m * 16 + fr;
                const float rs2 = rsqrtf(ssq[r] * (1.0f / 1024.0f) + EPS);
                f32x4 h[2];
#pragma unroll
                for (int n = 0; n < 2; ++n) {
                    const f32x4 g = acc[ai][0][m][n] * rs2, up = acc[ai][1][m][n] * rs2;
#pragma unroll
                    for (int j = 0; j < 4; ++j) h[n][j] = g[j] * sigmoidf_(g[j]) * up[j];
                }
                store_bf16x8(H + (size_t)r * DFF + c, h[0], h[1]);
            }
        }
    }
};

struct EpiFfnOut {
    static constexpr bool PERM = false, AFTER_DRAIN = false;
    float* out;
    __device__ __forceinline__ void operator()(const f32x4 (&acc)[2][2][4][2], const pg8::Unit& u, int wr, int wc, int fr, int fq) const {
        const int col0 = u.pn * 256 + wc * 32 + 4 * fq;
#pragma unroll
        for (int ai = 0; ai < 2; ++ai) {
            const int rbase = u.pm * 256 + ai * 128;
            if (rbase >= MR) continue;
            const bool samp = rbase >= MP;
#pragma unroll
            for (int m = 0; m < 4; ++m) {
                const int r = rbase + wr * 64 + m * 16 + fr;
                float* yrow = samp ? out + O_YS + (size_t)(r - MP) * D : out + O_YP + (size_t)r * D;
#pragma unroll
                for (int bj = 0; bj < 2; ++bj)
#pragma unroll
                    for (int n = 0; n < 2; ++n) { const int c = col0 + bj * 128 + n * 16; *(f32x4*)(yrow + c) = *(const f32x4*)(yrow + c) + acc[ai][bj][m][n]; }
            }
        }
    }
};

struct Params {
    const float* in[22];
    float* out;
    unsigned char* ws;
    double invf[32];
    int ph_lo, ph_hi;
};
enum { I_XP = 0, I_XS, I_CK, I_CV, I_CKI, I_SH, I_SC, I_NM, I_WIN, I_CW, I_CB, I_WRG, I_BRG, I_WIG, I_BIG, I_LAM, I_QN, I_KN, I_WOUT, I_NF, I_WFI, I_WFO };

struct Frame { LAS unsigned char* lds; int tid, lane, wave, G, bid; };

__device__ __forceinline__ float wave_sum(float v) {
#pragma unroll
    for (int o = 1; o < 64; o <<= 1) v += __shfl_xor(v, o);
    return v;
}

__device__ __forceinline__ void transpose_item(const float* W, int K, int N, int nvalid, const float* gain, bf16* WT, int k0, int row0, int lcol0, bool perm, LAS float* scr, int lane) {
#pragma unroll 8
    for (int i = 0; i < 32; ++i) {
        const int kk = 2 * i + (lane >> 5), col = lcol0 + (lane & 31);
        float v = 0.f;
        if (col < nvalid) { v = W[(size_t)(k0 + kk) * N + col]; if (gain) v *= gain[k0 + kk]; }
        scr[kk * 33 + (lane & 31)] = v;
    }
    asm volatile("s_waitcnt lgkmcnt(0)" ::: "memory");
    const int c = lane & 7;
#pragma unroll
    for (int j = 0; j < 4; ++j) {
        const int n = (lane >> 3) + 8 * j, src = perm ? pg8::perm32(n) : n;
        const LAS float* s = scr + (8 * c) * 33 + src;
        u32x4 o; o.x = pk2(s[0 * 33], s[1 * 33]); o.y = pk2(s[2 * 33], s[3 * 33]); o.z = pk2(s[4 * 33], s[5 * 33]); o.w = pk2(s[6 * 33], s[7 * 33]);
        *(u32x4*)(WT + (size_t)(row0 + n) * K + k0 + 8 * c) = o;
    }
    asm volatile("s_waitcnt lgkmcnt(0)" ::: "memory");
}

__device__ __forceinline__ void phase0(const Params& p, Frame& F) {
    unsigned char* ws = p.ws;
    LAS float* scr = (LAS float*)(F.lds + F.wave * 16384);
    const int gw = F.bid * 8 + F.wave, NGW = F.G * 8;
    constexpr int I_IN = 16 * (NIN / 32), I_OUT = 16 * (D / 32), I_FI = 16 * (2 * DFF / 32), I_FO = (DFF / 64) * (D / 32);
    constexpr int NITEMS = I_IN + I_OUT + I_FI + I_FO;
    for (int it = gw; it < NITEMS; it += NGW) {
        int r = it;
        if (r < I_IN) { const int kb = r / (NIN / 32), g = r % (NIN / 32), pn = g >> 3, sub = g & 7, bj = sub >> 2, wc = sub & 3;
            transpose_item(p.in[I_WIN], D, DIN, DIN, p.in[I_NM], (bf16*)(ws + WS_WIN), 64 * kb, 32 * g, 256 * pn + 64 * wc + 32 * bj, true, scr, F.lane); continue; }
        r -= I_IN;
        if (r < I_OUT) { const int kb = r / (D / 32), g = r % (D / 32);
            transpose_item(p.in[I_WOUT], D, D, D, nullptr, (bf16*)(ws + WS_WOUT), 64 * kb, 32 * g, 32 * g, false, scr, F.lane); continue; }
        r -= I_OUT;
        if (r < I_FI) { const int kb = r / (2 * DFF / 32), g = r % (2 * DFF / 32), pn = g >> 3, sub = g & 7, bj = sub >> 2, wc = sub & 3;
            transpose_item(p.in[I_WFI], D, 2 * DFF, 2 * DFF, p.in[I_NF], (bf16*)(ws + WS_WFI), 64 * kb, 32 * g, (bj ? DFF : 0) + 128 * pn + 32 * wc, true, scr, F.lane); continue; }
        r -= I_FI;
        { const int kb = r / (D / 32), g = r % (D / 32);
            transpose_item(p.in[I_WFO], DFF, D, D, nullptr, (bf16*)(ws + WS_WFO), 64 * kb, 32 * g, 32 * g, false, scr, F.lane); }
    }
    {
        bf16* XB = (bf16*)(ws + WS_XB); float* rstd = (float*)(ws + WS_RSTD);
        for (int m = gw; m < M; m += NGW) {
            unsigned long long* o8 = (unsigned long long*)(XB + (size_t)m * D) + F.lane;
            if (m >= MR) {
#pragma unroll
                for (int j = 0; j < 4; ++j) o8[64 * j] = 0ull;
                if (F.lane == 0) rstd[m] = 0.f;
                continue;
            }
            const float* xrow = (m < MP) ? p.in[I_XP] + (size_t)m * D : p.in[I_XS] + (size_t)(m - MP) * D;
            const f32x4* xr = (const f32x4*)xrow + F.lane;
            f32x4 v[4]; float s = 0.f;
#pragma unroll
            for (int j = 0; j < 4; ++j) { v[j] = xr[64 * j]; s += (v[j][0] * v[j][0] + v[j][1] * v[j][1]) + (v[j][2] * v[j][2] + v[j][3] * v[j][3]); }
            s = wave_sum(s);
            if (F.lane == 0) rstd[m] = rsqrtf(s * (1.0f / D) + EPS);
#pragma unroll
            for (int j = 0; j < 4; ++j) o8[64 * j] = (unsigned long long)pk2(v[j][0], v[j][1]) | ((unsigned long long)pk2(v[j][2], v[j][3]) << 32);
        }
    }
    const size_t gt = (size_t)F.bid * 512 + F.tid, GS = (size_t)F.G * 512;
    {
        bf16* KS = (bf16*)(ws + WS_KS); bf16* VS = (bf16*)(ws + WS_VS); bf16* KIS = (bf16*)(ws + WS_KIS);
        constexpr size_t NKV8 = (size_t)DB * PAST * KVW / 8, NKI8 = (size_t)DB * PAST * 64 / 8;
        for (size_t i = gt; i < 2 * NKV8 + NKI8; i += GS) {
            const float* src; bf16* dst; size_t e;
            if (i < NKV8) { e = i * 8; const size_t b = e / ((size_t)PAST * KVW), rem = e % ((size_t)PAST * KVW); src = p.in[I_CK] + e; dst = KS + b * SKEYS * KVW + rem; }
            else if (i < 2 * NKV8) { e = (i - NKV8) * 8; const size_t b = e / ((size_t)PAST * KVW), rem = e % ((size_t)PAST * KVW); src = p.in[I_CV] + e; dst = VS + b * SKEYS * KVW + rem; }
            else { e = (i - 2 * NKV8) * 8; const size_t b = e / ((size_t)PAST * 64), rem = e % ((size_t)PAST * 64); src = p.in[I_CKI] + e; dst = KIS + b * SKEYS * 64 + rem; }
            const f32x4 a = *(const f32x4*)src, b4 = *(const f32x4*)(src + 4);
            u32x4 w; w.x = pk2(a[0], a[1]); w.y = pk2(a[2], a[3]); w.z = pk2(b4[0], b4[1]); w.w = pk2(b4[2], b4[3]);
            *(u32x4*)dst = w;
        }
    }
    {
        float* rc = (float*)(ws + WS_RCOS); float* rsn = (float*)(ws + WS_RSIN);
        for (size_t i = gt; i < (size_t)8192 * 32; i += GS) {
            const int pos = (int)(i >> 5), fi = (int)(i & 31);
            const double ang = (double)pos * p.invf[fi];
            const double kq = rint(ang * 0.63661977236758134308);
            double r = fma(-kq, 1.57079632679489655800e+00, ang); r = fma(-kq, 6.12323399573676603587e-17, r);
            const double r2 = r * r;
            double sn = -1.0 / 1307674368000.0; sn = sn * r2 + 1.0 / 6227020800.0; sn = sn * r2 - 1.0 / 39916800.0; sn = sn * r2 + 1.0 / 362880.0; sn = sn * r2 - 1.0 / 5040.0; sn = sn * r2 + 1.0 / 120.0; sn = sn * r2 - 1.0 / 6.0; sn = sn * r2 + 1.0; sn *= r;
            double cs = 1.0 / 20922789888000.0; cs = cs * r2 - 1.0 / 87178291200.0; cs = cs * r2 + 1.0 / 479001600.0; cs = cs * r2 - 1.0 / 3628800.0; cs = cs * r2 + 1.0 / 40320.0; cs = cs * r2 - 1.0 / 720.0; cs = cs * r2 + 1.0 / 24.0; cs = cs * r2 - 0.5; cs = cs * r2 + 1.0;
            const int q = (int)((long long)kq & 3);
            const double sv = (q == 0) ? sn : (q == 1) ? cs : (q == 2) ? -sn : -cs;
            const double cv = (q == 0) ? cs : (q == 1) ? -sn : (q == 2) ? -cs : sn;
            rc[i] = (float)cv; rsn[i] = (float)sv;
        }
    }
    {
        float* ssq = (float*)(ws + WS_SSQ);
        for (size_t i = gt; i < (size_t)M; i += GS) ssq[i] = 0.f;
        float* sp = (float*)(ws + WS_SP);
        for (size_t i = gt; i < 512; i += GS) sp[i] = log1pf(__expf(-p.in[I_LAM][i]));
        bf16* WG = (bf16*)(ws + WS_WG);
        for (size_t i = gt; i < (size_t)2 * 8 * 64 * 64; i += GS) {
            const int ii = (int)(i & 63), j = (int)((i >> 6) & 63), nb = (int)((i >> 12) & 7), gsel = (int)(i >> 15);
            const float* W = gsel ? p.in[I_WIG] : p.in[I_WRG];
            WG[i] = (bf16)f2bf(W[(nb * 64 + ii) * 64 + j]);
        }
    }
}

constexpr int S_XS = 0, S_XC = 34816, S_XCB = S_XC + 32768, S_BT = S_XCB + 18432, S_AGS = S_BT + 32768;
static_assert(S_AGS + 4096 <= 131072, "scan LDS map");
__device__ __forceinline__ void scan_local_unit(const Params& p, Frame& F, int sbi  , int nb, int sg) {
    unsigned char* ws = p.ws;
    const bool samp = sbi >= NB; const int b = samp ? sbi - NB : sbi;
    const int T = samp ? DT : 128, t0 = samp ? 0 : sg * 128;
    const size_t r0 = samp ? (size_t)MP + b * DT : (size_t)b * SEQ + t0;
    const bf16* XR = (const bf16*)(ws + WS_XR);
    LAS float* xs = (LAS float*)(F.lds + S_XS); LAS float* xc = (LAS float*)(F.lds + S_XC); LAS bf16* xcb = (LAS bf16*)(F.lds + S_XCB);
    LAS float* bt = (LAS float*)(F.lds + S_BT); LAS float* av = xs; LAS f32x2* ags = (LAS f32x2*)(F.lds + S_AGS);
    const int tid = F.tid;
    for (int idx = tid; idx < (T + 3) * 64; idx += 512) {
        const int tt = idx >> 6, c = idx & 63, t = t0 - 3 + tt;
        float v;
        if (t >= 0) v = bf2f(XR[(r0 + tt - 3) * LW + nb * 64 + c]);
        else v = samp ? p.in[I_SC][((size_t)b * 3 + tt) * LW + nb * 64 + c] : 0.f;
        xs[tt * 64 + c] = v;
    }
    __syncthreads();
    {
        const int c = tid & 63; const int ch = nb * 64 + c;
        const float cb = p.in[I_CB][ch], w0 = p.in[I_CW][ch], w1 = p.in[I_CW][LW + ch], w2 = p.in[I_CW][2 * LW + ch], w3 = p.in[I_CW][3 * LW + ch];
        for (int t = tid >> 6; t < T; t += 8) {
            const float v = cb + w0 * xs[t * 64 + c] + w1 * xs[(t + 1) * 64 + c] + w2 * xs[(t + 2) * 64 + c] + w3 * xs[(t + 3) * 64 + c];
            xc[t * 64 + c] = v; xcb[t * 72 + c] = (bf16)f2bf(v);
        }
    }
    __syncthreads();
    if (F.wave * 16 < T) {
        const int row = F.lane & 15, kq = F.lane >> 4;
        const bf16x8 A0 = *(const LAS bf16x8*)(xcb + (F.wave * 16 + row) * 72 + 8 * kq), A1 = *(const LAS bf16x8*)(xcb + (F.wave * 16 + row) * 72 + 32 + 8 * kq);
        const bf16* WG = (const bf16*)(ws + WS_WG); const float* sp = (const float*)(ws + WS_SP);
#pragma unroll
        for (int jt = 0; jt < 4; ++jt) {
            const int j = 16 * jt + row, ch = nb * 64 + j;
            const bf16* wr_ = WG + ((size_t)(0 * 8 + nb) * 64 + j) * 64; const bf16* wi_ = WG + ((size_t)(1 * 8 + nb) * 64 + j) * 64;
            f32x4 ar = {0.f, 0.f, 0.f, 0.f}, ai = {0.f, 0.f, 0.f, 0.f};
            ar = __builtin_amdgcn_mfma_f32_16x16x32_bf16(A0, *(const bf16x8*)(wr_ + 8 * kq), ar, 0, 0, 0);
            ar = __builtin_amdgcn_mfma_f32_16x16x32_bf16(A1, *(const bf16x8*)(wr_ + 32 + 8 * kq), ar, 0, 0, 0);
            ai = __builtin_amdgcn_mfma_f32_16x16x32_bf16(A0, *(const bf16x8*)(wi_ + 8 * kq), ai, 0, 0, 0);
            ai = __builtin_amdgcn_mfma_f32_16x16x32_bf16(A1, *(const bf16x8*)(wi_ + 32 + 8 * kq), ai, 0, 0, 0);
            const float brg = p.in[I_BRG][ch], big = p.in[I_BIG][ch], spv = sp[ch];
#pragma unroll
            for (int ii = 0; ii < 4; ++ii) {
                const int t = F.wave * 16 + 4 * kq + ii;
                const float rg = sigmoidf_(ar[ii] + brg), ig = sigmoidf_(ai[ii] + big);
                const float la = -8.0f * rg * spv;
                const float a = __expf(la);
                const float mult = (!samp && (t0 + t) == 0) ? 1.0f : sqrtf(-expm1f(2.0f * la));
                av[t * 64 + j] = a; bt[t * 64 + j] = mult * ig * xc[t * 64 + j];
            }
        }
    }
    __syncthreads();
    const int c = tid & 63, sub = tid >> 6; const bool act = sub * 16 < T;
    if (act) {
        float Ac = 1.f, Bc = 0.f;
        for (int t = sub * 16; t < sub * 16 + 16; ++t) { const float a = av[t * 64 + c], bb = bt[t * 64 + c]; Bc = a * Bc + bb; Ac = Ac * a; av[t * 64 + c] = Ac; bt[t * 64 + c] = Bc; }
        ags[sub * 64 + c] = (f32x2){Ac, Bc};
    }
    __syncthreads();
    if (act) {
        float Ap = 1.f, Bp = 0.f;
        for (int s2 = 0; s2 < sub; ++s2) { const f32x2 g = ags[s2 * 64 + c]; Bp = g.x * Bp + g.y; Ap = Ap * g.x; }
        float* ACUM = (float*)(ws + WS_ACUM); float* BCUM = (float*)(ws + WS_BCUM);
        float ac = 0.f, bc = 0.f;
        for (int t = sub * 16; t < sub * 16 + 16; ++t) {
            const float al = av[t * 64 + c]; ac = al * Ap; bc = al * Bp + bt[t * 64 + c];
            ACUM[(r0 + t) * LW + nb * 64 + c] = ac; BCUM[(r0 + t) * LW + nb * 64 + c] = bc;
        }
        if (sub * 16 + 16 == T) ((f32x2*)(ws + WS_AGG))[((size_t)sbi * 64 + sg) * LW + nb * 64 + c] = (f32x2){ac, bc};
    }
    __syncthreads();
}

__device__ __forceinline__ void scan_apply_unit(const Params& p, Frame& F, int sbi, int sg) {
    unsigned char* ws = p.ws;
    const bool samp = sbi >= NB; const int b = samp ? sbi - NB : sbi;
    const int T = samp ? DT : 128;
    const size_t r0 = samp ? (size_t)MP + b * DT : (size_t)b * SEQ + sg * 128;
    const int ch = F.tid;
    float h = samp ? p.in[I_SH][b * LW + ch] : 0.f;
    const f32x2* AGG = (const f32x2*)(ws + WS_AGG) + (size_t)sbi * 64 * LW + ch;
    for (int s2 = 0; s2 < sg; ++s2) { const f32x2 g = AGG[(size_t)s2 * LW]; h = g.x * h + g.y; }
    const float* ACUM = (const float*)(ws + WS_ACUM) + r0 * LW + ch; const float* BCUM = (const float*)(ws + WS_BCUM) + r0 * LW + ch;
    const bf16* GG = (const bf16*)(ws + WS_GG) + r0 * LW + ch; bf16* YC = (bf16*)(ws + WS_YC) + r0 * D + ch;
    float ht = 0.f;
#pragma unroll 8
    for (int t = 0; t < T; ++t) {
        ht = ACUM[(size_t)t * LW] * h + BCUM[(size_t)t * LW];
        YC[(size_t)t * D] = (bf16)f2bf(ht * bf2f(GG[(size_t)t * LW]));
    }
    if (samp) p.out[O_HS + b * LW + ch] = ht;
    else if (sg == 63) p.out[O_HP + b * LW + ch] = ht;
}

constexpr int A_CAND = 0, A_CNT = 131072, A_THR = 131072 + 128, CAP = 1024;
__device__ __forceinline__ unsigned pack_key(float s, int key) {
    unsigned u = __float_as_uint(s);
    u = (u & 0x80000000u) ? ~u : (u | 0x80000000u);
    return (u & 0xFFFFE000u) | (unsigned)(8191 - key);
}
__device__ __forceinline__ unsigned select256(LAS unsigned* cq, int n, int lane) {
    unsigned e[16];
#pragma unroll
    for (int i = 0; i < 16; ++i) { const int idx = i * 64 + lane; e[i] = idx < n ? cq[idx] : 0u; }
    unsigned T = 0u;
    for (int bit = 31; bit >= 0; --bit) {
        const unsigned c = T | (1u << bit); int cnt = 0;
#pragma unroll
        for (int i = 0; i < 16; ++i) cnt += __popcll(__ballot(e[i] >= c));
        if (cnt >= 256) T = c;
    }
    asm volatile("s_waitcnt lgkmcnt(0)" ::: "memory");
    int base = 0;
#pragma unroll
    for (int i = 0; i < 16; ++i) {
        const bool keep = e[i] >= T; const unsigned long long mk = __ballot(keep);
        const int pos = base + (int)__builtin_amdgcn_mbcnt_hi((unsigned)(mk >> 32), __builtin_amdgcn_mbcnt_lo((unsigned)mk, 0u));
        if (keep) cq[pos] = e[i];
        base += __popcll(mk);
    }
    return T;
}

__device__ __forceinline__ void attn_unit(const Params& p, Frame& F, size_t q0row, int nq, int L, const bf16* KI, const bf16* Kb, const bf16* Vb) {
    unsigned char* ws = p.ws;
    const bf16* QI = (const bf16*)(ws + WS_QI); const bf16* Qb = (const bf16*)(ws + WS_Q); const float* WI = (const float*)(ws + WS_WI); bf16* YC = (bf16*)(ws + WS_YC);
    LAS unsigned* cand = (LAS unsigned*)(F.lds + A_CAND); LAS unsigned* cntp = (LAS unsigned*)(F.lds + A_CNT); LAS unsigned* thrp = (LAS unsigned*)(F.lds + A_THR);
    const int lane = F.lane, wid = F.wave, qc = lane & 15, kq = lane >> 4;
    if (F.tid < 32) { cntp[F.tid] = 0u; thrp[F.tid] = 0u; }
    const int nsub = nq >> 4, nslots = (nsub == 2) ? 4 : 8, slot = (nsub == 2) ? (wid & 3) : wid, sub = (nsub == 2) ? (wid >> 2) : 0;
    const int ql = sub * 16 + qc;
    bf16x8 Bq[8][2]; float sinf_[8];
    {
        const size_t qrow = q0row + ql;
#pragma unroll
        for (int h = 0; h < 8; ++h) {
            const float w = WI[qrow * 8 + h];
            sinf_[h] = (w < 0.f) ? -INFINITY : INFINITY;
#pragma unroll
            for (int s = 0; s < 2; ++s) {
                const u32x4 raw = *(const u32x4*)(QI + qrow * 512 + h * 64 + 32 * s + 8 * kq);
                u32x4 o; o.x = pk2(bflo(raw.x) * w, bfhi(raw.x) * w); o.y = pk2(bflo(raw.y) * w, bfhi(raw.y) * w); o.z = pk2(bflo(raw.z) * w, bfhi(raw.z) * w); o.w = pk2(bflo(raw.w) * w, bfhi(raw.w) * w);
                Bq[h][s] = __builtin_bit_cast(bf16x8, o);
            }
        }
    }
    __syncthreads();
    const int ngroups = (L + 63) >> 6, nrounds = (ngroups + nslots - 1) / nslots;
    const unsigned limit = (unsigned)(CAP - nslots * 64);
    for (int it = 0; it < nrounds; ++it) {
        const int gi = it * nslots + slot;
        if (gi < ngroups) {
            unsigned pk[16];
#pragma unroll
            for (int tl = 0; tl < 4; ++tl) {
                const int keybase = gi * 64 + tl * 16; int arow = keybase + qc; arow = arow < L ? arow : L - 1;
                const bf16x8 A0 = *(const bf16x8*)(KI + (size_t)arow * 64 + 8 * kq), A1 = *(const bf16x8*)(KI + (size_t)arow * 64 + 32 + 8 * kq);
                f32x4 sc = {0.f, 0.f, 0.f, 0.f};
#pragma unroll
                for (int h = 0; h < 8; ++h) {
                    f32x4 acc = {0.f, 0.f, 0.f, 0.f};
                    acc = __builtin_amdgcn_mfma_f32_16x16x32_bf16(A0, Bq[h][0], acc, 0, 0, 0);
                    acc = __builtin_amdgcn_mfma_f32_16x16x32_bf16(A1, Bq[h][1], acc, 0, 0, 0);
#pragma unroll
                    for (int i = 0; i < 4; ++i) sc[i] += __builtin_amdgcn_fmed3f(acc[i], 0.f, sinf_[h]);
                }
#pragma unroll
                for (int i = 0; i < 4; ++i) { const int key = keybase + 4 * kq + i; pk[tl * 4 + i] = key < L ? pack_key(sc[i], key) : 0u; }
            }
            const unsigned thr = thrp[ql];
            int n = 0;
#pragma unroll
            for (int j = 0; j < 16; ++j) n += (pk[j] > thr) ? 1 : 0;
            if (n) {
                unsigned base = __hip_atomic_fetch_add(cntp + ql, (unsigned)n, __ATOMIC_RELAXED, __HIP_MEMORY_SCOPE_WORKGROUP);
                LAS unsigned* cq = cand + ql * CAP;
#pragma unroll
                for (int j = 0; j < 16; ++j) if (pk[j] > thr) cq[base++] = pk[j];
            }
        }
        __syncthreads();
#pragma unroll 1
        for (int i2 = 0; i2 < 4; ++i2) {
            const int qq = wid * 4 + i2;
            if (qq < nq) {
                const unsigned n = (unsigned)__builtin_amdgcn_readfirstlane((int)cntp[qq]);
                if (n > limit) { const unsigned T = select256(cand + qq * CAP, (int)n, lane); if (lane == 0) { cntp[qq] = 256u; thrp[qq] = T; } }
            }
        }
        __syncthreads();
    }
    const int wb = wid * 16384;
    LAS unsigned short* idx16 = (LAS unsigned short*)(F.lds + wb);
    LAS float* linv = (LAS float*)(F.lds + wb + 2048);
    LAS int* nsl = (LAS int*)(F.lds + wb + 2048 + 64);
    LAS float* P = (LAS float*)(F.lds + wb + 4096);
    {
        unsigned ee[4][4]; int ns[4];
#pragma unroll
        for (int i2 = 0; i2 < 4; ++i2) {
            const int qq = wid * 4 + i2; int n = 0;
            if (qq < nq) {
                n = __builtin_amdgcn_readfirstlane((int)cntp[qq]);
                if (n > 256) { select256(cand + qq * CAP, n, lane); n = 256; }
            }
            ns[i2] = n;
        }
        asm volatile("s_waitcnt lgkmcnt(0)" ::: "memory");
#pragma unroll
        for (int i2 = 0; i2 < 4; ++i2)
#pragma unroll
            for (int m2 = 0; m2 < 4; ++m2) { const int k = lane + 64 * m2; ee[i2][m2] = (k < ns[i2]) ? cand[(wid * 4 + i2) * CAP + k] : 8191u; }
        asm volatile("s_waitcnt lgkmcnt(0)" ::: "memory");
#pragma unroll
        for (int i2 = 0; i2 < 4; ++i2) {
#pragma unroll
            for (int m2 = 0; m2 < 4; ++m2) idx16[i2 * 256 + lane + 64 * m2] = (unsigned short)(8191u - (ee[i2][m2] & 8191u));
            if (lane == 0) nsl[i2] = ns[i2];
        }
        asm volatile("s_waitcnt lgkmcnt(0)" ::: "memory");
    }
#pragma unroll 1
    for (int i2 = 0; i2 < 4; ++i2) {
        const int n = __builtin_amdgcn_readfirstlane(nsl[i2]);
        if (n == 0) continue;
        const size_t qrow = q0row + wid * 4 + i2;
        const int h = lane & 15;
        bf16x8 Bh[4];
#pragma unroll
        for (int s = 0; s < 4; ++s) {
            const bool v = (h < 8) && ((h >> 2) == (s >> 1));
            u32x4 raw = {0u, 0u, 0u, 0u};
            if (v) raw = *(const u32x4*)(Qb + qrow * 512 + h * 64 + 32 * (s & 1) + 8 * kq);
            Bh[s] = __builtin_bit_cast(bf16x8, raw);
        }
        float mx = -INFINITY;
#pragma unroll 2
        for (int tl = 0; tl < 16; ++tl) {
            const int idx = idx16[i2 * 256 + tl * 16 + qc];
            const bf16* kr = Kb + (size_t)idx * KVW + 8 * kq;
            f32x4 acc = {0.f, 0.f, 0.f, 0.f};
#pragma unroll
            for (int s = 0; s < 4; ++s) acc = __builtin_amdgcn_mfma_f32_16x16x32_bf16(*(const bf16x8*)(kr + 32 * s), Bh[s], acc, 0, 0, 0);
#pragma unroll
            for (int ii = 0; ii < 4; ++ii) {
                const int key = tl * 16 + 4 * kq + ii; const float sv = key < n ? acc[ii] * 0.125f : -INFINITY;
                mx = fmaxf(mx, sv);
                if (h < 8) P[key * 8 + h] = sv;
            }
        }
        mx = fmaxf(mx, __shfl_xor(mx, 16)); mx = fmaxf(mx, __shfl_xor(mx, 32));
        asm volatile("s_waitcnt lgkmcnt(0)" ::: "memory");
        float sum = 0.f;
        if (h < 8) {
#pragma unroll 4
            for (int tl = 0; tl < 16; ++tl)
#pragma unroll
                for (int ii = 0; ii < 4; ++ii) { const int key = tl * 16 + 4 * kq + ii; const float pv = __expf(P[key * 8 + h] - mx); P[key * 8 + h] = pv; sum += pv; }
        }
        sum += __shfl_xor(sum, 16); sum += __shfl_xor(sum, 32);
        if (h < 8 && kq == 0) linv[h] = 1.0f / sum;
        asm volatile("s_waitcnt lgkmcnt(0)" ::: "memory");
        const int g = lane >> 5;
        float o[4][2] = {{0.f, 0.f}, {0.f, 0.f}, {0.f, 0.f}, {0.f, 0.f}};
#pragma unroll 4
        for (int k = 0; k < n; ++k) {
            const int idx = idx16[i2 * 256 + k];
            const unsigned vv = *(const unsigned*)(Vb + (size_t)idx * KVW + 2 * lane);
            const f32x4 p4 = *(const LAS f32x4*)(P + k * 8 + 4 * g);
            const float lo = bflo(vv), hi = bfhi(vv);
#pragma unroll
            for (int hh = 0; hh < 4; ++hh) { o[hh][0] += p4[hh] * lo; o[hh][1] += p4[hh] * hi; }
        }
#pragma unroll
        for (int hh = 0; hh < 4; ++hh) {
            const int head = 4 * g + hh; const float rl = linv[head];
            *(unsigned*)(YC + qrow * D + 512 + head * 64 + 2 * (lane & 31)) = pk2(o[hh][0] * rl, o[hh][1] * rl);
        }
        asm volatile("s_waitcnt lgkmcnt(0)" ::: "memory");
    }
    __syncthreads();
}

__device__ __forceinline__ void phase3(const Params& p, Frame& F) {
    unsigned char* ws = p.ws;
    for (int u = F.bid; u < 256 + DB; u += F.G) { if (u < 256) scan_apply_unit(p, F, u >> 6, u & 63); else scan_apply_unit(p, F, NB + (u - 256), 0); }
    for (int k = 0;; ++k) {
        const int u = k * F.G + ((k & 1) ? F.G - 1 - F.bid : F.bid);
        if (k * F.G >= 1024) break;
        if (u >= 1024) continue;
        const int chunk = 127 - (u >> 3), b = (u & 7) >> 1, half = u & 1;
        const size_t q0row = (size_t)b * SEQ + chunk * 64 + half * 32;
        attn_unit(p, F, q0row, 32, 64 * (chunk + 1), (const bf16*)(ws + WS_KIB) + (size_t)b * SEQ * 64, (const bf16*)(ws + WS_KB) + (size_t)b * SEQ * KVW, (const bf16*)(ws + WS_VB) + (size_t)b * SEQ * KVW);
    }
    for (int s = F.bid; s < DB; s += F.G)
        attn_unit(p, F, (size_t)MP + s * DT, 16, SKEYS, (const bf16*)(ws + WS_KIS) + (size_t)s * SKEYS * 64, (const bf16*)(ws + WS_KS) + (size_t)s * SKEYS * KVW, (const bf16*)(ws + WS_VS) + (size_t)s * SKEYS * KVW);
}

__global__ void __launch_bounds__(512, 2) fwd_kernel(Params p) {
    extern __shared__ __attribute__((aligned(16))) unsigned char lds_raw[];
    Frame F; F.lds = (LAS unsigned char*)lds_raw; F.tid = threadIdx.x; F.lane = F.tid & 63; F.wave = __builtin_amdgcn_readfirstlane(F.tid >> 6); F.G = gridDim.x; F.bid = blockIdx.x;
    unsigned char* ws = p.ws;
    const int lo = p.ph_lo, hi = p.ph_hi;
#define IN(k) (lo <= (k) && (k) < hi)
#ifndef SKIPMASK
#define SKIPMASK 0
#endif
#define SKIP(k) ((SKIPMASK >> (k)) & 1)
#define SEAM(k) do { if (IN(k) && IN((k) + 1)) { cg::this_grid().sync(); } } while (0)
    if (IN(0) && !SKIP(0)) phase0(p, F);
    SEAM(0);
    if (IN(1) && !SKIP(1)) {
        pg8::Gemm g{(const pg8::bf16_t*)(ws + WS_XB), (const pg8::bf16_t*)(ws + WS_WIN), M, NIN, D};
        pg8::StaticOrder S; S.init(M, NIN, F.G, F.bid);
        EpiInProj E{(const float*)(ws + WS_RSTD), (const float*)(ws + WS_RCOS), (const float*)(ws + WS_RSIN), p.in[I_QN], p.in[I_KN],
                    (bf16*)(ws + WS_XR), (bf16*)(ws + WS_GG), (bf16*)(ws + WS_Q), (bf16*)(ws + WS_QI), (bf16*)(ws + WS_KB), (bf16*)(ws + WS_VB), (bf16*)(ws + WS_KIB),
                    (bf16*)(ws + WS_KS), (bf16*)(ws + WS_VS), (bf16*)(ws + WS_KIS), (float*)(ws + WS_WI), p.out};
        pg8::gemm_phase<EpiInProj, pg8::StaticOrder, true, true>(F.lds, g, S, E);
    }
    SEAM(1);
    if (IN(2) && !SKIP(2)) {
        for (int u = F.bid; u < 2048 + 64; u += F.G) {
            if (u < 2048) scan_local_unit(p, F, u >> 9, u & 7, (u & 511) >> 3);
            else scan_local_unit(p, F, NB + ((u - 2048) >> 3), (u - 2048) & 7, 0);
        }
    }
    SEAM(2);
    if (IN(3) && !SKIP(3)) phase3(p, F);
    SEAM(3);
    if (IN(4) && !SKIP(4)) {
        pg8::Gemm g{(const pg8::bf16_t*)(ws + WS_YC), (const pg8::bf16_t*)(ws + WS_WOUT), M, D, D};
        pg8::StaticOrder S; S.init(M, D, F.G, F.bid);
        EpiOutProj E{p.in[I_XP], p.in[I_XS], p.out, (bf16*)(ws + WS_XB), (float*)(ws + WS_SSQ)};
        pg8::gemm_phase<EpiOutProj, pg8::StaticOrder, true, true>(F.lds, g, S, E);
    }
    SEAM(4);
    if (IN(5) && !SKIP(5)) {
        pg8::Gemm g{(const pg8::bf16_t*)(ws + WS_XB), (const pg8::bf16_t*)(ws + WS_WFI), M, 2 * DFF, D};
        pg8::StaticOrder S; S.init(M, 2 * DFF, F.G, F.bid);
        EpiFfnIn E{(const float*)(ws + WS_SSQ), (bf16*)(ws + WS_H)};
        pg8::gemm_phase<EpiFfnIn, pg8::StaticOrder, true, true>(F.lds, g, S, E);
    }
    SEAM(5);
    if (IN(6) && !SKIP(6)) {
        pg8::Gemm g{(const pg8::bf16_t*)(ws + WS_H), (const pg8::bf16_t*)(ws + WS_WFO), M, D, DFF};
        pg8::StaticOrder S; S.init(M, D, F.G, F.bid);
        EpiFfnOut E{p.out};
        pg8::gemm_phase<EpiFfnOut, pg8::StaticOrder, true, true>(F.lds, g, S, E);
    }
#undef IN
#undef SEAM
}

#ifndef N_LAUNCHES
#define N_LAUNCHES 1
#endif
constexpr int NPHASE = 7;
extern "C" void kernel_launch(void* const* d_in, const int* in_sizes, int n_in, void* d_out, int out_size, void* d_ws, size_t ws_size, hipStream_t stream) {
    static int grid = 0;
    if (grid == 0) {
        if (n_in != 22 || out_size != (int)O_END || ws_size < WS_END) { fprintf(stderr, "kernel_launch: unexpected shapes: n_in %d out %d ws %zu (need %zu)\n", n_in, out_size, ws_size, (size_t)WS_END); grid = -1; return; }
        int dev = 0, cus = 0, per_cu = 0;
        if (hipGetDevice(&dev) != hipSuccess || hipDeviceGetAttribute(&cus, hipDeviceAttributeMultiprocessorCount, dev) != hipSuccess) { grid = -1; return; }
        if (hipFuncSetAttribute((const void*)fwd_kernel, hipFuncAttributeMaxDynamicSharedMemorySize, LDS_BYTES) != hipSuccess) { fprintf(stderr, "kernel_launch: hipFuncSetAttribute failed\n"); grid = -1; return; }
        if (hipOccupancyMaxActiveBlocksPerMultiprocessor(&per_cu, (const void*)fwd_kernel, 512, LDS_BYTES) != hipSuccess || per_cu < 1) { fprintf(stderr, "kernel_launch: occupancy query says %d blocks/CU\n", per_cu); per_cu = 1; }
        (void)hipGetLastError();
        grid = cus;
    }
    if (grid < 0) return;
    Params p{};
    for (int i = 0; i < 22; ++i) p.in[i] = (const float*)d_in[i];
    p.out = (float*)d_out; p.ws = (unsigned char*)d_ws;
    for (int i = 0; i < 32; ++i) p.invf[i] = pow(10000.0, -(double)i / 32.0);
    if (N_LAUNCHES == 1) {
        p.ph_lo = 0; p.ph_hi = NPHASE;
        void* args[] = {&p};
        hipError_t e = hipLaunchCooperativeKernel((const void*)fwd_kernel, dim3(grid), dim3(512), args, LDS_BYTES, stream);
        if (e != hipSuccess) fprintf(stderr, "kernel_launch: cooperative launch failed: %s (grid %d)\n", hipGetErrorString(e), grid);
    } else {
        for (int k = 0; k < NPHASE; ++k) { p.ph_lo = k; p.ph_hi = k + 1; hipLaunchKernelGGL(fwd_kernel, dim3(grid), dim3(512), LDS_BYTES, stream, p); }
    }
}
```

```cpp
#include <hip/hip_runtime.h>
#include <hip/hip_cooperative_groups.h>
#include <cstdio>
#include <cstdint>
#include <cmath>
namespace cg = cooperative_groups;
namespace pg8 {
#define PG8_LAS __attribute__((address_space(3)))
typedef unsigned short bf16_t;
typedef short bf16x8 __attribute__((ext_vector_type(8)));
typedef float f32x4 __attribute__((ext_vector_type(4)));
typedef unsigned u32x4 __attribute__((ext_vector_type(4)));
constexpr int BM = 256, BK = 64, HALF = 128, HTB = HALF * BK * 2  , STAGE_BYTES = 8 * HTB, NXCD = 8, WGM = 8;

__host__ __device__ __forceinline__ int lds_byte(int r, int c) { const int st = (r >> 4) * 2 + (c >> 5), rr = r & 15, cc = c & 31, ob = rr * 64 + cc * 2; return st * 1024 + (ob ^ (((ob >> 9) & 1) << 5)); }
__host__ __device__ __forceinline__ void stage_rc(int b, int& R, int& C) { const int st = b / 1024, sb = b % 1024, swz = sb ^ (((sb >> 9) & 1) << 5); R = (st >> 1) * 16 + swz / 64; C = (st & 1) * 32 + (swz % 64) / 2; }
__host__ __device__ __forceinline__ int perm32(int rho) { const int n = rho >> 4, i = rho & 15; return 8 * (i >> 2) + 4 * n + (i & 3); }

struct Unit { int pm, pn; };
struct Gemm { const bf16_t* A; const bf16_t* Bt; int M, N, K; };

struct StaticOrder {
    int nM, nN, nwg, G, c;
    __host__ __device__ void init(int M, int N, int G_, int c_) { nM = M / BM; nN = N / BM; nwg = nM * nN; G = G_; c = c_; }
    __host__ __device__ bool next(int i, Unit& u) const {
        const long L = (long)i * G + c; if (L >= nwg) return false;
        int wgid = (int)L; { const int q = nwg / NXCD, r = nwg % NXCD, xcd = wgid % NXCD, off = wgid / NXCD; wgid = (xcd < r ? xcd * (q + 1) : r * (q + 1) + (xcd - r) * q) + off; }
        const int nig = WGM * nN, gid = wgid / nig, fm = gid * WGM, gsz = (nM - fm) < WGM ? (nM - fm) : WGM;
        u.pm = fm + ((wgid % nig) % gsz); u.pn = (wgid % nig) / gsz; return true;
    }
    __device__ __forceinline__ void a_ready(const Unit&) const {}
    __device__ __forceinline__ void done(const Unit&) const {}
};
__device__ __forceinline__ unsigned cvt_pk_bf16(float lo, float hi) { unsigned r; asm volatile("v_cvt_pk_bf16_f32 %0, %1, %2" : "=v"(r) : "v"(lo), "v"(hi)); return r; }
template <class Epi, class Sched, bool ALIGN_EPI = false, bool SP2 = false>
__device__ __forceinline__ void gemm_phase(PG8_LAS unsigned char* lds, const Gemm g, const Sched& S, const Epi& E) {
    const int tid = threadIdx.x, wid = __builtin_amdgcn_readfirstlane(tid >> 6), lane = tid & 63, wr = wid >> 2, wc = wid & 3, fr = lane & 15, fq = lane >> 4;
    const int K = g.K, nt = K / BK;
    unsigned voffA[2], voffB[2];
#pragma unroll
    for (int i = 0; i < 2; ++i) { int R, C; stage_rc(tid * 16 + i * 8192, R, C); const int Rb = Epi::PERM ? ((R & ~31) + perm32(R & 31)) : R;
        voffA[i] = (unsigned)(R * K + C) * 2u; voffB[i] = (unsigned)(Rb * K + C) * 2u; }
    const size_t kstep = (size_t)(BK * 2);
    const size_t hstep = (size_t)HALF * K * 2;
    const size_t tstep = 2 * hstep;
    const unsigned ldsw = (unsigned)wid * 1024u;
    const int aoff = lds_byte(wr * 64 + fr, fq * 8), boff = lds_byte(wc * 32 + fr, fq * 8);
#define PG8_SA(b, h) (((b) * 2 + (h)) * HTB)
#define PG8_SB(b, h) ((4 + (b) * 2 + (h)) * HTB)
#define PG8_STAGE(bufoff, gbase, voff) do { _Pragma("unroll") for (int _i = 0; _i < 2; ++_i) \
        __builtin_amdgcn_global_load_lds((const unsigned*)((const char*)(gbase) + (voff)[_i]), (PG8_LAS unsigned*)(lds + (bufoff) + ldsw + _i * 8192), 16, 0, 0); } while (0)
#define PG8_LDA(dst, b, h) do { _Pragma("unroll") for (int m = 0; m < 4; ++m) _Pragma("unroll") for (int k = 0; k < 2; ++k) dst[m][k] = *(const PG8_LAS bf16x8*)(lds + PG8_SA(b, h) + aoff + m * 2048 + k * 1024); } while (0)
#define PG8_LDB(dst, b, h) do { _Pragma("unroll") for (int n = 0; n < 2; ++n) _Pragma("unroll") for (int k = 0; k < 2; ++k) dst[n][k] = *(const PG8_LAS bf16x8*)(lds + PG8_SB(b, h) + boff + n * 2048 + k * 1024); } while (0)
#define PG8_MMA(ai, bj, At, Bt) do { __builtin_amdgcn_s_setprio(1); _Pragma("unroll") for (int m = 0; m < 4; ++m) _Pragma("unroll") for (int n = 0; n < 2; ++n) _Pragma("unroll") for (int k = 0; k < 2; ++k) \
        acc[ai][bj][m][n] = __builtin_amdgcn_mfma_f32_16x16x32_bf16(Bt[n][k], At[m][k], acc[ai][bj][m][n], 0, 0, 0); __builtin_amdgcn_s_setprio(0); } while (0)
#define PG8_WAIT_V(n) asm volatile("s_waitcnt vmcnt(" #n ")" ::: "memory")
#define PG8_WAIT_L(n) asm volatile("s_waitcnt lgkmcnt(" #n ")" ::: "memory")
#define PG8_BAR __builtin_amdgcn_s_barrier()
#define PG8_SCHED __builtin_amdgcn_sched_barrier(0)
    Unit cur, nxt; int ui = 0;
    if (!S.next(0, cur)) return;
    f32x4 acc[2][2][4][2];
#pragma unroll
    for (int a = 0; a < 2; ++a)
#pragma unroll
        for (int b = 0; b < 2; ++b)
#pragma unroll
            for (int m = 0; m < 4; ++m)
#pragma unroll
                for (int n = 0; n < 2; ++n) acc[a][b][m][n] = (f32x4){0.f, 0.f, 0.f, 0.f};
    bf16x8 At[4][2], B0[2][2], B1[2][2];
    const char* cA = (const char*)g.A + (size_t)cur.pm * tstep; const char* cB = (const char*)g.Bt + (size_t)cur.pn * tstep;
    S.a_ready(cur);
    if constexpr (SP2) {
        PG8_STAGE(PG8_SB(0, 0), cB, voffB); PG8_STAGE(PG8_SB(0, 1), cB + hstep, voffB); PG8_STAGE(PG8_SA(0, 0), cA, voffA); PG8_STAGE(PG8_SA(0, 1), cA + hstep, voffA);
        if (wr == 1) PG8_BAR;
        PG8_WAIT_V(2); PG8_BAR;
        PG8_STAGE(PG8_SB(1, 0), cB + kstep, voffB); PG8_STAGE(PG8_SA(1, 0), cA + kstep, voffA); PG8_STAGE(PG8_SB(1, 1), cB + hstep + kstep, voffB);
        PG8_WAIT_V(6); PG8_BAR;
    } else {
        PG8_STAGE(PG8_SB(0, 0), cB, voffB); PG8_STAGE(PG8_SA(0, 0), cA, voffA); PG8_STAGE(PG8_SB(0, 1), cB + hstep, voffB); PG8_STAGE(PG8_SA(0, 1), cA + hstep, voffA);
        if (wr == 1) PG8_BAR;
        PG8_WAIT_V(4); PG8_BAR;
        PG8_STAGE(PG8_SB(1, 0), cB + kstep, voffB); PG8_STAGE(PG8_SA(1, 0), cA + kstep, voffA); PG8_STAGE(PG8_SB(1, 1), cB + hstep + kstep, voffB);
        PG8_WAIT_V(6); PG8_BAR;
    }
    for (;;) {
        const bool has_next = S.next(ui + 1, nxt);
        const char* nA = has_next ? (const char*)g.A + (size_t)nxt.pm * tstep : cA; const char* nB = has_next ? (const char*)g.Bt + (size_t)nxt.pn * tstep : cB;
        for (int t = 0; t < nt; t += 2) {
            const bool last = (t == nt - 2);
            const char* a1 = cA + (size_t)(t + 1) * kstep;
            const char* a2 = last ? nA : cA + (size_t)(t + 2) * kstep; const char* b2 = last ? nB : cB + (size_t)(t + 2) * kstep;
            const char* a3 = a2 + kstep; const char* b3 = b2 + kstep;
            if (last && has_next) S.a_ready(nxt);
            if constexpr (SP2) {
            PG8_LDB(B0, 0, 0); PG8_LDB(B1, 0, 1); PG8_SCHED; PG8_LDA(At, 0, 0); PG8_STAGE(PG8_SA(1, 1), a1 + hstep, voffA);
            PG8_WAIT_V(8); PG8_WAIT_L(0); PG8_BAR; PG8_MMA(0, 0, At, B0); PG8_MMA(0, 1, At, B1); PG8_BAR; PG8_SCHED;
            PG8_LDA(At, 0, 1); PG8_STAGE(PG8_SB(0, 0), b2, voffB); PG8_STAGE(PG8_SB(0, 1), b2 + hstep, voffB); PG8_STAGE(PG8_SA(0, 0), a2, voffA);
            PG8_WAIT_V(8); PG8_WAIT_L(0); PG8_BAR; PG8_MMA(1, 0, At, B0); PG8_MMA(1, 1, At, B1); PG8_BAR; PG8_SCHED;
            PG8_LDB(B0, 1, 0); PG8_LDB(B1, 1, 1); PG8_SCHED; PG8_LDA(At, 1, 0); PG8_STAGE(PG8_SA(0, 1), a2 + hstep, voffA);
            PG8_WAIT_V(8); PG8_WAIT_L(0); PG8_BAR; PG8_MMA(0, 0, At, B0); PG8_MMA(0, 1, At, B1); PG8_BAR; PG8_SCHED;
            PG8_LDA(At, 1, 1); PG8_STAGE(PG8_SB(1, 0), b3, voffB); PG8_STAGE(PG8_SB(1, 1), b3 + hstep, voffB); PG8_STAGE(PG8_SA(1, 0), a3, voffA);
            PG8_WAIT_V(8); PG8_WAIT_L(0); PG8_BAR; PG8_MMA(1, 0, At, B0); PG8_MMA(1, 1, At, B1); PG8_BAR; PG8_SCHED;
            } else {
            PG8_LDB(B0, 0, 0); PG8_SCHED; PG8_LDA(At, 0, 0); PG8_STAGE(PG8_SA(1, 1), a1 + hstep, voffA);
            PG8_WAIT_L(8); PG8_BAR; PG8_WAIT_L(0); PG8_MMA(0, 0, At, B0); PG8_BAR; PG8_SCHED;
            PG8_LDB(B1, 0, 1); PG8_STAGE(PG8_SB(0, 0), b2, voffB);
            PG8_BAR; PG8_WAIT_L(0); PG8_MMA(0, 1, At, B1); PG8_BAR;
            PG8_LDA(At, 0, 1); PG8_STAGE(PG8_SA(0, 0), a2, voffA);
            PG8_BAR; PG8_WAIT_L(0); PG8_MMA(1, 0, At, B0); PG8_BAR; PG8_SCHED;
            PG8_STAGE(PG8_SB(0, 1), b2 + hstep, voffB);
            PG8_WAIT_V(6); PG8_BAR; PG8_MMA(1, 1, At, B1); PG8_BAR;
            PG8_LDB(B0, 1, 0); PG8_SCHED; PG8_LDA(At, 1, 0); PG8_STAGE(PG8_SA(0, 1), a2 + hstep, voffA);
            PG8_WAIT_L(8); PG8_BAR; PG8_WAIT_L(0); PG8_MMA(0, 0, At, B0); PG8_BAR; PG8_SCHED;
            PG8_LDB(B1, 1, 1); PG8_STAGE(PG8_SB(1, 0), b3, voffB);
            PG8_BAR; PG8_WAIT_L(0); PG8_MMA(0, 1, At, B1); PG8_BAR;
            PG8_LDA(At, 1, 1); PG8_STAGE(PG8_SA(1, 0), a3, voffA);
            PG8_BAR; PG8_WAIT_L(0); PG8_MMA(1, 0, At, B0); PG8_BAR; PG8_SCHED;
            PG8_STAGE(PG8_SB(1, 1), b3 + hstep, voffB);
            PG8_WAIT_V(6); PG8_BAR; PG8_MMA(1, 1, At, B1); PG8_BAR;
            }
        }
        if constexpr (ALIGN_EPI) { if (wr == 0) PG8_BAR; }
        if constexpr (!Epi::AFTER_DRAIN) { E(acc, cur, wr, wc, fr, fq); S.done(cur); }
        if (!has_next) break;
#pragma unroll
        for (int a = 0; a < 2; ++a)
#pragma unroll
            for (int b = 0; b < 2; ++b)
#pragma unroll
                for (int m = 0; m < 4; ++m)
#pragma unroll
                    for (int n = 0; n < 2; ++n) acc[a][b][m][n] = (f32x4){0.f, 0.f, 0.f, 0.f};
        cur = nxt; cA = nA; cB = nB; ++ui;
        if constexpr (ALIGN_EPI) { if (wr == 1) PG8_BAR; }
    }
    PG8_WAIT_V(0);
    if constexpr (!ALIGN_EPI) { if (wr == 0) PG8_BAR; }
    PG8_BAR;
    if constexpr (Epi::AFTER_DRAIN) { E.fused(acc, cur, wr, wc, fr, fq, lds, wid, lane); S.done(cur); }
#undef PG8_SA
#undef PG8_SB
#undef PG8_STAGE
#undef PG8_LDA
#undef PG8_LDB
#undef PG8_MMA
#undef PG8_WAIT_V
#undef PG8_WAIT_L
#undef PG8_BAR
#undef PG8_SCHED
}
}

constexpr int D = 1024, NB = 4, SEQ = 8192, DB = 8, DT = 16, PAST = 4096;
constexpr int MP = NB * SEQ;
constexpr int MS = DB * DT;
constexpr int MR = MP + MS;
constexpr int M = 33024;
constexpr int LW = 512, NLB = 8, LBW = 64;
constexpr int KVW = 128;
constexpr int DIN = 2376, NIN = 2560;
constexpr int DFF = 2816;
constexpr int SKEYS = PAST + DT;
constexpr float EPS = 1e-6f;
constexpr float WI_SCALE = 0.044194173824159216f;

constexpr size_t O_YP = 0;
constexpr size_t O_YS = O_YP + (size_t)MP * D;
constexpr size_t O_KP = O_YS + (size_t)MS * D;
constexpr size_t O_VP = O_KP + (size_t)MP * KVW;
constexpr size_t O_KIP = O_VP + (size_t)MP * KVW;
constexpr size_t O_HP = O_KIP + (size_t)MP * 64;
constexpr size_t O_CP = O_HP + (size_t)NB * LW;
constexpr size_t O_KS = O_CP + (size_t)NB * 3 * LW;
constexpr size_t O_VS = O_KS + (size_t)MS * KVW;
constexpr size_t O_KIS = O_VS + (size_t)MS * KVW;
constexpr size_t O_HS = O_KIS + (size_t)MS * 64;
constexpr size_t O_CS = O_HS + (size_t)DB * LW;
constexpr size_t O_END = O_CS + (size_t)DB * 3 * LW;
static_assert(O_END == 44236800, "output size");

constexpr size_t al256(size_t x) { return (x + 255) & ~(size_t)255; }
constexpr size_t WS_CTL = 0, CTL_BYTES = 1u << 20;
constexpr size_t WS_WIN = WS_CTL + CTL_BYTES;
constexpr size_t WS_WOUT = WS_WIN + al256((size_t)NIN * D * 2);
constexpr size_t WS_WFI = WS_WOUT + al256((size_t)D * D * 2);
constexpr size_t WS_WFO = WS_WFI + al256((size_t)2 * DFF * D * 2);
constexpr size_t WS_WG = WS_WFO + al256((size_t)D * DFF * 2);
constexpr size_t WS_RCOS = WS_WG + al256((size_t)2 * 8 * 64 * 64 * 2);
constexpr size_t WS_RSIN = WS_RCOS + al256((size_t)8192 * 32 * 4);
constexpr size_t WS_SP = WS_RSIN + al256((size_t)8192 * 32 * 4);
constexpr size_t WS_RSTD = WS_SP + al256(512 * 4);
constexpr size_t WS_SSQ = WS_RSTD + al256((size_t)M * 4);
constexpr size_t WS_WI = WS_SSQ + al256((size_t)M * 4);
constexpr size_t WS_AGG = WS_WI + al256((size_t)M * 8 * 4);
constexpr size_t WS_XB = WS_AGG + al256((size_t)12 * 64 * 512 * 8);
constexpr size_t WS_YC = WS_XB + al256((size_t)M * D * 2);
constexpr size_t WS_KB = WS_YC + al256((size_t)M * D * 2);
constexpr size_t WS_VB = WS_KB + al256((size_t)MP * KVW * 2);
constexpr size_t WS_KIB = WS_VB + al256((size_t)MP * KVW * 2);
constexpr size_t WS_KS = WS_KIB + al256((size_t)MP * 64 * 2);
constexpr size_t WS_VS = WS_KS + al256((size_t)DB * SKEYS * KVW * 2);
constexpr size_t WS_KIS = WS_VS + al256((size_t)DB * SKEYS * KVW * 2);
constexpr size_t WS_R1 = WS_KIS + al256((size_t)DB * SKEYS * 64 * 2);
constexpr size_t WS_XR = WS_R1;
constexpr size_t WS_GG = WS_XR + al256((size_t)M * LW * 2);
constexpr size_t WS_Q = WS_GG + al256((size_t)M * LW * 2);
constexpr size_t WS_QI = WS_Q + al256((size_t)M * LW * 2);
constexpr size_t WS_ACUM = WS_QI + al256((size_t)M * LW * 2);
constexpr size_t WS_BCUM = WS_ACUM + al256((size_t)M * LW * 4);
constexpr size_t WS_R1_END = WS_BCUM + al256((size_t)M * LW * 4);
constexpr size_t WS_H = WS_R1;
static_assert(WS_H + (size_t)M * DFF * 2 <= WS_R1_END, "H overlay fits");
constexpr size_t WS_END = WS_R1_END;

#ifndef DUPMASK
#define DUPMASK 0
#endif
#define DUP(k) ((DUPMASK >> (k)) & 1)
#ifndef USE_CG_SYNC
#define USE_CG_SYNC 0
#endif
constexpr int CW_BAR = 4096;
constexpr int LDSCTL_OFF = 131072 + 1024;
constexpr int LDS_BYTES = 147456;

#define LAS __attribute__((address_space(3)))
typedef unsigned short bf16;
typedef float f32x4 __attribute__((ext_vector_type(4)));
typedef float f32x2 __attribute__((ext_vector_type(2)));
typedef unsigned u32x4 __attribute__((ext_vector_type(4)));
typedef unsigned u32x2 __attribute__((ext_vector_type(2)));
typedef short bf16x8 __attribute__((ext_vector_type(8)));

__device__ __forceinline__ unsigned f2bf(float f) { unsigned u = __builtin_bit_cast(unsigned, f); return (u + 0x7fffu + ((u >> 16) & 1u)) >> 16; }
__device__ __forceinline__ unsigned pk2(float lo, float hi) { return f2bf(lo) | (f2bf(hi) << 16); }
__device__ __forceinline__ float bf2f(unsigned b) { return __builtin_bit_cast(float, b << 16); }
__device__ __forceinline__ float bflo(unsigned w) { return __builtin_bit_cast(float, w << 16); }
__device__ __forceinline__ float bfhi(unsigned w) { return __builtin_bit_cast(float, w & 0xffff0000u); }
__device__ __forceinline__ void store_bf16x8(bf16* p, f32x4 lo, f32x4 hi) {
    u32x4 w; w.x = pg8::cvt_pk_bf16(lo[0], lo[1]); w.y = pg8::cvt_pk_bf16(lo[2], lo[3]); w.z = pg8::cvt_pk_bf16(hi[0], hi[1]); w.w = pg8::cvt_pk_bf16(hi[2], hi[3]);
    *(u32x4*)p = w;
}
__device__ __forceinline__ float gelu_tanh(float x) {
    const float u = 0.7978845608028654f * (x + 0.044715f * x * x * x);
    const float e = __expf(2.0f * u);
    const float th = 1.0f - 2.0f / (e + 1.0f);
    return 0.5f * x * (1.0f + th);
}
__device__ __forceinline__ float sigmoidf_(float x) { return 1.0f / (1.0f + __expf(-x)); }

#define XB_TMO      128
#define XB_XCNT(j)  (256  + 64 * (j))
#define XB_XSUB(j)  (1280 + 64 * (j))
#define XB_XGEN(j)  (2304 + 64 * (j))
#define XB_TOP      3328
#define XB_TOPGEN   3392
#define XCD_BAR_WORDS 3456
#define XB_SPIN_CAP (1u << 18)

__device__ __forceinline__ unsigned xb_ld(unsigned* p)              { return __hip_atomic_load(p, __ATOMIC_RELAXED, __HIP_MEMORY_SCOPE_AGENT); }
__device__ __forceinline__ unsigned xb_add(unsigned* p, unsigned v) { return __hip_atomic_fetch_add(p, v, __ATOMIC_RELAXED, __HIP_MEMORY_SCOPE_AGENT); }
__device__ __forceinline__ unsigned xb_xcc_id() { return (unsigned)__builtin_amdgcn_s_getreg((3 << 11) | 20) & 0xFu; }
#define XB_SPIN(cond, bar) do { unsigned _sp = 0; while (cond) { __builtin_amdgcn_s_sleep(1); \
    if ((++_sp & 255u) == 0u) { if (xb_ld(&(bar)[XB_TMO])) break; if (_sp > XB_SPIN_CAP) { atomicAdd(&(bar)[XB_TMO], 1u); break; } } } } while (0)

struct XcdBarrier {
    unsigned* bar; unsigned x;
    volatile LAS unsigned* st;
};

__device__ __forceinline__ XcdBarrier xcd_barrier_post(unsigned* bar, volatile LAS unsigned* st) {
    XcdBarrier b; b.bar = bar; b.x = xb_xcc_id(); b.st = st;
    if (threadIdx.x == 0) (void)xb_add(&bar[XB_XCNT(b.x)], 1u);
    return b;
}
__device__ __forceinline__ void xcd_barrier_complete(unsigned* bar, unsigned x, unsigned& nloc, unsigned& nx) {
    const unsigned G = gridDim.x * gridDim.y * gridDim.z;
    unsigned sum, cnt, mine, sp = 0u;
    for (;;) {
        sum = 0u; cnt = 0u; mine = 0u;
#pragma unroll
        for (unsigned j = 0; j < 16; ++j) { const unsigned c = xb_ld(&bar[XB_XCNT(j)]); sum += c; cnt += (c > 0u) ? 1u : 0u; mine = (j == x) ? c : mine; }
        if (sum == G) break;
        __builtin_amdgcn_s_sleep(1);
        if ((++sp & 255u) == 0u) { if (xb_ld(&bar[XB_TMO])) break; if (sp > XB_SPIN_CAP) { atomicAdd(&bar[XB_TMO], 1u); break; } }
    }
    nloc = mine > 0u ? mine : 1u; nx = cnt > 0u ? cnt : 1u;
}

__device__ __forceinline__ void xcd_barrier(const XcdBarrier& b) {
    asm volatile("s_waitcnt vmcnt(0)" ::: "memory");
    __syncthreads();
    if (threadIdx.x == 0) {
        unsigned* bar = b.bar;
        __builtin_amdgcn_s_waitcnt(0);
        unsigned nloc = b.st[0], nx = b.st[1];
        if (nloc == 0u) { xcd_barrier_complete(bar, b.x, nloc, nx); b.st[0] = nloc; b.st[1] = nx; }
        const unsigned old = xb_add(&bar[XB_XSUB(b.x)], 1u);
        const unsigned gen = old / nloc;
        if (old + 1u == (gen + 1u) * nloc) {
            __builtin_amdgcn_fence(__ATOMIC_RELEASE, "agent");
            asm volatile("s_waitcnt vmcnt(0)" ::: "memory");
            const unsigned og = xb_add(&bar[XB_TOP], 1u);
            const unsigned tg = og / nx;
            if (og + 1u == (tg + 1u) * nx) xb_add(&bar[XB_TOPGEN], 1u);
            else XB_SPIN(xb_ld(&bar[XB_TOPGEN]) == tg, bar);
            __builtin_amdgcn_fence(__ATOMIC_ACQUIRE, "agent");
            xb_add(&bar[XB_XGEN(b.x)], 1u);
            asm volatile("s_waitcnt vmcnt(0)" ::: "memory");
        } else {
            XB_SPIN(xb_ld(&bar[XB_XGEN(b.x)]) == gen, bar);
            __builtin_amdgcn_fence(__ATOMIC_ACQUIRE, "agent");
            asm volatile("s_waitcnt vmcnt(0)" ::: "memory");
        }
    }
    __syncthreads();
}
struct EpiInProj {
    static constexpr bool PERM = false, AFTER_DRAIN = false;
    const float* rstd; const float* rcos; const float* rsin; const float* gq; const float* gk;
    bf16* XR; bf16* GG; bf16* Q; bf16* QI; bf16* KB; bf16* VB; bf16* KIB; bf16* KS; bf16* VS; bf16* KIS; float* WI; float* out;

    template <bool NORM> __device__ __forceinline__ void head_rope(f32x4 (&v)[2][2], const float* g, int pos, int fq) const {
        if (NORM) {
            float ss = 0.f;
#pragma unroll
            for (int bj = 0; bj < 2; ++bj)
#pragma unroll
                for (int n = 0; n < 2; ++n) ss += (v[bj][n][0] * v[bj][n][0] + v[bj][n][1] * v[bj][n][1]) + (v[bj][n][2] * v[bj][n][2] + v[bj][n][3] * v[bj][n][3]);
            ss += __shfl_xor(ss, 16); ss += __shfl_xor(ss, 32);
            const float inv = rsqrtf(ss * (1.0f / 64.0f) + EPS);
#pragma unroll
            for (int bj = 0; bj < 2; ++bj)
#pragma unroll
                for (int n = 0; n < 2; ++n) { const f32x4 g4 = *(const f32x4*)(g + 32 * bj + 8 * fq + 4 * n); v[bj][n] = v[bj][n] * inv * g4; }
        }
#pragma unroll
        for (int n = 0; n < 2; ++n) {
            const f32x4 c4 = *(const f32x4*)(rcos + pos * 32 + 8 * fq + 4 * n), s4 = *(const f32x4*)(rsin + pos * 32 + 8 * fq + 4 * n);
            const f32x4 x1 = v[0][n], x2 = v[1][n];
            v[0][n] = x1 * c4 - x2 * s4; v[1][n] = x2 * c4 + x1 * s4;
        }
    }
    __device__ __forceinline__ void operator()(const f32x4 (&acc)[2][2][4][2], const pg8::Unit& u, int wr, int wc, int fr, int fq) const {
        const int pn = u.pn;
#pragma unroll
        for (int ai = 0; ai < 2; ++ai) {
            const int rbase = u.pm * 256 + ai * 128;
            if (rbase >= MR) continue;
            const bool samp = rbase >= MP;
#pragma unroll
            for (int m = 0; m < 4; ++m) {
                const int r = rbase + wr * 64 + m * 16 + fr;
                int sb, t, pos;
                if (!samp) { sb = r >> 13; t = r & 8191; pos = t; } else { const int rs = r - MP; sb = rs >> 4; t = rs & 15; pos = PAST + t; }
                const float rsd = rstd[r];
                f32x4 v[2][2];
#pragma unroll
                for (int bj = 0; bj < 2; ++bj)
#pragma unroll
                    for (int n = 0; n < 2; ++n) v[bj][n] = acc[ai][bj][m][n] * rsd;
                if (pn < 2) {
#pragma unroll
                    for (int bj = 0; bj < 2; ++bj) {
                        const int c = 256 * pn + 64 * wc + 32 * bj + 8 * fq;
                        store_bf16x8(XR + (size_t)r * LW + c, v[bj][0], v[bj][1]);
                        const int tl = samp ? DT - 3 : SEQ - 3;
                        if (t >= tl) {
                            float* o = samp ? out + O_CS + ((size_t)(sb * 3 + (t - tl))) * LW + c : out + O_CP + ((size_t)(sb * 3 + (t - tl))) * LW + c;
                            *(f32x4*)o = v[bj][0]; *(f32x4*)(o + 4) = v[bj][1];
                        }
                    }
                } else if (pn < 4) {
#pragma unroll
                    for (int bj = 0; bj < 2; ++bj) {
                        const int c = 256 * (pn - 2) + 64 * wc + 32 * bj + 8 * fq;
                        f32x4 a = v[bj][0], b = v[bj][1];
#pragma unroll
                        for (int j = 0; j < 4; ++j) { a[j] = gelu_tanh(a[j]); b[j] = gelu_tanh(b[j]); }
                        store_bf16x8(GG + (size_t)r * LW + c, a, b);
                    }
                } else if (pn < 6) {
                    head_rope<true>(v, gq, pos, fq);
                    const int head = 4 * (pn - 4) + wc;
#pragma unroll
                    for (int bj = 0; bj < 2; ++bj) store_bf16x8(Q + (size_t)r * 512 + head * 64 + 32 * bj + 8 * fq, v[bj][0], v[bj][1]);
                } else if (pn == 6) {
                    if (wc < 2) head_rope<true>(v, gk, pos, fq);
                    const int hh = wc & 1;
                    float* of; bf16* ob;
                    if (wc < 2) { of = samp ? out + O_KS + (size_t)(r - MP) * KVW : out + O_KP + (size_t)r * KVW; ob = samp ? KS + ((size_t)sb * SKEYS + PAST + t) * KVW : KB + (size_t)r * KVW; }
                    else        { of = samp ? out + O_VS + (size_t)(r - MP) * KVW : out + O_VP + (size_t)r * KVW; ob = samp ? VS + ((size_t)sb * SKEYS + PAST + t) * KVW : VB + (size_t)r * KVW; }
#pragma unroll
                    for (int bj = 0; bj < 2; ++bj) {
                        const int c = hh * 64 + 32 * bj + 8 * fq;
                        *(f32x4*)(of + c) = v[bj][0]; *(f32x4*)(of + c + 4) = v[bj][1];
                        store_bf16x8(ob + c, v[bj][0], v[bj][1]);
                    }
                } else if (pn < 9) {
                    head_rope<false>(v, nullptr, pos, fq);
                    const int head = 4 * (pn - 7) + wc;
#pragma unroll
                    for (int bj = 0; bj < 2; ++bj) store_bf16x8(QI + (size_t)r * 512 + head * 64 + 32 * bj + 8 * fq, v[bj][0], v[bj][1]);
                } else {
                    if (wc == 0) {
                        head_rope<false>(v, nullptr, pos, fq);
                        float* of = samp ? out + O_KIS + (size_t)(r - MP) * 64 : out + O_KIP + (size_t)r * 64;
                        bf16* ob = samp ? KIS + ((size_t)sb * SKEYS + PAST + t) * 64 : KIB + (size_t)r * 64;
#pragma unroll
                        for (int bj = 0; bj < 2; ++bj) {
                            const int c = 32 * bj + 8 * fq;
                            *(f32x4*)(of + c) = v[bj][0]; *(f32x4*)(of + c + 4) = v[bj][1];
                            store_bf16x8(ob + c, v[bj][0], v[bj][1]);
                        }
                    } else if (wc == 1) {
                        if (fq == 0) { *(f32x4*)(WI + (size_t)r * 8) = v[0][0] * WI_SCALE; *(f32x4*)(WI + (size_t)r * 8 + 4) = v[0][1] * WI_SCALE; }
                    }
                }
            }
        }
    }
};

struct EpiOutProj {
    static constexpr bool PERM = false, AFTER_DRAIN = false;
    const float* xp; const float* xs; float* out; bf16* XB2; float* ssq;
    __device__ __forceinline__ void operator()(const f32x4 (&acc)[2][2][4][2], const pg8::Unit& u, int wr, int wc, int fr, int fq) const {
        const int col0 = u.pn * 256 + wc * 32 + 4 * fq;
#pragma unroll
        for (int ai = 0; ai < 2; ++ai) {
            const int rbase = u.pm * 256 + ai * 128;
            if (rbase >= MR) continue;
            const bool samp = rbase >= MP;
#pragma unroll
            for (int m = 0; m < 4; ++m) {
                const int r = rbase + wr * 64 + m * 16 + fr;
                const float* xrow = samp ? xs + (size_t)(r - MP) * D : xp + (size_t)r * D;
                float* yrow = samp ? out + O_YS + (size_t)(r - MP) * D : out + O_YP + (size_t)r * D;
                float ss = 0.f;
#pragma unroll
                for (int bj = 0; bj < 2; ++bj)
#pragma unroll
                    for (int n = 0; n < 2; ++n) {
                        const int c = col0 + bj * 128 + n * 16;
                        const f32x4 y = *(const f32x4*)(xrow + c) + acc[ai][bj][m][n];
                        *(f32x4*)(yrow + c) = y;
                        ss += (y[0] * y[0] + y[1] * y[1]) + (y[2] * y[2] + y[3] * y[3]);
                        u32x2 w; w.x = pg8::cvt_pk_bf16(y[0], y[1]); w.y = pg8::cvt_pk_bf16(y[2], y[3]);
                        *(u32x2*)(XB2 + (size_t)r * D + c) = w;
                    }
                ss += __shfl_xor(ss, 16); ss += __shfl_xor(ss, 32);
                if (fq == 0) atomicAdd(ssq + r, ss);
            }
        }
    }
};

struct EpiFfnIn {
    static constexpr bool PERM = false, AFTER_DRAIN = false;
    const float* ssq; bf16* H;
    __device__ __forceinline__ void operator()(const f32x4 (&acc)[2][2][4][2], const pg8::Unit& u, int wr, int wc, int fr, int fq) const {
        const int c = 128 * u.pn + 32 * wc + 8 * fq;
#pragma unroll
        for (int ai = 0; ai < 2; ++ai) {
            const int rbase = u.pm * 256 + ai * 128;
            if (rbase >= MR) continue;
#pragma unroll
            for (int m = 0; m < 4; ++m) {
                const int r = rbase + wr * 64 + m * 16 + fr;
                const float rs2 = rsqrtf(ssq[r] * (1.0f / 1024.0f) + EPS);
                f32x4 h[2];
#pragma unroll
                for (int n = 0; n < 2; ++n) {
                    const f32x4 g = acc[ai][0][m][n] * rs2, up = acc[ai][1][m][n] * rs2;
#pragma unroll
                    for (int j = 0; j < 4; ++j) h[n][j] = g[j] * sigmoidf_(g[j]) * up[j];
                }
                store_bf16x8(H + (size_t)r * DFF + c, h[0], h[1]);
            }
        }
    }
};

struct EpiFfnOut {
    static constexpr bool PERM = false, AFTER_DRAIN = false;
    float* out;
    __device__ __forceinline__ void operator()(const f32x4 (&acc)[2][2][4][2], const pg8::Unit& u, int wr, int wc, int fr, int fq) const {
        const int col0 = u.pn * 256 + wc * 32 + 4 * fq;
#pragma unroll
        for (int ai = 0; ai < 2; ++ai) {
            const int rbase = u.pm * 256 + ai * 128;
            if (rbase >= MR) continue;
            const bool samp = rbase >= MP;
#pragma unroll
            for (int m = 0; m < 4; ++m) {
                const int r = rbase + wr * 64 + m * 16 + fr;
                float* yrow = samp ? out + O_YS + (size_t)(r - MP) * D : out + O_YP + (size_t)r * D;
#pragma unroll
                for (int bj = 0; bj < 2; ++bj)
#pragma unroll
                    for (int n = 0; n < 2; ++n) { const int c = col0 + bj * 128 + n * 16; *(f32x4*)(yrow + c) = *(const f32x4*)(yrow + c) + acc[ai][bj][m][n]; }
            }
        }
    }
};

struct Params {
    const float* in[22];
    float* out;
    unsigned char* ws;
    double invf[32];
    int ph_lo, ph_hi;
};
enum { I_XP = 0, I_XS, I_CK, I_CV, I_CKI, I_SH, I_SC, I_NM, I_WIN, I_CW, I_CB, I_WRG, I_BRG, I_WIG, I_BIG, I_LAM, I_QN, I_KN, I_WOUT, I_NF, I_WFI, I_WFO };

struct Frame { LAS unsigned char* lds; int tid, lane, wave, G, bid; };

__device__ __forceinline__ float wave_sum(float v) {
#pragma unroll
    for (int o = 1; o < 64; o <<= 1) v += __shfl_xor(v, o);
    return v;
}

__device__ __forceinline__ void transpose_item(const float* W, int K, int N, int nvalid, const float* gain, bf16* WT, int k0, int row0, int lcol0, bool perm, LAS float* scr, int lane) {
#pragma unroll 8
    for (int i = 0; i < 32; ++i) {
        const int kk = 2 * i + (lane >> 5), col = lcol0 + (lane & 31);
        float v = 0.f;
        if (col < nvalid) { v = W[(size_t)(k0 + kk) * N + col]; if (gain) v *= gain[k0 + kk]; }
        scr[kk * 33 + (lane & 31)] = v;
    }
    asm volatile("s_waitcnt lgkmcnt(0)" ::: "memory");
    const int c = lane & 7;
#pragma unroll
    for (int j = 0; j < 4; ++j) {
        const int n = (lane >> 3) + 8 * j, src = perm ? pg8::perm32(n) : n;
        const LAS float* s = scr + (8 * c) * 33 + src;
        u32x4 o; o.x = pk2(s[0 * 33], s[1 * 33]); o.y = pk2(s[2 * 33], s[3 * 33]); o.z = pk2(s[4 * 33], s[5 * 33]); o.w = pk2(s[6 * 33], s[7 * 33]);
        *(u32x4*)(WT + (size_t)(row0 + n) * K + k0 + 8 * c) = o;
    }
    asm volatile("s_waitcnt lgkmcnt(0)" ::: "memory");
}

__device__ __forceinline__ void phase0(const Params& p, Frame& F) {
    unsigned char* ws = p.ws;
    LAS float* scr = (LAS float*)(F.lds + F.wave * 16384);
    const int gw = F.bid * 8 + F.wave, NGW = F.G * 8;
    constexpr int I_IN = 16 * (NIN / 32), I_OUT = 16 * (D / 32), I_FI = 16 * (2 * DFF / 32), I_FO = (DFF / 64) * (D / 32);
    constexpr int NITEMS = I_IN + I_OUT + I_FI + I_FO;
    for (int it = gw; it < NITEMS; it += NGW) {
        int r = it;
        if (r < I_IN) { const int kb = r / (NIN / 32), g = r % (NIN / 32), pn = g >> 3, sub = g & 7, bj = sub >> 2, wc = sub & 3;
            transpose_item(p.in[I_WIN], D, DIN, DIN, p.in[I_NM], (bf16*)(ws + WS_WIN), 64 * kb, 32 * g, 256 * pn + 64 * wc + 32 * bj, true, scr, F.lane); continue; }
        r -= I_IN;
        if (r < I_OUT) { const int kb = r / (D / 32), g = r % (D / 32);
            transpose_item(p.in[I_WOUT], D, D, D, nullptr, (bf16*)(ws + WS_WOUT), 64 * kb, 32 * g, 32 * g, false, scr, F.lane); continue; }
        r -= I_OUT;
        if (r < I_FI) { const int kb = r / (2 * DFF / 32), g = r % (2 * DFF / 32), pn = g >> 3, sub = g & 7, bj = sub >> 2, wc = sub & 3;
            transpose_item(p.in[I_WFI], D, 2 * DFF, 2 * DFF, p.in[I_NF], (bf16*)(ws + WS_WFI), 64 * kb, 32 * g, (bj ? DFF : 0) + 128 * pn + 32 * wc, true, scr, F.lane); continue; }
        r -= I_FI;
        { const int kb = r / (D / 32), g = r % (D / 32);
            transpose_item(p.in[I_WFO], DFF, D, D, nullptr, (bf16*)(ws + WS_WFO), 64 * kb, 32 * g, 32 * g, false, scr, F.lane); }
    }
    {
        bf16* XB = (bf16*)(ws + WS_XB); float* rstd = (float*)(ws + WS_RSTD);
        for (int m = gw; m < M; m += NGW) {
            unsigned long long* o8 = (unsigned long long*)(XB + (size_t)m * D) + F.lane;
            if (m >= MR) {
#pragma unroll
                for (int j = 0; j < 4; ++j) o8[64 * j] = 0ull;
                if (F.lane == 0) rstd[m] = 0.f;
                continue;
            }
            const float* xrow = (m < MP) ? p.in[I_XP] + (size_t)m * D : p.in[I_XS] + (size_t)(m - MP) * D;
            const f32x4* xr = (const f32x4*)xrow + F.lane;
            f32x4 v[4]; float s = 0.f;
#pragma unroll
            for (int j = 0; j < 4; ++j) { v[j] = xr[64 * j]; s += (v[j][0] * v[j][0] + v[j][1] * v[j][1]) + (v[j][2] * v[j][2] + v[j][3] * v[j][3]); }
            s = wave_sum(s);
            if (F.lane == 0) rstd[m] = rsqrtf(s * (1.0f / D) + EPS);
#pragma unroll
            for (int j = 0; j < 4; ++j) o8[64 * j] = (unsigned long long)pk2(v[j][0], v[j][1]) | ((unsigned long long)pk2(v[j][2], v[j][3]) << 32);
        }
    }
    const size_t gt = (size_t)F.bid * 512 + F.tid, GS = (size_t)F.G * 512;
    {
        bf16* KS = (bf16*)(ws + WS_KS); bf16* VS = (bf16*)(ws + WS_VS); bf16* KIS = (bf16*)(ws + WS_KIS);
        constexpr size_t NKV8 = (size_t)DB * PAST * KVW / 8, NKI8 = (size_t)DB * PAST * 64 / 8;
        for (size_t i = gt; i < 2 * NKV8 + NKI8; i += GS) {
            const float* src; bf16* dst; size_t e;
            if (i < NKV8) { e = i * 8; const size_t b = e / ((size_t)PAST * KVW), rem = e % ((size_t)PAST * KVW); src = p.in[I_CK] + e; dst = KS + b * SKEYS * KVW + rem; }
            else if (i < 2 * NKV8) { e = (i - NKV8) * 8; const size_t b = e / ((size_t)PAST * KVW), rem = e % ((size_t)PAST * KVW); src = p.in[I_CV] + e; dst = VS + b * SKEYS * KVW + rem; }
            else { e = (i - 2 * NKV8) * 8; const size_t b = e / ((size_t)PAST * 64), rem = e % ((size_t)PAST * 64); src = p.in[I_CKI] + e; dst = KIS + b * SKEYS * 64 + rem; }
            const f32x4 a = *(const f32x4*)src, b4 = *(const f32x4*)(src + 4);
            u32x4 w; w.x = pk2(a[0], a[1]); w.y = pk2(a[2], a[3]); w.z = pk2(b4[0], b4[1]); w.w = pk2(b4[2], b4[3]);
            *(u32x4*)dst = w;
        }
    }
    {
        float* rc = (float*)(ws + WS_RCOS); float* rsn = (float*)(ws + WS_RSIN);
        for (size_t i = gt; i < (size_t)8192 * 32; i += GS) {
            const int pos = (int)(i >> 5), fi = (int)(i & 31);
            const double ang = (double)pos * p.invf[fi];
            const double kq = rint(ang * 0.63661977236758134308);
            double r = fma(-kq, 1.57079632679489655800e+00, ang); r = fma(-kq, 6.12323399573676603587e-17, r);
            const double r2 = r * r;
            double sn = -1.0 / 1307674368000.0; sn = sn * r2 + 1.0 / 6227020800.0; sn = sn * r2 - 1.0 / 39916800.0; sn = sn * r2 + 1.0 / 362880.0; sn = sn * r2 - 1.0 / 5040.0; sn = sn * r2 + 1.0 / 120.0; sn = sn * r2 - 1.0 / 6.0; sn = sn * r2 + 1.0; sn *= r;
            double cs = 1.0 / 20922789888000.0; cs = cs * r2 - 1.0 / 87178291200.0; cs = cs * r2 + 1.0 / 479001600.0; cs = cs * r2 - 1.0 / 3628800.0; cs = cs * r2 + 1.0 / 40320.0; cs = cs * r2 - 1.0 / 720.0; cs = cs * r2 + 1.0 / 24.0; cs = cs * r2 - 0.5; cs = cs * r2 + 1.0;
            const int q = (int)((long long)kq & 3);
            const double sv = (q == 0) ? sn : (q == 1) ? cs : (q == 2) ? -sn : -cs;
            const double cv = (q == 0) ? cs : (q == 1) ? -sn : (q == 2) ? -cs : sn;
            rc[i] = (float)cv; rsn[i] = (float)sv;
        }
    }
    {
        float* ssq = (float*)(ws + WS_SSQ);
        for (size_t i = gt; i < (size_t)M; i += GS) ssq[i] = 0.f;
        float* sp = (float*)(ws + WS_SP);
        for (size_t i = gt; i < 512; i += GS) sp[i] = log1pf(__expf(-p.in[I_LAM][i]));
        bf16* WG = (bf16*)(ws + WS_WG);
        for (size_t i = gt; i < (size_t)2 * 8 * 64 * 64; i += GS) {
            const int ii = (int)(i & 63), j = (int)((i >> 6) & 63), nb = (int)((i >> 12) & 7), gsel = (int)(i >> 15);
            const float* W = gsel ? p.in[I_WIG] : p.in[I_WRG];
            WG[i] = (bf16)f2bf(W[(nb * 64 + ii) * 64 + j]);
        }
    }
}

constexpr int S_XS = 0, S_XC = 34816, S_XCB = S_XC + 32768, S_BT = S_XCB + 18432, S_AGS = S_BT + 32768;
static_assert(S_AGS + 4096 <= 131072, "scan LDS map");
__device__ __forceinline__ void scan_local_unit(const Params& p, Frame& F, int sbi  , int nb, int sg) {
    unsigned char* ws = p.ws;
    const bool samp = sbi >= NB; const int b = samp ? sbi - NB : sbi;
    const int T = samp ? DT : 128, t0 = samp ? 0 : sg * 128;
    const size_t r0 = samp ? (size_t)MP + b * DT : (size_t)b * SEQ + t0;
    const bf16* XR = (const bf16*)(ws + WS_XR);
    LAS float* xs = (LAS float*)(F.lds + S_XS); LAS float* xc = (LAS float*)(F.lds + S_XC); LAS bf16* xcb = (LAS bf16*)(F.lds + S_XCB);
    LAS float* bt = (LAS float*)(F.lds + S_BT); LAS float* av = xs; LAS f32x2* ags = (LAS f32x2*)(F.lds + S_AGS);
    const int tid = F.tid;
    for (int idx = tid; idx < (T + 3) * 64; idx += 512) {
        const int tt = idx >> 6, c = idx & 63, t = t0 - 3 + tt;
        float v;
        if (t >= 0) v = bf2f(XR[(r0 + tt - 3) * LW + nb * 64 + c]);
        else v = samp ? p.in[I_SC][((size_t)b * 3 + tt) * LW + nb * 64 + c] : 0.f;
        xs[tt * 64 + c] = v;
    }
    __syncthreads();
    {
        const int c = tid & 63; const int ch = nb * 64 + c;
        const float cb = p.in[I_CB][ch], w0 = p.in[I_CW][ch], w1 = p.in[I_CW][LW + ch], w2 = p.in[I_CW][2 * LW + ch], w3 = p.in[I_CW][3 * LW + ch];
        for (int t = tid >> 6; t < T; t += 8) {
            const float v = cb + w0 * xs[t * 64 + c] + w1 * xs[(t + 1) * 64 + c] + w2 * xs[(t + 2) * 64 + c] + w3 * xs[(t + 3) * 64 + c];
            xc[t * 64 + c] = v; xcb[t * 72 + c] = (bf16)f2bf(v);
        }
    }
    __syncthreads();
    if (F.wave * 16 < T) {
        const int row = F.lane & 15, kq = F.lane >> 4;
        const bf16x8 A0 = *(const LAS bf16x8*)(xcb + (F.wave * 16 + row) * 72 + 8 * kq), A1 = *(const LAS bf16x8*)(xcb + (F.wave * 16 + row) * 72 + 32 + 8 * kq);
        const bf16* WG = (const bf16*)(ws + WS_WG); const float* sp = (const float*)(ws + WS_SP);
#pragma unroll
        for (int jt = 0; jt < 4; ++jt) {
            const int j = 16 * jt + row, ch = nb * 64 + j;
            const bf16* wr_ = WG + ((size_t)(0 * 8 + nb) * 64 + j) * 64; const bf16* wi_ = WG + ((size_t)(1 * 8 + nb) * 64 + j) * 64;
            f32x4 ar = {0.f, 0.f, 0.f, 0.f}, ai = {0.f, 0.f, 0.f, 0.f};
            ar = __builtin_amdgcn_mfma_f32_16x16x32_bf16(A0, *(const bf16x8*)(wr_ + 8 * kq), ar, 0, 0, 0);
            ar = __builtin_amdgcn_mfma_f32_16x16x32_bf16(A1, *(const bf16x8*)(wr_ + 32 + 8 * kq), ar, 0, 0, 0);
            ai = __builtin_amdgcn_mfma_f32_16x16x32_bf16(A0, *(const bf16x8*)(wi_ + 8 * kq), ai, 0, 0, 0);
            ai = __builtin_amdgcn_mfma_f32_16x16x32_bf16(A1, *(const bf16x8*)(wi_ + 32 + 8 * kq), ai, 0, 0, 0);
            const float brg = p.in[I_BRG][ch], big = p.in[I_BIG][ch], spv = sp[ch];
#pragma unroll
            for (int ii = 0; ii < 4; ++ii) {
                const int t = F.wave * 16 + 4 * kq + ii;
                const float rg = sigmoidf_(ar[ii] + brg), ig = sigmoidf_(ai[ii] + big);
                const float la = -8.0f * rg * spv;
                const float a = __expf(la);
                const float mult = (!samp && (t0 + t) == 0) ? 1.0f : sqrtf(-expm1f(2.0f * la));
                av[t * 64 + j] = a; bt[t * 64 + j] = mult * ig * xc[t * 64 + j];
            }
        }
    }
    __syncthreads();
    const int c = tid & 63, sub = tid >> 6; const bool act = sub * 16 < T;
    if (act) {
        float Ac = 1.f, Bc = 0.f;
        for (int t = sub * 16; t < sub * 16 + 16; ++t) { const float a = av[t * 64 + c], bb = bt[t * 64 + c]; Bc = a * Bc + bb; Ac = Ac * a; av[t * 64 + c] = Ac; bt[t * 64 + c] = Bc; }
        ags[sub * 64 + c] = (f32x2){Ac, Bc};
    }
    __syncthreads();
    if (act) {
        float Ap = 1.f, Bp = 0.f;
        for (int s2 = 0; s2 < sub; ++s2) { const f32x2 g = ags[s2 * 64 + c]; Bp = g.x * Bp + g.y; Ap = Ap * g.x; }
        float* ACUM = (float*)(ws + WS_ACUM); float* BCUM = (float*)(ws + WS_BCUM);
        float ac = 0.f, bc = 0.f;
        for (int t = sub * 16; t < sub * 16 + 16; ++t) {
            const float al = av[t * 64 + c]; ac = al * Ap; bc = al * Bp + bt[t * 64 + c];
            ACUM[(r0 + t) * LW + nb * 64 + c] = ac; BCUM[(r0 + t) * LW + nb * 64 + c] = bc;
        }
        if (sub * 16 + 16 == T) ((f32x2*)(ws + WS_AGG))[((size_t)sbi * 64 + sg) * LW + nb * 64 + c] = (f32x2){ac, bc};
    }
    __syncthreads();
}

__device__ __forceinline__ void scan_apply_unit(const Params& p, Frame& F, int sbi, int sg) {
    unsigned char* ws = p.ws;
    const bool samp = sbi >= NB; const int b = samp ? sbi - NB : sbi;
    const int T = samp ? DT : 128;
    const size_t r0 = samp ? (size_t)MP + b * DT : (size_t)b * SEQ + sg * 128;
    const int ch = F.tid;
    float h = samp ? p.in[I_SH][b * LW + ch] : 0.f;
    const f32x2* AGG = (const f32x2*)(ws + WS_AGG) + (size_t)sbi * 64 * LW + ch;
    for (int s2 = 0; s2 < sg; ++s2) { const f32x2 g = AGG[(size_t)s2 * LW]; h = g.x * h + g.y; }
    const float* ACUM = (const float*)(ws + WS_ACUM) + r0 * LW + ch; const float* BCUM = (const float*)(ws + WS_BCUM) + r0 * LW + ch;
    const bf16* GG = (const bf16*)(ws + WS_GG) + r0 * LW + ch; bf16* YC = (bf16*)(ws + WS_YC) + r0 * D + ch;
    float ht = 0.f;
#pragma unroll 8
    for (int t = 0; t < T; ++t) {
        ht = ACUM[(size_t)t * LW] * h + BCUM[(size_t)t * LW];
        YC[(size_t)t * D] = (bf16)f2bf(ht * bf2f(GG[(size_t)t * LW]));
    }
    if (samp) p.out[O_HS + b * LW + ch] = ht;
    else if (sg == 63) p.out[O_HP + b * LW + ch] = ht;
}

constexpr int A_CAND = 0, A_CNT = 131072, A_THR = 131072 + 128, A_FLAG = 131072 + 256, CAP = 1024;
constexpr int VPITCH = 288;
extern "C" __device__ unsigned __ockl_wfred_max_u32(unsigned);
extern "C" __device__ unsigned __ockl_wfred_min_u32(unsigned);
typedef short v4i16_t __attribute__((ext_vector_type(4)));

__device__ __forceinline__ unsigned pack_key(float s, int key) {
    unsigned u = __float_as_uint(s);
    u = (u & 0x80000000u) ? ~u : (u | 0x80000000u);
    return (u & 0xFFFFE000u) | (unsigned)(8191 - key);
}
__device__ __forceinline__ unsigned select256(LAS unsigned* cq, int n, int lane) {
    unsigned e[16]; unsigned mx = 0u, mn = 0xFFFFFFFFu;
#pragma unroll
    for (int i = 0; i < 16; ++i) { const int idx = i * 64 + lane; const bool v = idx < n; const unsigned x = v ? cq[idx] : 0u; e[i] = x; mx = x > mx ? x : mx; const unsigned y = v ? x : 0xFFFFFFFFu; mn = y < mn ? y : mn; }
    unsigned lo = (unsigned)__builtin_amdgcn_readfirstlane((int)__ockl_wfred_min_u32(mn));
    unsigned hi = (unsigned)__builtin_amdgcn_readfirstlane((int)__ockl_wfred_max_u32(mx)); hi = hi == 0xFFFFFFFFu ? hi : hi + 1u;
    int clo = n;
    for (int it = 0; it < 40 && clo != 256; ++it) {
        const unsigned piv = lo + ((hi - lo) >> 1);
        int c = 0;
#pragma unroll
        for (int i = 0; i < 16; ++i) c += __popcll(__ballot(e[i] >= piv));
        if (c >= 256) { lo = piv; clo = c; } else hi = piv;
    }
    int base = 0;
#pragma unroll
    for (int i = 0; i < 16; ++i) {
        const bool keep = e[i] >= lo; const unsigned long long mk = __ballot(keep);
        const int pos = base + (int)__builtin_amdgcn_mbcnt_hi((unsigned)(mk >> 32), __builtin_amdgcn_mbcnt_lo((unsigned)mk, 0u));
        if (keep && pos < 256) cq[pos] = e[i];
        base += __popcll(mk);
    }
    return lo;
}

__device__ __forceinline__ void attn_unit(const Params& p, Frame& F, size_t q0row, int nq, int L, const bf16* KI, const bf16* Kb, const bf16* Vb) {
    unsigned char* ws = p.ws;
    const bf16* QI = (const bf16*)(ws + WS_QI); const bf16* Qb = (const bf16*)(ws + WS_Q); const float* WI = (const float*)(ws + WS_WI); bf16* YC = (bf16*)(ws + WS_YC);
    LAS unsigned* cand = (LAS unsigned*)(F.lds + A_CAND); LAS unsigned* cntp = (LAS unsigned*)(F.lds + A_CNT); LAS unsigned* thrp = (LAS unsigned*)(F.lds + A_THR);
    LAS unsigned* flagp = (LAS unsigned*)(F.lds + A_FLAG);
    const int lane = F.lane, wid = F.wave, qc = lane & 15, kq = lane >> 4;
    if (F.tid < 32) { cntp[F.tid] = 0u; thrp[F.tid] = 0u; }
    if (F.tid == 32) { flagp[0] = 0u; flagp[1] = 0u; }
    const int nsub = nq >> 4, nslots = (nsub == 2) ? 4 : 8, slot = (nsub == 2) ? (wid & 3) : wid, sub = (nsub == 2) ? (wid >> 2) : 0;
    const int ql = sub * 16 + qc;
    bf16x8 Bq[8][2]; float sinf_[8];
    {
        const size_t qrow = q0row + ql;
#pragma unroll
        for (int h = 0; h < 8; ++h) {
            const float w = WI[qrow * 8 + h];
            sinf_[h] = (w < 0.f) ? -INFINITY : INFINITY;
#pragma unroll
            for (int s = 0; s < 2; ++s) {
                const u32x4 raw = *(const u32x4*)(QI + qrow * 512 + h * 64 + 32 * s + 8 * kq);
                u32x4 o; o.x = pk2(bflo(raw.x) * w, bfhi(raw.x) * w); o.y = pk2(bflo(raw.y) * w, bfhi(raw.y) * w); o.z = pk2(bflo(raw.z) * w, bfhi(raw.z) * w); o.w = pk2(bflo(raw.w) * w, bfhi(raw.w) * w);
                Bq[h][s] = __builtin_bit_cast(bf16x8, o);
            }
        }
    }
    __syncthreads();
    for (int arep_ = 0; arep_ <= DUP(8); ++arep_) {
    if (arep_) { if (F.tid < 32) { cntp[F.tid] = 0u; thrp[F.tid] = 0u; } if (F.tid == 32) { flagp[0] = 0u; flagp[1] = 0u; } __syncthreads(); }
    const int ngroups = (L + 63) >> 6, nrounds = (ngroups + nslots - 1) / nslots;
    const unsigned limit = (unsigned)(CAP - nslots * 64);
    bf16x8 An[4][2];
    {
        const int gi = slot < ngroups ? slot : 0;
#pragma unroll
        for (int tl = 0; tl < 4; ++tl) { int arow = gi * 64 + tl * 16 + qc; arow = arow < L ? arow : L - 1;
            An[tl][0] = *(const bf16x8*)(KI + (size_t)arow * 64 + 8 * kq); An[tl][1] = *(const bf16x8*)(KI + (size_t)arow * 64 + 32 + 8 * kq); }
    }
    for (int it = 0; it < nrounds; ++it) {
        const int gi = it * nslots + slot;
        if (F.tid == 0) flagp[(it + 1) & 1] = 0u;
        if (gi < ngroups) {
            bf16x8 Ac[4][2];
#pragma unroll
            for (int tl = 0; tl < 4; ++tl) { Ac[tl][0] = An[tl][0]; Ac[tl][1] = An[tl][1]; }
            {
                int gn = gi + nslots; gn = gn < ngroups ? gn : gi;
#pragma unroll
                for (int tl = 0; tl < 4; ++tl) { int arow = gn * 64 + tl * 16 + qc; arow = arow < L ? arow : L - 1;
                    An[tl][0] = *(const bf16x8*)(KI + (size_t)arow * 64 + 8 * kq); An[tl][1] = *(const bf16x8*)(KI + (size_t)arow * 64 + 32 + 8 * kq); }
            }
            unsigned pk[16];
#pragma unroll
            for (int tl = 0; tl < 4; ++tl) {
                const int keybase = gi * 64 + tl * 16;
                f32x4 sc = {0.f, 0.f, 0.f, 0.f};
#pragma unroll
                for (int h = 0; h < 8; ++h) {
                    f32x4 acc = {0.f, 0.f, 0.f, 0.f};
                    acc = __builtin_amdgcn_mfma_f32_16x16x32_bf16(Ac[tl][0], Bq[h][0], acc, 0, 0, 0);
                    acc = __builtin_amdgcn_mfma_f32_16x16x32_bf16(Ac[tl][1], Bq[h][1], acc, 0, 0, 0);
#pragma unroll
                    for (int i = 0; i < 4; ++i) sc[i] += __builtin_amdgcn_fmed3f(acc[i], 0.f, sinf_[h]);
                }
#pragma unroll
                for (int i = 0; i < 4; ++i) { const int key = keybase + 4 * kq + i; pk[tl * 4 + i] = key < L ? pack_key(sc[i], key) : 0u; }
            }
            const unsigned thr = thrp[ql];
            int n = 0;
#pragma unroll
            for (int j = 0; j < 16; ++j) n += (pk[j] > thr) ? 1 : 0;
            if (n) {
                unsigned base = __hip_atomic_fetch_add(cntp + ql, (unsigned)n, __ATOMIC_RELAXED, __HIP_MEMORY_SCOPE_WORKGROUP);
                if (base + (unsigned)n > limit) flagp[it & 1] = 1u;
                LAS unsigned* cq = cand + ql * CAP;
#pragma unroll
                for (int j = 0; j < 16; ++j) if (pk[j] > thr) cq[base++] = pk[j];
            }
        }
        __syncthreads();
        if (flagp[it & 1]) {
#pragma unroll 1
            for (int i2 = 0; i2 < 4; ++i2) {
                const int qq = wid * 4 + i2;
                if (qq < nq) {
                    const unsigned n = (unsigned)__builtin_amdgcn_readfirstlane((int)cntp[qq]);
                    if (n > limit) { const unsigned T = select256(cand + qq * CAP, (int)n, lane); if (lane == 0) { cntp[qq] = 256u; thrp[qq] = T; } }
                }
            }
            __syncthreads();
        }
    }
    }
    const int wb = wid * 16384;
    LAS unsigned short* idx16 = (LAS unsigned short*)(F.lds + wb);
    LAS int* nsl = (LAS int*)(F.lds + wb + 2048);
    LAS unsigned char* vst = F.lds + wb + 2304;
    {
        unsigned ee[4][4]; int ns[4];
#pragma unroll
        for (int i2 = 0; i2 < 4; ++i2) {
            const int qq = wid * 4 + i2; int n = 0;
            if (qq < nq) {
                n = __builtin_amdgcn_readfirstlane((int)cntp[qq]);
                if (n > 256) { select256(cand + qq * CAP, n, lane); n = 256; }
            }
            ns[i2] = n;
        }
        asm volatile("s_waitcnt lgkmcnt(0)" ::: "memory");
#pragma unroll
        for (int i2 = 0; i2 < 4; ++i2)
#pragma unroll
            for (int m2 = 0; m2 < 4; ++m2) { const int k = lane + 64 * m2; ee[i2][m2] = (k < ns[i2]) ? cand[(wid * 4 + i2) * CAP + k] : 8191u; }
        asm volatile("s_waitcnt lgkmcnt(0)" ::: "memory");
#pragma unroll
        for (int i2 = 0; i2 < 4; ++i2) {
#pragma unroll
            for (int m2 = 0; m2 < 4; ++m2) idx16[i2 * 256 + lane + 64 * m2] = (unsigned short)(8191u - (ee[i2][m2] & 8191u));
            if (lane == 0) nsl[i2] = ns[i2];
        }
        asm volatile("s_waitcnt lgkmcnt(0)" ::: "memory");
    }
    for (int srep_ = 0; srep_ <= DUP(9); ++srep_)
#pragma unroll 1
    for (int i2 = 0; i2 < 4; ++i2) {
        const int n = __builtin_amdgcn_readfirstlane(nsl[i2]);
        if (n == 0) continue;
        const size_t qrow = q0row + wid * 4 + i2;
        const int h = lane & 15;
        const LAS unsigned short* ix = idx16 + i2 * 256;
        bf16x8 Bh[4];
#pragma unroll
        for (int s = 0; s < 4; ++s) {
            const bool v = (h < 8) && ((h >> 2) == (s >> 1));
            u32x4 raw = {0u, 0u, 0u, 0u};
            if (v) raw = *(const u32x4*)(Qb + qrow * 512 + h * 64 + 32 * (s & 1) + 8 * kq);
            Bh[s] = __builtin_bit_cast(bf16x8, raw);
        }
        float sc[64];
        bf16x8 Ka[2][4], Kn[2][4];
#pragma unroll
        for (int t2 = 0; t2 < 2; ++t2) { const bf16* kr = Kb + (size_t)ix[t2 * 16 + qc] * KVW + 8 * kq;
#pragma unroll
            for (int s = 0; s < 4; ++s) Kn[t2][s] = *(const bf16x8*)(kr + 32 * s); }
#pragma unroll
        for (int g2 = 0; g2 < 8; ++g2) {
#pragma unroll
            for (int t2 = 0; t2 < 2; ++t2)
#pragma unroll
                for (int s = 0; s < 4; ++s) Ka[t2][s] = Kn[t2][s];
            if (g2 < 7) {
#pragma unroll
                for (int t2 = 0; t2 < 2; ++t2) { const bf16* kr = Kb + (size_t)ix[(g2 + 1) * 32 + t2 * 16 + qc] * KVW + 8 * kq;
#pragma unroll
                    for (int s = 0; s < 4; ++s) Kn[t2][s] = *(const bf16x8*)(kr + 32 * s); }
            }
#pragma unroll
            for (int t2 = 0; t2 < 2; ++t2) {
                f32x4 acc = {0.f, 0.f, 0.f, 0.f};
#pragma unroll
                for (int s = 0; s < 4; ++s) acc = __builtin_amdgcn_mfma_f32_16x16x32_bf16(Ka[t2][s], Bh[s], acc, 0, 0, 0);
#pragma unroll
                for (int ii = 0; ii < 4; ++ii) { const int key = (g2 * 2 + t2) * 16 + 4 * kq + ii; sc[(g2 * 2 + t2) * 4 + ii] = key < n ? acc[ii] * 0.125f : -INFINITY; }
            }
            __builtin_amdgcn_sched_barrier(0);
        }
        float mx = sc[0];
#pragma unroll
        for (int j = 1; j < 64; ++j) mx = fmaxf(mx, sc[j]);
        mx = fmaxf(mx, __shfl_xor(mx, 16)); mx = fmaxf(mx, __shfl_xor(mx, 32));
        float sum = 0.f;
#pragma unroll
        for (int j = 0; j < 64; ++j) { sc[j] = __expf(sc[j] - mx); sum += sc[j]; }
        sum += __shfl_xor(sum, 16); sum += __shfl_xor(sum, 32);
        const float rl = 1.0f / sum;
        bf16x8 pb[8];
#pragma unroll
        for (int b = 0; b < 8; ++b) { u32x4 w; w.x = pk2(sc[b * 8 + 0], sc[b * 8 + 1]); w.y = pk2(sc[b * 8 + 2], sc[b * 8 + 3]); w.z = pk2(sc[b * 8 + 4], sc[b * 8 + 5]); w.w = pk2(sc[b * 8 + 6], sc[b * 8 + 7]); pb[b] = __builtin_bit_cast(bf16x8, w); }
        f32x4 oacc[8];
#pragma unroll
        for (int dt = 0; dt < 8; ++dt) oacc[dt] = (f32x4){0.f, 0.f, 0.f, 0.f};
        u32x4 vr[8];
#pragma unroll
        for (int i = 0; i < 8; ++i) { const int r = 4 * i + kq; vr[i] = *(const u32x4*)(Vb + (size_t)ix[r] * KVW + qc * 8); }
        const LAS unsigned char* trb = vst + (4 * kq + (qc >> 2)) * VPITCH + (qc & 3) * 8;
#pragma unroll
        for (int b = 0; b < 8; ++b) {
#pragma unroll
            for (int i = 0; i < 8; ++i) *(LAS u32x4*)(vst + (4 * i + kq) * VPITCH + qc * 16) = vr[i];
            if (b < 7) {
#pragma unroll
                for (int i = 0; i < 8; ++i) { const int r = 32 * (b + 1) + 4 * i + kq; vr[i] = *(const u32x4*)(Vb + (size_t)ix[r] * KVW + qc * 8); }
            }
            asm volatile("s_waitcnt lgkmcnt(0)" ::: "memory");
#pragma unroll
            for (int dt = 0; dt < 8; ++dt) {
                const v4i16_t lo = __builtin_amdgcn_ds_read_tr16_b64_v4i16((LAS v4i16_t*)(trb + dt * 32));
                const v4i16_t hi = __builtin_amdgcn_ds_read_tr16_b64_v4i16((LAS v4i16_t*)(trb + 16 * VPITCH + dt * 32));
                const bf16x8 Av = {lo[0], lo[1], lo[2], lo[3], hi[0], hi[1], hi[2], hi[3]};
                oacc[dt] = __builtin_amdgcn_mfma_f32_16x16x32_bf16(Av, pb[b], oacc[dt], 0, 0, 0);
            }
            asm volatile("s_waitcnt lgkmcnt(0)" ::: "memory");
            __builtin_amdgcn_sched_barrier(0);
        }
        if (h < 4) {
#pragma unroll
            for (int dd = 0; dd < 4; ++dd) { const f32x4 o = oacc[dd] * rl; u32x2 w; w.x = pk2(o[0], o[1]); w.y = pk2(o[2], o[3]); *(u32x2*)(YC + qrow * D + 512 + h * 64 + dd * 16 + 4 * kq) = w; }
        } else if (h < 8) {
#pragma unroll
            for (int dd = 0; dd < 4; ++dd) { const f32x4 o = oacc[4 + dd] * rl; u32x2 w; w.x = pk2(o[0], o[1]); w.y = pk2(o[2], o[3]); *(u32x2*)(YC + qrow * D + 512 + h * 64 + dd * 16 + 4 * kq) = w; }
        }
    }
    __syncthreads();
}

__device__ __forceinline__ void phase3(const Params& p, Frame& F) {
    unsigned char* ws = p.ws;
    for (int u = F.bid; u < 256 + DB; u += F.G) { if (u < 256) scan_apply_unit(p, F, u >> 6, u & 63); else scan_apply_unit(p, F, NB + (u - 256), 0); }
    for (int u = F.bid; u < 1024 + DB; u += F.G) {
        size_t q0row; int nq, L; const bf16 *KI, *Kb, *Vb;
        if (u < 1024) {
            const int k = u >> 8, c = u & 255, x = c & 7, b = x >> 1, j = (c >> 3) * 2 + (x & 1), tix = k * 64 + ((k & 1) ? 63 - j : j), chunk = tix >> 1, half = tix & 1;
            q0row = (size_t)b * SEQ + chunk * 64 + half * 32; nq = 32; L = 64 * (chunk + 1);
            KI = (const bf16*)(ws + WS_KIB) + (size_t)b * SEQ * 64; Kb = (const bf16*)(ws + WS_KB) + (size_t)b * SEQ * KVW; Vb = (const bf16*)(ws + WS_VB) + (size_t)b * SEQ * KVW;
        } else {
            const int s = u - 1024;
            q0row = (size_t)MP + s * DT; nq = 16; L = SKEYS;
            KI = (const bf16*)(ws + WS_KIS) + (size_t)s * SKEYS * 64; Kb = (const bf16*)(ws + WS_KS) + (size_t)s * SKEYS * KVW; Vb = (const bf16*)(ws + WS_VS) + (size_t)s * SKEYS * KVW;
        }
        attn_unit(p, F, q0row, nq, L, KI, Kb, Vb);
    }
}

__global__ void __launch_bounds__(512, 2) fwd_kernel(Params p) {
    extern __shared__ __attribute__((aligned(16))) unsigned char lds_raw[];
    Frame F; F.lds = (LAS unsigned char*)lds_raw; F.tid = threadIdx.x; F.lane = F.tid & 63; F.wave = __builtin_amdgcn_readfirstlane(F.tid >> 6); F.G = gridDim.x; F.bid = blockIdx.x;
    unsigned char* ws = p.ws;
    const int lo = p.ph_lo, hi = p.ph_hi;
#if !USE_CG_SYNC
    if (F.tid < 64) ((LAS unsigned*)(F.lds + LDSCTL_OFF))[F.tid] = 0u;
    __syncthreads();
    XcdBarrier xbar = xcd_barrier_post((unsigned*)(ws + WS_CTL) + CW_BAR, (volatile LAS unsigned*)(F.lds + LDSCTL_OFF));
#endif
#define IN(k) (lo <= (k) && (k) < hi)
#ifndef SKIPMASK
#define SKIPMASK 0
#endif
#define SKIP(k) ((SKIPMASK >> (k)) & 1)
#define REPS(k) for (int rep_ = 0; rep_ <= DUP(k); ++rep_, (rep_ <= DUP(k) ? GSYNC() : (void)0))
#if USE_CG_SYNC
#define GSYNC() cg::this_grid().sync()
#else
#define GSYNC() xcd_barrier(xbar)
#endif
#define SEAM(k) do { if (IN(k) && IN((k) + 1)) { GSYNC(); } } while (0)
    if (IN(0) && !SKIP(0)) REPS(0) phase0(p, F);
    SEAM(0);
    if (IN(1) && !SKIP(1)) REPS(1) {
        pg8::Gemm g{(const pg8::bf16_t*)(ws + WS_XB), (const pg8::bf16_t*)(ws + WS_WIN), M, NIN, D};
        pg8::StaticOrder S; S.init(M, NIN, F.G, F.bid);
        EpiInProj E{(const float*)(ws + WS_RSTD), (const float*)(ws + WS_RCOS), (const float*)(ws + WS_RSIN), p.in[I_QN], p.in[I_KN],
                    (bf16*)(ws + WS_XR), (bf16*)(ws + WS_GG), (bf16*)(ws + WS_Q), (bf16*)(ws + WS_QI), (bf16*)(ws + WS_KB), (bf16*)(ws + WS_VB), (bf16*)(ws + WS_KIB),
                    (bf16*)(ws + WS_KS), (bf16*)(ws + WS_VS), (bf16*)(ws + WS_KIS), (float*)(ws + WS_WI), p.out};
        pg8::gemm_phase<EpiInProj, pg8::StaticOrder, true, true>(F.lds, g, S, E);
    }
    SEAM(1);
    if (IN(2) && !SKIP(2)) REPS(2) {
        for (int u = F.bid; u < 2048 + 64; u += F.G) {
            if (u < 2048) scan_local_unit(p, F, u >> 9, u & 7, (u & 511) >> 3);
            else scan_local_unit(p, F, NB + ((u - 2048) >> 3), (u - 2048) & 7, 0);
        }
    }
    SEAM(2);
    if (IN(3) && !SKIP(3)) REPS(3) phase3(p, F);
    SEAM(3);
    if (IN(4) && !SKIP(4)) REPS(4) {
        pg8::Gemm g{(const pg8::bf16_t*)(ws + WS_YC), (const pg8::bf16_t*)(ws + WS_WOUT), M, D, D};
        pg8::StaticOrder S; S.init(M, D, F.G, F.bid);
        EpiOutProj E{p.in[I_XP], p.in[I_XS], p.out, (bf16*)(ws + WS_XB), (rep_ < DUP(4)) ? (float*)(ws + WS_CTL + 65536) : (float*)(ws + WS_SSQ)};
        pg8::gemm_phase<EpiOutProj, pg8::StaticOrder, true, true>(F.lds, g, S, E);
    }
    SEAM(4);
    if (IN(5) && !SKIP(5)) REPS(5) {
        pg8::Gemm g{(const pg8::bf16_t*)(ws + WS_XB), (const pg8::bf16_t*)(ws + WS_WFI), M, 2 * DFF, D};
        pg8::StaticOrder S; S.init(M, 2 * DFF, F.G, F.bid);
        EpiFfnIn E{(const float*)(ws + WS_SSQ), (bf16*)(ws + WS_H)};
        pg8::gemm_phase<EpiFfnIn, pg8::StaticOrder, true, true>(F.lds, g, S, E);
    }
    SEAM(5);
    if (IN(6) && !SKIP(6)) {
        pg8::Gemm g{(const pg8::bf16_t*)(ws + WS_H), (const pg8::bf16_t*)(ws + WS_WFO), M, D, DFF};
        pg8::StaticOrder S; S.init(M, D, F.G, F.bid);
        EpiFfnOut E{p.out};
        pg8::gemm_phase<EpiFfnOut, pg8::StaticOrder, true, true>(F.lds, g, S, E);
    }
#undef IN
#undef SEAM
}

#ifndef N_LAUNCHES
#define N_LAUNCHES 1
#endif
constexpr int NPHASE = 7;
extern "C" void kernel_launch(void* const* d_in, const int* in_sizes, int n_in, void* d_out, int out_size, void* d_ws, size_t ws_size, hipStream_t stream) {
    static int grid = 0;
    if (grid == 0) {
        if (n_in != 22 || out_size != (int)O_END || ws_size < WS_END) { fprintf(stderr, "kernel_launch: unexpected shapes: n_in %d out %d ws %zu (need %zu)\n", n_in, out_size, ws_size, (size_t)WS_END); grid = -1; return; }
        int dev = 0, cus = 0, per_cu = 0;
        if (hipGetDevice(&dev) != hipSuccess || hipDeviceGetAttribute(&cus, hipDeviceAttributeMultiprocessorCount, dev) != hipSuccess) { grid = -1; return; }
        if (hipFuncSetAttribute((const void*)fwd_kernel, hipFuncAttributeMaxDynamicSharedMemorySize, LDS_BYTES) != hipSuccess) { fprintf(stderr, "kernel_launch: hipFuncSetAttribute failed\n"); grid = -1; return; }
        if (hipOccupancyMaxActiveBlocksPerMultiprocessor(&per_cu, (const void*)fwd_kernel, 512, LDS_BYTES) != hipSuccess || per_cu < 1) { fprintf(stderr, "kernel_launch: occupancy query says %d blocks/CU\n", per_cu); per_cu = 1; }
        (void)hipGetLastError();
        grid = cus;
    }
    if (grid < 0) return;
    if (!USE_CG_SYNC) { if (hipMemsetAsync((char*)d_ws + WS_CTL, 0, 65536, stream) != hipSuccess) { fprintf(stderr, "kernel_launch: memset failed\n"); return; } }
    Params p{};
    for (int i = 0; i < 22; ++i) p.in[i] = (const float*)d_in[i];
    p.out = (float*)d_out; p.ws = (unsigned char*)d_ws;
    for (int i = 0; i < 32; ++i) p.invf[i] = pow(10000.0, -(double)i / 32.0);
    if (N_LAUNCHES == 1) {
        p.ph_lo = 0; p.ph_hi = NPHASE;
        void* args[] = {&p};
        hipError_t e = hipLaunchCooperativeKernel((const void*)fwd_kernel, dim3(grid), dim3(512), args, LDS_BYTES, stream);
        if (e != hipSuccess) fprintf(stderr, "kernel_launch: cooperative launch failed: %s (grid %d)\n", hipGetErrorString(e), grid);
    } else {
        for (int k = 0; k < NPHASE; ++k) { p.ph_lo = k; p.ph_hi = k + 1; hipLaunchKernelGGL(fwd_kernel, dim3(grid), dim3(512), LDS_BYTES, stream, p); }
    }
}
```

```cpp
#include <hip/hip_runtime.h>
#include <hip/hip_cooperative_groups.h>
#include <cstdio>
#include <cstdint>
#include <cmath>
namespace cg = cooperative_groups;
namespace pg8 {
#define PG8_LAS __attribute__((address_space(3)))
typedef unsigned short bf16_t;
typedef short bf16x8 __attribute__((ext_vector_type(8)));
typedef float f32x4 __attribute__((ext_vector_type(4)));
typedef unsigned u32x4 __attribute__((ext_vector_type(4)));
constexpr int BM = 256, BK = 64, HALF = 128, HTB = HALF * BK * 2  , STAGE_BYTES = 8 * HTB, NXCD = 8, WGM = 8;

__host__ __device__ __forceinline__ int lds_byte(int r, int c) { const int st = (r >> 4) * 2 + (c >> 5), rr = r & 15, cc = c & 31, ob = rr * 64 + cc * 2; return st * 1024 + (ob ^ (((ob >> 9) & 1) << 5)); }
__host__ __device__ __forceinline__ void stage_rc(int b, int& R, int& C) { const int st = b / 1024, sb = b % 1024, swz = sb ^ (((sb >> 9) & 1) << 5); R = (st >> 1) * 16 + swz / 64; C = (st & 1) * 32 + (swz % 64) / 2; }
__host__ __device__ __forceinline__ int perm32(int rho) { const int n = rho >> 4, i = rho & 15; return 8 * (i >> 2) + 4 * n + (i & 3); }

struct Unit { int pm, pn; };
struct Gemm { const bf16_t* A; const bf16_t* Bt; int M, N, K; };

struct StaticOrder {
    int nM, nN, nwg, G, c;
    __host__ __device__ void init(int M, int N, int G_, int c_) { nM = M / BM; nN = N / BM; nwg = nM * nN; G = G_; c = c_; }
    __host__ __device__ bool next(int i, Unit& u) const {
        const long L = (long)i * G + c; if (L >= nwg) return false;
        int wgid = (int)L; { const int q = nwg / NXCD, r = nwg % NXCD, xcd = wgid % NXCD, off = wgid / NXCD; wgid = (xcd < r ? xcd * (q + 1) : r * (q + 1) + (xcd - r) * q) + off; }
        const int nig = WGM * nN, gid = wgid / nig, fm = gid * WGM, gsz = (nM - fm) < WGM ? (nM - fm) : WGM;
        u.pm = fm + ((wgid % nig) % gsz); u.pn = (wgid % nig) / gsz; return true;
    }
    __device__ __forceinline__ void a_ready(const Unit&) const {}
    __device__ __forceinline__ void done(const Unit&) const {}
};
__device__ __forceinline__ unsigned cvt_pk_bf16(float lo, float hi) { unsigned r; asm volatile("v_cvt_pk_bf16_f32 %0, %1, %2" : "=v"(r) : "v"(lo), "v"(hi)); return r; }
template <class Epi, class Sched, bool ALIGN_EPI = false, bool SP2 = false>
__device__ __forceinline__ void gemm_phase(PG8_LAS unsigned char* lds, const Gemm g, const Sched& S, const Epi& E) {
    const int tid = threadIdx.x, wid = __builtin_amdgcn_readfirstlane(tid >> 6), lane = tid & 63, wr = wid >> 2, wc = wid & 3, fr = lane & 15, fq = lane >> 4;
    const int K = g.K, nt = K / BK;
    unsigned voffA[2], voffB[2];
#pragma unroll
    for (int i = 0; i < 2; ++i) { int R, C; stage_rc(tid * 16 + i * 8192, R, C); const int Rb = Epi::PERM ? ((R & ~31) + perm32(R & 31)) : R;
        voffA[i] = (unsigned)(R * K + C) * 2u; voffB[i] = (unsigned)(Rb * K + C) * 2u; }
    const size_t kstep = (size_t)(BK * 2);
    const size_t hstep = (size_t)HALF * K * 2;
    const size_t tstep = 2 * hstep;
    const unsigned ldsw = (unsigned)wid * 1024u;
    const int aoff = lds_byte(wr * 64 + fr, fq * 8), boff = lds_byte(wc * 32 + fr, fq * 8);
#define PG8_SA(b, h) (((b) * 2 + (h)) * HTB)
#define PG8_SB(b, h) ((4 + (b) * 2 + (h)) * HTB)
#define PG8_STAGE(bufoff, gbase, voff) do { _Pragma("unroll") for (int _i = 0; _i < 2; ++_i) \
        __builtin_amdgcn_global_load_lds((const unsigned*)((const char*)(gbase) + (voff)[_i]), (PG8_LAS unsigned*)(lds + (bufoff) + ldsw + _i * 8192), 16, 0, 0); } while (0)
#define PG8_LDA(dst, b, h) do { _Pragma("unroll") for (int m = 0; m < 4; ++m) _Pragma("unroll") for (int k = 0; k < 2; ++k) dst[m][k] = *(const PG8_LAS bf16x8*)(lds + PG8_SA(b, h) + aoff + m * 2048 + k * 1024); } while (0)
#define PG8_LDB(dst, b, h) do { _Pragma("unroll") for (int n = 0; n < 2; ++n) _Pragma("unroll") for (int k = 0; k < 2; ++k) dst[n][k] = *(const PG8_LAS bf16x8*)(lds + PG8_SB(b, h) + boff + n * 2048 + k * 1024); } while (0)
#define PG8_MMA(ai, bj, At, Bt) do { __builtin_amdgcn_s_setprio(1); _Pragma("unroll") for (int m = 0; m < 4; ++m) _Pragma("unroll") for (int n = 0; n < 2; ++n) _Pragma("unroll") for (int k = 0; k < 2; ++k) \
        acc[ai][bj][m][n] = __builtin_amdgcn_mfma_f32_16x16x32_bf16(Bt[n][k], At[m][k], acc[ai][bj][m][n], 0, 0, 0); __builtin_amdgcn_s_setprio(0); } while (0)
#define PG8_WAIT_V(n) asm volatile("s_waitcnt vmcnt(" #n ")" ::: "memory")
#define PG8_WAIT_L(n) asm volatile("s_waitcnt lgkmcnt(" #n ")" ::: "memory")
#define PG8_BAR __builtin_amdgcn_s_barrier()
#define PG8_SCHED __builtin_amdgcn_sched_barrier(0)
    Unit cur, nxt; int ui = 0;
    if (!S.next(0, cur)) return;
    f32x4 acc[2][2][4][2];
#pragma unroll
    for (int a = 0; a < 2; ++a)
#pragma unroll
        for (int b = 0; b < 2; ++b)
#pragma unroll
            for (int m = 0; m < 4; ++m)
#pragma unroll
                for (int n = 0; n < 2; ++n) acc[a][b][m][n] = (f32x4){0.f, 0.f, 0.f, 0.f};
    bf16x8 At[4][2], B0[2][2], B1[2][2];
    const char* cA = (const char*)g.A + (size_t)cur.pm * tstep; const char* cB = (const char*)g.Bt + (size_t)cur.pn * tstep;
    S.a_ready(cur);
    if constexpr (SP2) {
        PG8_STAGE(PG8_SB(0, 0), cB, voffB); PG8_STAGE(PG8_SB(0, 1), cB + hstep, voffB); PG8_STAGE(PG8_SA(0, 0), cA, voffA); PG8_STAGE(PG8_SA(0, 1), cA + hstep, voffA);
        if (wr == 1) PG8_BAR;
        PG8_WAIT_V(2); PG8_BAR;
        PG8_STAGE(PG8_SB(1, 0), cB + kstep, voffB); PG8_STAGE(PG8_SA(1, 0), cA + kstep, voffA); PG8_STAGE(PG8_SB(1, 1), cB + hstep + kstep, voffB);
        PG8_WAIT_V(6); PG8_BAR;
    } else {
        PG8_STAGE(PG8_SB(0, 0), cB, voffB); PG8_STAGE(PG8_SA(0, 0), cA, voffA); PG8_STAGE(PG8_SB(0, 1), cB + hstep, voffB); PG8_STAGE(PG8_SA(0, 1), cA + hstep, voffA);
        if (wr == 1) PG8_BAR;
        PG8_WAIT_V(4); PG8_BAR;
        PG8_STAGE(PG8_SB(1, 0), cB + kstep, voffB); PG8_STAGE(PG8_SA(1, 0), cA + kstep, voffA); PG8_STAGE(PG8_SB(1, 1), cB + hstep + kstep, voffB);
        PG8_WAIT_V(6); PG8_BAR;
    }
    for (;;) {
        const bool has_next = S.next(ui + 1, nxt);
        const char* nA = has_next ? (const char*)g.A + (size_t)nxt.pm * tstep : cA; const char* nB = has_next ? (const char*)g.Bt + (size_t)nxt.pn * tstep : cB;
        for (int t = 0; t < nt; t += 2) {
            const bool last = (t == nt - 2);
            const char* a1 = cA + (size_t)(t + 1) * kstep;
            const char* a2 = last ? nA : cA + (size_t)(t + 2) * kstep; const char* b2 = last ? nB : cB + (size_t)(t + 2) * kstep;
            const char* a3 = a2 + kstep; const char* b3 = b2 + kstep;
            if (last && has_next) S.a_ready(nxt);
            if constexpr (SP2) {
            PG8_LDB(B0, 0, 0); PG8_LDB(B1, 0, 1); PG8_SCHED; PG8_LDA(At, 0, 0); PG8_STAGE(PG8_SA(1, 1), a1 + hstep, voffA);
            PG8_WAIT_V(8); PG8_WAIT_L(0); PG8_BAR; PG8_MMA(0, 0, At, B0); PG8_MMA(0, 1, At, B1); PG8_BAR; PG8_SCHED;
            PG8_LDA(At, 0, 1); PG8_STAGE(PG8_SB(0, 0), b2, voffB); PG8_STAGE(PG8_SB(0, 1), b2 + hstep, voffB); PG8_STAGE(PG8_SA(0, 0), a2, voffA);
            PG8_WAIT_V(8); PG8_WAIT_L(0); PG8_BAR; PG8_MMA(1, 0, At, B0); PG8_MMA(1, 1, At, B1); PG8_BAR; PG8_SCHED;
            PG8_LDB(B0, 1, 0); PG8_LDB(B1, 1, 1); PG8_SCHED; PG8_LDA(At, 1, 0); PG8_STAGE(PG8_SA(0, 1), a2 + hstep, voffA);
            PG8_WAIT_V(8); PG8_WAIT_L(0); PG8_BAR; PG8_MMA(0, 0, At, B0); PG8_MMA(0, 1, At, B1); PG8_BAR; PG8_SCHED;
            PG8_LDA(At, 1, 1); PG8_STAGE(PG8_SB(1, 0), b3, voffB); PG8_STAGE(PG8_SB(1, 1), b3 + hstep, voffB); PG8_STAGE(PG8_SA(1, 0), a3, voffA);
            PG8_WAIT_V(8); PG8_WAIT_L(0); PG8_BAR; PG8_MMA(1, 0, At, B0); PG8_MMA(1, 1, At, B1); PG8_BAR; PG8_SCHED;
            } else {
            PG8_LDB(B0, 0, 0); PG8_SCHED; PG8_LDA(At, 0, 0); PG8_STAGE(PG8_SA(1, 1), a1 + hstep, voffA);
            PG8_WAIT_L(8); PG8_BAR; PG8_WAIT_L(0); PG8_MMA(0, 0, At, B0); PG8_BAR; PG8_SCHED;
            PG8_LDB(B1, 0, 1); PG8_STAGE(PG8_SB(0, 0), b2, voffB);
            PG8_BAR; PG8_WAIT_L(0); PG8_MMA(0, 1, At, B1); PG8_BAR;
            PG8_LDA(At, 0, 1); PG8_STAGE(PG8_SA(0, 0), a2, voffA);
            PG8_BAR; PG8_WAIT_L(0); PG8_MMA(1, 0, At, B0); PG8_BAR; PG8_SCHED;
            PG8_STAGE(PG8_SB(0, 1), b2 + hstep, voffB);
            PG8_WAIT_V(6); PG8_BAR; PG8_MMA(1, 1, At, B1); PG8_BAR;
            PG8_LDB(B0, 1, 0); PG8_SCHED; PG8_LDA(At, 1, 0); PG8_STAGE(PG8_SA(0, 1), a2 + hstep, voffA);
            PG8_WAIT_L(8); PG8_BAR; PG8_WAIT_L(0); PG8_MMA(0, 0, At, B0); PG8_BAR; PG8_SCHED;
            PG8_LDB(B1, 1, 1); PG8_STAGE(PG8_SB(1, 0), b3, voffB);
            PG8_BAR; PG8_WAIT_L(0); PG8_MMA(0, 1, At, B1); PG8_BAR;
            PG8_LDA(At, 1, 1); PG8_STAGE(PG8_SA(1, 0), a3, voffA);
            PG8_BAR; PG8_WAIT_L(0); PG8_MMA(1, 0, At, B0); PG8_BAR; PG8_SCHED;
            PG8_STAGE(PG8_SB(1, 1), b3 + hstep, voffB);
            PG8_WAIT_V(6); PG8_BAR; PG8_MMA(1, 1, At, B1); PG8_BAR;
            }
        }
        if constexpr (ALIGN_EPI) { if (wr == 0) PG8_BAR; }
        if constexpr (!Epi::AFTER_DRAIN) { E(acc, cur, wr, wc, fr, fq); S.done(cur); }
        if (!has_next) break;
#pragma unroll
        for (int a = 0; a < 2; ++a)
#pragma unroll
            for (int b = 0; b < 2; ++b)
#pragma unroll
                for (int m = 0; m < 4; ++m)
#pragma unroll
                    for (int n = 0; n < 2; ++n) acc[a][b][m][n] = (f32x4){0.f, 0.f, 0.f, 0.f};
        cur = nxt; cA = nA; cB = nB; ++ui;
        if constexpr (ALIGN_EPI) { if (wr == 1) PG8_BAR; }
    }
    PG8_WAIT_V(0);
    if constexpr (!ALIGN_EPI) { if (wr == 0) PG8_BAR; }
    PG8_BAR;
    if constexpr (Epi::AFTER_DRAIN) { E.fused(acc, cur, wr, wc, fr, fq, lds, wid, lane); S.done(cur); }
#undef PG8_SA
#undef PG8_SB
#undef PG8_STAGE
#undef PG8_LDA
#undef PG8_LDB
#undef PG8_MMA
#undef PG8_WAIT_V
#undef PG8_WAIT_L
#undef PG8_BAR
#undef PG8_SCHED
}
}

constexpr int D = 1024, NB = 4, SEQ = 8192, DB = 8, DT = 16, PAST = 4096;
constexpr int MP = NB * SEQ;
constexpr int MS = DB * DT;
constexpr int MR = MP + MS;
constexpr int M = 33024;
constexpr int LW = 512, NLB = 8, LBW = 64;
constexpr int KVW = 128;
constexpr int DIN = 2376, NIN = 2560;
constexpr int DFF = 2816;
constexpr int SKEYS = PAST + DT;
constexpr float EPS = 1e-6f;
constexpr float WI_SCALE = 0.044194173824159216f;

constexpr size_t O_YP = 0;
constexpr size_t O_YS = O_YP + (size_t)MP * D;
constexpr size_t O_KP = O_YS + (size_t)MS * D;
constexpr size_t O_VP = O_KP + (size_t)MP * KVW;
constexpr size_t O_KIP = O_VP + (size_t)MP * KVW;
constexpr size_t O_HP = O_KIP + (size_t)MP * 64;
constexpr size_t O_CP = O_HP + (size_t)NB * LW;
constexpr size_t O_KS = O_CP + (size_t)NB * 3 * LW;
constexpr size_t O_VS = O_KS + (size_t)MS * KVW;
constexpr size_t O_KIS = O_VS + (size_t)MS * KVW;
constexpr size_t O_HS = O_KIS + (size_t)MS * 64;
constexpr size_t O_CS = O_HS + (size_t)DB * LW;
constexpr size_t O_END = O_CS + (size_t)DB * 3 * LW;
static_assert(O_END == 44236800, "output size");

constexpr size_t al256(size_t x) { return (x + 255) & ~(size_t)255; }
constexpr size_t WS_CTL = 0, CTL_BYTES = 1u << 20;
constexpr size_t WS_WIN = WS_CTL + CTL_BYTES;
constexpr size_t WS_WOUT = WS_WIN + al256((size_t)NIN * D * 2);
constexpr size_t WS_WFI = WS_WOUT + al256((size_t)D * D * 2);
constexpr size_t WS_WFO = WS_WFI + al256((size_t)2 * DFF * D * 2);
constexpr size_t WS_WG = WS_WFO + al256((size_t)D * DFF * 2);
constexpr size_t WS_RCOS = WS_WG + al256((size_t)2 * 8 * 64 * 64 * 2);
constexpr size_t WS_RSIN = WS_RCOS + al256((size_t)8192 * 32 * 4);
constexpr size_t WS_SP = WS_RSIN + al256((size_t)8192 * 32 * 4);
constexpr size_t WS_RSTD = WS_SP + al256(512 * 4);
constexpr size_t WS_SSQ = WS_RSTD + al256((size_t)M * 4);
constexpr size_t WS_WI = WS_SSQ + al256((size_t)M * 4);
constexpr size_t WS_AGG = WS_WI + al256((size_t)M * 8 * 4);
constexpr size_t WS_XB = WS_AGG + al256((size_t)12 * 64 * 512 * 8);
constexpr size_t WS_YC = WS_XB + al256((size_t)M * D * 2);
constexpr size_t WS_KB = WS_YC + al256((size_t)M * D * 2);
constexpr size_t WS_VB = WS_KB + al256((size_t)MP * KVW * 2);
constexpr size_t WS_KIB = WS_VB + al256((size_t)MP * KVW * 2);
constexpr size_t WS_KS = WS_KIB + al256((size_t)MP * 64 * 2);
constexpr size_t WS_VS = WS_KS + al256((size_t)DB * SKEYS * KVW * 2);
constexpr size_t WS_KIS = WS_VS + al256((size_t)DB * SKEYS * KVW * 2);
constexpr size_t WS_R1 = WS_KIS + al256((size_t)DB * SKEYS * 64 * 2);
constexpr size_t WS_XR = WS_R1;
constexpr size_t WS_GG = WS_XR + al256((size_t)M * LW * 2);
constexpr size_t WS_Q = WS_GG + al256((size_t)M * LW * 2);
constexpr size_t WS_QI = WS_Q + al256((size_t)M * LW * 2);
constexpr size_t WS_ACUM = WS_QI + al256((size_t)M * LW * 2);
constexpr size_t WS_BCUM = WS_ACUM + al256((size_t)M * LW * 4);
constexpr size_t WS_R1_END = WS_BCUM + al256((size_t)M * LW * 4);
constexpr size_t WS_H = WS_R1;
static_assert(WS_H + (size_t)M * DFF * 2 <= WS_R1_END, "H overlay fits");
constexpr size_t WS_CANDG = WS_ACUM;
static_assert(WS_CANDG + (size_t)M * 1024 * 4 <= WS_R1_END, "candidate lists fit");
constexpr size_t WS_SEL = WS_R1_END;
constexpr size_t WS_NSEL = WS_SEL + al256((size_t)M * 256 * 2);
constexpr size_t WS_END = WS_NSEL + al256((size_t)M * 4);

#ifndef DUPMASK
#define DUPMASK 0
#endif
#define DUP(k) ((DUPMASK >> (k)) & 1)
#ifndef USE_CG_SYNC
#define USE_CG_SYNC 0
#endif
constexpr int CW_QUEUE = 2048;
constexpr int CW_BAR = 4096;
constexpr int LDSCTL_OFF = 131072 + 1024;
#ifndef FORCE_SAFE_MODE
#define FORCE_SAFE_MODE 0
#endif
#ifndef TSEG
#define TSEG 0
#endif
#define TIC(id) unsigned long long tic_##id = (TSEG == (id)) ? __builtin_amdgcn_s_memrealtime() : 0ull
#define TOC(id) do { if (TSEG == (id) && F.bid == 0 && F.wave == 0) { const unsigned d_ = (unsigned)(__builtin_amdgcn_s_memrealtime() - tic_##id); if (F.lane == 0) { LAS unsigned* a_ = (LAS unsigned*)(F.lds + LDSCTL_OFF + 128); *a_ += d_; } } } while (0)
constexpr int LDS_BYTES = 147456;

#define LAS __attribute__((address_space(3)))
typedef unsigned short bf16;
typedef float f32x4 __attribute__((ext_vector_type(4)));
typedef float f32x2 __attribute__((ext_vector_type(2)));
typedef unsigned u32x4 __attribute__((ext_vector_type(4)));
typedef unsigned u32x2 __attribute__((ext_vector_type(2)));
typedef short bf16x8 __attribute__((ext_vector_type(8)));

__device__ __forceinline__ unsigned pk2(float lo, float hi) { unsigned r; asm("v_cvt_pk_bf16_f32 %0, %1, %2" : "=v"(r) : "v"(lo), "v"(hi)); return r; }
__device__ __forceinline__ unsigned f2bf(float f) { return pk2(f, 0.f) & 0xffffu; }
__device__ __forceinline__ float bf2f(unsigned b) { return __builtin_bit_cast(float, b << 16); }
__device__ __forceinline__ float bflo(unsigned w) { return __builtin_bit_cast(float, w << 16); }
__device__ __forceinline__ float bfhi(unsigned w) { return __builtin_bit_cast(float, w & 0xffff0000u); }
__device__ __forceinline__ void store_bf16x8(bf16* p, f32x4 lo, f32x4 hi) {
    u32x4 w; w.x = pg8::cvt_pk_bf16(lo[0], lo[1]); w.y = pg8::cvt_pk_bf16(lo[2], lo[3]); w.z = pg8::cvt_pk_bf16(hi[0], hi[1]); w.w = pg8::cvt_pk_bf16(hi[2], hi[3]);
    *(u32x4*)p = w;
}
typedef unsigned char fp8;
__device__ __forceinline__ unsigned pk4_fp8(float a, float b, float c, float d) { int w = __builtin_amdgcn_cvt_pk_fp8_f32(a, b, 0, false); w = __builtin_amdgcn_cvt_pk_fp8_f32(c, d, w, true); return (unsigned)w; }
__device__ __forceinline__ void store_fp8x8(fp8* p, f32x4 lo, f32x4 hi) { u32x2 w; w.x = pk4_fp8(lo[0], lo[1], lo[2], lo[3]); w.y = pk4_fp8(hi[0], hi[1], hi[2], hi[3]); *(u32x2*)p = w; }
__device__ __forceinline__ u32x2 fp8x4_bf16x4(unsigned w) {
    const f32x2 a = __builtin_amdgcn_cvt_pk_f32_fp8((int)w, false); const f32x2 b = __builtin_amdgcn_cvt_pk_f32_fp8((int)w, true);
    const float a0 = a.x, a1 = a.y, b0 = b.x, b1 = b.y;
    u32x2 o; o.x = __builtin_amdgcn_perm(__float_as_uint(a1), __float_as_uint(a0), 0x07060302u); o.y = __builtin_amdgcn_perm(__float_as_uint(b1), __float_as_uint(b0), 0x07060302u);
    return o;
}
__device__ __forceinline__ float gelu_tanh(float x) {
    const float u = 0.7978845608028654f * (x + 0.044715f * x * x * x);
    const float e = __expf(2.0f * u);
    const float th = 1.0f - 2.0f * __builtin_amdgcn_rcpf(e + 1.0f);
    return 0.5f * x * (1.0f + th);
}
__device__ __forceinline__ float sigmoidf_(float x) { return __builtin_amdgcn_rcpf(1.0f + __expf(-x)); }

#define XB_TMO      128
#define XB_XCNT(j)  (256  + 64 * (j))
#define XB_XSUB(j)  (1280 + 64 * (j))
#define XB_XGEN(j)  (2304 + 64 * (j))
#define XB_TOP      3328
#define XB_TOPGEN   3392
#define XCD_BAR_WORDS 3456
#define XB_SPIN_CAP (1u << 18)

__device__ __forceinline__ unsigned xb_ld(unsigned* p)              { return __hip_atomic_load(p, __ATOMIC_RELAXED, __HIP_MEMORY_SCOPE_AGENT); }
__device__ __forceinline__ unsigned xb_add(unsigned* p, unsigned v) { return __hip_atomic_fetch_add(p, v, __ATOMIC_RELAXED, __HIP_MEMORY_SCOPE_AGENT); }
__device__ __forceinline__ unsigned xb_xcc_id() { return (unsigned)__builtin_amdgcn_s_getreg((3 << 11) | 20) & 0xFu; }
#define XB_SPIN(cond, bar) do { unsigned _sp = 0; while (cond) { __builtin_amdgcn_s_sleep(1); \
    if ((++_sp & 255u) == 0u) { if (xb_ld(&(bar)[XB_TMO])) break; if (_sp > XB_SPIN_CAP) { atomicAdd(&(bar)[XB_TMO], 1u); break; } } } } while (0)

struct XcdBarrier {
    unsigned* bar; unsigned x;
    volatile LAS unsigned* st;
};

__device__ __forceinline__ XcdBarrier xcd_barrier_post(unsigned* bar, volatile LAS unsigned* st) {
    XcdBarrier b; b.bar = bar; b.x = xb_xcc_id(); b.st = st;
    if (threadIdx.x == 0) (void)xb_add(&bar[XB_XCNT(b.x)], 1u);
    return b;
}
__device__ __forceinline__ void xcd_barrier_complete(unsigned* bar, unsigned x, unsigned& nloc, unsigned& nx) {
    const unsigned G = gridDim.x * gridDim.y * gridDim.z;
    unsigned sum, cnt, mine, sp = 0u;
    for (;;) {
        sum = 0u; cnt = 0u; mine = 0u;
#pragma unroll
        for (unsigned j = 0; j < 16; ++j) { const unsigned c = xb_ld(&bar[XB_XCNT(j)]); sum += c; cnt += (c > 0u) ? 1u : 0u; mine = (j == x) ? c : mine; }
        if (sum == G) break;
        __builtin_amdgcn_s_sleep(1);
        if ((++sp & 255u) == 0u) { if (xb_ld(&bar[XB_TMO])) break; if (sp > XB_SPIN_CAP) { atomicAdd(&bar[XB_TMO], 1u); break; } }
    }
    nloc = mine > 0u ? mine : 1u; nx = cnt > 0u ? cnt : 1u;
}

__device__ __forceinline__ void xcd_barrier(const XcdBarrier& b) {
    asm volatile("s_waitcnt vmcnt(0)" ::: "memory");
    __syncthreads();
    if (threadIdx.x == 0) {
        unsigned* bar = b.bar;
        __builtin_amdgcn_s_waitcnt(0);
        unsigned nloc = b.st[0], nx = b.st[1];
        if (nloc == 0u) { xcd_barrier_complete(bar, b.x, nloc, nx); b.st[0] = nloc; b.st[1] = nx; }
        const unsigned old = xb_add(&bar[XB_XSUB(b.x)], 1u);
        const unsigned gen = old / nloc;
        if (old + 1u == (gen + 1u) * nloc) {
            __builtin_amdgcn_fence(__ATOMIC_RELEASE, "agent");
            asm volatile("s_waitcnt vmcnt(0)" ::: "memory");
            const unsigned og = xb_add(&bar[XB_TOP], 1u);
            const unsigned tg = og / nx;
            if (og + 1u == (tg + 1u) * nx) xb_add(&bar[XB_TOPGEN], 1u);
            else XB_SPIN(xb_ld(&bar[XB_TOPGEN]) == tg, bar);
            __builtin_amdgcn_fence(__ATOMIC_ACQUIRE, "agent");
            xb_add(&bar[XB_XGEN(b.x)], 1u);
            asm volatile("s_waitcnt vmcnt(0)" ::: "memory");
        } else {
            XB_SPIN(xb_ld(&bar[XB_XGEN(b.x)]) == gen, bar);
            __builtin_amdgcn_fence(__ATOMIC_ACQUIRE, "agent");
            asm volatile("s_waitcnt vmcnt(0)" ::: "memory");
        }
    }
    __syncthreads();
}
struct EpiInProj {
    static constexpr bool PERM = false, AFTER_DRAIN = false;
    const float* rstd; const float* rcos; const float* rsin; const float* gq; const float* gk;
    bf16* XR; bf16* GG; bf16* Q; bf16* QI; fp8* KB; fp8* VB; bf16* KIB; fp8* KS; fp8* VS; bf16* KIS; float* WI; float* out;

    template <bool NORM> __device__ __forceinline__ void head_rope(f32x4 (&v)[2][2], const float* g, int pos, int fq) const {
        if (NORM) {
            float ss = 0.f;
#pragma unroll
            for (int bj = 0; bj < 2; ++bj)
#pragma unroll
                for (int n = 0; n < 2; ++n) ss += (v[bj][n][0] * v[bj][n][0] + v[bj][n][1] * v[bj][n][1]) + (v[bj][n][2] * v[bj][n][2] + v[bj][n][3] * v[bj][n][3]);
            ss += __shfl_xor(ss, 16); ss += __shfl_xor(ss, 32);
            const float inv = rsqrtf(ss * (1.0f / 64.0f) + EPS);
#pragma unroll
            for (int bj = 0; bj < 2; ++bj)
#pragma unroll
                for (int n = 0; n < 2; ++n) { const f32x4 g4 = *(const f32x4*)(g + 32 * bj + 8 * fq + 4 * n); v[bj][n] = v[bj][n] * inv * g4; }
        }
#pragma unroll
        for (int n = 0; n < 2; ++n) {
            const f32x4 c4 = *(const f32x4*)(rcos + pos * 32 + 8 * fq + 4 * n), s4 = *(const f32x4*)(rsin + pos * 32 + 8 * fq + 4 * n);
            const f32x4 x1 = v[0][n], x2 = v[1][n];
            v[0][n] = x1 * c4 - x2 * s4; v[1][n] = x2 * c4 + x1 * s4;
        }
    }
    __device__ __forceinline__ void operator()(const f32x4 (&acc)[2][2][4][2], const pg8::Unit& u, int wr, int wc, int fr, int fq) const {
        const int pn = u.pn;
#pragma unroll
        for (int ai = 0; ai < 2; ++ai) {
            const int rbase = u.pm * 256 + ai * 128;
            if (rbase >= MR) continue;
            const bool samp = rbase >= MP;
#pragma unroll
            for (int m = 0; m < 4; ++m) {
                const int r = rbase + wr * 64 + m * 16 + fr;
                int sb, t, pos;
                if (!samp) { sb = r >> 13; t = r & 8191; pos = t; } else { const int rs = r - MP; sb = rs >> 4; t = rs & 15; pos = PAST + t; }
                const float rsd = rstd[r];
                f32x4 v[2][2];
#pragma unroll
                for (int bj = 0; bj < 2; ++bj)
#pragma unroll
                    for (int n = 0; n < 2; ++n) v[bj][n] = acc[ai][bj][m][n] * rsd;
                if (pn < 2) {
#pragma unroll
                    for (int bj = 0; bj < 2; ++bj) {
                        const int c = 256 * pn + 64 * wc + 32 * bj + 8 * fq;
                        store_bf16x8(XR + (size_t)r * LW + c, v[bj][0], v[bj][1]);
                        const int tl = samp ? DT - 3 : SEQ - 3;
                        if (t >= tl) {
                            float* o = samp ? out + O_CS + ((size_t)(sb * 3 + (t - tl))) * LW + c : out + O_CP + ((size_t)(sb * 3 + (t - tl))) * LW + c;
                            *(f32x4*)o = v[bj][0]; *(f32x4*)(o + 4) = v[bj][1];
                        }
                    }
                } else if (pn < 4) {
#pragma unroll
                    for (int bj = 0; bj < 2; ++bj) {
                        const int c = 256 * (pn - 2) + 64 * wc + 32 * bj + 8 * fq;
                        f32x4 a = v[bj][0], b = v[bj][1];
#pragma unroll
                        for (int j = 0; j < 4; ++j) { a[j] = gelu_tanh(a[j]); b[j] = gelu_tanh(b[j]); }
                        store_bf16x8(GG + (size_t)r * LW + c, a, b);
                    }
                } else if (pn < 6) {
                    head_rope<true>(v, gq, pos, fq);
                    const int head = 4 * (pn - 4) + wc;
#pragma unroll
                    for (int bj = 0; bj < 2; ++bj) store_bf16x8(Q + (size_t)r * 512 + head * 64 + 32 * bj + 8 * fq, v[bj][0], v[bj][1]);
                } else if (pn == 6) {
                    if (wc < 2) head_rope<true>(v, gk, pos, fq);
                    const int hh = wc & 1;
                    float* of; fp8* ob;
                    if (wc < 2) { of = samp ? out + O_KS + (size_t)(r - MP) * KVW : out + O_KP + (size_t)r * KVW; ob = samp ? KS + ((size_t)sb * SKEYS + PAST + t) * KVW : KB + (size_t)r * KVW; }
                    else        { of = samp ? out + O_VS + (size_t)(r - MP) * KVW : out + O_VP + (size_t)r * KVW; ob = samp ? VS + ((size_t)sb * SKEYS + PAST + t) * KVW : VB + (size_t)r * KVW; }
#pragma unroll
                    for (int bj = 0; bj < 2; ++bj) {
                        const int c = hh * 64 + 32 * bj + 8 * fq;
                        *(f32x4*)(of + c) = v[bj][0]; *(f32x4*)(of + c + 4) = v[bj][1];
                        store_fp8x8(ob + c, v[bj][0], v[bj][1]);
                    }
                } else if (pn < 9) {
                    head_rope<false>(v, nullptr, pos, fq);
                    const int head = 4 * (pn - 7) + wc;
#pragma unroll
                    for (int bj = 0; bj < 2; ++bj) store_bf16x8(QI + (size_t)r * 512 + head * 64 + 32 * bj + 8 * fq, v[bj][0], v[bj][1]);
                } else {
                    if (wc == 0) {
                        head_rope<false>(v, nullptr, pos, fq);
                        float* of = samp ? out + O_KIS + (size_t)(r - MP) * 64 : out + O_KIP + (size_t)r * 64;
                        bf16* ob = samp ? KIS + ((size_t)sb * SKEYS + PAST + t) * 64 : KIB + (size_t)r * 64;
#pragma unroll
                        for (int bj = 0; bj < 2; ++bj) {
                            const int c = 32 * bj + 8 * fq;
                            *(f32x4*)(of + c) = v[bj][0]; *(f32x4*)(of + c + 4) = v[bj][1];
                            store_bf16x8(ob + c, v[bj][0], v[bj][1]);
                        }
                    } else if (wc == 1) {
                        if (fq == 0) { *(f32x4*)(WI + (size_t)r * 8) = v[0][0] * WI_SCALE; *(f32x4*)(WI + (size_t)r * 8 + 4) = v[0][1] * WI_SCALE; }
                    }
                }
            }
        }
    }
};

struct EpiOutProj {
    static constexpr bool PERM = false, AFTER_DRAIN = false;
    const float* xp; const float* xs; float* out; bf16* XB2; float* ssq;
    __device__ __forceinline__ void operator()(const f32x4 (&acc)[2][2][4][2], const pg8::Unit& u, int wr, int wc, int fr, int fq) const {
        const int col0 = u.pn * 256 + wc * 32 + 4 * fq;
#pragma unroll
        for (int ai = 0; ai < 2; ++ai) {
            const int rbase = u.pm * 256 + ai * 128;
            if (rbase >= MR) continue;
            const bool samp = rbase >= MP;
#pragma unroll
            for (int m = 0; m < 4; ++m) {
                const int r = rbase + wr * 64 + m * 16 + fr;
                const float* xrow = samp ? xs + (size_t)(r - MP) * D : xp + (size_t)r * D;
                float* yrow = samp ? out + O_YS + (size_t)(r - MP) * D : out + O_YP + (size_t)r * D;
                float ss = 0.f;
#pragma unroll
                for (int bj = 0; bj < 2; ++bj)
#pragma unroll
                    for (int n = 0; n < 2; ++n) {
                        const int c = col0 + bj * 128 + n * 16;
                        const f32x4 y = *(const f32x4*)(xrow + c) + acc[ai][bj][m][n];
                        if (samp) *(f32x4*)(yrow + c) = y;
                        ss += (y[0] * y[0] + y[1] * y[1]) + (y[2] * y[2] + y[3] * y[3]);
                        u32x2 w; w.x = pg8::cvt_pk_bf16(y[0], y[1]); w.y = pg8::cvt_pk_bf16(y[2], y[3]);
                        *(u32x2*)(XB2 + (size_t)r * D + c) = w;
                    }
                ss += __shfl_xor(ss, 16); ss += __shfl_xor(ss, 32);
                if (fq == 0) atomicAdd(ssq + r, ss);
            }
        }
    }
};

struct EpiFfnIn {
    static constexpr bool PERM = false, AFTER_DRAIN = false;
    const float* ssq; bf16* H;
    __device__ __forceinline__ void operator()(const f32x4 (&acc)[2][2][4][2], const pg8::Unit& u, int wr, int wc, int fr, int fq) const {
        const int c = 128 * u.pn + 32 * wc + 8 * fq;
#pragma unroll
        for (int ai = 0; ai < 2; ++ai) {
            const int rbase = u.pm * 256 + ai * 128;
            if (rbase >= MR) continue;
#pragma unroll
            for (int m = 0; m < 4; ++m) {
                const int r = rbase + wr * 64 + m * 16 + fr;
                const float rs2 = rsqrtf(ssq[r] * (1.0f / 1024.0f) + EPS);
                f32x4 h[2];
#pragma unroll
                for (int n = 0; n < 2; ++n) {
                    const f32x4 g = acc[ai][0][m][n] * rs2, up = acc[ai][1][m][n] * rs2;
#pragma unroll
                    for (int j = 0; j < 4; ++j) h[n][j] = g[j] * sigmoidf_(g[j]) * up[j];
                }
                store_bf16x8(H + (size_t)r * DFF + c, h[0], h[1]);
            }
        }
    }
};

struct EpiFfnOut {
    static constexpr bool PERM = false, AFTER_DRAIN = false;
    float* out; const bf16* XB2;
    __device__ __forceinline__ void operator()(const f32x4 (&acc)[2][2][4][2], const pg8::Unit& u, int wr, int wc, int fr, int fq) const {
        const int col0 = u.pn * 256 + wc * 32 + 4 * fq;
#pragma unroll
        for (int ai = 0; ai < 2; ++ai) {
            const int rbase = u.pm * 256 + ai * 128;
            if (rbase >= MP) continue;
#pragma unroll
            for (int m = 0; m < 4; ++m) {
                const int r = rbase + wr * 64 + m * 16 + fr;
                float* yrow = out + O_YP + (size_t)r * D;
#pragma unroll
                for (int bj = 0; bj < 2; ++bj)
#pragma unroll
                    for (int n = 0; n < 2; ++n) { const int c = col0 + bj * 128 + n * 16; const u32x2 xw = *(const u32x2*)(XB2 + (size_t)r * D + c);
                        const f32x4 x1 = {bflo(xw.x), bfhi(xw.x), bflo(xw.y), bfhi(xw.y)}; *(f32x4*)(yrow + c) = x1 + acc[ai][bj][m][n]; }
            }
        }
    }
};

struct Params {
    const float* in[22];
    float* out;
    unsigned char* ws;
    double invf[32];
    int ph_lo, ph_hi;
};
enum { I_XP = 0, I_XS, I_CK, I_CV, I_CKI, I_SH, I_SC, I_NM, I_WIN, I_CW, I_CB, I_WRG, I_BRG, I_WIG, I_BIG, I_LAM, I_QN, I_KN, I_WOUT, I_NF, I_WFI, I_WFO };

struct Frame { LAS unsigned char* lds; int tid, lane, wave, G, bid; };

template <int NB, int KSTEPS, class BRow, class Epi>
__device__ __forceinline__ void skinny_gemm(Frame& F, const bf16* A, int lda, const bf16* Bt, int K, int nct, BRow brow, Epi epi) {
    const int lane = F.lane, qc = lane & 15, kq = lane >> 4, w = F.wave;
    LAS f32x4* red = (LAS f32x4*)F.lds;
    for (int item = F.bid; item < 4 * nct; item += F.G) {
        const int rb = item & 3, ct = item >> 2;
        const bf16* a0 = A + (size_t)(rb * 32 + qc) * lda + 8 * kq + w * (KSTEPS * 32); const bf16* a1 = a0 + (size_t)16 * lda;
        const bf16* bp[NB];
#pragma unroll
        for (int nb = 0; nb < NB; ++nb) bp[nb] = Bt + (size_t)brow(ct, nb, qc) * K + 8 * kq + w * (KSTEPS * 32);
        f32x4 acc[2][NB];
#pragma unroll
        for (int m = 0; m < 2; ++m)
#pragma unroll
            for (int nb = 0; nb < NB; ++nb) acc[m][nb] = (f32x4){0.f, 0.f, 0.f, 0.f};
#pragma unroll
        for (int ks = 0; ks < KSTEPS; ++ks) {
            const bf16x8 fa0 = *(const bf16x8*)(a0 + 32 * ks), fa1 = *(const bf16x8*)(a1 + 32 * ks);
#pragma unroll
            for (int nb = 0; nb < NB; ++nb) {
                const bf16x8 fb = *(const bf16x8*)(bp[nb] + 32 * ks);
                acc[0][nb] = __builtin_amdgcn_mfma_f32_16x16x32_bf16(fb, fa0, acc[0][nb], 0, 0, 0);
                acc[1][nb] = __builtin_amdgcn_mfma_f32_16x16x32_bf16(fb, fa1, acc[1][nb], 0, 0, 0);
            }
        }
#pragma unroll
        for (int m = 0; m < 2; ++m)
#pragma unroll
            for (int nb = 0; nb < NB; ++nb) red[(w * 2 * NB + m * NB + nb) * 64 + lane] = acc[m][nb];
        __syncthreads();
        if (w < 2) {
            f32x4 s[NB];
#pragma unroll
            for (int nb = 0; nb < NB; ++nb) { s[nb] = red[(w * NB + nb) * 64 + lane];
#pragma unroll
                for (int w2 = 1; w2 < 8; ++w2) s[nb] += red[(w2 * 2 * NB + w * NB + nb) * 64 + lane]; }
            epi(s, rb * 32 + w * 16 + qc, 16 * ct + 4 * kq, kq);
        }
        __syncthreads();
    }
}

__device__ __forceinline__ float wave_sum(float v) {
#pragma unroll
    for (int o = 1; o < 64; o <<= 1) v += __shfl_xor(v, o);
    return v;
}

__device__ __forceinline__ void transpose_item(const float* W, int K, int N, int nvalid, const float* gain, bf16* WT, int k0, int row0, int lcol0, bool perm, LAS float* scr, int lane) {
    const int c4 = (lane & 7) * 4, col = lcol0 + c4; const bool ok = col < nvalid;
    f32x4 v[8];
#pragma unroll
    for (int i = 0; i < 8; ++i) { const int kk = (lane >> 3) + 8 * i; v[i] = ok ? *(const f32x4*)(W + (size_t)(k0 + kk) * N + col) : (f32x4){0.f, 0.f, 0.f, 0.f}; }
#pragma unroll
    for (int i = 0; i < 8; ++i) { const int kk = (lane >> 3) + 8 * i; const float g = gain ? gain[k0 + kk] : 1.0f; *(LAS f32x4*)(scr + kk * 36 + c4) = v[i] * g; }
    asm volatile("s_waitcnt lgkmcnt(0)" ::: "memory");
    const int c = lane & 7;
#pragma unroll
    for (int j = 0; j < 4; ++j) {
        const int n = (lane >> 3) + 8 * j, src = perm ? pg8::perm32(n) : n;
        const LAS float* s = scr + (8 * c) * 36 + src;
        u32x4 o; o.x = pk2(s[0 * 36], s[1 * 36]); o.y = pk2(s[2 * 36], s[3 * 36]); o.z = pk2(s[4 * 36], s[5 * 36]); o.w = pk2(s[6 * 36], s[7 * 36]);
        *(u32x4*)(WT + (size_t)(row0 + n) * K + k0 + 8 * c) = o;
    }
    asm volatile("s_waitcnt lgkmcnt(0)" ::: "memory");
}

__device__ __forceinline__ void phase0(const Params& p, Frame& F) {
    unsigned char* ws = p.ws;
    LAS float* scr = (LAS float*)(F.lds + F.wave * 16384);
    const int gw = F.bid * 8 + F.wave, NGW = F.G * 8;
    TIC(50);
    constexpr int I_IN = 16 * (NIN / 32), I_OUT = 16 * (D / 32), I_FI = 16 * (2 * DFF / 32), I_FO = (DFF / 64) * (D / 32);
    constexpr int NITEMS = I_IN + I_OUT + I_FI + I_FO;
    for (int it = gw; it < NITEMS; it += NGW) {
        int r = it;
        if (r < I_IN) { const int kb = r / (NIN / 32), g = r % (NIN / 32), pn = g >> 3, sub = g & 7, bj = sub >> 2, wc = sub & 3;
            transpose_item(p.in[I_WIN], D, DIN, DIN, p.in[I_NM], (bf16*)(ws + WS_WIN), 64 * kb, 32 * g, 256 * pn + 64 * wc + 32 * bj, true, scr, F.lane); continue; }
        r -= I_IN;
        if (r < I_OUT) { const int kb = r / (D / 32), g = r % (D / 32);
            transpose_item(p.in[I_WOUT], D, D, D, nullptr, (bf16*)(ws + WS_WOUT), 64 * kb, 32 * g, 32 * g, false, scr, F.lane); continue; }
        r -= I_OUT;
        if (r < I_FI) { const int kb = r / (2 * DFF / 32), g = r % (2 * DFF / 32), pn = g >> 3, sub = g & 7, bj = sub >> 2, wc = sub & 3;
            transpose_item(p.in[I_WFI], D, 2 * DFF, 2 * DFF, p.in[I_NF], (bf16*)(ws + WS_WFI), 64 * kb, 32 * g, (bj ? DFF : 0) + 128 * pn + 32 * wc, true, scr, F.lane); continue; }
        r -= I_FI;
        { const int kb = r / (D / 32), g = r % (D / 32);
            transpose_item(p.in[I_WFO], DFF, D, D, nullptr, (bf16*)(ws + WS_WFO), 64 * kb, 32 * g, 32 * g, false, scr, F.lane); }
    }
    TOC(50);
    TIC(51);
    {
        bf16* XB = (bf16*)(ws + WS_XB); float* rstd = (float*)(ws + WS_RSTD);
        for (int m0 = gw; m0 < M; m0 += 4 * NGW) {
            f32x4 v[4][4];
#pragma unroll
            for (int rr = 0; rr < 4; ++rr) {
                const int m = m0 + rr * NGW;
                const bool real = m < MR;
                const float* xrow = (m < MP) ? p.in[I_XP] + (size_t)m * D : p.in[I_XS] + (size_t)((real ? m : MP) - MP) * D;
                const f32x4* xr = (const f32x4*)xrow + F.lane;
#pragma unroll
                for (int j = 0; j < 4; ++j) v[rr][j] = real ? xr[64 * j] : (f32x4){0.f, 0.f, 0.f, 0.f};
            }
#pragma unroll
            for (int rr = 0; rr < 4; ++rr) {
                const int m = m0 + rr * NGW;
                if (m >= M) continue;
                float s = 0.f;
#pragma unroll
                for (int j = 0; j < 4; ++j) s += (v[rr][j][0] * v[rr][j][0] + v[rr][j][1] * v[rr][j][1]) + (v[rr][j][2] * v[rr][j][2] + v[rr][j][3] * v[rr][j][3]);
                s = wave_sum(s);
                if (F.lane == 0) rstd[m] = (m < MR) ? rsqrtf(s * (1.0f / D) + EPS) : 0.f;
                unsigned long long* o8 = (unsigned long long*)(XB + (size_t)m * D) + F.lane;
#pragma unroll
                for (int j = 0; j < 4; ++j) o8[64 * j] = (unsigned long long)pk2(v[rr][j][0], v[rr][j][1]) | ((unsigned long long)pk2(v[rr][j][2], v[rr][j][3]) << 32);
            }
        }
    }
    TOC(51);
    TIC(52);
    const size_t gt = (size_t)F.bid * 512 + F.tid, GS = (size_t)F.G * 512;
    {
        fp8* KS = (fp8*)(ws + WS_KS); fp8* VS = (fp8*)(ws + WS_VS); bf16* KIS = (bf16*)(ws + WS_KIS);
        constexpr size_t NKV8 = (size_t)DB * PAST * KVW / 8, NKI8 = (size_t)DB * PAST * 64 / 8;
        for (size_t i = gt; i < 2 * NKV8 + NKI8; i += GS) {
            if (i < 2 * NKV8) {
                const bool isv = i >= NKV8; const size_t e = (isv ? i - NKV8 : i) * 8, b = e / ((size_t)PAST * KVW), rem = e % ((size_t)PAST * KVW);
                const float* src = (isv ? p.in[I_CV] : p.in[I_CK]) + e; fp8* dst = (isv ? VS : KS) + b * SKEYS * KVW + rem;
                store_fp8x8(dst, *(const f32x4*)src, *(const f32x4*)(src + 4));
            } else {
                const size_t e = (i - 2 * NKV8) * 8, b = e / ((size_t)PAST * 64), rem = e % ((size_t)PAST * 64);
                const float* src = p.in[I_CKI] + e;
                store_bf16x8(KIS + b * SKEYS * 64 + rem, *(const f32x4*)src, *(const f32x4*)(src + 4));
            }
        }
    }
    {
        float* rc = (float*)(ws + WS_RCOS); float* rsn = (float*)(ws + WS_RSIN);
        for (size_t i = gt; i < (size_t)8192 * 32; i += GS) {
            const int pos = (int)(i >> 5), fi = (int)(i & 31);
            const double ang = (double)pos * p.invf[fi];
            const double kq = rint(ang * 0.63661977236758134308);
            double r = fma(-kq, 1.57079632679489655800e+00, ang); r = fma(-kq, 6.12323399573676603587e-17, r);
            const double r2 = r * r;
            double sn = -1.0 / 1307674368000.0; sn = sn * r2 + 1.0 / 6227020800.0; sn = sn * r2 - 1.0 / 39916800.0; sn = sn * r2 + 1.0 / 362880.0; sn = sn * r2 - 1.0 / 5040.0; sn = sn * r2 + 1.0 / 120.0; sn = sn * r2 - 1.0 / 6.0; sn = sn * r2 + 1.0; sn *= r;
            double cs = 1.0 / 20922789888000.0; cs = cs * r2 - 1.0 / 87178291200.0; cs = cs * r2 + 1.0 / 479001600.0; cs = cs * r2 - 1.0 / 3628800.0; cs = cs * r2 + 1.0 / 40320.0; cs = cs * r2 - 1.0 / 720.0; cs = cs * r2 + 1.0 / 24.0; cs = cs * r2 - 0.5; cs = cs * r2 + 1.0;
            const int q = (int)((long long)kq & 3);
            const double sv = (q == 0) ? sn : (q == 1) ? cs : (q == 2) ? -sn : -cs;
            const double cv = (q == 0) ? cs : (q == 1) ? -sn : (q == 2) ? -cs : sn;
            rc[i] = (float)cv; rsn[i] = (float)sv;
        }
    }
    {
        float* ssq = (float*)(ws + WS_SSQ);
        for (size_t i = gt; i < (size_t)M; i += GS) ssq[i] = 0.f;
        float* sp = (float*)(ws + WS_SP);
        for (size_t i = gt; i < 512; i += GS) sp[i] = log1pf(__expf(-p.in[I_LAM][i]));
        bf16* WG = (bf16*)(ws + WS_WG);
        for (size_t i = gt; i < (size_t)2 * 8 * 64 * 64; i += GS) {
            const int ii = (int)(i & 63), j = (int)((i >> 6) & 63), nb = (int)((i >> 12) & 7), gsel = (int)(i >> 15);
            const float* W = gsel ? p.in[I_WIG] : p.in[I_WRG];
            WG[i] = (bf16)f2bf(W[(nb * 64 + ii) * 64 + j]);
        }
    }
    TOC(52);
}

constexpr int LRU_WLDS = 14848;
template <int PASS> __device__ __forceinline__ void lru_unit(const Params& p, Frame& F, int sbi  , int nb, int sg) {
    unsigned char* ws = p.ws;
    const bool samp = sbi >= NB; const int b = samp ? sbi - NB : sbi;
    const int T = samp ? DT : 128, t0 = samp ? 0 : sg * 128;
    const size_t r0 = samp ? (size_t)MP + b * DT : (size_t)b * SEQ + t0;
    const int lane = F.lane, qc = lane & 15, kq = lane >> 4, ch = nb * 64 + lane;
    LAS unsigned char* wl = F.lds + F.wave * LRU_WLDS;
    LAS bf16* xcb = (LAS bf16*)wl; LAS float* xcf = (LAS float*)(wl + 2304); LAS float* av = (LAS float*)(wl + 2304 + 4096); LAS float* bv = (LAS float*)(wl + 2304 + 8192);
    const bf16* XR = (const bf16*)(ws + WS_XR) + r0 * LW + ch;
    const float cb = p.in[I_CB][ch], w0 = p.in[I_CW][ch], w1 = p.in[I_CW][LW + ch], w2 = p.in[I_CW][2 * LW + ch], w3 = p.in[I_CW][3 * LW + ch];
    float x1, x2, x3;
    if (t0 > 0) { x1 = bf2f(XR[-3 * LW]); x2 = bf2f(XR[-2 * LW]); x3 = bf2f(XR[-1 * LW]); }
    else if (samp) { const float* sc = p.in[I_SC] + (size_t)b * 3 * LW + ch; x1 = sc[0]; x2 = sc[LW]; x3 = sc[2 * LW]; }
    else { x1 = 0.f; x2 = 0.f; x3 = 0.f; }
    const bf16* GG = (const bf16*)(ws + WS_GG) + r0 * LW + ch; bf16* YC = (bf16*)(ws + WS_YC) + r0 * D + ch;
    unsigned short xn[16], gn2[16];
#pragma unroll
    for (int k = 0; k < 16; ++k) { xn[k] = XR[(size_t)k * LW]; gn2[k] = (PASS == 1) ? GG[(size_t)k * LW] : (unsigned short)0; }
    float Ac = 1.f, h = 0.f;
    if (PASS == 1) {
        h = samp ? p.in[I_SH][b * LW + ch] : 0.f;
        const f32x2* AGG = (const f32x2*)(ws + WS_AGG) + (size_t)sbi * 64 * LW + ch;
        f32x2 gn[8];
#pragma unroll
        for (int j = 0; j < 8; ++j) gn[j] = AGG[(size_t)(j < sg ? j : 0) * LW];
        for (int s0 = 0; s0 < sg; s0 += 8) {
            f32x2 g[8];
#pragma unroll
            for (int j = 0; j < 8; ++j) g[j] = gn[j];
            if (s0 + 8 < sg) {
#pragma unroll
                for (int j = 0; j < 8; ++j) gn[j] = AGG[(size_t)(s0 + 8 + j < sg ? s0 + 8 + j : 0) * LW];
            }
#pragma unroll
            for (int j = 0; j < 8; ++j) h = (s0 + j < sg) ? g[j].x * h + g[j].y : h;
        }
    }
    asm volatile("" ::: "memory");
    const bf16* WG = (const bf16*)(ws + WS_WG); const float* sp = (const float*)(ws + WS_SP);
    bf16x8 Wr[4][2], Wi[4][2]; float brg[4], big[4], spv[4];
#pragma unroll
    for (int jt = 0; jt < 4; ++jt) {
        const int j = 16 * jt + qc;
        const bf16* wr_ = WG + ((size_t)(0 * 8 + nb) * 64 + j) * 64 + 8 * kq; const bf16* wi_ = WG + ((size_t)(1 * 8 + nb) * 64 + j) * 64 + 8 * kq;
        Wr[jt][0] = *(const bf16x8*)wr_; Wr[jt][1] = *(const bf16x8*)(wr_ + 32); Wi[jt][0] = *(const bf16x8*)wi_; Wi[jt][1] = *(const bf16x8*)(wi_ + 32);
        brg[jt] = p.in[I_BRG][nb * 64 + j]; big[jt] = p.in[I_BIG][nb * 64 + j]; spv[jt] = sp[nb * 64 + j];
    }
    for (int st = 0; st < T; st += 16) {
        float xv[16], gg[16];
#pragma unroll
        for (int k = 0; k < 16; ++k) { xv[k] = bf2f(xn[k]); if (PASS == 1) gg[k] = bf2f(gn2[k]); }
        if (st + 16 < T) {
#pragma unroll
            for (int k = 0; k < 16; ++k) { xn[k] = XR[(size_t)(st + 16 + k) * LW]; if (PASS == 1) gn2[k] = GG[(size_t)(st + 16 + k) * LW]; }
        }
#pragma unroll
        for (int k = 0; k < 16; ++k) {
            const float xc = cb + w0 * x1 + w1 * x2 + w2 * x3 + w3 * xv[k];
            x1 = x2; x2 = x3; x3 = xv[k];
            xcf[k * 64 + lane] = xc; xcb[k * 72 + lane] = (bf16)f2bf(xc);
        }
        asm volatile("s_waitcnt lgkmcnt(0)" ::: "memory");
        const bf16x8 A0 = *(const LAS bf16x8*)(xcb + qc * 72 + 8 * kq), A1 = *(const LAS bf16x8*)(xcb + qc * 72 + 32 + 8 * kq);
#pragma unroll
        for (int jt = 0; jt < 4; ++jt) {
            const int j = 16 * jt + qc;
            f32x4 ar = {0.f, 0.f, 0.f, 0.f}, ai = {0.f, 0.f, 0.f, 0.f};
            ar = __builtin_amdgcn_mfma_f32_16x16x32_bf16(A0, Wr[jt][0], ar, 0, 0, 0); ar = __builtin_amdgcn_mfma_f32_16x16x32_bf16(A1, Wr[jt][1], ar, 0, 0, 0);
            ai = __builtin_amdgcn_mfma_f32_16x16x32_bf16(A0, Wi[jt][0], ai, 0, 0, 0); ai = __builtin_amdgcn_mfma_f32_16x16x32_bf16(A1, Wi[jt][1], ai, 0, 0, 0);
#pragma unroll
            for (int ii = 0; ii < 4; ++ii) {
                const int t = 4 * kq + ii;
                const float rg = sigmoidf_(ar[ii] + brg[jt]), ig = sigmoidf_(ai[ii] + big[jt]);
                const float a = __expf(-8.0f * rg * spv[jt]);
                float mult = sqrtf(fmaxf(1.0f - a * a, 0.f));
                if (!samp && (t0 + st + t) == 0) mult = 1.0f;
                av[t * 64 + j] = a; bv[t * 64 + j] = mult * ig * xcf[t * 64 + j];
            }
        }
        asm volatile("s_waitcnt lgkmcnt(0)" ::: "memory");
#pragma unroll
        for (int k = 0; k < 16; ++k) {
            const float a = av[k * 64 + lane], bb = bv[k * 64 + lane];
            h = a * h + bb;
            if (PASS == 0) Ac *= a;
            else YC[(size_t)(st + k) * D] = (bf16)f2bf(h * gg[k]);
        }
        asm volatile("s_waitcnt lgkmcnt(0)" ::: "memory");
    }
    if (PASS == 0) ((f32x2*)(ws + WS_AGG))[((size_t)sbi * 64 + sg) * LW + ch] = (f32x2){Ac, h};
    else { if (samp) p.out[O_HS + b * LW + ch] = h; else if (sg == 63) p.out[O_HP + b * LW + ch] = h; }
}
template <int PASS> __device__ __forceinline__ void lru_phase(const Params& p, Frame& F) {
    for (int u = F.bid * 8 + F.wave; u < 2048 + 64; u += F.G * 8) {
        if (u < 2048) lru_unit<PASS>(p, F, u >> 9, u & 7, (u >> 3) & 63);
        else lru_unit<PASS>(p, F, NB + ((u - 2048) >> 3), (u - 2048) & 7, 0);
    }
}

constexpr int A_CAND = 0, A_CNT = 131072, A_THR = 131072 + 128, A_FLAG = 131072 + 256, A_CNT0 = 131072 + 384, A_HBAR = 131072 + 512, A_TICK = 131072 + 576, CAP = 1024;
constexpr int VPITCH = 288;
extern "C" __device__ unsigned __ockl_wfred_max_u32(unsigned);
extern "C" __device__ unsigned __ockl_wfred_min_u32(unsigned);
typedef short v4i16_t __attribute__((ext_vector_type(4)));

__device__ __forceinline__ unsigned pack_key(float s, int key) {
    unsigned u = __float_as_uint(s);
    u = (u & 0x80000000u) ? ~u : (u | 0x80000000u);
    return (u & 0xFFFFE000u) | (unsigned)(8191 - key);
}
extern "C" __device__ unsigned __ockl_wfred_add_u32(unsigned);
extern "C" __device__ unsigned __ockl_wfscan_add_u32(unsigned, bool);
struct SelRes { unsigned thr; int cnt; };
__device__ __forceinline__ SelRes select_rank(LAS unsigned* cq, int n, int rlo, int rhi, int lane) {
    unsigned e[16]; unsigned mx = 0u, mn = 0xFFFFFFFFu;
#pragma unroll
    for (int i = 0; i < 16; ++i) { const int idx = i * 64 + lane; const unsigned x = cq[idx]; const bool v = idx < n; e[i] = v ? x : 0u; mx = e[i] > mx ? e[i] : mx; const unsigned y = v ? x : 0xFFFFFFFFu; mn = y < mn ? y : mn; }
    unsigned lo = (unsigned)__builtin_amdgcn_readfirstlane((int)__ockl_wfred_min_u32(mn));
    unsigned hi = (unsigned)__builtin_amdgcn_readfirstlane((int)__ockl_wfred_max_u32(mx)); hi = hi == 0xFFFFFFFFu ? hi : hi + 1u;
    int clo = n;
    for (int it = 0; it < 40 && clo > rhi; ++it) {
        const unsigned piv = lo + ((hi - lo) >> 1);
        int c = 0;
#pragma unroll
        for (int i = 0; i < 16; ++i) c += __popcll(__ballot(e[i] >= piv));
        if (c >= rlo) { lo = piv; clo = c; } else hi = piv;
    }
    unsigned cl = 0u;
#pragma unroll
    for (int i = 0; i < 16; ++i) cl += (e[i] >= lo) ? 1u : 0u;
    unsigned pos = __ockl_wfscan_add_u32(cl, false);
#pragma unroll
    for (int i = 0; i < 16; ++i) { const bool k = e[i] >= lo; if (k) cq[pos] = e[i]; pos += k ? 1u : 0u; }
    SelRes r; r.thr = lo; r.cnt = clo; return r;
}

__device__ __forceinline__ void half_barrier(LAS unsigned* hb, int lane) {
    asm volatile("s_waitcnt vmcnt(0) lgkmcnt(0)" ::: "memory");
    if (lane == 0) {
        const unsigned gen = __hip_atomic_load(hb + 1, __ATOMIC_RELAXED, __HIP_MEMORY_SCOPE_WORKGROUP);
        const unsigned old = __hip_atomic_fetch_add(hb, 1u, __ATOMIC_RELAXED, __HIP_MEMORY_SCOPE_WORKGROUP);
        if (old == 3u) { __hip_atomic_store(hb, 0u, __ATOMIC_RELAXED, __HIP_MEMORY_SCOPE_WORKGROUP); __hip_atomic_store(hb + 1, gen + 1u, __ATOMIC_RELAXED, __HIP_MEMORY_SCOPE_WORKGROUP); }
        else { while (__hip_atomic_load(hb + 1, __ATOMIC_RELAXED, __HIP_MEMORY_SCOPE_WORKGROUP) == gen) __builtin_amdgcn_s_sleep(1); }
    }
    asm volatile("s_waitcnt lgkmcnt(0)" ::: "memory");
}
__device__ __forceinline__ void select_unit(const Params& p, Frame& F, size_t q0row, int L, const bf16* KI) {
    unsigned char* ws = p.ws;
    const bf16* QI = (const bf16*)(ws + WS_QI); const float* WI = (const float*)(ws + WS_WI);
    const int lane = F.lane, half = F.wave >> 2, wid = F.wave & 3, htid = F.tid & 255, qc = lane & 15, kq = lane >> 4;
    LAS unsigned* cand = (LAS unsigned*)(F.lds + A_CAND + half * 65536); LAS unsigned* cntp = (LAS unsigned*)(F.lds + A_CNT + half * 64); LAS unsigned* thrp = (LAS unsigned*)(F.lds + A_THR + half * 64);
    LAS unsigned* flagp = (LAS unsigned*)(F.lds + A_FLAG + half * 16); LAS unsigned* hb = (LAS unsigned*)(F.lds + A_HBAR + half * 16);
    constexpr int nq = 16;
    constexpr int nslots = 4; const int slot = wid;
    const int ql = qc;
    TIC(1);
    bf16x8 Bq[8][2]; float sinf_[8];
    {
        const size_t qrow = q0row + ql;
#pragma unroll
        for (int h = 0; h < 8; ++h) {
            const float w = WI[qrow * 8 + h];
            sinf_[h] = (w < 0.f) ? -INFINITY : INFINITY;
#pragma unroll
            for (int s = 0; s < 2; ++s) {
                const u32x4 raw = *(const u32x4*)(QI + qrow * 512 + h * 64 + 32 * s + 8 * kq);
                u32x4 o; o.x = pk2(bflo(raw.x) * w, bfhi(raw.x) * w); o.y = pk2(bflo(raw.y) * w, bfhi(raw.y) * w); o.z = pk2(bflo(raw.z) * w, bfhi(raw.z) * w); o.w = pk2(bflo(raw.w) * w, bfhi(raw.w) * w);
                Bq[h][s] = __builtin_bit_cast(bf16x8, o);
            }
        }
    }
    half_barrier(hb, lane);
    TOC(1);
    TIC(2);
    for (int arep_ = 0; arep_ <= DUP(8); ++arep_) {
    const int NG = (L + 63) >> 6; const bool tail = (L & 63) != 0;
    LAS unsigned* cnt0 = (LAS unsigned*)(F.lds + A_CNT0 + half * 64);
    int rk = (600 * 1024) / L; rk = rk < 48 ? 48 : (rk > 256 ? 256 : rk);
#if FORCE_SAFE_MODE
    const int mode0 = 1;
#else
    const int mode0 = 0;
#endif
    bf16x8 An[2][2];
#define LOAD_A(DST, G, T0, T1) do { int g_ = (G); g_ = g_ < NG ? g_ : NG - 1; _Pragma("unroll") for (int tl = T0; tl < T1; ++tl) { int arow = g_ * 64 + tl * 16 + qc; arow = arow < L ? arow : L - 1; \
        DST[tl - T0][0] = *(const bf16x8*)(KI + (size_t)arow * 64 + 8 * kq); DST[tl - T0][1] = *(const bf16x8*)(KI + (size_t)arow * 64 + 32 + 8 * kq); } } while (0)
#define LOAD_AN(G) LOAD_A(An, G, 0, 2)
    for (int mode = mode0; mode < 2; ++mode) {
    bool redo = false;
    if (htid < 16) { cntp[htid] = 0u; thrp[htid] = 0u; cnt0[htid] = 0u; }
    if (htid == 32) flagp[1] = 0u;
    int g0 = 0, KG = 16;
    LOAD_AN(slot);
    while (g0 < NG) {
        const int gend = (g0 + KG < NG) ? g0 + KG : NG;
        if (htid == 32) flagp[0] = 0u;
        half_barrier(hb, lane);
        const unsigned thr = thrp[ql];
        LAS unsigned* cq = cand + ql * CAP;
        TIC(3);
        for (int g = g0 + slot; g < gend; g += nslots) {
            TIC(7);
            bf16x8 Ah[2][2]; LOAD_A(Ah, g, 2, 4);
            unsigned pk[16];
#define TILE(TL, A0_, A1_) do { f32x4 s0 = {0.f, 0.f, 0.f, 0.f}; \
                _Pragma("unroll") for (int h = 0; h < 8; ++h) { f32x4 acc = {0.f, 0.f, 0.f, 0.f}; \
                    acc = __builtin_amdgcn_mfma_f32_16x16x32_bf16(A0_, Bq[h][0], acc, 0, 0, 0); acc = __builtin_amdgcn_mfma_f32_16x16x32_bf16(A1_, Bq[h][1], acc, 0, 0, 0); \
                    _Pragma("unroll") for (int i = 0; i < 4; ++i) s0[i] += __builtin_amdgcn_fmed3f(acc[i], 0.f, sinf_[h]); } \
                _Pragma("unroll") for (int i = 0; i < 4; ++i) pk[(TL) * 4 + i] = pack_key(s0[i], g * 64 + (TL) * 16 + 4 * kq + i); } while (0)
            TILE(0, An[0][0], An[0][1]); TILE(1, An[1][0], An[1][1]);
            __builtin_amdgcn_sched_barrier(0);
            { const int gn = g + nslots; LOAD_AN(gn < gend ? gn : gend + slot); }
            TILE(2, Ah[0][0], Ah[0][1]); TILE(3, Ah[1][0], Ah[1][1]);
#undef TILE
            if (tail && g == NG - 1) {
                int vt = L - g * 64 - 4 * kq; asm volatile("" : "+v"(vt));
#pragma unroll
                for (int j = 0; j < 16; ++j) pk[j] = ((j >> 2) * 16 + (j & 3) < vt) ? pk[j] : 0u;
            }
            TOC(7);
            TIC(8);
            int n = 0;
#pragma unroll
            for (int j = 0; j < 16; ++j) n += (pk[j] > thr) ? 1 : 0;
            if (n) {
                unsigned base = __hip_atomic_fetch_add(cntp + ql, (unsigned)n, __ATOMIC_RELAXED, __HIP_MEMORY_SCOPE_WORKGROUP);
                if (base + (unsigned)n > (unsigned)CAP) flagp[0] = 1u;
                else {
#pragma unroll
                    for (int j = 0; j < 16; ++j) if (pk[j] > thr) cq[base++] = pk[j];
                }
            }
            TOC(8);
        }
        TOC(3);
        TIC(4);
        half_barrier(hb, lane);
        TOC(4);
        TIC(5);
        const bool ovf = flagp[0] != 0u;
        if (ovf && mode == 0) { redo = true; break; }
        if (ovf) { if (htid < 16) cntp[htid] = cnt0[htid]; half_barrier(hb, lane); }
        const bool last = !ovf && gend == NG;
        if (!last) {
            const int plim = ovf ? 256 : (mode == 0 ? rk + (rk >> 2) : 512), rlo = mode == 0 ? rk : 256, rhi = mode == 0 ? rk + (rk >> 2) : 256;
#pragma unroll 1
            for (int i2 = 0; i2 < 4; ++i2) {
                const int qq = wid * 4 + i2;
                if (qq < nq) {
                    int n = __builtin_amdgcn_readfirstlane((int)cntp[qq]);
                    if (n > plim) { const SelRes r = select_rank(cand + qq * CAP, n, rlo, rhi, lane); n = r.cnt; if (lane == 0) { cntp[qq] = (unsigned)n; thrp[qq] = r.thr; } }
                    if (lane == 0) cnt0[qq] = (unsigned)n;
                }
            }
        }
        TOC(5);
        if (ovf) { KG = (KG >> 1) > nslots ? (KG >> 1) : nslots; LOAD_AN(g0 + slot); }
        else { g0 = gend; KG = mode == 0 ? NG : ((KG * 2 < 32) ? KG * 2 : 32); }
    }
    if (!redo && mode == 0 && L > 1024) {
        if (lane < 4) { const int qq = wid * 4 + lane; if (qq < nq && cntp[qq] < 256u) flagp[1] = 1u; }
        half_barrier(hb, lane);
        redo = flagp[1] != 0u;
    }
    half_barrier(hb, lane);
    if (!redo) break;
    }
    TOC(2);
#undef LOAD_AN
#undef LOAD_A
    }
    TIC(6);
    {
        int lane_b = lane; asm volatile("" : "+v"(lane_b));
        unsigned short* SEL = (unsigned short*)(ws + WS_SEL); int* NSEL = (int*)(ws + WS_NSEL);
#pragma unroll 1
        for (int i2 = 0; i2 < 4; ++i2) {
            const int qq = wid * 4 + i2;
            if (qq >= nq) continue;
            int n = __builtin_amdgcn_readfirstlane((int)cntp[qq]);
            if (n > 256) { select_rank(cand + qq * CAP, n, 256, 256, lane_b); n = 256; }
            asm volatile("s_waitcnt lgkmcnt(0)" ::: "memory");
            const LAS unsigned* cq = cand + qq * CAP;
            const size_t row = q0row + qq;
            u32x2 w;
            { const int k = 4 * lane_b; const unsigned e0 = k < n ? cq[k] : 8191u, e1 = k + 1 < n ? cq[k + 1] : 8191u, e2 = k + 2 < n ? cq[k + 2] : 8191u, e3 = k + 3 < n ? cq[k + 3] : 8191u;
              w.x = (8191u - (e0 & 8191u)) | ((8191u - (e1 & 8191u)) << 16); w.y = (8191u - (e2 & 8191u)) | ((8191u - (e3 & 8191u)) << 16); }
            *(u32x2*)(SEL + row * 256 + 4 * lane_b) = w;
            if (lane_b == 0) NSEL[row] = n;
        }
    }
    half_barrier(hb, lane);
    TOC(6);
}

__device__ __forceinline__ void attend_query(const Params& p, Frame& F, size_t qrow, const fp8* Kb, const fp8* Vb) {
    unsigned char* ws = p.ws;
    const bf16* Qb = (const bf16*)(ws + WS_Q); bf16* YC = (bf16*)(ws + WS_YC);
    const int lane_b = F.lane, qc_b = lane_b & 15, kq_b = lane_b >> 4, wid = F.wave;
    const int wb = wid * LRU_WLDS;
    LAS unsigned short* ix = (LAS unsigned short*)(F.lds + wb);
    LAS unsigned char* vst = F.lds + wb + 512;
    const int n = __builtin_amdgcn_readfirstlane(((const int*)(ws + WS_NSEL))[qrow]);
    *(LAS u32x2*)(ix + 4 * lane_b) = __builtin_nontemporal_load((const u32x2*)((const unsigned short*)(ws + WS_SEL) + qrow * 256 + 4 * lane_b));
    asm volatile("s_waitcnt lgkmcnt(0)" ::: "memory");
    const int h = lane_b & 15;
    long Bh8[4];
#pragma unroll
    for (int s = 0; s < 4; ++s) {
        const bool v = (h < 8) && ((h >> 2) == (kq_b >> 1));
        u32x4 raw = {0u, 0u, 0u, 0u};
        if (v) raw = __builtin_nontemporal_load((const u32x4*)(Qb + qrow * 512 + h * 64 + 32 * (kq_b & 1) + 8 * s));
        constexpr float QS = 0.125f * 1.4426950408889634f;
        const unsigned lo = pk4_fp8(bflo(raw.x) * QS, bfhi(raw.x) * QS, bflo(raw.y) * QS, bfhi(raw.y) * QS), hi = pk4_fp8(bflo(raw.z) * QS, bfhi(raw.z) * QS, bflo(raw.w) * QS, bfhi(raw.w) * QS);
        Bh8[s] = (long)(((unsigned long long)hi << 32) | lo);
    }
    float sc[64];
    u32x4 Kn[4][2];
#pragma unroll
    for (int t4 = 0; t4 < 4; ++t4) { const fp8* kr = Kb + (size_t)ix[t4 * 16 + qc_b] * KVW + 32 * kq_b; Kn[t4][0] = *(const u32x4*)kr; Kn[t4][1] = *(const u32x4*)(kr + 16); }
#pragma unroll
    for (int g4 = 0; g4 < 4; ++g4) {
        u32x4 Ka[4][2];
#pragma unroll
        for (int t4 = 0; t4 < 4; ++t4) { Ka[t4][0] = Kn[t4][0]; Ka[t4][1] = Kn[t4][1]; }
        if (g4 < 3) {
#pragma unroll
            for (int t4 = 0; t4 < 4; ++t4) { const fp8* kr = Kb + (size_t)ix[(g4 + 1) * 64 + t4 * 16 + qc_b] * KVW + 32 * kq_b; Kn[t4][0] = *(const u32x4*)kr; Kn[t4][1] = *(const u32x4*)(kr + 16); }
        }
#pragma unroll
        for (int t4 = 0; t4 < 4; ++t4) {
            f32x4 acc = {0.f, 0.f, 0.f, 0.f};
#pragma unroll
            for (int s = 0; s < 4; ++s) {
                const u32x4 kw = Ka[t4][s >> 1];
                const long a8 = (long)(((unsigned long long)((s & 1) ? kw.w : kw.y) << 32) | ((s & 1) ? kw.z : kw.x));
                acc = __builtin_amdgcn_mfma_f32_16x16x32_fp8_fp8(a8, Bh8[s], acc, 0, 0, 0);
            }
#pragma unroll
            for (int ii = 0; ii < 4; ++ii) sc[(g4 * 4 + t4) * 4 + ii] = acc[ii];
        }
        __builtin_amdgcn_sched_barrier(0);
    }
    if (n < 256) {
#pragma unroll
        for (int j = 0; j < 64; ++j) { const int key = (j >> 2) * 16 + 4 * kq_b + (j & 3); sc[j] = key < n ? sc[j] : -INFINITY; }
    }
    float mx = sc[0];
#pragma unroll
    for (int j = 1; j < 64; ++j) mx = fmaxf(mx, sc[j]);
    mx = fmaxf(mx, __shfl_xor(mx, 16)); mx = fmaxf(mx, __shfl_xor(mx, 32));
    float sum = 0.f;
#pragma unroll
    for (int j = 0; j < 64; ++j) { sc[j] = __builtin_amdgcn_exp2f(sc[j] - mx); sum += sc[j]; }
    sum += __shfl_xor(sum, 16); sum += __shfl_xor(sum, 32);
    const float rl = 1.0f / sum;
    bf16x8 pb[8];
#pragma unroll
    for (int b = 0; b < 8; ++b) { u32x4 w; w.x = pk2(sc[b * 8 + 0], sc[b * 8 + 1]); w.y = pk2(sc[b * 8 + 2], sc[b * 8 + 3]); w.z = pk2(sc[b * 8 + 4], sc[b * 8 + 5]); w.w = pk2(sc[b * 8 + 6], sc[b * 8 + 7]); pb[b] = __builtin_bit_cast(bf16x8, w); }
    f32x4 oacc[8];
#pragma unroll
    for (int dt = 0; dt < 8; ++dt) oacc[dt] = (f32x4){0.f, 0.f, 0.f, 0.f};
    u32x4 vr[4], vr2[4];
    const int vrow = lane_b >> 3, vch = lane_b & 7;
#pragma unroll
    for (int i = 0; i < 4; ++i) { vr[i] = *(const u32x4*)(Vb + (size_t)ix[8 * i + vrow] * KVW + vch * 16); vr2[i] = *(const u32x4*)(Vb + (size_t)ix[32 + 8 * i + vrow] * KVW + vch * 16); }
    const LAS unsigned char* trb = vst + (4 * kq_b + (qc_b >> 2)) * VPITCH + (qc_b & 3) * 8;
#pragma unroll
    for (int b = 0; b < 8; ++b) {
#pragma unroll
        for (int i = 0; i < 4; ++i) {
            const u32x2 c0 = fp8x4_bf16x4(vr[i].x), c1 = fp8x4_bf16x4(vr[i].y), c2 = fp8x4_bf16x4(vr[i].z), c3 = fp8x4_bf16x4(vr[i].w);
            LAS unsigned char* d = vst + (8 * i + vrow) * VPITCH + vch * 32;
            *(LAS u32x4*)d = (u32x4){c0.x, c0.y, c1.x, c1.y}; *(LAS u32x4*)(d + 16) = (u32x4){c2.x, c2.y, c3.x, c3.y};
        }
#pragma unroll
        for (int i = 0; i < 4; ++i) vr[i] = vr2[i];
        if (b < 6) {
#pragma unroll
            for (int i = 0; i < 4; ++i) vr2[i] = *(const u32x4*)(Vb + (size_t)ix[32 * (b + 2) + 8 * i + vrow] * KVW + vch * 16);
        }
        asm volatile("s_waitcnt lgkmcnt(0)" ::: "memory");
#pragma unroll
        for (int dt = 0; dt < 8; ++dt) {
            const v4i16_t lo = __builtin_amdgcn_ds_read_tr16_b64_v4i16((LAS v4i16_t*)(trb + dt * 32));
            const v4i16_t hi = __builtin_amdgcn_ds_read_tr16_b64_v4i16((LAS v4i16_t*)(trb + 16 * VPITCH + dt * 32));
            const bf16x8 Av = {lo[0], lo[1], lo[2], lo[3], hi[0], hi[1], hi[2], hi[3]};
            oacc[dt] = __builtin_amdgcn_mfma_f32_16x16x32_bf16(Av, pb[b], oacc[dt], 0, 0, 0);
        }
        asm volatile("s_waitcnt lgkmcnt(0)" ::: "memory");
        __builtin_amdgcn_sched_barrier(0);
    }
    if (h < 4) {
#pragma unroll
        for (int dd = 0; dd < 4; ++dd) { const f32x4 o = oacc[dd] * rl; u32x2 w; w.x = pk2(o[0], o[1]); w.y = pk2(o[2], o[3]); __builtin_nontemporal_store(w, (u32x2*)(YC + qrow * D + 512 + h * 64 + dd * 16 + 4 * kq_b)); }
    } else if (h < 8) {
#pragma unroll
        for (int dd = 0; dd < 4; ++dd) { const f32x4 o = oacc[4 + dd] * rl; u32x2 w; w.x = pk2(o[0], o[1]); w.y = pk2(o[2], o[3]); __builtin_nontemporal_store(w, (u32x2*)(YC + qrow * D + 512 + h * 64 + dd * 16 + 4 * kq_b)); }
    }
}

__device__ __forceinline__ void phase3(const Params& p, Frame& F) {
    unsigned char* ws = p.ws;
    lru_phase<0>(p, F);
    __syncthreads();
    TIC(9);
    TOC(9);
    {
        const int half = F.wave >> 2, htid = F.tid & 255;
        LAS unsigned* hb = (LAS unsigned*)(F.lds + A_HBAR + half * 16); LAS int* tick = (LAS int*)(F.lds + A_TICK + half * 16);
        if (htid == 0) { hb[0] = 0u; hb[1] = 0u; }
        __syncthreads();
        unsigned* ctr = (unsigned*)(ws + WS_CTL) + CW_QUEUE;
        for (int q = 2 * F.bid + half;;) {
            if (q >= 2048 + DB) break;
            size_t q0row; int L; const bf16* KI;
            const bool is_s = q >= 1024 && q < 1024 + DB;
            if (!is_s) {
                const int u = q < 1024 ? q : q - DB, chunk = 127 - (u >> 4), b = (u & 15) >> 2, quarter = u & 3;
                q0row = (size_t)b * SEQ + chunk * 64 + quarter * 16; L = 64 * (chunk + 1);
                KI = (const bf16*)(ws + WS_KIB) + (size_t)b * SEQ * 64;
            } else {
                const int s = q - 1024;
                q0row = (size_t)MP + s * DT; L = SKEYS;
                KI = (const bf16*)(ws + WS_KIS) + (size_t)s * SKEYS * 64;
            }
            select_unit(p, F, q0row, L, KI);
            if (htid == 0) *tick = (int)(2 * F.G + __hip_atomic_fetch_add(ctr, 1u, __ATOMIC_RELAXED, __HIP_MEMORY_SCOPE_AGENT));
            half_barrier(hb, F.lane);
            q = *tick;
            half_barrier(hb, F.lane);
        }
    }
}

__device__ __forceinline__ void phase4(const Params& p, Frame& F) {
    unsigned char* ws = p.ws;
    if (F.wave < 4) {
        for (int u = F.bid * 4 + F.wave; u < 2048 + 64; u += F.G * 4) {
            if (u < 2048) lru_unit<1>(p, F, u >> 9, u & 7, (u >> 3) & 63);
            else lru_unit<1>(p, F, NB + ((u - 2048) >> 3), (u - 2048) & 7, 0);
        }
    }
    const bool aff = (F.G & 7) == 0;
    const int x = F.bid & 7, b = aff ? (x >> 1) : (F.bid & 3);
    const int nwv = aff ? (F.G >> 2) * 8 : ((F.G + 3 - (F.bid & 3)) / 4) * 8;
    const int wv = aff ? ((F.bid >> 3) * 2 + (x & 1)) * 8 + F.wave : (F.bid >> 2) * 8 + F.wave;
    unsigned* ctr = (unsigned*)(ws + WS_CTL) + CW_QUEUE + 64 * (1 + b);
    const fp8* Kb = (const fp8*)(ws + WS_KB) + (size_t)b * SEQ * KVW; const fp8* Vb = (const fp8*)(ws + WS_VB) + (size_t)b * SEQ * KVW;
    for (int q = wv;;) {
        if (q >= SEQ + 2 * DT) break;
        if (q < SEQ) attend_query(p, F, (size_t)b * SEQ + q, Kb, Vb);
        else { const int qs = q - SEQ, s = 2 * b + (qs >> 4);
            attend_query(p, F, (size_t)MP + s * DT + (qs & 15), (const fp8*)(ws + WS_KS) + (size_t)s * SKEYS * KVW, (const fp8*)(ws + WS_VS) + (size_t)s * SKEYS * KVW); }
        unsigned t = 0u;
        if (F.lane == 0) t = __hip_atomic_fetch_add(ctr, 1u, __ATOMIC_RELAXED, __HIP_MEMORY_SCOPE_AGENT);
        q = nwv + __builtin_amdgcn_readfirstlane((int)t);
    }
}

__global__ void __launch_bounds__(512, 2) fwd_kernel(Params p) {
    extern __shared__ __attribute__((aligned(16))) unsigned char lds_raw[];
    Frame F; F.lds = (LAS unsigned char*)lds_raw; F.tid = threadIdx.x; F.lane = F.tid & 63; F.wave = __builtin_amdgcn_readfirstlane(F.tid >> 6); F.G = gridDim.x; F.bid = blockIdx.x;
    unsigned char* ws = p.ws;
    const int lo = p.ph_lo, hi = p.ph_hi;
#if !USE_CG_SYNC
    if (F.tid < 64) ((LAS unsigned*)(F.lds + LDSCTL_OFF))[F.tid] = 0u;
    __syncthreads();
    XcdBarrier xbar = xcd_barrier_post((unsigned*)(ws + WS_CTL) + CW_BAR, (volatile LAS unsigned*)(F.lds + LDSCTL_OFF));
#endif
#define IN(k) (lo <= (k) && (k) < hi)
#ifndef SKIPMASK
#define SKIPMASK 0
#endif
#define SKIP(k) ((SKIPMASK >> (k)) & 1)
#define REPS(k) for (int rep_ = 0; rep_ <= DUP(k); ++rep_, (rep_ <= DUP(k) ? GSYNC() : (void)0))
#if USE_CG_SYNC
#define GSYNC() cg::this_grid().sync()
#else
#define GSYNC() xcd_barrier(xbar)
#endif
#define SEAM(k) do { if (IN(k) && IN((k) + 1)) { GSYNC(); } } while (0)
    { TIC(20); if (IN(0) && !SKIP(0)) REPS(0) phase0(p, F); TOC(20); }
    { TIC(40); SEAM(0); TOC(40); }
    if (IN(1) && !SKIP(1)) REPS(1) {
        pg8::Gemm g{(const pg8::bf16_t*)(ws + WS_XB), (const pg8::bf16_t*)(ws + WS_WIN), MP, NIN, D};
        pg8::StaticOrder S; S.init(MP, NIN, F.G, F.bid);
        EpiInProj E{(const float*)(ws + WS_RSTD), (const float*)(ws + WS_RCOS), (const float*)(ws + WS_RSIN), p.in[I_QN], p.in[I_KN],
                    (bf16*)(ws + WS_XR), (bf16*)(ws + WS_GG), (bf16*)(ws + WS_Q), (bf16*)(ws + WS_QI), (fp8*)(ws + WS_KB), (fp8*)(ws + WS_VB), (bf16*)(ws + WS_KIB),
                    (fp8*)(ws + WS_KS), (fp8*)(ws + WS_VS), (bf16*)(ws + WS_KIS), (float*)(ws + WS_WI), p.out};
        { TIC(21); pg8::gemm_phase<EpiInProj, pg8::StaticOrder, true, true>(F.lds, g, S, E); TOC(21); }
        TIC(31);
        {
            const float* rstd = E.rstd + MP; const float* rcos = E.rcos; const float* rsin = E.rsin; const float* gq = E.gq; const float* gk = E.gk; float* out = p.out;
            bf16* XR = E.XR + (size_t)MP * LW; bf16* GG = E.GG + (size_t)MP * LW; bf16* Q = E.Q + (size_t)MP * 512; bf16* QI = E.QI + (size_t)MP * 512;
            fp8* KS = E.KS; fp8* VS = E.VS; bf16* KIS = E.KIS; float* WI = E.WI + (size_t)MP * 8;
            skinny_gemm<4, 4>(F, (const bf16*)(ws + WS_XB) + (size_t)MP * D, D, (const bf16*)(ws + WS_WIN), D, 38,
                [](int hb_, int nb, int r) { const int c = 64 * hb_ + 16 * nb + r, pn = c >> 8, wc = (c >> 6) & 3, bj = (c >> 5) & 1, w32 = c & 31, fq = w32 >> 3, n = (w32 >> 2) & 1, j = w32 & 3;
                                             return 256 * pn + 128 * bj + 32 * wc + 16 * n + 4 * fq + j; },
                [=](const f32x4 (&acc)[4], int r, int c0, int kq) {
                    const int hbk = c0 >> 4, sb = r >> 4, t = r & 15, pos = PAST + t;
                    const float rsd = rstd[r];
                    f32x4 v[4];
#pragma unroll
                    for (int nb = 0; nb < 4; ++nb) v[nb] = acc[nb] * rsd;
                    const bool norm = (hbk >= 16 && hbk < 26), rope = norm || (hbk >= 28 && hbk < 37);
                    if (norm) {
                        float ss = 0.f;
#pragma unroll
                        for (int nb = 0; nb < 4; ++nb) ss += (v[nb][0] * v[nb][0] + v[nb][1] * v[nb][1]) + (v[nb][2] * v[nb][2] + v[nb][3] * v[nb][3]);
                        ss += __shfl_xor(ss, 16); ss += __shfl_xor(ss, 32);
                        const float inv = rsqrtf(ss * (1.0f / 64.0f) + EPS); const float* g = hbk < 24 ? gq : gk;
#pragma unroll
                        for (int nb = 0; nb < 4; ++nb) v[nb] = v[nb] * inv * *(const f32x4*)(g + 16 * nb + 4 * kq);
                    }
                    if (rope) {
#pragma unroll
                        for (int nb = 0; nb < 2; ++nb) {
                            const f32x4 c4 = *(const f32x4*)(rcos + pos * 32 + 16 * nb + 4 * kq), s4 = *(const f32x4*)(rsin + pos * 32 + 16 * nb + 4 * kq);
                            const f32x4 x1 = v[nb], x2 = v[nb + 2];
                            v[nb] = x1 * c4 - x2 * s4; v[nb + 2] = x2 * c4 + x1 * s4;
                        }
                    }
#pragma unroll
                    for (int nb = 0; nb < 4; ++nb) {
                        const int d = 16 * nb + 4 * kq; const f32x4 x = v[nb];
                        u32x2 wb; wb.x = pg8::cvt_pk_bf16(x[0], x[1]); wb.y = pg8::cvt_pk_bf16(x[2], x[3]);
                        if (hbk < 8) {
                            const int c = 64 * hbk + d; *(u32x2*)(XR + (size_t)r * LW + c) = wb;
                            if (t >= DT - 3) *(f32x4*)(out + O_CS + ((size_t)(sb * 3 + (t - (DT - 3)))) * LW + c) = x;
                        } else if (hbk < 16) {
                            f32x4 gl; gl[0] = gelu_tanh(x[0]); gl[1] = gelu_tanh(x[1]); gl[2] = gelu_tanh(x[2]); gl[3] = gelu_tanh(x[3]);
                            u32x2 wg; wg.x = pg8::cvt_pk_bf16(gl[0], gl[1]); wg.y = pg8::cvt_pk_bf16(gl[2], gl[3]);
                            *(u32x2*)(GG + (size_t)r * LW + 64 * (hbk - 8) + d) = wg;
                        } else if (hbk < 24) { *(u32x2*)(Q + (size_t)r * 512 + 64 * (hbk - 16) + d) = wb;
                        } else if (hbk < 28) {
                            const int kvh = hbk & 1; const bool isk = hbk < 26;
                            *(f32x4*)(out + (isk ? O_KS : O_VS) + (size_t)r * KVW + kvh * 64 + d) = x;
                            *(unsigned*)((isk ? KS : VS) + ((size_t)sb * SKEYS + PAST + t) * KVW + kvh * 64 + d) = pk4_fp8(x[0], x[1], x[2], x[3]);
                        } else if (hbk < 36) { *(u32x2*)(QI + (size_t)r * 512 + 64 * (hbk - 28) + d) = wb;
                        } else if (hbk == 36) {
                            *(f32x4*)(out + O_KIS + (size_t)r * 64 + d) = x;
                            *(u32x2*)(KIS + ((size_t)sb * SKEYS + PAST + t) * 64 + d) = wb;
                        } else if (d < 8) { *(f32x4*)(WI + (size_t)r * 8 + d) = x * WI_SCALE; }
                    }
                });
        }
        TOC(31);
    }
    { TIC(41); SEAM(1); TOC(41); }
    { TIC(23); if (IN(2) && !SKIP(2)) REPS(2) phase3(p, F); TOC(23); }
    { TIC(43); SEAM(2); TOC(43); }
    { TIC(24); if (IN(3) && !SKIP(3)) REPS(3) phase4(p, F); TOC(24); }
    { TIC(44); SEAM(3); TOC(44); }
    if (IN(4) && !SKIP(4)) REPS(4) {
        pg8::Gemm g{(const pg8::bf16_t*)(ws + WS_YC), (const pg8::bf16_t*)(ws + WS_WOUT), MP, D, D};
        pg8::StaticOrder S; S.init(MP, D, F.G, F.bid);
        EpiOutProj E{p.in[I_XP], p.in[I_XS], p.out, (bf16*)(ws + WS_XB), (rep_ < DUP(4)) ? (float*)(ws + WS_CTL + 65536) : (float*)(ws + WS_SSQ)};
        { TIC(25); pg8::gemm_phase<EpiOutProj, pg8::StaticOrder, true, true>(F.lds, g, S, E); TOC(25); }
        TIC(35);
        {
            const float* xs = p.in[I_XS]; float* ys = p.out + O_YS; bf16* XB2 = (bf16*)(ws + WS_XB) + (size_t)MP * D; float* ssq = E.ssq + MP;
            skinny_gemm<1, 4>(F, (const bf16*)(ws + WS_YC) + (size_t)MP * D, D, (const bf16*)(ws + WS_WOUT), D, D / 16,
                [](int ct, int, int r) { return 16 * ct + r; },
                [=](const f32x4 (&acc)[1], int r, int c0, int) {
                    const f32x4 y = *(const f32x4*)(xs + (size_t)r * D + c0) + acc[0];
                    *(f32x4*)(ys + (size_t)r * D + c0) = y;
                    u32x2 w; w.x = pg8::cvt_pk_bf16(y[0], y[1]); w.y = pg8::cvt_pk_bf16(y[2], y[3]); *(u32x2*)(XB2 + (size_t)r * D + c0) = w;
                    float ss = (y[0] * y[0] + y[1] * y[1]) + (y[2] * y[2] + y[3] * y[3]);
                    ss += __shfl_xor(ss, 16); ss += __shfl_xor(ss, 32);
                    if ((threadIdx.x & 48) == 0) atomicAdd(ssq + r, ss);
                });
        }
        TOC(35);
    }
    { TIC(45); SEAM(4); TOC(45); }
    if (IN(5) && !SKIP(5)) REPS(5) {
        pg8::Gemm g{(const pg8::bf16_t*)(ws + WS_XB), (const pg8::bf16_t*)(ws + WS_WFI), MP, 2 * DFF, D};
        pg8::StaticOrder S; S.init(MP, 2 * DFF, F.G, F.bid);
        EpiFfnIn E{(const float*)(ws + WS_SSQ), (bf16*)(ws + WS_H)};
        { TIC(26); pg8::gemm_phase<EpiFfnIn, pg8::StaticOrder, true, true>(F.lds, g, S, E); TOC(26); }
        TIC(36);
        {
            const float* ssq = (const float*)(ws + WS_SSQ) + MP; bf16* H = (bf16*)(ws + WS_H) + (size_t)MP * DFF;
            skinny_gemm<2, 4>(F, (const bf16*)(ws + WS_XB) + (size_t)MP * D, D, (const bf16*)(ws + WS_WFI), D, DFF / 16,
                [](int ct, int nb, int r) { const int c = 16 * ct + r, pn = c >> 7, wc = (c >> 5) & 3, w32 = c & 31, fq = w32 >> 3, n = (w32 >> 2) & 1, j = w32 & 3; return 256 * pn + 128 * nb + 32 * wc + 16 * n + 4 * fq + j; },
                [=](const f32x4 (&acc)[2], int r, int c0, int) {
                    const float rs2 = rsqrtf(ssq[r] * (1.0f / 1024.0f) + EPS);
                    const f32x4 g = acc[0] * rs2, up = acc[1] * rs2; f32x4 h;
#pragma unroll
                    for (int j = 0; j < 4; ++j) h[j] = g[j] * sigmoidf_(g[j]) * up[j];
                    u32x2 w; w.x = pg8::cvt_pk_bf16(h[0], h[1]); w.y = pg8::cvt_pk_bf16(h[2], h[3]); *(u32x2*)(H + (size_t)r * DFF + c0) = w;
                });
        }
        TOC(36);
    }
    { TIC(46); SEAM(5); TOC(46); }
    if (IN(6) && !SKIP(6)) {
        pg8::Gemm g{(const pg8::bf16_t*)(ws + WS_H), (const pg8::bf16_t*)(ws + WS_WFO), MP, D, DFF};
        pg8::StaticOrder S; S.init(MP, D, F.G, F.bid);
        EpiFfnOut E{p.out, (const bf16*)(ws + WS_XB)};
        { TIC(27); pg8::gemm_phase<EpiFfnOut, pg8::StaticOrder, true, true>(F.lds, g, S, E); TOC(27); }
        TIC(37);
        {
            float* ys = p.out + O_YS;
            skinny_gemm<1, 11>(F, (const bf16*)(ws + WS_H) + (size_t)MP * DFF, DFF, (const bf16*)(ws + WS_WFO), DFF, D / 16,
                [](int ct, int, int r) { return 16 * ct + r; },
                [=](const f32x4 (&acc)[1], int r, int c0, int) { float* y = ys + (size_t)r * D + c0; *(f32x4*)y = *(const f32x4*)y + acc[0]; });
        }
        TOC(37);
    }
    if (TSEG && F.bid == 0 && F.tid == 0) { const unsigned acc_ = *(LAS unsigned*)(F.lds + LDSCTL_OFF + 128); const unsigned long long t0_ = __builtin_amdgcn_s_memrealtime(); while ((unsigned)(__builtin_amdgcn_s_memrealtime() - t0_) < acc_) __builtin_amdgcn_s_sleep(8); }
#undef IN
#undef SEAM
}

#ifndef N_LAUNCHES
#define N_LAUNCHES 1
#endif
constexpr int NPHASE = 7;
extern "C" void kernel_launch(void* const* d_in, const int* in_sizes, int n_in, void* d_out, int out_size, void* d_ws, size_t ws_size, hipStream_t stream) {
    static int grid = 0;
    if (grid == 0) {
        if (n_in != 22 || out_size != (int)O_END || ws_size < WS_END) { fprintf(stderr, "kernel_launch: unexpected shapes: n_in %d out %d ws %zu (need %zu)\n", n_in, out_size, ws_size, (size_t)WS_END); grid = -1; return; }
        int dev = 0, cus = 0, per_cu = 0;
        if (hipGetDevice(&dev) != hipSuccess || hipDeviceGetAttribute(&cus, hipDeviceAttributeMultiprocessorCount, dev) != hipSuccess) { grid = -1; return; }
        if (hipFuncSetAttribute((const void*)fwd_kernel, hipFuncAttributeMaxDynamicSharedMemorySize, LDS_BYTES) != hipSuccess) { fprintf(stderr, "kernel_launch: hipFuncSetAttribute failed\n"); grid = -1; return; }
        if (hipOccupancyMaxActiveBlocksPerMultiprocessor(&per_cu, (const void*)fwd_kernel, 512, LDS_BYTES) != hipSuccess || per_cu < 1) { fprintf(stderr, "kernel_launch: occupancy query says %d blocks/CU\n", per_cu); per_cu = 1; }
        (void)hipGetLastError();
        grid = cus;
    }
    if (grid < 0) return;
    if (!USE_CG_SYNC) { if (hipMemsetAsync((char*)d_ws + WS_CTL, 0, 65536, stream) != hipSuccess) { fprintf(stderr, "kernel_launch: memset failed\n"); return; } }
    Params p{};
    for (int i = 0; i < 22; ++i) p.in[i] = (const float*)d_in[i];
    p.out = (float*)d_out; p.ws = (unsigned char*)d_ws;
    for (int i = 0; i < 32; ++i) p.invf[i] = pow(10000.0, -(double)i / 32.0);
    if (N_LAUNCHES == 1) {
        p.ph_lo = 0; p.ph_hi = NPHASE;
        void* args[] = {&p};
        hipError_t e = hipLaunchCooperativeKernel((const void*)fwd_kernel, dim3(grid), dim3(512), args, LDS_BYTES, stream);
        if (e != hipSuccess) fprintf(stderr, "kernel_launch: cooperative launch failed: %s (grid %d)\n", hipGetErrorString(e), grid);
    } else {
        for (int k = 0; k < NPHASE; ++k) { p.ph_lo = k; p.ph_hi = k + 1; hipLaunchKernelGGL(fwd_kernel, dim3(grid), dim3(512), LDS_BYTES, stream, p); }
    }
}
```

```cpp
#include <hip/hip_runtime.h>
#include <hip/hip_cooperative_groups.h>
#include <cstdio>
#include <cstdint>
#include <cmath>
namespace cg = cooperative_groups;
namespace pg8 {
#define PG8_LAS __attribute__((address_space(3)))
typedef unsigned short bf16_t;
typedef short bf16x8 __attribute__((ext_vector_type(8)));
typedef float f32x4 __attribute__((ext_vector_type(4)));
typedef unsigned u32x4 __attribute__((ext_vector_type(4)));
constexpr int BM = 256, BK = 64, HALF = 128, HTB = HALF * BK * 2  , STAGE_BYTES = 8 * HTB, NXCD = 8, WGM = 8;

__host__ __device__ __forceinline__ int lds_byte(int r, int c) { const int st = (r >> 4) * 2 + (c >> 5), rr = r & 15, cc = c & 31, ob = rr * 64 + cc * 2; return st * 1024 + (ob ^ (((ob >> 9) & 1) << 5)); }
__host__ __device__ __forceinline__ void stage_rc(int b, int& R, int& C) { const int st = b / 1024, sb = b % 1024, swz = sb ^ (((sb >> 9) & 1) << 5); R = (st >> 1) * 16 + swz / 64; C = (st & 1) * 32 + (swz % 64) / 2; }
__host__ __device__ __forceinline__ int perm32(int rho) { const int n = rho >> 4, i = rho & 15; return 8 * (i >> 2) + 4 * n + (i & 3); }

struct Unit { int pm, pn; };
struct Gemm { const bf16_t* A; const bf16_t* Bt; int M, N, K; };

struct StaticOrder {
    int nM, nN, nwg, G, c;
    __host__ __device__ void init(int M, int N, int G_, int c_) { nM = M / BM; nN = N / BM; nwg = nM * nN; G = G_; c = c_; }
    __host__ __device__ bool next(int i, Unit& u) const {
        const long L = (long)i * G + c; if (L >= nwg) return false;
        int wgid = (int)L; { const int q = nwg / NXCD, r = nwg % NXCD, xcd = wgid % NXCD, off = wgid / NXCD; wgid = (xcd < r ? xcd * (q + 1) : r * (q + 1) + (xcd - r) * q) + off; }
        const int nig = WGM * nN, gid = wgid / nig, fm = gid * WGM, gsz = (nM - fm) < WGM ? (nM - fm) : WGM;
        u.pm = fm + ((wgid % nig) % gsz); u.pn = (wgid % nig) / gsz; return true;
    }
    __device__ __forceinline__ void a_ready(const Unit&) const {}
    __device__ __forceinline__ void done(const Unit&) const {}
};
__device__ __forceinline__ unsigned cvt_pk_bf16(float lo, float hi) { unsigned r; asm volatile("v_cvt_pk_bf16_f32 %0, %1, %2" : "=v"(r) : "v"(lo), "v"(hi)); return r; }
template <class Epi, class Sched, bool ALIGN_EPI = false, bool SP2 = false>
__device__ __forceinline__ void gemm_phase(PG8_LAS unsigned char* lds, const Gemm g, const Sched& S, const Epi& E) {
    const int tid = threadIdx.x, wid = __builtin_amdgcn_readfirstlane(tid >> 6), lane = tid & 63, wr = wid >> 2, wc = wid & 3, fr = lane & 15, fq = lane >> 4;
    const int K = g.K, nt = K / BK;
    unsigned voffA[2], voffB[2];
#pragma unroll
    for (int i = 0; i < 2; ++i) { int R, C; stage_rc(tid * 16 + i * 8192, R, C); const int Rb = Epi::PERM ? ((R & ~31) + perm32(R & 31)) : R;
        voffA[i] = (unsigned)(R * K + C) * 2u; voffB[i] = (unsigned)(Rb * K + C) * 2u; }
    const size_t kstep = (size_t)(BK * 2);
    const size_t hstep = (size_t)HALF * K * 2;
    const size_t tstep = 2 * hstep;
    const unsigned ldsw = (unsigned)wid * 1024u;
    const int aoff = lds_byte(wr * 64 + fr, fq * 8), boff = lds_byte(wc * 32 + fr, fq * 8);
#define PG8_SA(b, h) (((b) * 2 + (h)) * HTB)
#define PG8_SB(b, h) ((4 + (b) * 2 + (h)) * HTB)
#define PG8_STAGE(bufoff, gbase, voff) do { _Pragma("unroll") for (int _i = 0; _i < 2; ++_i) \
        __builtin_amdgcn_global_load_lds((const unsigned*)((const char*)(gbase) + (voff)[_i]), (PG8_LAS unsigned*)(lds + (bufoff) + ldsw + _i * 8192), 16, 0, 0); } while (0)
#define PG8_LDA(dst, b, h) do { _Pragma("unroll") for (int m = 0; m < 4; ++m) _Pragma("unroll") for (int k = 0; k < 2; ++k) dst[m][k] = *(const PG8_LAS bf16x8*)(lds + PG8_SA(b, h) + aoff + m * 2048 + k * 1024); } while (0)
#define PG8_LDB(dst, b, h) do { _Pragma("unroll") for (int n = 0; n < 2; ++n) _Pragma("unroll") for (int k = 0; k < 2; ++k) dst[n][k] = *(const PG8_LAS bf16x8*)(lds + PG8_SB(b, h) + boff + n * 2048 + k * 1024); } while (0)
#define PG8_MMA(ai, bj, At, Bt) do { __builtin_amdgcn_s_setprio(1); _Pragma("unroll") for (int m = 0; m < 4; ++m) _Pragma("unroll") for (int n = 0; n < 2; ++n) _Pragma("unroll") for (int k = 0; k < 2; ++k) \
        acc[ai][bj][m][n] = __builtin_amdgcn_mfma_f32_16x16x32_bf16(Bt[n][k], At[m][k], acc[ai][bj][m][n], 0, 0, 0); __builtin_amdgcn_s_setprio(0); } while (0)
#define PG8_WAIT_V(n) asm volatile("s_waitcnt vmcnt(" #n ")" ::: "memory")
#define PG8_WAIT_L(n) asm volatile("s_waitcnt lgkmcnt(" #n ")" ::: "memory")
#define PG8_BAR __builtin_amdgcn_s_barrier()
#define PG8_SCHED __builtin_amdgcn_sched_barrier(0)
    Unit cur, nxt; int ui = 0;
    if (!S.next(0, cur)) return;
    f32x4 acc[2][2][4][2];
#pragma unroll
    for (int a = 0; a < 2; ++a)
#pragma unroll
        for (int b = 0; b < 2; ++b)
#pragma unroll
            for (int m = 0; m < 4; ++m)
#pragma unroll
                for (int n = 0; n < 2; ++n) acc[a][b][m][n] = (f32x4){0.f, 0.f, 0.f, 0.f};
    bf16x8 At[4][2], B0[2][2], B1[2][2];
    const char* cA = (const char*)g.A + (size_t)cur.pm * tstep; const char* cB = (const char*)g.Bt + (size_t)cur.pn * tstep;
    S.a_ready(cur);
    if constexpr (SP2) {
        PG8_STAGE(PG8_SB(0, 0), cB, voffB); PG8_STAGE(PG8_SB(0, 1), cB + hstep, voffB); PG8_STAGE(PG8_SA(0, 0), cA, voffA); PG8_STAGE(PG8_SA(0, 1), cA + hstep, voffA);
        if (wr == 1) PG8_BAR;
        PG8_WAIT_V(2); PG8_BAR;
        PG8_STAGE(PG8_SB(1, 0), cB + kstep, voffB); PG8_STAGE(PG8_SA(1, 0), cA + kstep, voffA); PG8_STAGE(PG8_SB(1, 1), cB + hstep + kstep, voffB);
        PG8_WAIT_V(6); PG8_BAR;
    } else {
        PG8_STAGE(PG8_SB(0, 0), cB, voffB); PG8_STAGE(PG8_SA(0, 0), cA, voffA); PG8_STAGE(PG8_SB(0, 1), cB + hstep, voffB); PG8_STAGE(PG8_SA(0, 1), cA + hstep, voffA);
        if (wr == 1) PG8_BAR;
        PG8_WAIT_V(4); PG8_BAR;
        PG8_STAGE(PG8_SB(1, 0), cB + kstep, voffB); PG8_STAGE(PG8_SA(1, 0), cA + kstep, voffA); PG8_STAGE(PG8_SB(1, 1), cB + hstep + kstep, voffB);
        PG8_WAIT_V(6); PG8_BAR;
    }
    for (;;) {
        const bool has_next = S.next(ui + 1, nxt);
        const char* nA = has_next ? (const char*)g.A + (size_t)nxt.pm * tstep : cA; const char* nB = has_next ? (const char*)g.Bt + (size_t)nxt.pn * tstep : cB;
        for (int t = 0; t < nt; t += 2) {
            const bool last = (t == nt - 2);
            const char* a1 = cA + (size_t)(t + 1) * kstep;
            const char* a2 = last ? nA : cA + (size_t)(t + 2) * kstep; const char* b2 = last ? nB : cB + (size_t)(t + 2) * kstep;
            const char* a3 = a2 + kstep; const char* b3 = b2 + kstep;
            if (last && has_next) S.a_ready(nxt);
            if constexpr (SP2) {
            PG8_LDB(B0, 0, 0); PG8_LDB(B1, 0, 1); PG8_SCHED; PG8_LDA(At, 0, 0); PG8_STAGE(PG8_SA(1, 1), a1 + hstep, voffA);
            PG8_WAIT_V(8); PG8_WAIT_L(0); PG8_BAR; PG8_MMA(0, 0, At, B0); PG8_MMA(0, 1, At, B1); PG8_BAR; PG8_SCHED;
            PG8_LDA(At, 0, 1); PG8_STAGE(PG8_SB(0, 0), b2, voffB); PG8_STAGE(PG8_SB(0, 1), b2 + hstep, voffB); PG8_STAGE(PG8_SA(0, 0), a2, voffA);
            PG8_WAIT_V(8); PG8_WAIT_L(0); PG8_BAR; PG8_MMA(1, 0, At, B0); PG8_MMA(1, 1, At, B1); PG8_BAR; PG8_SCHED;
            PG8_LDB(B0, 1, 0); PG8_LDB(B1, 1, 1); PG8_SCHED; PG8_LDA(At, 1, 0); PG8_STAGE(PG8_SA(0, 1), a2 + hstep, voffA);
            PG8_WAIT_V(8); PG8_WAIT_L(0); PG8_BAR; PG8_MMA(0, 0, At, B0); PG8_MMA(0, 1, At, B1); PG8_BAR; PG8_SCHED;
            PG8_LDA(At, 1, 1); PG8_STAGE(PG8_SB(1, 0), b3, voffB); PG8_STAGE(PG8_SB(1, 1), b3 + hstep, voffB); PG8_STAGE(PG8_SA(1, 0), a3, voffA);
            PG8_WAIT_V(8); PG8_WAIT_L(0); PG8_BAR; PG8_MMA(1, 0, At, B0); PG8_MMA(1, 1, At, B1); PG8_BAR; PG8_SCHED;
            } else {
            PG8_LDB(B0, 0, 0); PG8_SCHED; PG8_LDA(At, 0, 0); PG8_STAGE(PG8_SA(1, 1), a1 + hstep, voffA);
            PG8_WAIT_L(8); PG8_BAR; PG8_WAIT_L(0); PG8_MMA(0, 0, At, B0); PG8_BAR; PG8_SCHED;
            PG8_LDB(B1, 0, 1); PG8_STAGE(PG8_SB(0, 0), b2, voffB);
            PG8_BAR; PG8_WAIT_L(0); PG8_MMA(0, 1, At, B1); PG8_BAR;
            PG8_LDA(At, 0, 1); PG8_STAGE(PG8_SA(0, 0), a2, voffA);
            PG8_BAR; PG8_WAIT_L(0); PG8_MMA(1, 0, At, B0); PG8_BAR; PG8_SCHED;
            PG8_STAGE(PG8_SB(0, 1), b2 + hstep, voffB);
            PG8_WAIT_V(6); PG8_BAR; PG8_MMA(1, 1, At, B1); PG8_BAR;
            PG8_LDB(B0, 1, 0); PG8_SCHED; PG8_LDA(At, 1, 0); PG8_STAGE(PG8_SA(0, 1), a2 + hstep, voffA);
            PG8_WAIT_L(8); PG8_BAR; PG8_WAIT_L(0); PG8_MMA(0, 0, At, B0); PG8_BAR; PG8_SCHED;
            PG8_LDB(B1, 1, 1); PG8_STAGE(PG8_SB(1, 0), b3, voffB);
            PG8_BAR; PG8_WAIT_L(0); PG8_MMA(0, 1, At, B1); PG8_BAR;
            PG8_LDA(At, 1, 1); PG8_STAGE(PG8_SA(1, 0), a3, voffA);
            PG8_BAR; PG8_WAIT_L(0); PG8_MMA(1, 0, At, B0); PG8_BAR; PG8_SCHED;
            PG8_STAGE(PG8_SB(1, 1), b3 + hstep, voffB);
            PG8_WAIT_V(6); PG8_BAR; PG8_MMA(1, 1, At, B1); PG8_BAR;
            }
        }
        if constexpr (ALIGN_EPI) { if (wr == 0) PG8_BAR; }
        if constexpr (!Epi::AFTER_DRAIN) { E(acc, cur, wr, wc, fr, fq); S.done(cur); }
        if (!has_next) break;
#pragma unroll
        for (int a = 0; a < 2; ++a)
#pragma unroll
            for (int b = 0; b < 2; ++b)
#pragma unroll
                for (int m = 0; m < 4; ++m)
#pragma unroll
                    for (int n = 0; n < 2; ++n) acc[a][b][m][n] = (f32x4){0.f, 0.f, 0.f, 0.f};
        cur = nxt; cA = nA; cB = nB; ++ui;
        if constexpr (ALIGN_EPI) { if (wr == 1) PG8_BAR; }
    }
    PG8_WAIT_V(0);
    if constexpr (!ALIGN_EPI) { if (wr == 0) PG8_BAR; }
    PG8_BAR;
    if constexpr (Epi::AFTER_DRAIN) { E.fused(acc, cur, wr, wc, fr, fq, lds, wid, lane); S.done(cur); }
#undef PG8_SA
#undef PG8_SB
#undef PG8_STAGE
#undef PG8_LDA
#undef PG8_LDB
#undef PG8_MMA
#undef PG8_WAIT_V
#undef PG8_WAIT_L
#undef PG8_BAR
#undef PG8_SCHED
}
}

constexpr int D = 1024, NB = 4, SEQ = 8192, DB = 8, DT = 16, PAST = 4096;
constexpr int MP = NB * SEQ;
constexpr int MS = DB * DT;
constexpr int MR = MP + MS;
constexpr int M = 33024;
constexpr int LW = 512, NLB = 8, LBW = 64;
constexpr int KVW = 128;
constexpr int DIN = 2376, NIN = 2560;
constexpr int DFF = 2816;
constexpr int SKEYS = PAST + DT;
constexpr float EPS = 1e-6f;
constexpr float WI_SCALE = 0.044194173824159216f;

constexpr size_t O_YP = 0;
constexpr size_t O_YS = O_YP + (size_t)MP * D;
constexpr size_t O_KP = O_YS + (size_t)MS * D;
constexpr size_t O_VP = O_KP + (size_t)MP * KVW;
constexpr size_t O_KIP = O_VP + (size_t)MP * KVW;
constexpr size_t O_HP = O_KIP + (size_t)MP * 64;
constexpr size_t O_CP = O_HP + (size_t)NB * LW;
constexpr size_t O_KS = O_CP + (size_t)NB * 3 * LW;
constexpr size_t O_VS = O_KS + (size_t)MS * KVW;
constexpr size_t O_KIS = O_VS + (size_t)MS * KVW;
constexpr size_t O_HS = O_KIS + (size_t)MS * 64;
constexpr size_t O_CS = O_HS + (size_t)DB * LW;
constexpr size_t O_END = O_CS + (size_t)DB * 3 * LW;
static_assert(O_END == 44236800, "output size");

constexpr size_t al256(size_t x) { return (x + 255) & ~(size_t)255; }
constexpr size_t WS_CTL = 0, CTL_BYTES = 1u << 20;
constexpr size_t WS_WIN = WS_CTL + CTL_BYTES;
constexpr size_t WS_WOUT = WS_WIN + al256((size_t)NIN * D * 2);
constexpr size_t WS_WFI = WS_WOUT + al256((size_t)D * D * 2);
constexpr size_t WS_WFO = WS_WFI + al256((size_t)2 * DFF * D * 2);
constexpr size_t WS_WG = WS_WFO + al256((size_t)D * DFF * 2);
constexpr size_t WS_RCOS = WS_WG + al256((size_t)2 * 8 * 64 * 64 * 2);
constexpr size_t WS_RSIN = WS_RCOS + al256((size_t)8192 * 32 * 4);
constexpr size_t WS_SP = WS_RSIN + al256((size_t)8192 * 32 * 4);
constexpr size_t WS_RSTD = WS_SP + al256(512 * 4);
constexpr size_t WS_SSQ = WS_RSTD + al256((size_t)M * 4);
constexpr size_t WS_WI = WS_SSQ + al256((size_t)M * 4);
constexpr size_t WS_AGG = WS_WI + al256((size_t)M * 8 * 4);
constexpr size_t WS_XB = WS_AGG + al256((size_t)12 * 64 * 512 * 8);
constexpr size_t WS_YC = WS_XB + al256((size_t)M * D * 2);
constexpr size_t WS_KB = WS_YC + al256((size_t)M * D * 2);
constexpr size_t WS_VB = WS_KB + al256((size_t)MP * KVW * 2);
constexpr size_t WS_KIB = WS_VB + al256((size_t)MP * KVW * 2);
constexpr size_t WS_KS = WS_KIB + al256((size_t)MP * 64 * 2);
constexpr size_t WS_VS = WS_KS + al256((size_t)DB * SKEYS * KVW * 2);
constexpr size_t WS_KIS = WS_VS + al256((size_t)DB * SKEYS * KVW * 2);
constexpr size_t WS_R1 = WS_KIS + al256((size_t)DB * SKEYS * 64 * 2);
constexpr size_t WS_XR = WS_R1;
constexpr size_t WS_GG = WS_XR + al256((size_t)M * LW * 2);
constexpr size_t WS_Q = WS_GG + al256((size_t)M * LW * 2);
constexpr size_t WS_QI = WS_Q + al256((size_t)M * LW * 2);
constexpr size_t WS_ACUM = WS_QI + al256((size_t)M * LW * 2);
constexpr size_t WS_BCUM = WS_ACUM + al256((size_t)M * LW * 4);
constexpr size_t WS_R1_END = WS_BCUM + al256((size_t)M * LW * 4);
constexpr size_t WS_H = WS_R1;
static_assert(WS_H + (size_t)M * DFF * 2 <= WS_R1_END, "H overlay fits");
constexpr size_t WS_CANDG = WS_ACUM;
static_assert(WS_CANDG + (size_t)M * 1024 * 4 <= WS_R1_END, "candidate lists fit");
constexpr size_t WS_SEL = WS_R1_END;
constexpr size_t WS_NSEL = WS_SEL + al256((size_t)M * 256 * 2);
constexpr size_t WS_END = WS_NSEL + al256((size_t)M * 4);

#ifndef DUPMASK
#define DUPMASK 0
#endif
#define DUP(k) ((DUPMASK >> (k)) & 1)
#ifndef USE_CG_SYNC
#define USE_CG_SYNC 0
#endif
constexpr int CW_QUEUE = 2048;
constexpr int CW_BAR = 4096;
constexpr int LDSCTL_OFF = 131072 + 1024;
#ifndef FORCE_SAFE_MODE
#define FORCE_SAFE_MODE 0
#endif
#ifndef TSEG
#define TSEG 0
#endif
#define TIC(id) unsigned long long tic_##id = (TSEG == (id)) ? __builtin_amdgcn_s_memrealtime() : 0ull
#define TOC(id) do { if (TSEG == (id) && F.bid == 0 && F.wave == 0) { const unsigned d_ = (unsigned)(__builtin_amdgcn_s_memrealtime() - tic_##id); if (F.lane == 0) { LAS unsigned* a_ = (LAS unsigned*)(F.lds + LDSCTL_OFF + 128); *a_ += d_; } } } while (0)
constexpr int LDS_BYTES = 147456;

#define LAS __attribute__((address_space(3)))
typedef unsigned short bf16;
typedef float f32x4 __attribute__((ext_vector_type(4)));
typedef float f32x2 __attribute__((ext_vector_type(2)));
typedef unsigned u32x4 __attribute__((ext_vector_type(4)));
typedef unsigned u32x2 __attribute__((ext_vector_type(2)));
typedef short bf16x8 __attribute__((ext_vector_type(8)));

__device__ __forceinline__ unsigned pk2(float lo, float hi) { unsigned r; asm("v_cvt_pk_bf16_f32 %0, %1, %2" : "=v"(r) : "v"(lo), "v"(hi)); return r; }
__device__ __forceinline__ unsigned f2bf(float f) { return pk2(f, 0.f) & 0xffffu; }
__device__ __forceinline__ float bf2f(unsigned b) { return __builtin_bit_cast(float, b << 16); }
__device__ __forceinline__ float bflo(unsigned w) { return __builtin_bit_cast(float, w << 16); }
__device__ __forceinline__ float bfhi(unsigned w) { return __builtin_bit_cast(float, w & 0xffff0000u); }
__device__ __forceinline__ void store_bf16x8(bf16* p, f32x4 lo, f32x4 hi) {
    u32x4 w; w.x = pg8::cvt_pk_bf16(lo[0], lo[1]); w.y = pg8::cvt_pk_bf16(lo[2], lo[3]); w.z = pg8::cvt_pk_bf16(hi[0], hi[1]); w.w = pg8::cvt_pk_bf16(hi[2], hi[3]);
    *(u32x4*)p = w;
}
typedef unsigned char fp8;
__device__ __forceinline__ unsigned pk4_fp8(float a, float b, float c, float d) { int w = __builtin_amdgcn_cvt_pk_fp8_f32(a, b, 0, false); w = __builtin_amdgcn_cvt_pk_fp8_f32(c, d, w, true); return (unsigned)w; }
__device__ __forceinline__ void store_fp8x8(fp8* p, f32x4 lo, f32x4 hi) { u32x2 w; w.x = pk4_fp8(lo[0], lo[1], lo[2], lo[3]); w.y = pk4_fp8(hi[0], hi[1], hi[2], hi[3]); *(u32x2*)p = w; }
__device__ __forceinline__ u32x2 fp8x4_bf16x4(unsigned w) {
    const f32x2 a = __builtin_amdgcn_cvt_pk_f32_fp8((int)w, false); const f32x2 b = __builtin_amdgcn_cvt_pk_f32_fp8((int)w, true);
    const float a0 = a.x, a1 = a.y, b0 = b.x, b1 = b.y;
    u32x2 o; o.x = __builtin_amdgcn_perm(__float_as_uint(a1), __float_as_uint(a0), 0x07060302u); o.y = __builtin_amdgcn_perm(__float_as_uint(b1), __float_as_uint(b0), 0x07060302u);
    return o;
}
__device__ __forceinline__ float gelu_tanh(float x) {
    const float u = 0.7978845608028654f * (x + 0.044715f * x * x * x);
    const float e = __expf(2.0f * u);
    const float th = 1.0f - 2.0f * __builtin_amdgcn_rcpf(e + 1.0f);
    return 0.5f * x * (1.0f + th);
}
__device__ __forceinline__ float sigmoidf_(float x) { return __builtin_amdgcn_rcpf(1.0f + __expf(-x)); }

#define XB_TMO      128
#define XB_XCNT(j)  (256  + 64 * (j))
#define XB_XSUB(j)  (1280 + 64 * (j))
#define XB_XGEN(j)  (2304 + 64 * (j))
#define XB_TOP      3328
#define XB_TOPGEN   3392
#define XCD_BAR_WORDS 3456
#define XB_SPIN_CAP (1u << 18)

__device__ __forceinline__ unsigned xb_ld(unsigned* p)              { return __hip_atomic_load(p, __ATOMIC_RELAXED, __HIP_MEMORY_SCOPE_AGENT); }
__device__ __forceinline__ unsigned xb_add(unsigned* p, unsigned v) { return __hip_atomic_fetch_add(p, v, __ATOMIC_RELAXED, __HIP_MEMORY_SCOPE_AGENT); }
__device__ __forceinline__ unsigned xb_xcc_id() { return (unsigned)__builtin_amdgcn_s_getreg((3 << 11) | 20) & 0xFu; }
#define XB_SPIN(cond, bar) do { unsigned _sp = 0; while (cond) { __builtin_amdgcn_s_sleep(1); \
    if ((++_sp & 255u) == 0u) { if (xb_ld(&(bar)[XB_TMO])) break; if (_sp > XB_SPIN_CAP) { atomicAdd(&(bar)[XB_TMO], 1u); break; } } } } while (0)

struct XcdBarrier {
    unsigned* bar; unsigned x;
    volatile LAS unsigned* st;
};

__device__ __forceinline__ XcdBarrier xcd_barrier_post(unsigned* bar, volatile LAS unsigned* st) {
    XcdBarrier b; b.bar = bar; b.x = xb_xcc_id(); b.st = st;
    if (threadIdx.x == 0) (void)xb_add(&bar[XB_XCNT(b.x)], 1u);
    return b;
}
__device__ __forceinline__ void xcd_barrier_complete(unsigned* bar, unsigned x, unsigned& nloc, unsigned& nx) {
    const unsigned G = gridDim.x * gridDim.y * gridDim.z;
    unsigned sum, cnt, mine, sp = 0u;
    for (;;) {
        sum = 0u; cnt = 0u; mine = 0u;
#pragma unroll
        for (unsigned j = 0; j < 16; ++j) { const unsigned c = xb_ld(&bar[XB_XCNT(j)]); sum += c; cnt += (c > 0u) ? 1u : 0u; mine = (j == x) ? c : mine; }
        if (sum == G) break;
        __builtin_amdgcn_s_sleep(1);
        if ((++sp & 255u) == 0u) { if (xb_ld(&bar[XB_TMO])) break; if (sp > XB_SPIN_CAP) { atomicAdd(&bar[XB_TMO], 1u); break; } }
    }
    nloc = mine > 0u ? mine : 1u; nx = cnt > 0u ? cnt : 1u;
}

__device__ __forceinline__ void xcd_barrier(const XcdBarrier& b) {
    asm volatile("s_waitcnt vmcnt(0)" ::: "memory");
    __syncthreads();
    if (threadIdx.x == 0) {
        unsigned* bar = b.bar;
        __builtin_amdgcn_s_waitcnt(0);
        unsigned nloc = b.st[0], nx = b.st[1];
        if (nloc == 0u) { xcd_barrier_complete(bar, b.x, nloc, nx); b.st[0] = nloc; b.st[1] = nx; }
        const unsigned old = xb_add(&bar[XB_XSUB(b.x)], 1u);
        const unsigned gen = old / nloc;
        if (old + 1u == (gen + 1u) * nloc) {
            __builtin_amdgcn_fence(__ATOMIC_RELEASE, "agent");
            asm volatile("s_waitcnt vmcnt(0)" ::: "memory");
            const unsigned og = xb_add(&bar[XB_TOP], 1u);
            const unsigned tg = og / nx;
            if (og + 1u == (tg + 1u) * nx) xb_add(&bar[XB_TOPGEN], 1u);
            else XB_SPIN(xb_ld(&bar[XB_TOPGEN]) == tg, bar);
            __builtin_amdgcn_fence(__ATOMIC_ACQUIRE, "agent");
            xb_add(&bar[XB_XGEN(b.x)], 1u);
            asm volatile("s_waitcnt vmcnt(0)" ::: "memory");
        } else {
            XB_SPIN(xb_ld(&bar[XB_XGEN(b.x)]) == gen, bar);
            __builtin_amdgcn_fence(__ATOMIC_ACQUIRE, "agent");
            asm volatile("s_waitcnt vmcnt(0)" ::: "memory");
        }
    }
    __syncthreads();
}
struct EpiInProj {
    static constexpr bool PERM = false, AFTER_DRAIN = false;
    const float* rstd; const float* rcos; const float* rsin; const float* gq; const float* gk;
    bf16* XR; bf16* GG; bf16* Q; bf16* QI; fp8* KB; fp8* VB; bf16* KIB; fp8* KS; fp8* VS; bf16* KIS; float* WI; float* out;

    template <bool NORM> __device__ __forceinline__ void head_rope(f32x4 (&v)[2][2], const float* g, int pos, int fq) const {
        if (NORM) {
            float ss = 0.f;
#pragma unroll
            for (int bj = 0; bj < 2; ++bj)
#pragma unroll
                for (int n = 0; n < 2; ++n) ss += (v[bj][n][0] * v[bj][n][0] + v[bj][n][1] * v[bj][n][1]) + (v[bj][n][2] * v[bj][n][2] + v[bj][n][3] * v[bj][n][3]);
            ss += __shfl_xor(ss, 16); ss += __shfl_xor(ss, 32);
            const float inv = rsqrtf(ss * (1.0f / 64.0f) + EPS);
#pragma unroll
            for (int bj = 0; bj < 2; ++bj)
#pragma unroll
                for (int n = 0; n < 2; ++n) { const f32x4 g4 = *(const f32x4*)(g + 32 * bj + 8 * fq + 4 * n); v[bj][n] = v[bj][n] * inv * g4; }
        }
#pragma unroll
        for (int n = 0; n < 2; ++n) {
            const f32x4 c4 = *(const f32x4*)(rcos + pos * 32 + 8 * fq + 4 * n), s4 = *(const f32x4*)(rsin + pos * 32 + 8 * fq + 4 * n);
            const f32x4 x1 = v[0][n], x2 = v[1][n];
            v[0][n] = x1 * c4 - x2 * s4; v[1][n] = x2 * c4 + x1 * s4;
        }
    }
    __device__ __forceinline__ void operator()(const f32x4 (&acc)[2][2][4][2], const pg8::Unit& u, int wr, int wc, int fr, int fq) const {
        const int pn = u.pn;
#pragma unroll
        for (int ai = 0; ai < 2; ++ai) {
            const int rbase = u.pm * 256 + ai * 128;
            if (rbase >= MR) continue;
            const bool samp = rbase >= MP;
#pragma unroll
            for (int m = 0; m < 4; ++m) {
                const int r = rbase + wr * 64 + m * 16 + fr;
                int sb, t, pos;
                if (!samp) { sb = r >> 13; t = r & 8191; pos = t; } else { const int rs = r - MP; sb = rs >> 4; t = rs & 15; pos = PAST + t; }
                const float rsd = rstd[r];
                f32x4 v[2][2];
#pragma unroll
                for (int bj = 0; bj < 2; ++bj)
#pragma unroll
                    for (int n = 0; n < 2; ++n) v[bj][n] = acc[ai][bj][m][n] * rsd;
                if (pn < 2) {
#pragma unroll
                    for (int bj = 0; bj < 2; ++bj) {
                        const int c = 256 * pn + 64 * wc + 32 * bj + 8 * fq;
                        store_bf16x8(XR + (size_t)r * LW + c, v[bj][0], v[bj][1]);
                        const int tl = samp ? DT - 3 : SEQ - 3;
                        if (t >= tl) {
                            float* o = samp ? out + O_CS + ((size_t)(sb * 3 + (t - tl))) * LW + c : out + O_CP + ((size_t)(sb * 3 + (t - tl))) * LW + c;
                            *(f32x4*)o = v[bj][0]; *(f32x4*)(o + 4) = v[bj][1];
                        }
                    }
                } else if (pn < 4) {
#pragma unroll
                    for (int bj = 0; bj < 2; ++bj) {
                        const int c = 256 * (pn - 2) + 64 * wc + 32 * bj + 8 * fq;
                        f32x4 a = v[bj][0], b = v[bj][1];
#pragma unroll
                        for (int j = 0; j < 4; ++j) { a[j] = gelu_tanh(a[j]); b[j] = gelu_tanh(b[j]); }
                        store_bf16x8(GG + (size_t)r * LW + c, a, b);
                    }
                } else if (pn < 6) {
                    head_rope<true>(v, gq, pos, fq);
                    const int head = 4 * (pn - 4) + wc;
#pragma unroll
                    for (int bj = 0; bj < 2; ++bj) store_bf16x8(Q + (size_t)r * 512 + head * 64 + 32 * bj + 8 * fq, v[bj][0], v[bj][1]);
                } else if (pn == 6) {
                    if (wc < 2) head_rope<true>(v, gk, pos, fq);
                    const int hh = wc & 1;
                    float* of; fp8* ob;
                    if (wc < 2) { of = samp ? out + O_KS + (size_t)(r - MP) * KVW : out + O_KP + (size_t)r * KVW; ob = samp ? KS + ((size_t)sb * SKEYS + PAST + t) * KVW : KB + (size_t)r * KVW; }
                    else        { of = samp ? out + O_VS + (size_t)(r - MP) * KVW : out + O_VP + (size_t)r * KVW; ob = samp ? VS + ((size_t)sb * SKEYS + PAST + t) * KVW : VB + (size_t)r * KVW; }
#pragma unroll
                    for (int bj = 0; bj < 2; ++bj) {
                        const int c = hh * 64 + 32 * bj + 8 * fq;
                        *(f32x4*)(of + c) = v[bj][0]; *(f32x4*)(of + c + 4) = v[bj][1];
                        store_fp8x8(ob + c, v[bj][0], v[bj][1]);
                    }
                } else if (pn < 9) {
                    head_rope<false>(v, nullptr, pos, fq);
                    const int head = 4 * (pn - 7) + wc;
#pragma unroll
                    for (int bj = 0; bj < 2; ++bj) store_bf16x8(QI + (size_t)r * 512 + head * 64 + 32 * bj + 8 * fq, v[bj][0], v[bj][1]);
                } else {
                    if (wc == 0) {
                        head_rope<false>(v, nullptr, pos, fq);
                        float* of = samp ? out + O_KIS + (size_t)(r - MP) * 64 : out + O_KIP + (size_t)r * 64;
                        bf16* ob = samp ? KIS + ((size_t)sb * SKEYS + PAST + t) * 64 : KIB + (size_t)r * 64;
#pragma unroll
                        for (int bj = 0; bj < 2; ++bj) {
                            const int c = 32 * bj + 8 * fq;
                            *(f32x4*)(of + c) = v[bj][0]; *(f32x4*)(of + c + 4) = v[bj][1];
                            store_bf16x8(ob + c, v[bj][0], v[bj][1]);
                        }
                    } else if (wc == 1) {
                        if (fq == 0) { *(f32x4*)(WI + (size_t)r * 8) = v[0][0] * WI_SCALE; *(f32x4*)(WI + (size_t)r * 8 + 4) = v[0][1] * WI_SCALE; }
                    }
                }
            }
        }
    }
};

struct EpiOutProj {
    static constexpr bool PERM = false, AFTER_DRAIN = false;
    const float* xp; const float* xs; float* out; bf16* XB2; float* ssq;
    __device__ __forceinline__ void operator()(const f32x4 (&acc)[2][2][4][2], const pg8::Unit& u, int wr, int wc, int fr, int fq) const {
        const int col0 = u.pn * 256 + wc * 32 + 4 * fq;
#pragma unroll
        for (int ai = 0; ai < 2; ++ai) {
            const int rbase = u.pm * 256 + ai * 128;
            if (rbase >= MR) continue;
            const bool samp = rbase >= MP;
#pragma unroll
            for (int m = 0; m < 4; ++m) {
                const int r = rbase + wr * 64 + m * 16 + fr;
                const float* xrow = samp ? xs + (size_t)(r - MP) * D : xp + (size_t)r * D;
                float* yrow = samp ? out + O_YS + (size_t)(r - MP) * D : out + O_YP + (size_t)r * D;
                float ss = 0.f;
#pragma unroll
                for (int bj = 0; bj < 2; ++bj)
#pragma unroll
                    for (int n = 0; n < 2; ++n) {
                        const int c = col0 + bj * 128 + n * 16;
                        const f32x4 y = *(const f32x4*)(xrow + c) + acc[ai][bj][m][n];
                        if (samp) *(f32x4*)(yrow + c) = y;
                        ss += (y[0] * y[0] + y[1] * y[1]) + (y[2] * y[2] + y[3] * y[3]);
                        u32x2 w; w.x = pg8::cvt_pk_bf16(y[0], y[1]); w.y = pg8::cvt_pk_bf16(y[2], y[3]);
                        *(u32x2*)(XB2 + (size_t)r * D + c) = w;
                    }
                ss += __shfl_xor(ss, 16); ss += __shfl_xor(ss, 32);
                if (fq == 0) atomicAdd(ssq + r, ss);
            }
        }
    }
};

struct EpiFfnIn {
    static constexpr bool PERM = false, AFTER_DRAIN = false;
    const float* ssq; bf16* H;
    __device__ __forceinline__ void operator()(const f32x4 (&acc)[2][2][4][2], const pg8::Unit& u, int wr, int wc, int fr, int fq) const {
        const int c = 128 * u.pn + 32 * wc + 8 * fq;
#pragma unroll
        for (int ai = 0; ai < 2; ++ai) {
            const int rbase = u.pm * 256 + ai * 128;
            if (rbase >= MR) continue;
#pragma unroll
            for (int m = 0; m < 4; ++m) {
                const int r = rbase + wr * 64 + m * 16 + fr;
                const float rs2 = rsqrtf(ssq[r] * (1.0f / 1024.0f) + EPS);
                f32x4 h[2];
#pragma unroll
                for (int n = 0; n < 2; ++n) {
                    const f32x4 g = acc[ai][0][m][n] * rs2, up = acc[ai][1][m][n] * rs2;
#pragma unroll
                    for (int j = 0; j < 4; ++j) h[n][j] = g[j] * sigmoidf_(g[j]) * up[j];
                }
                store_bf16x8(H + (size_t)r * DFF + c, h[0], h[1]);
            }
        }
    }
};

struct EpiFfnOut {
    static constexpr bool PERM = false, AFTER_DRAIN = false;
    float* out; const bf16* XB2;
    __device__ __forceinline__ void operator()(const f32x4 (&acc)[2][2][4][2], const pg8::Unit& u, int wr, int wc, int fr, int fq) const {
        const int col0 = u.pn * 256 + wc * 32 + 4 * fq;
#pragma unroll
        for (int ai = 0; ai < 2; ++ai) {
            const int rbase = u.pm * 256 + ai * 128;
            if (rbase >= MP) continue;
#pragma unroll
            for (int m = 0; m < 4; ++m) {
                const int r = rbase + wr * 64 + m * 16 + fr;
                float* yrow = out + O_YP + (size_t)r * D;
#pragma unroll
                for (int bj = 0; bj < 2; ++bj)
#pragma unroll
                    for (int n = 0; n < 2; ++n) { const int c = col0 + bj * 128 + n * 16; const u32x2 xw = *(const u32x2*)(XB2 + (size_t)r * D + c);
                        const f32x4 x1 = {bflo(xw.x), bfhi(xw.x), bflo(xw.y), bfhi(xw.y)}; *(f32x4*)(yrow + c) = x1 + acc[ai][bj][m][n]; }
            }
        }
    }
};

struct Params {
    const float* in[22];
    float* out;
    unsigned char* ws;
    double invf[32];
    int ph_lo, ph_hi;
};
enum { I_XP = 0, I_XS, I_CK, I_CV, I_CKI, I_SH, I_SC, I_NM, I_WIN, I_CW, I_CB, I_WRG, I_BRG, I_WIG, I_BIG, I_LAM, I_QN, I_KN, I_WOUT, I_NF, I_WFI, I_WFO };

struct Frame { LAS unsigned char* lds; int tid, lane, wave, G, bid; };

template <int NB, int KSTEPS, class BRow, class Epi>
__device__ __forceinline__ void skinny_gemm(Frame& F, const bf16* A, int lda, const bf16* Bt, int K, int nct, BRow brow, Epi epi) {
    const int lane = F.lane, qc = lane & 15, kq = lane >> 4, w = F.wave;
    LAS f32x4* red = (LAS f32x4*)F.lds;
    for (int item = F.bid; item < 4 * nct; item += F.G) {
        const int rb = item & 3, ct = item >> 2;
        const bf16* a0 = A + (size_t)(rb * 32 + qc) * lda + 8 * kq + w * (KSTEPS * 32); const bf16* a1 = a0 + (size_t)16 * lda;
        const bf16* bp[NB];
#pragma unroll
        for (int nb = 0; nb < NB; ++nb) bp[nb] = Bt + (size_t)brow(ct, nb, qc) * K + 8 * kq + w * (KSTEPS * 32);
        f32x4 acc[2][NB];
#pragma unroll
        for (int m = 0; m < 2; ++m)
#pragma unroll
            for (int nb = 0; nb < NB; ++nb) acc[m][nb] = (f32x4){0.f, 0.f, 0.f, 0.f};
#pragma unroll
        for (int ks = 0; ks < KSTEPS; ++ks) {
            const bf16x8 fa0 = *(const bf16x8*)(a0 + 32 * ks), fa1 = *(const bf16x8*)(a1 + 32 * ks);
#pragma unroll
            for (int nb = 0; nb < NB; ++nb) {
                const bf16x8 fb = *(const bf16x8*)(bp[nb] + 32 * ks);
                acc[0][nb] = __builtin_amdgcn_mfma_f32_16x16x32_bf16(fb, fa0, acc[0][nb], 0, 0, 0);
                acc[1][nb] = __builtin_amdgcn_mfma_f32_16x16x32_bf16(fb, fa1, acc[1][nb], 0, 0, 0);
            }
        }
#pragma unroll
        for (int m = 0; m < 2; ++m)
#pragma unroll
            for (int nb = 0; nb < NB; ++nb) red[(w * 2 * NB + m * NB + nb) * 64 + lane] = acc[m][nb];
        __syncthreads();
        if (w < 2) {
            f32x4 s[NB];
#pragma unroll
            for (int nb = 0; nb < NB; ++nb) { s[nb] = red[(w * NB + nb) * 64 + lane];
#pragma unroll
                for (int w2 = 1; w2 < 8; ++w2) s[nb] += red[(w2 * 2 * NB + w * NB + nb) * 64 + lane]; }
            epi(s, rb * 32 + w * 16 + qc, 16 * ct + 4 * kq, kq);
        }
        __syncthreads();
    }
}

__device__ __forceinline__ float wave_sum(float v) {
#pragma unroll
    for (int o = 1; o < 64; o <<= 1) v += __shfl_xor(v, o);
    return v;
}

__device__ __forceinline__ void transpose_item(const float* W, int K, int N, int nvalid, const float* gain, bf16* WT, int k0, int row0, int lcol0, bool perm, LAS float* scr, int lane) {
    const int c4 = (lane & 7) * 4, col = lcol0 + c4; const bool ok = col < nvalid;
    f32x4 v[8];
#pragma unroll
    for (int i = 0; i < 8; ++i) { const int kk = (lane >> 3) + 8 * i; v[i] = ok ? *(const f32x4*)(W + (size_t)(k0 + kk) * N + col) : (f32x4){0.f, 0.f, 0.f, 0.f}; }
#pragma unroll
    for (int i = 0; i < 8; ++i) { const int kk = (lane >> 3) + 8 * i; const float g = gain ? gain[k0 + kk] : 1.0f; *(LAS f32x4*)(scr + kk * 36 + c4) = v[i] * g; }
    asm volatile("s_waitcnt lgkmcnt(0)" ::: "memory");
    const int c = lane & 7;
#pragma unroll
    for (int j = 0; j < 4; ++j) {
        const int n = (lane >> 3) + 8 * j, src = perm ? pg8::perm32(n) : n;
        const LAS float* s = scr + (8 * c) * 36 + src;
        u32x4 o; o.x = pk2(s[0 * 36], s[1 * 36]); o.y = pk2(s[2 * 36], s[3 * 36]); o.z = pk2(s[4 * 36], s[5 * 36]); o.w = pk2(s[6 * 36], s[7 * 36]);
        *(u32x4*)(WT + (size_t)(row0 + n) * K + k0 + 8 * c) = o;
    }
    asm volatile("s_waitcnt lgkmcnt(0)" ::: "memory");
}

__device__ __forceinline__ void phase0(const Params& p, Frame& F) {
    unsigned char* ws = p.ws;
    LAS float* scr = (LAS float*)(F.lds + F.wave * 16384);
    const int gw = F.bid * 8 + F.wave, NGW = F.G * 8;
    TIC(50);
    constexpr int I_IN = 16 * (NIN / 32), I_OUT = 16 * (D / 32), I_FI = 16 * (2 * DFF / 32), I_FO = (DFF / 64) * (D / 32);
    constexpr int NITEMS = I_IN + I_OUT + I_FI + I_FO;
    for (int it = gw; it < NITEMS; it += NGW) {
        int r = it;
        if (r < I_IN) { const int kb = r / (NIN / 32), g = r % (NIN / 32), pn = g >> 3, sub = g & 7, bj = sub >> 2, wc = sub & 3;
            transpose_item(p.in[I_WIN], D, DIN, DIN, p.in[I_NM], (bf16*)(ws + WS_WIN), 64 * kb, 32 * g, 256 * pn + 64 * wc + 32 * bj, true, scr, F.lane); continue; }
        r -= I_IN;
        if (r < I_OUT) { const int kb = r / (D / 32), g = r % (D / 32);
            transpose_item(p.in[I_WOUT], D, D, D, nullptr, (bf16*)(ws + WS_WOUT), 64 * kb, 32 * g, 32 * g, false, scr, F.lane); continue; }
        r -= I_OUT;
        if (r < I_FI) { const int kb = r / (2 * DFF / 32), g = r % (2 * DFF / 32), pn = g >> 3, sub = g & 7, bj = sub >> 2, wc = sub & 3;
            transpose_item(p.in[I_WFI], D, 2 * DFF, 2 * DFF, p.in[I_NF], (bf16*)(ws + WS_WFI), 64 * kb, 32 * g, (bj ? DFF : 0) + 128 * pn + 32 * wc, true, scr, F.lane); continue; }
        r -= I_FI;
        { const int kb = r / (D / 32), g = r % (D / 32);
            transpose_item(p.in[I_WFO], DFF, D, D, nullptr, (bf16*)(ws + WS_WFO), 64 * kb, 32 * g, 32 * g, false, scr, F.lane); }
    }
    TOC(50);
    TIC(51);
    {
        bf16* XB = (bf16*)(ws + WS_XB); float* rstd = (float*)(ws + WS_RSTD);
        for (int m0 = gw; m0 < M; m0 += 4 * NGW) {
            f32x4 v[4][4];
#pragma unroll
            for (int rr = 0; rr < 4; ++rr) {
                const int m = m0 + rr * NGW;
                const bool real = m < MR;
                const float* xrow = (m < MP) ? p.in[I_XP] + (size_t)m * D : p.in[I_XS] + (size_t)((real ? m : MP) - MP) * D;
                const f32x4* xr = (const f32x4*)xrow + F.lane;
#pragma unroll
                for (int j = 0; j < 4; ++j) v[rr][j] = real ? xr[64 * j] : (f32x4){0.f, 0.f, 0.f, 0.f};
            }
#pragma unroll
            for (int rr = 0; rr < 4; ++rr) {
                const int m = m0 + rr * NGW;
                if (m >= M) continue;
                float s = 0.f;
#pragma unroll
                for (int j = 0; j < 4; ++j) s += (v[rr][j][0] * v[rr][j][0] + v[rr][j][1] * v[rr][j][1]) + (v[rr][j][2] * v[rr][j][2] + v[rr][j][3] * v[rr][j][3]);
                s = wave_sum(s);
                if (F.lane == 0) rstd[m] = (m < MR) ? rsqrtf(s * (1.0f / D) + EPS) : 0.f;
                unsigned long long* o8 = (unsigned long long*)(XB + (size_t)m * D) + F.lane;
#pragma unroll
                for (int j = 0; j < 4; ++j) o8[64 * j] = (unsigned long long)pk2(v[rr][j][0], v[rr][j][1]) | ((unsigned long long)pk2(v[rr][j][2], v[rr][j][3]) << 32);
            }
        }
    }
    TOC(51);
    TIC(52);
    const size_t gt = (size_t)F.bid * 512 + F.tid, GS = (size_t)F.G * 512;
    {
        fp8* KS = (fp8*)(ws + WS_KS); fp8* VS = (fp8*)(ws + WS_VS); bf16* KIS = (bf16*)(ws + WS_KIS);
        constexpr size_t NKV8 = (size_t)DB * PAST * KVW / 8, NKI8 = (size_t)DB * PAST * 64 / 8;
        for (size_t i = gt; i < 2 * NKV8 + NKI8; i += GS) {
            if (i < 2 * NKV8) {
                const bool isv = i >= NKV8; const size_t e = (isv ? i - NKV8 : i) * 8, b = e / ((size_t)PAST * KVW), rem = e % ((size_t)PAST * KVW);
                const float* src = (isv ? p.in[I_CV] : p.in[I_CK]) + e; fp8* dst = (isv ? VS : KS) + b * SKEYS * KVW + rem;
                store_fp8x8(dst, *(const f32x4*)src, *(const f32x4*)(src + 4));
            } else {
                const size_t e = (i - 2 * NKV8) * 8, b = e / ((size_t)PAST * 64), rem = e % ((size_t)PAST * 64);
                const float* src = p.in[I_CKI] + e;
                store_bf16x8(KIS + b * SKEYS * 64 + rem, *(const f32x4*)src, *(const f32x4*)(src + 4));
            }
        }
    }
    {
        float* rc = (float*)(ws + WS_RCOS); float* rsn = (float*)(ws + WS_RSIN);
        for (size_t i = gt; i < (size_t)8192 * 32; i += GS) {
            const int pos = (int)(i >> 5), fi = (int)(i & 31);
            const double ang = (double)pos * p.invf[fi];
            const double kq = rint(ang * 0.63661977236758134308);
            double r = fma(-kq, 1.57079632679489655800e+00, ang); r = fma(-kq, 6.12323399573676603587e-17, r);
            const double r2 = r * r;
            double sn = -1.0 / 1307674368000.0; sn = sn * r2 + 1.0 / 6227020800.0; sn = sn * r2 - 1.0 / 39916800.0; sn = sn * r2 + 1.0 / 362880.0; sn = sn * r2 - 1.0 / 5040.0; sn = sn * r2 + 1.0 / 120.0; sn = sn * r2 - 1.0 / 6.0; sn = sn * r2 + 1.0; sn *= r;
            double cs = 1.0 / 20922789888000.0; cs = cs * r2 - 1.0 / 87178291200.0; cs = cs * r2 + 1.0 / 479001600.0; cs = cs * r2 - 1.0 / 3628800.0; cs = cs * r2 + 1.0 / 40320.0; cs = cs * r2 - 1.0 / 720.0; cs = cs * r2 + 1.0 / 24.0; cs = cs * r2 - 0.5; cs = cs * r2 + 1.0;
            const int q = (int)((long long)kq & 3);
            const double sv = (q == 0) ? sn : (q == 1) ? cs : (q == 2) ? -sn : -cs;
            const double cv = (q == 0) ? cs : (q == 1) ? -sn : (q == 2) ? -cs : sn;
            rc[i] = (float)cv; rsn[i] = (float)sv;
        }
    }
    {
        float* ssq = (float*)(ws + WS_SSQ);
        for (size_t i = gt; i < (size_t)M; i += GS) ssq[i] = 0.f;
        float* sp = (float*)(ws + WS_SP);
        for (size_t i = gt; i < 512; i += GS) sp[i] = log1pf(__expf(-p.in[I_LAM][i]));
        bf16* WG = (bf16*)(ws + WS_WG);
        for (size_t i = gt; i < (size_t)2 * 8 * 64 * 64; i += GS) {
            const int ii = (int)(i & 63), j = (int)((i >> 6) & 63), nb = (int)((i >> 12) & 7), gsel = (int)(i >> 15);
            const float* W = gsel ? p.in[I_WIG] : p.in[I_WRG];
            WG[i] = (bf16)f2bf(W[(nb * 64 + ii) * 64 + j]);
        }
    }
    TOC(52);
}

constexpr int LRU_WLDS = 14848;
template <int PASS> __device__ __forceinline__ void lru_unit(const Params& p, Frame& F, int sbi  , int nb, int sg) {
    unsigned char* ws = p.ws;
    const bool samp = sbi >= NB; const int b = samp ? sbi - NB : sbi;
    const int T = samp ? DT : 128, t0 = samp ? 0 : sg * 128;
    const size_t r0 = samp ? (size_t)MP + b * DT : (size_t)b * SEQ + t0;
    const int lane = F.lane, qc = lane & 15, kq = lane >> 4, ch = nb * 64 + lane;
    LAS unsigned char* wl = F.lds + F.wave * LRU_WLDS;
    LAS bf16* xcb = (LAS bf16*)wl; LAS float* xcf = (LAS float*)(wl + 2304); LAS float* av = (LAS float*)(wl + 2304 + 4096); LAS float* bv = (LAS float*)(wl + 2304 + 8192);
    const bf16* XR = (const bf16*)(ws + WS_XR) + r0 * LW + ch;
    const float cb = p.in[I_CB][ch], w0 = p.in[I_CW][ch], w1 = p.in[I_CW][LW + ch], w2 = p.in[I_CW][2 * LW + ch], w3 = p.in[I_CW][3 * LW + ch];
    float x1, x2, x3;
    if (t0 > 0) { x1 = bf2f(XR[-3 * LW]); x2 = bf2f(XR[-2 * LW]); x3 = bf2f(XR[-1 * LW]); }
    else if (samp) { const float* sc = p.in[I_SC] + (size_t)b * 3 * LW + ch; x1 = sc[0]; x2 = sc[LW]; x3 = sc[2 * LW]; }
    else { x1 = 0.f; x2 = 0.f; x3 = 0.f; }
    const bf16* GG = (const bf16*)(ws + WS_GG) + r0 * LW + ch; bf16* YC = (bf16*)(ws + WS_YC) + r0 * D + ch;
    unsigned short xn[16], gn2[16];
#pragma unroll
    for (int k = 0; k < 16; ++k) { xn[k] = XR[(size_t)k * LW]; gn2[k] = (PASS == 1) ? GG[(size_t)k * LW] : (unsigned short)0; }
    float Ac = 1.f, h = 0.f;
    if (PASS == 1) {
        h = samp ? p.in[I_SH][b * LW + ch] : 0.f;
        const f32x2* AGG = (const f32x2*)(ws + WS_AGG) + (size_t)sbi * 64 * LW + ch;
        f32x2 gn[8];
#pragma unroll
        for (int j = 0; j < 8; ++j) gn[j] = AGG[(size_t)(j < sg ? j : 0) * LW];
        for (int s0 = 0; s0 < sg; s0 += 8) {
            f32x2 g[8];
#pragma unroll
            for (int j = 0; j < 8; ++j) g[j] = gn[j];
            if (s0 + 8 < sg) {
#pragma unroll
                for (int j = 0; j < 8; ++j) gn[j] = AGG[(size_t)(s0 + 8 + j < sg ? s0 + 8 + j : 0) * LW];
            }
#pragma unroll
            for (int j = 0; j < 8; ++j) h = (s0 + j < sg) ? g[j].x * h + g[j].y : h;
        }
    }
    asm volatile("" ::: "memory");
    const bf16* WG = (const bf16*)(ws + WS_WG); const float* sp = (const float*)(ws + WS_SP);
    bf16x8 Wr[4][2], Wi[4][2]; float brg[4], big[4], spv[4];
#pragma unroll
    for (int jt = 0; jt < 4; ++jt) {
        const int j = 16 * jt + qc;
        const bf16* wr_ = WG + ((size_t)(0 * 8 + nb) * 64 + j) * 64 + 8 * kq; const bf16* wi_ = WG + ((size_t)(1 * 8 + nb) * 64 + j) * 64 + 8 * kq;
        Wr[jt][0] = *(const bf16x8*)wr_; Wr[jt][1] = *(const bf16x8*)(wr_ + 32); Wi[jt][0] = *(const bf16x8*)wi_; Wi[jt][1] = *(const bf16x8*)(wi_ + 32);
        brg[jt] = p.in[I_BRG][nb * 64 + j]; big[jt] = p.in[I_BIG][nb * 64 + j]; spv[jt] = sp[nb * 64 + j];
    }
    for (int st = 0; st < T; st += 16) {
        float xv[16], gg[16];
#pragma unroll
        for (int k = 0; k < 16; ++k) { xv[k] = bf2f(xn[k]); if (PASS == 1) gg[k] = bf2f(gn2[k]); }
        if (st + 16 < T) {
#pragma unroll
            for (int k = 0; k < 16; ++k) { xn[k] = XR[(size_t)(st + 16 + k) * LW]; if (PASS == 1) gn2[k] = GG[(size_t)(st + 16 + k) * LW]; }
        }
#pragma unroll
        for (int k = 0; k < 16; ++k) {
            const float xc = cb + w0 * x1 + w1 * x2 + w2 * x3 + w3 * xv[k];
            x1 = x2; x2 = x3; x3 = xv[k];
            xcf[k * 64 + lane] = xc; xcb[k * 72 + lane] = (bf16)f2bf(xc);
        }
        asm volatile("s_waitcnt lgkmcnt(0)" ::: "memory");
        const bf16x8 A0 = *(const LAS bf16x8*)(xcb + qc * 72 + 8 * kq), A1 = *(const LAS bf16x8*)(xcb + qc * 72 + 32 + 8 * kq);
#pragma unroll
        for (int jt = 0; jt < 4; ++jt) {
            const int j = 16 * jt + qc;
            f32x4 ar = {0.f, 0.f, 0.f, 0.f}, ai = {0.f, 0.f, 0.f, 0.f};
            ar = __builtin_amdgcn_mfma_f32_16x16x32_bf16(A0, Wr[jt][0], ar, 0, 0, 0); ar = __builtin_amdgcn_mfma_f32_16x16x32_bf16(A1, Wr[jt][1], ar, 0, 0, 0);
            ai = __builtin_amdgcn_mfma_f32_16x16x32_bf16(A0, Wi[jt][0], ai, 0, 0, 0); ai = __builtin_amdgcn_mfma_f32_16x16x32_bf16(A1, Wi[jt][1], ai, 0, 0, 0);
#pragma unroll
            for (int ii = 0; ii < 4; ++ii) {
                const int t = 4 * kq + ii;
                const float rg = sigmoidf_(ar[ii] + brg[jt]), ig = sigmoidf_(ai[ii] + big[jt]);
                const float a = __expf(-8.0f * rg * spv[jt]);
                float mult = sqrtf(fmaxf(1.0f - a * a, 0.f));
                if (!samp && (t0 + st + t) == 0) mult = 1.0f;
                av[t * 64 + j] = a; bv[t * 64 + j] = mult * ig * xcf[t * 64 + j];
            }
        }
        asm volatile("s_waitcnt lgkmcnt(0)" ::: "memory");
#pragma unroll
        for (int k = 0; k < 16; ++k) {
            const float a = av[k * 64 + lane], bb = bv[k * 64 + lane];
            h = a * h + bb;
            if (PASS == 0) Ac *= a;
            else YC[(size_t)(st + k) * D] = (bf16)f2bf(h * gg[k]);
        }
        asm volatile("s_waitcnt lgkmcnt(0)" ::: "memory");
    }
    if (PASS == 0) ((f32x2*)(ws + WS_AGG))[((size_t)sbi * 64 + sg) * LW + ch] = (f32x2){Ac, h};
    else { if (samp) p.out[O_HS + b * LW + ch] = h; else if (sg == 63) p.out[O_HP + b * LW + ch] = h; }
}
template <int PASS> __device__ __forceinline__ void lru_phase(const Params& p, Frame& F) {
    for (int u = F.bid * 8 + F.wave; u < 2048 + 64; u += F.G * 8) {
        if (u < 2048) lru_unit<PASS>(p, F, u >> 9, u & 7, (u >> 3) & 63);
        else lru_unit<PASS>(p, F, NB + ((u - 2048) >> 3), (u - 2048) & 7, 0);
    }
}

constexpr int A_CAND = 0, A_CNT = 131072, A_THR = 131072 + 128, A_FLAG = 131072 + 256, A_CNT0 = 131072 + 384, A_HBAR = 131072 + 512, A_TICK = 131072 + 576, CAP = 1024;
constexpr int VPITCH = 288;
extern "C" __device__ unsigned __ockl_wfred_max_u32(unsigned);
extern "C" __device__ unsigned __ockl_wfred_min_u32(unsigned);
typedef short v4i16_t __attribute__((ext_vector_type(4)));

__device__ __forceinline__ unsigned pack_key(float s, int key) {
    unsigned u = __float_as_uint(s);
    u = (u & 0x80000000u) ? ~u : (u | 0x80000000u);
    return (u & 0xFFFFE000u) | (unsigned)(8191 - key);
}
extern "C" __device__ unsigned __ockl_wfred_add_u32(unsigned);
extern "C" __device__ unsigned __ockl_wfscan_add_u32(unsigned, bool);
struct SelRes { unsigned thr; int cnt; };
__device__ __forceinline__ SelRes select_rank(LAS unsigned* cq, int n, int rlo, int rhi, int lane) {
    unsigned e[16]; unsigned mx = 0u, mn = 0xFFFFFFFFu;
#pragma unroll
    for (int i = 0; i < 16; ++i) { const int idx = i * 64 + lane; const unsigned x = cq[idx]; const bool v = idx < n; e[i] = v ? x : 0u; mx = e[i] > mx ? e[i] : mx; const unsigned y = v ? x : 0xFFFFFFFFu; mn = y < mn ? y : mn; }
    unsigned lo = (unsigned)__builtin_amdgcn_readfirstlane((int)__ockl_wfred_min_u32(mn));
    unsigned hi = (unsigned)__builtin_amdgcn_readfirstlane((int)__ockl_wfred_max_u32(mx)); hi = hi == 0xFFFFFFFFu ? hi : hi + 1u;
    int clo = n;
    for (int it = 0; it < 40 && clo > rhi; ++it) {
        const unsigned piv = lo + ((hi - lo) >> 1);
        int c = 0;
#pragma unroll
        for (int i = 0; i < 16; ++i) c += __popcll(__ballot(e[i] >= piv));
        if (c >= rlo) { lo = piv; clo = c; } else hi = piv;
    }
    unsigned cl = 0u;
#pragma unroll
    for (int i = 0; i < 16; ++i) cl += (e[i] >= lo) ? 1u : 0u;
    unsigned pos = __ockl_wfscan_add_u32(cl, false);
#pragma unroll
    for (int i = 0; i < 16; ++i) { const bool k = e[i] >= lo; if (k) cq[pos] = e[i]; pos += k ? 1u : 0u; }
    SelRes r; r.thr = lo; r.cnt = clo; return r;
}

__device__ __forceinline__ void half_barrier(LAS unsigned* hb, int lane) {
    asm volatile("s_waitcnt vmcnt(0) lgkmcnt(0)" ::: "memory");
    if (lane == 0) {
        const unsigned gen = __hip_atomic_load(hb + 1, __ATOMIC_RELAXED, __HIP_MEMORY_SCOPE_WORKGROUP);
        const unsigned old = __hip_atomic_fetch_add(hb, 1u, __ATOMIC_RELAXED, __HIP_MEMORY_SCOPE_WORKGROUP);
        if (old == 3u) { __hip_atomic_store(hb, 0u, __ATOMIC_RELAXED, __HIP_MEMORY_SCOPE_WORKGROUP); __hip_atomic_store(hb + 1, gen + 1u, __ATOMIC_RELAXED, __HIP_MEMORY_SCOPE_WORKGROUP); }
        else { while (__hip_atomic_load(hb + 1, __ATOMIC_RELAXED, __HIP_MEMORY_SCOPE_WORKGROUP) == gen) __builtin_amdgcn_s_sleep(1); }
    }
    asm volatile("s_waitcnt lgkmcnt(0)" ::: "memory");
}
__device__ __forceinline__ void select_unit(const Params& p, Frame& F, size_t q0row, int L, const bf16* KI) {
    unsigned char* ws = p.ws;
    const bf16* QI = (const bf16*)(ws + WS_QI); const float* WI = (const float*)(ws + WS_WI);
    const int lane = F.lane, half = F.wave >> 2, wid = F.wave & 3, htid = F.tid & 255, qc = lane & 15, kq = lane >> 4;
    LAS unsigned* cand = (LAS unsigned*)(F.lds + A_CAND + half * 65536); LAS unsigned* cntp = (LAS unsigned*)(F.lds + A_CNT + half * 64); LAS unsigned* thrp = (LAS unsigned*)(F.lds + A_THR + half * 64);
    LAS unsigned* flagp = (LAS unsigned*)(F.lds + A_FLAG + half * 16); LAS unsigned* hb = (LAS unsigned*)(F.lds + A_HBAR + half * 16);
    constexpr int nq = 16;
    constexpr int nslots = 4; const int slot = wid;
    const int ql = qc;
    TIC(1);
    bf16x8 Bq[8][2]; float sinf_[8];
    {
        const size_t qrow = q0row + ql;
#pragma unroll
        for (int h = 0; h < 8; ++h) {
            const float w = WI[qrow * 8 + h];
            sinf_[h] = (w < 0.f) ? -INFINITY : INFINITY;
#pragma unroll
            for (int s = 0; s < 2; ++s) {
                const u32x4 raw = *(const u32x4*)(QI + qrow * 512 + h * 64 + 32 * s + 8 * kq);
                u32x4 o; o.x = pk2(bflo(raw.x) * w, bfhi(raw.x) * w); o.y = pk2(bflo(raw.y) * w, bfhi(raw.y) * w); o.z = pk2(bflo(raw.z) * w, bfhi(raw.z) * w); o.w = pk2(bflo(raw.w) * w, bfhi(raw.w) * w);
                Bq[h][s] = __builtin_bit_cast(bf16x8, o);
            }
        }
    }
    half_barrier(hb, lane);
    TOC(1);
    TIC(2);
    for (int arep_ = 0; arep_ <= DUP(8); ++arep_) {
    const int NG = (L + 63) >> 6; const bool tail = (L & 63) != 0;
    LAS unsigned* cnt0 = (LAS unsigned*)(F.lds + A_CNT0 + half * 64);
    int rk = (600 * 1024) / L; rk = rk < 48 ? 48 : (rk > 256 ? 256 : rk);
#if FORCE_SAFE_MODE
    const int mode0 = 1;
#else
    const int mode0 = 0;
#endif
    bf16x8 An[2][2];
#define LOAD_A(DST, G, T0, T1) do { int g_ = (G); g_ = g_ < NG ? g_ : NG - 1; _Pragma("unroll") for (int tl = T0; tl < T1; ++tl) { int arow = g_ * 64 + tl * 16 + qc; arow = arow < L ? arow : L - 1; \
        DST[tl - T0][0] = *(const bf16x8*)(KI + (size_t)arow * 64 + 8 * kq); DST[tl - T0][1] = *(const bf16x8*)(KI + (size_t)arow * 64 + 32 + 8 * kq); } } while (0)
#define LOAD_AN(G) LOAD_A(An, G, 0, 2)
    for (int mode = mode0; mode < 2; ++mode) {
    bool redo = false;
    if (htid < 16) { cntp[htid] = 0u; thrp[htid] = 0u; cnt0[htid] = 0u; }
    if (htid == 32) flagp[1] = 0u;
    int g0 = 0, KG = 16;
    LOAD_AN(slot);
    while (g0 < NG) {
        const int gend = (g0 + KG < NG) ? g0 + KG : NG;
        if (htid == 32) flagp[0] = 0u;
        half_barrier(hb, lane);
        const unsigned thr = thrp[ql];
        LAS unsigned* cq = cand + ql * CAP;
        TIC(3);
        for (int g = g0 + slot; g < gend; g += nslots) {
            TIC(7);
            bf16x8 Ah[2][2]; LOAD_A(Ah, g, 2, 4);
            unsigned pk[16];
#define TILE(TL, A0_, A1_) do { f32x4 s0 = {0.f, 0.f, 0.f, 0.f}; \
                _Pragma("unroll") for (int h = 0; h < 8; ++h) { f32x4 acc = {0.f, 0.f, 0.f, 0.f}; \
                    acc = __builtin_amdgcn_mfma_f32_16x16x32_bf16(A0_, Bq[h][0], acc, 0, 0, 0); acc = __builtin_amdgcn_mfma_f32_16x16x32_bf16(A1_, Bq[h][1], acc, 0, 0, 0); \
                    _Pragma("unroll") for (int i = 0; i < 4; ++i) s0[i] += __builtin_amdgcn_fmed3f(acc[i], 0.f, sinf_[h]); } \
                _Pragma("unroll") for (int i = 0; i < 4; ++i) pk[(TL) * 4 + i] = pack_key(s0[i], g * 64 + (TL) * 16 + 4 * kq + i); } while (0)
            TILE(0, An[0][0], An[0][1]); TILE(1, An[1][0], An[1][1]);
            __builtin_amdgcn_sched_barrier(0);
            { const int gn = g + nslots; LOAD_AN(gn < gend ? gn : gend + slot); }
            TILE(2, Ah[0][0], Ah[0][1]); TILE(3, Ah[1][0], Ah[1][1]);
#undef TILE
            if (tail && g == NG - 1) {
                int vt = L - g * 64 - 4 * kq; asm volatile("" : "+v"(vt));
#pragma unroll
                for (int j = 0; j < 16; ++j) pk[j] = ((j >> 2) * 16 + (j & 3) < vt) ? pk[j] : 0u;
            }
            TOC(7);
            TIC(8);
            int n = 0;
#pragma unroll
            for (int j = 0; j < 16; ++j) n += (pk[j] > thr) ? 1 : 0;
            if (n) {
                unsigned base = __hip_atomic_fetch_add(cntp + ql, (unsigned)n, __ATOMIC_RELAXED, __HIP_MEMORY_SCOPE_WORKGROUP);
                if (base + (unsigned)n > (unsigned)CAP) flagp[0] = 1u;
                else {
#pragma unroll
                    for (int j = 0; j < 16; ++j) if (pk[j] > thr) cq[base++] = pk[j];
                }
            }
            TOC(8);
        }
        TOC(3);
        TIC(4);
        half_barrier(hb, lane);
        TOC(4);
        TIC(5);
        const bool ovf = flagp[0] != 0u;
        if (ovf && mode == 0) { redo = true; break; }
        if (ovf) { if (htid < 16) cntp[htid] = cnt0[htid]; half_barrier(hb, lane); }
        const bool last = !ovf && gend == NG;
        if (!last) {
            const int plim = ovf ? 256 : (mode == 0 ? rk + (rk >> 2) : 512), rlo = mode == 0 ? rk : 256, rhi = mode == 0 ? rk + (rk >> 2) : 256;
#pragma unroll 1
            for (int i2 = 0; i2 < 4; ++i2) {
                const int qq = wid * 4 + i2;
                if (qq < nq) {
                    int n = __builtin_amdgcn_readfirstlane((int)cntp[qq]);
                    if (n > plim) { const SelRes r = select_rank(cand + qq * CAP, n, rlo, rhi, lane); n = r.cnt; if (lane == 0) { cntp[qq] = (unsigned)n; thrp[qq] = r.thr; } }
                    if (lane == 0) cnt0[qq] = (unsigned)n;
                }
            }
        }
        TOC(5);
        if (ovf) { KG = (KG >> 1) > nslots ? (KG >> 1) : nslots; LOAD_AN(g0 + slot); }
        else { g0 = gend; KG = mode == 0 ? NG : ((KG * 2 < 32) ? KG * 2 : 32); }
    }
    if (!redo && mode == 0 && L > 1024) {
        if (lane < 4) { const int qq = wid * 4 + lane; if (qq < nq && cntp[qq] < 256u) flagp[1] = 1u; }
        half_barrier(hb, lane);
        redo = flagp[1] != 0u;
    }
    half_barrier(hb, lane);
    if (!redo) break;
    }
    TOC(2);
#undef LOAD_AN
#undef LOAD_A
    }
    TIC(6);
    {
        int lane_b = lane; asm volatile("" : "+v"(lane_b));
        unsigned short* SEL = (unsigned short*)(ws + WS_SEL); int* NSEL = (int*)(ws + WS_NSEL);
#pragma unroll 1
        for (int i2 = 0; i2 < 4; ++i2) {
            const int qq = wid * 4 + i2;
            if (qq >= nq) continue;
            int n = __builtin_amdgcn_readfirstlane((int)cntp[qq]);
            if (n > 256) { select_rank(cand + qq * CAP, n, 256, 256, lane_b); n = 256; }
            asm volatile("s_waitcnt lgkmcnt(0)" ::: "memory");
            const LAS unsigned* cq = cand + qq * CAP;
            const size_t row = q0row + qq;
            u32x2 w;
            { const int k = 4 * lane_b; const unsigned e0 = k < n ? cq[k] : 8191u, e1 = k + 1 < n ? cq[k + 1] : 8191u, e2 = k + 2 < n ? cq[k + 2] : 8191u, e3 = k + 3 < n ? cq[k + 3] : 8191u;
              w.x = (8191u - (e0 & 8191u)) | ((8191u - (e1 & 8191u)) << 16); w.y = (8191u - (e2 & 8191u)) | ((8191u - (e3 & 8191u)) << 16); }
            *(u32x2*)(SEL + row * 256 + 4 * lane_b) = w;
            if (lane_b == 0) NSEL[row] = n;
        }
    }
    half_barrier(hb, lane);
    TOC(6);
}

__device__ __forceinline__ void attend_query(const Params& p, Frame& F, size_t qrow, const fp8* Kb, const fp8* Vb) {
    unsigned char* ws = p.ws;
    const bf16* Qb = (const bf16*)(ws + WS_Q); bf16* YC = (bf16*)(ws + WS_YC);
    const int lane_b = F.lane, qc_b = lane_b & 15, kq_b = lane_b >> 4, wid = F.wave;
    const int wb = wid * LRU_WLDS;
    LAS unsigned short* ix = (LAS unsigned short*)(F.lds + wb);
    LAS unsigned char* vst = F.lds + wb + 512;
    const int n = __builtin_amdgcn_readfirstlane(((const int*)(ws + WS_NSEL))[qrow]);
    *(LAS u32x2*)(ix + 4 * lane_b) = __builtin_nontemporal_load((const u32x2*)((const unsigned short*)(ws + WS_SEL) + qrow * 256 + 4 * lane_b));
    asm volatile("s_waitcnt lgkmcnt(0)" ::: "memory");
    const int h = lane_b & 15;
    long Bh8[4];
#pragma unroll
    for (int s = 0; s < 4; ++s) {
        const bool v = (h < 8) && ((h >> 2) == (kq_b >> 1));
        u32x4 raw = {0u, 0u, 0u, 0u};
        if (v) raw = __builtin_nontemporal_load((const u32x4*)(Qb + qrow * 512 + h * 64 + 32 * (kq_b & 1) + 8 * s));
        constexpr float QS = 0.125f * 1.4426950408889634f;
        const unsigned lo = pk4_fp8(bflo(raw.x) * QS, bfhi(raw.x) * QS, bflo(raw.y) * QS, bfhi(raw.y) * QS), hi = pk4_fp8(bflo(raw.z) * QS, bfhi(raw.z) * QS, bflo(raw.w) * QS, bfhi(raw.w) * QS);
        Bh8[s] = (long)(((unsigned long long)hi << 32) | lo);
    }
    float sc[64];
    u32x4 Kn[4][2];
#pragma unroll
    for (int t4 = 0; t4 < 4; ++t4) { const fp8* kr = Kb + (size_t)ix[t4 * 16 + qc_b] * KVW + 32 * kq_b; Kn[t4][0] = *(const u32x4*)kr; Kn[t4][1] = *(const u32x4*)(kr + 16); }
#pragma unroll
    for (int g4 = 0; g4 < 4; ++g4) {
        u32x4 Ka[4][2];
#pragma unroll
        for (int t4 = 0; t4 < 4; ++t4) { Ka[t4][0] = Kn[t4][0]; Ka[t4][1] = Kn[t4][1]; }
        if (g4 < 3) {
#pragma unroll
            for (int t4 = 0; t4 < 4; ++t4) { const fp8* kr = Kb + (size_t)ix[(g4 + 1) * 64 + t4 * 16 + qc_b] * KVW + 32 * kq_b; Kn[t4][0] = *(const u32x4*)kr; Kn[t4][1] = *(const u32x4*)(kr + 16); }
        }
#pragma unroll
        for (int t4 = 0; t4 < 4; ++t4) {
            f32x4 acc = {0.f, 0.f, 0.f, 0.f};
#pragma unroll
            for (int s = 0; s < 4; ++s) {
                const u32x4 kw = Ka[t4][s >> 1];
                const long a8 = (long)(((unsigned long long)((s & 1) ? kw.w : kw.y) << 32) | ((s & 1) ? kw.z : kw.x));
                acc = __builtin_amdgcn_mfma_f32_16x16x32_fp8_fp8(a8, Bh8[s], acc, 0, 0, 0);
            }
#pragma unroll
            for (int ii = 0; ii < 4; ++ii) { const int key = (g4 * 4 + t4) * 16 + 4 * kq_b + ii; sc[(g4 * 4 + t4) * 4 + ii] = key < n ? acc[ii] : -INFINITY; }
        }
        __builtin_amdgcn_sched_barrier(0);
    }
    float mx = sc[0];
#pragma unroll
    for (int j = 1; j < 64; ++j) mx = fmaxf(mx, sc[j]);
    mx = fmaxf(mx, __shfl_xor(mx, 16)); mx = fmaxf(mx, __shfl_xor(mx, 32));
    float sum = 0.f;
#pragma unroll
    for (int j = 0; j < 64; ++j) { sc[j] = __builtin_amdgcn_exp2f(sc[j] - mx); sum += sc[j]; }
    sum += __shfl_xor(sum, 16); sum += __shfl_xor(sum, 32);
    const float rl = 1.0f / sum;
    bf16x8 pb[8];
#pragma unroll
    for (int b = 0; b < 8; ++b) { u32x4 w; w.x = pk2(sc[b * 8 + 0], sc[b * 8 + 1]); w.y = pk2(sc[b * 8 + 2], sc[b * 8 + 3]); w.z = pk2(sc[b * 8 + 4], sc[b * 8 + 5]); w.w = pk2(sc[b * 8 + 6], sc[b * 8 + 7]); pb[b] = __builtin_bit_cast(bf16x8, w); }
    f32x4 oacc[8];
#pragma unroll
    for (int dt = 0; dt < 8; ++dt) oacc[dt] = (f32x4){0.f, 0.f, 0.f, 0.f};
    u32x4 vr[4], vr2[4];
    const int vrow = lane_b >> 3, vch = lane_b & 7;
#pragma unroll
    for (int i = 0; i < 4; ++i) { vr[i] = *(const u32x4*)(Vb + (size_t)ix[8 * i + vrow] * KVW + vch * 16); vr2[i] = *(const u32x4*)(Vb + (size_t)ix[32 + 8 * i + vrow] * KVW + vch * 16); }
    const LAS unsigned char* trb = vst + (4 * kq_b + (qc_b >> 2)) * VPITCH + (qc_b & 3) * 8;
#pragma unroll
    for (int b = 0; b < 8; ++b) {
#pragma unroll
        for (int i = 0; i < 4; ++i) {
            const u32x2 c0 = fp8x4_bf16x4(vr[i].x), c1 = fp8x4_bf16x4(vr[i].y), c2 = fp8x4_bf16x4(vr[i].z), c3 = fp8x4_bf16x4(vr[i].w);
            LAS unsigned char* d = vst + (8 * i + vrow) * VPITCH + vch * 32;
            *(LAS u32x4*)d = (u32x4){c0.x, c0.y, c1.x, c1.y}; *(LAS u32x4*)(d + 16) = (u32x4){c2.x, c2.y, c3.x, c3.y};
        }
#pragma unroll
        for (int i = 0; i < 4; ++i) vr[i] = vr2[i];
        if (b < 6) {
#pragma unroll
            for (int i = 0; i < 4; ++i) vr2[i] = *(const u32x4*)(Vb + (size_t)ix[32 * (b + 2) + 8 * i + vrow] * KVW + vch * 16);
        }
        asm volatile("s_waitcnt lgkmcnt(0)" ::: "memory");
#pragma unroll
        for (int dt = 0; dt < 8; ++dt) {
            const v4i16_t lo = __builtin_amdgcn_ds_read_tr16_b64_v4i16((LAS v4i16_t*)(trb + dt * 32));
            const v4i16_t hi = __builtin_amdgcn_ds_read_tr16_b64_v4i16((LAS v4i16_t*)(trb + 16 * VPITCH + dt * 32));
            const bf16x8 Av = {lo[0], lo[1], lo[2], lo[3], hi[0], hi[1], hi[2], hi[3]};
            oacc[dt] = __builtin_amdgcn_mfma_f32_16x16x32_bf16(Av, pb[b], oacc[dt], 0, 0, 0);
        }
        asm volatile("s_waitcnt lgkmcnt(0)" ::: "memory");
        __builtin_amdgcn_sched_barrier(0);
    }
    if (h < 4) {
#pragma unroll
        for (int dd = 0; dd < 4; ++dd) { const f32x4 o = oacc[dd] * rl; u32x2 w; w.x = pk2(o[0], o[1]); w.y = pk2(o[2], o[3]); __builtin_nontemporal_store(w, (u32x2*)(YC + qrow * D + 512 + h * 64 + dd * 16 + 4 * kq_b)); }
    } else if (h < 8) {
#pragma unroll
        for (int dd = 0; dd < 4; ++dd) { const f32x4 o = oacc[4 + dd] * rl; u32x2 w; w.x = pk2(o[0], o[1]); w.y = pk2(o[2], o[3]); __builtin_nontemporal_store(w, (u32x2*)(YC + qrow * D + 512 + h * 64 + dd * 16 + 4 * kq_b)); }
    }
}

__device__ __forceinline__ void phase3(const Params& p, Frame& F) {
    unsigned char* ws = p.ws;
    lru_phase<0>(p, F);
    __syncthreads();
    TIC(9);
    TOC(9);
    {
        const int half = F.wave >> 2, htid = F.tid & 255;
        LAS unsigned* hb = (LAS unsigned*)(F.lds + A_HBAR + half * 16); LAS int* tick = (LAS int*)(F.lds + A_TICK + half * 16);
        if (htid == 0) { hb[0] = 0u; hb[1] = 0u; }
        __syncthreads();
        unsigned* ctr = (unsigned*)(ws + WS_CTL) + CW_QUEUE;
        for (int q = 2 * F.bid + half;;) {
            if (q >= 2048 + DB) break;
            size_t q0row; int L; const bf16* KI;
            const bool is_s = q >= 1024 && q < 1024 + DB;
            if (!is_s) {
                const int u = q < 1024 ? q : q - DB, chunk = 127 - (u >> 4), b = (u & 15) >> 2, quarter = u & 3;
                q0row = (size_t)b * SEQ + chunk * 64 + quarter * 16; L = 64 * (chunk + 1);
                KI = (const bf16*)(ws + WS_KIB) + (size_t)b * SEQ * 64;
            } else {
                const int s = q - 1024;
                q0row = (size_t)MP + s * DT; L = SKEYS;
                KI = (const bf16*)(ws + WS_KIS) + (size_t)s * SKEYS * 64;
            }
            select_unit(p, F, q0row, L, KI);
            if (htid == 0) *tick = (int)(2 * F.G + __hip_atomic_fetch_add(ctr, 1u, __ATOMIC_RELAXED, __HIP_MEMORY_SCOPE_AGENT));
            half_barrier(hb, F.lane);
            q = *tick;
            half_barrier(hb, F.lane);
        }
    }
}

__device__ __forceinline__ void phase4(const Params& p, Frame& F) {
    unsigned char* ws = p.ws;
    if (F.wave < 4) {
        for (int u = F.bid * 4 + F.wave; u < 2048 + 64; u += F.G * 4) {
            if (u < 2048) lru_unit<1>(p, F, u >> 9, u & 7, (u >> 3) & 63);
            else lru_unit<1>(p, F, NB + ((u - 2048) >> 3), (u - 2048) & 7, 0);
        }
    }
    const bool aff = (F.G & 7) == 0;
    const int x = F.bid & 7, b = aff ? (x >> 1) : (F.bid & 3);
    const int nwv = aff ? (F.G >> 2) * 8 : ((F.G + 3 - (F.bid & 3)) / 4) * 8;
    const int wv = aff ? ((F.bid >> 3) * 2 + (x & 1)) * 8 + F.wave : (F.bid >> 2) * 8 + F.wave;
    unsigned* ctr = (unsigned*)(ws + WS_CTL) + CW_QUEUE + 64 * (1 + b);
    const fp8* Kb = (const fp8*)(ws + WS_KB) + (size_t)b * SEQ * KVW; const fp8* Vb = (const fp8*)(ws + WS_VB) + (size_t)b * SEQ * KVW;
    for (int q = wv;;) {
        if (q >= SEQ + 2 * DT) break;
        if (q < SEQ) attend_query(p, F, (size_t)b * SEQ + q, Kb, Vb);
        else { const int qs = q - SEQ, s = 2 * b + (qs >> 4);
            attend_query(p, F, (size_t)MP + s * DT + (qs & 15), (const fp8*)(ws + WS_KS) + (size_t)s * SKEYS * KVW, (const fp8*)(ws + WS_VS) + (size_t)s * SKEYS * KVW); }
        unsigned t = 0u;
        if (F.lane == 0) t = __hip_atomic_fetch_add(ctr, 1u, __ATOMIC_RELAXED, __HIP_MEMORY_SCOPE_AGENT);
        q = nwv + __builtin_amdgcn_readfirstlane((int)t);
    }
}

__global__ void __launch_bounds__(512, 2) fwd_kernel(Params p) {
    extern __shared__ __attribute__((aligned(16))) unsigned char lds_raw[];
    Frame F; F.lds = (LAS unsigned char*)lds_raw; F.tid = threadIdx.x; F.lane = F.tid & 63; F.wave = __builtin_amdgcn_readfirstlane(F.tid >> 6); F.G = gridDim.x; F.bid = blockIdx.x;
    unsigned char* ws = p.ws;
    const int lo = p.ph_lo, hi = p.ph_hi;
#if !USE_CG_SYNC
    if (F.tid < 64) ((LAS unsigned*)(F.lds + LDSCTL_OFF))[F.tid] = 0u;
    __syncthreads();
    XcdBarrier xbar = xcd_barrier_post((unsigned*)(ws + WS_CTL) + CW_BAR, (volatile LAS unsigned*)(F.lds + LDSCTL_OFF));
#endif
#define IN(k) (lo <= (k) && (k) < hi)
#ifndef SKIPMASK
#define SKIPMASK 0
#endif
#define SKIP(k) ((SKIPMASK >> (k)) & 1)
#define REPS(k) for (int rep_ = 0; rep_ <= DUP(k); ++rep_, (rep_ <= DUP(k) ? GSYNC() : (void)0))
#if USE_CG_SYNC
#define GSYNC() cg::this_grid().sync()
#else
#define GSYNC() xcd_barrier(xbar)
#endif
#define SEAM(k) do { if (IN(k) && IN((k) + 1)) { GSYNC(); } } while (0)
    { TIC(20); if (IN(0) && !SKIP(0)) REPS(0) phase0(p, F); TOC(20); }
    { TIC(40); SEAM(0); TOC(40); }
    if (IN(1) && !SKIP(1)) REPS(1) {
        pg8::Gemm g{(const pg8::bf16_t*)(ws + WS_XB), (const pg8::bf16_t*)(ws + WS_WIN), MP, NIN, D};
        pg8::StaticOrder S; S.init(MP, NIN, F.G, F.bid);
        EpiInProj E{(const float*)(ws + WS_RSTD), (const float*)(ws + WS_RCOS), (const float*)(ws + WS_RSIN), p.in[I_QN], p.in[I_KN],
                    (bf16*)(ws + WS_XR), (bf16*)(ws + WS_GG), (bf16*)(ws + WS_Q), (bf16*)(ws + WS_QI), (fp8*)(ws + WS_KB), (fp8*)(ws + WS_VB), (bf16*)(ws + WS_KIB),
                    (fp8*)(ws + WS_KS), (fp8*)(ws + WS_VS), (bf16*)(ws + WS_KIS), (float*)(ws + WS_WI), p.out};
        { TIC(21); pg8::gemm_phase<EpiInProj, pg8::StaticOrder, true, true>(F.lds, g, S, E); TOC(21); }
        TIC(31);
        {
            const float* rstd = E.rstd + MP; const float* rcos = E.rcos; const float* rsin = E.rsin; const float* gq = E.gq; const float* gk = E.gk; float* out = p.out;
            bf16* XR = E.XR + (size_t)MP * LW; bf16* GG = E.GG + (size_t)MP * LW; bf16* Q = E.Q + (size_t)MP * 512; bf16* QI = E.QI + (size_t)MP * 512;
            fp8* KS = E.KS; fp8* VS = E.VS; bf16* KIS = E.KIS; float* WI = E.WI + (size_t)MP * 8;
            skinny_gemm<4, 4>(F, (const bf16*)(ws + WS_XB) + (size_t)MP * D, D, (const bf16*)(ws + WS_WIN), D, 38,
                [](int hb_, int nb, int r) { const int c = 64 * hb_ + 16 * nb + r, pn = c >> 8, wc = (c >> 6) & 3, bj = (c >> 5) & 1, w32 = c & 31, fq = w32 >> 3, n = (w32 >> 2) & 1, j = w32 & 3;
                                             return 256 * pn + 128 * bj + 32 * wc + 16 * n + 4 * fq + j; },
                [=](const f32x4 (&acc)[4], int r, int c0, int kq) {
                    const int hbk = c0 >> 4, sb = r >> 4, t = r & 15, pos = PAST + t;
                    const float rsd = rstd[r];
                    f32x4 v[4];
#pragma unroll
                    for (int nb = 0; nb < 4; ++nb) v[nb] = acc[nb] * rsd;
                    const bool norm = (hbk >= 16 && hbk < 26), rope = norm || (hbk >= 28 && hbk < 37);
                    if (norm) {
                        float ss = 0.f;
#pragma unroll
                        for (int nb = 0; nb < 4; ++nb) ss += (v[nb][0] * v[nb][0] + v[nb][1] * v[nb][1]) + (v[nb][2] * v[nb][2] + v[nb][3] * v[nb][3]);
                        ss += __shfl_xor(ss, 16); ss += __shfl_xor(ss, 32);
                        const float inv = rsqrtf(ss * (1.0f / 64.0f) + EPS); const float* g = hbk < 24 ? gq : gk;
#pragma unroll
                        for (int nb = 0; nb < 4; ++nb) v[nb] = v[nb] * inv * *(const f32x4*)(g + 16 * nb + 4 * kq);
                    }
                    if (rope) {
#pragma unroll
                        for (int nb = 0; nb < 2; ++nb) {
                            const f32x4 c4 = *(const f32x4*)(rcos + pos * 32 + 16 * nb + 4 * kq), s4 = *(const f32x4*)(rsin + pos * 32 + 16 * nb + 4 * kq);
                            const f32x4 x1 = v[nb], x2 = v[nb + 2];
                            v[nb] = x1 * c4 - x2 * s4; v[nb + 2] = x2 * c4 + x1 * s4;
                        }
                    }
#pragma unroll
                    for (int nb = 0; nb < 4; ++nb) {
                        const int d = 16 * nb + 4 * kq; const f32x4 x = v[nb];
                        u32x2 wb; wb.x = pg8::cvt_pk_bf16(x[0], x[1]); wb.y = pg8::cvt_pk_bf16(x[2], x[3]);
                        if (hbk < 8) {
                            const int c = 64 * hbk + d; *(u32x2*)(XR + (size_t)r * LW + c) = wb;
                            if (t >= DT - 3) *(f32x4*)(out + O_CS + ((size_t)(sb * 3 + (t - (DT - 3)))) * LW + c) = x;
                        } else if (hbk < 16) {
                            f32x4 gl; gl[0] = gelu_tanh(x[0]); gl[1] = gelu_tanh(x[1]); gl[2] = gelu_tanh(x[2]); gl[3] = gelu_tanh(x[3]);
                            u32x2 wg; wg.x = pg8::cvt_pk_bf16(gl[0], gl[1]); wg.y = pg8::cvt_pk_bf16(gl[2], gl[3]);
                            *(u32x2*)(GG + (size_t)r * LW + 64 * (hbk - 8) + d) = wg;
                        } else if (hbk < 24) { *(u32x2*)(Q + (size_t)r * 512 + 64 * (hbk - 16) + d) = wb;
                        } else if (hbk < 28) {
                            const int kvh = hbk & 1; const bool isk = hbk < 26;
                            *(f32x4*)(out + (isk ? O_KS : O_VS) + (size_t)r * KVW + kvh * 64 + d) = x;
                            *(unsigned*)((isk ? KS : VS) + ((size_t)sb * SKEYS + PAST + t) * KVW + kvh * 64 + d) = pk4_fp8(x[0], x[1], x[2], x[3]);
                        } else if (hbk < 36) { *(u32x2*)(QI + (size_t)r * 512 + 64 * (hbk - 28) + d) = wb;
                        } else if (hbk == 36) {
                            *(f32x4*)(out + O_KIS + (size_t)r * 64 + d) = x;
                            *(u32x2*)(KIS + ((size_t)sb * SKEYS + PAST + t) * 64 + d) = wb;
                        } else if (d < 8) { *(f32x4*)(WI + (size_t)r * 8 + d) = x * WI_SCALE; }
                    }
                });
        }
        TOC(31);
    }
    { TIC(41); SEAM(1); TOC(41); }
    { TIC(23); if (IN(2) && !SKIP(2)) REPS(2) phase3(p, F); TOC(23); }
    { TIC(43); SEAM(2); TOC(43); }
    { TIC(24); if (IN(3) && !SKIP(3)) REPS(3) phase4(p, F); TOC(24); }
    { TIC(44); SEAM(3); TOC(44); }
    if (IN(4) && !SKIP(4)) REPS(4) {
        pg8::Gemm g{(const pg8::bf16_t*)(ws + WS_YC), (const pg8::bf16_t*)(ws + WS_WOUT), MP, D, D};
        pg8::StaticOrder S; S.init(MP, D, F.G, F.bid);
        EpiOutProj E{p.in[I_XP], p.in[I_XS], p.out, (bf16*)(ws + WS_XB), (rep_ < DUP(4)) ? (float*)(ws + WS_CTL + 65536) : (float*)(ws + WS_SSQ)};
        { TIC(25); pg8::gemm_phase<EpiOutProj, pg8::StaticOrder, true, true>(F.lds, g, S, E); TOC(25); }
        TIC(35);
        {
            const float* xs = p.in[I_XS]; float* ys = p.out + O_YS; bf16* XB2 = (bf16*)(ws + WS_XB) + (size_t)MP * D; float* ssq = E.ssq + MP;
            skinny_gemm<1, 4>(F, (const bf16*)(ws + WS_YC) + (size_t)MP * D, D, (const bf16*)(ws + WS_WOUT), D, D / 16,
                [](int ct, int, int r) { return 16 * ct + r; },
                [=](const f32x4 (&acc)[1], int r, int c0, int) {
                    const f32x4 y = *(const f32x4*)(xs + (size_t)r * D + c0) + acc[0];
                    *(f32x4*)(ys + (size_t)r * D + c0) = y;
                    u32x2 w; w.x = pg8::cvt_pk_bf16(y[0], y[1]); w.y = pg8::cvt_pk_bf16(y[2], y[3]); *(u32x2*)(XB2 + (size_t)r * D + c0) = w;
                    float ss = (y[0] * y[0] + y[1] * y[1]) + (y[2] * y[2] + y[3] * y[3]);
                    ss += __shfl_xor(ss, 16); ss += __shfl_xor(ss, 32);
                    if ((threadIdx.x & 48) == 0) atomicAdd(ssq + r, ss);
                });
        }
        TOC(35);
    }
    { TIC(45); SEAM(4); TOC(45); }
    if (IN(5) && !SKIP(5)) REPS(5) {
        pg8::Gemm g{(const pg8::bf16_t*)(ws + WS_XB), (const pg8::bf16_t*)(ws + WS_WFI), MP, 2 * DFF, D};
        pg8::StaticOrder S; S.init(MP, 2 * DFF, F.G, F.bid);
        EpiFfnIn E{(const float*)(ws + WS_SSQ), (bf16*)(ws + WS_H)};
        { TIC(26); pg8::gemm_phase<EpiFfnIn, pg8::StaticOrder, true, true>(F.lds, g, S, E); TOC(26); }
        TIC(36);
        {
            const float* ssq = (const float*)(ws + WS_SSQ) + MP; bf16* H = (bf16*)(ws + WS_H) + (size_t)MP * DFF;
            skinny_gemm<2, 4>(F, (const bf16*)(ws + WS_XB) + (size_t)MP * D, D, (const bf16*)(ws + WS_WFI), D, DFF / 16,
                [](int ct, int nb, int r) { const int c = 16 * ct + r, pn = c >> 7, wc = (c >> 5) & 3, w32 = c & 31, fq = w32 >> 3, n = (w32 >> 2) & 1, j = w32 & 3; return 256 * pn + 128 * nb + 32 * wc + 16 * n + 4 * fq + j; },
                [=](const f32x4 (&acc)[2], int r, int c0, int) {
                    const float rs2 = rsqrtf(ssq[r] * (1.0f / 1024.0f) + EPS);
                    const f32x4 g = acc[0] * rs2, up = acc[1] * rs2; f32x4 h;
#pragma unroll
                    for (int j = 0; j < 4; ++j) h[j] = g[j] * sigmoidf_(g[j]) * up[j];
                    u32x2 w; w.x = pg8::cvt_pk_bf16(h[0], h[1]); w.y = pg8::cvt_pk_bf16(h[2], h[3]); *(u32x2*)(H + (size_t)r * DFF + c0) = w;
                });
        }
        TOC(36);
    }
    { TIC(46); SEAM(5); TOC(46); }
    if (IN(6) && !SKIP(6)) {
        pg8::Gemm g{(const pg8::bf16_t*)(ws + WS_H), (const pg8::bf16_t*)(ws + WS_WFO), MP, D, DFF};
        pg8::StaticOrder S; S.init(MP, D, F.G, F.bid);
        EpiFfnOut E{p.out, (const bf16*)(ws + WS_XB)};
        { TIC(27); pg8::gemm_phase<EpiFfnOut, pg8::StaticOrder, true, true>(F.lds, g, S, E); TOC(27); }
        TIC(37);
        {
            float* ys = p.out + O_YS;
            skinny_gemm<1, 11>(F, (const bf16*)(ws + WS_H) + (size_t)MP * DFF, DFF, (const bf16*)(ws + WS_WFO), DFF, D / 16,
                [](int ct, int, int r) { return 16 * ct + r; },
                [=](const f32x4 (&acc)[1], int r, int c0, int) { float* y = ys + (size_t)r * D + c0; *(f32x4*)y = *(const f32x4*)y + acc[0]; });
        }
        TOC(37);
    }
    if (TSEG && F.bid == 0 && F.tid == 0) { const unsigned acc_ = *(LAS unsigned*)(F.lds + LDSCTL_OFF + 128); const unsigned long long t0_ = __builtin_amdgcn_s_memrealtime(); while ((unsigned)(__builtin_amdgcn_s_memrealtime() - t0_) < acc_) __builtin_amdgcn_s_sleep(8); }
#undef IN
#undef SEAM
}

#ifndef N_LAUNCHES
#define N_LAUNCHES 1
#endif
constexpr int NPHASE = 7;
extern "C" void kernel_launch(void* const* d_in, const int* in_sizes, int n_in, void* d_out, int out_size, void* d_ws, size_t ws_size, hipStream_t stream) {
    static int grid = 0;
    if (grid == 0) {
        if (n_in != 22 || out_size != (int)O_END || ws_size < WS_END) { fprintf(stderr, "kernel_launch: unexpected shapes: n_in %d out %d ws %zu (need %zu)\n", n_in, out_size, ws_size, (size_t)WS_END); grid = -1; return; }
        int dev = 0, cus = 0, per_cu = 0;
        if (hipGetDevice(&dev) != hipSuccess || hipDeviceGetAttribute(&cus, hipDeviceAttributeMultiprocessorCount, dev) != hipSuccess) { grid = -1; return; }
        if (hipFuncSetAttribute((const void*)fwd_kernel, hipFuncAttributeMaxDynamicSharedMemorySize, LDS_BYTES) != hipSuccess) { fprintf(stderr, "kernel_launch: hipFuncSetAttribute failed\n"); grid = -1; return; }
        if (hipOccupancyMaxActiveBlocksPerMultiprocessor(&per_cu, (const void*)fwd_kernel, 512, LDS_BYTES) != hipSuccess || per_cu < 1) { fprintf(stderr, "kernel_launch: occupancy query says %d blocks/CU\n", per_cu); per_cu = 1; }
        (void)hipGetLastError();
        grid = cus;
    }
    if (grid < 0) return;
    if (!USE_CG_SYNC) { if (hipMemsetAsync((char*)d_ws + WS_CTL, 0, 65536, stream) != hipSuccess) { fprintf(stderr, "kernel_launch: memset failed\n"); return; } }
    Params p{};
    for (int i = 0; i < 22; ++i) p.in[i] = (const float*)d_in[i];
    p.out = (float*)d_out; p.ws = (unsigned char*)d_ws;
    for (int i = 0; i < 32; ++i) p.invf[i] = pow(10000.0, -(double)i / 32.0);
    if (N_LAUNCHES == 1) {
        p.ph_lo = 0; p.ph_hi = NPHASE;
        void* args[] = {&p};
        hipError_t e = hipLaunchCooperativeKernel((const void*)fwd_kernel, dim3(grid), dim3(512), args, LDS_BYTES, stream);
        if (e != hipSuccess) fprintf(stderr, "kernel_launch: cooperative launch failed: %s (grid %d)\n", hipGetErrorString(e), grid);
    } else {
        for (int k = 0; k < NPHASE; ++k) { p.ph_lo = k; p.ph_hi = k + 1; hipLaunchKernelGGL(fwd_kernel, dim3(grid), dim3(512), LDS_BYTES, stream, p); }
    }
}
```

```cpp
#include <hip/hip_runtime.h>
#include <hip/hip_cooperative_groups.h>
#include <cstdio>
#include <cstdint>
#include <cmath>
namespace cg = cooperative_groups;
namespace pg8 {
#define PG8_LAS __attribute__((address_space(3)))
typedef unsigned short bf16_t;
typedef short bf16x8 __attribute__((ext_vector_type(8)));
typedef float f32x4 __attribute__((ext_vector_type(4)));
typedef unsigned u32x4 __attribute__((ext_vector_type(4)));
constexpr int BM = 256, BK = 64, HALF = 128, HTB = HALF * BK * 2  , STAGE_BYTES = 8 * HTB, NXCD = 8, WGM = 8;

__host__ __device__ __forceinline__ int lds_byte(int r, int c) { const int st = (r >> 4) * 2 + (c >> 5), rr = r & 15, cc = c & 31, ob = rr * 64 + cc * 2; return st * 1024 + (ob ^ (((ob >> 9) & 1) << 5)); }
__host__ __device__ __forceinline__ void stage_rc(int b, int& R, int& C) { const int st = b / 1024, sb = b % 1024, swz = sb ^ (((sb >> 9) & 1) << 5); R = (st >> 1) * 16 + swz / 64; C = (st & 1) * 32 + (swz % 64) / 2; }
__host__ __device__ __forceinline__ int perm32(int rho) { const int n = rho >> 4, i = rho & 15; return 8 * (i >> 2) + 4 * n + (i & 3); }

struct Unit { int pm, pn; };
struct Gemm { const bf16_t* A; const bf16_t* Bt; int M, N, K; };

struct StaticOrder {
    int nM, nN, nwg, G, c;
    __host__ __device__ void init(int M, int N, int G_, int c_) { nM = M / BM; nN = N / BM; nwg = nM * nN; G = G_; c = c_; }
    __host__ __device__ bool next(int i, Unit& u) const {
        const long L = (long)i * G + c; if (L >= nwg) return false;
        int wgid = (int)L; { const int q = nwg / NXCD, r = nwg % NXCD, xcd = wgid % NXCD, off = wgid / NXCD; wgid = (xcd < r ? xcd * (q + 1) : r * (q + 1) + (xcd - r) * q) + off; }
        const int nig = WGM * nN, gid = wgid / nig, fm = gid * WGM, gsz = (nM - fm) < WGM ? (nM - fm) : WGM;
        u.pm = fm + ((wgid % nig) % gsz); u.pn = (wgid % nig) / gsz; return true;
    }
    __device__ __forceinline__ void a_ready(const Unit&) const {}
    __device__ __forceinline__ void done(const Unit&) const {}
};
__device__ __forceinline__ unsigned cvt_pk_bf16(float lo, float hi) { unsigned r; asm volatile("v_cvt_pk_bf16_f32 %0, %1, %2" : "=v"(r) : "v"(lo), "v"(hi)); return r; }
template <class Epi, class Sched, bool ALIGN_EPI = false, bool SP2 = false>
__device__ __forceinline__ void gemm_phase(PG8_LAS unsigned char* lds, const Gemm g, const Sched& S, const Epi& E) {
    const int tid = threadIdx.x, wid = __builtin_amdgcn_readfirstlane(tid >> 6), lane = tid & 63, wr = wid >> 2, wc = wid & 3, fr = lane & 15, fq = lane >> 4;
    const int K = g.K, nt = K / BK;
    unsigned voffA[2], voffB[2];
#pragma unroll
    for (int i = 0; i < 2; ++i) { int R, C; stage_rc(tid * 16 + i * 8192, R, C); const int Rb = Epi::PERM ? ((R & ~31) + perm32(R & 31)) : R;
        voffA[i] = (unsigned)(R * K + C) * 2u; voffB[i] = (unsigned)(Rb * K + C) * 2u; }
    const size_t kstep = (size_t)(BK * 2);
    const size_t hstep = (size_t)HALF * K * 2;
    const size_t tstep = 2 * hstep;
    const unsigned ldsw = (unsigned)wid * 1024u;
    const int aoff = lds_byte(wr * 64 + fr, fq * 8), boff = lds_byte(wc * 32 + fr, fq * 8);
#define PG8_SA(b, h) (((b) * 2 + (h)) * HTB)
#define PG8_SB(b, h) ((4 + (b) * 2 + (h)) * HTB)
#define PG8_STAGE(bufoff, gbase, voff) do { _Pragma("unroll") for (int _i = 0; _i < 2; ++_i) \
        __builtin_amdgcn_global_load_lds((const unsigned*)((const char*)(gbase) + (voff)[_i]), (PG8_LAS unsigned*)(lds + (bufoff) + ldsw + _i * 8192), 16, 0, 0); } while (0)
#define PG8_LDA(dst, b, h) do { _Pragma("unroll") for (int m = 0; m < 4; ++m) _Pragma("unroll") for (int k = 0; k < 2; ++k) dst[m][k] = *(const PG8_LAS bf16x8*)(lds + PG8_SA(b, h) + aoff + m * 2048 + k * 1024); } while (0)
#define PG8_LDB(dst, b, h) do { _Pragma("unroll") for (int n = 0; n < 2; ++n) _Pragma("unroll") for (int k = 0; k < 2; ++k) dst[n][k] = *(const PG8_LAS bf16x8*)(lds + PG8_SB(b, h) + boff + n * 2048 + k * 1024); } while (0)
#define PG8_MMA(ai, bj, At, Bt) do { __builtin_amdgcn_s_setprio(1); _Pragma("unroll") for (int m = 0; m < 4; ++m) _Pragma("unroll") for (int n = 0; n < 2; ++n) _Pragma("unroll") for (int k = 0; k < 2; ++k) \
        acc[ai][bj][m][n] = __builtin_amdgcn_mfma_f32_16x16x32_bf16(Bt[n][k], At[m][k], acc[ai][bj][m][n], 0, 0, 0); __builtin_amdgcn_s_setprio(0); } while (0)
#define PG8_WAIT_V(n) asm volatile("s_waitcnt vmcnt(" #n ")" ::: "memory")
#define PG8_WAIT_L(n) asm volatile("s_waitcnt lgkmcnt(" #n ")" ::: "memory")
#define PG8_BAR __builtin_amdgcn_s_barrier()
#define PG8_SCHED __builtin_amdgcn_sched_barrier(0)
    Unit cur, nxt; int ui = 0;
    if (!S.next(0, cur)) return;
    f32x4 acc[2][2][4][2];
#pragma unroll
    for (int a = 0; a < 2; ++a)
#pragma unroll
        for (int b = 0; b < 2; ++b)
#pragma unroll
            for (int m = 0; m < 4; ++m)
#pragma unroll
                for (int n = 0; n < 2; ++n) acc[a][b][m][n] = (f32x4){0.f, 0.f, 0.f, 0.f};
    bf16x8 At[4][2], B0[2][2], B1[2][2];
    const char* cA = (const char*)g.A + (size_t)cur.pm * tstep; const char* cB = (const char*)g.Bt + (size_t)cur.pn * tstep;
    S.a_ready(cur);
    if constexpr (SP2) {
        PG8_STAGE(PG8_SB(0, 0), cB, voffB); PG8_STAGE(PG8_SB(0, 1), cB + hstep, voffB); PG8_STAGE(PG8_SA(0, 0), cA, voffA); PG8_STAGE(PG8_SA(0, 1), cA + hstep, voffA);
        if (wr == 1) PG8_BAR;
        PG8_WAIT_V(2); PG8_BAR;
        PG8_STAGE(PG8_SB(1, 0), cB + kstep, voffB); PG8_STAGE(PG8_SA(1, 0), cA + kstep, voffA); PG8_STAGE(PG8_SB(1, 1), cB + hstep + kstep, voffB);
        PG8_WAIT_V(6); PG8_BAR;
    } else {
        PG8_STAGE(PG8_SB(0, 0), cB, voffB); PG8_STAGE(PG8_SA(0, 0), cA, voffA); PG8_STAGE(PG8_SB(0, 1), cB + hstep, voffB); PG8_STAGE(PG8_SA(0, 1), cA + hstep, voffA);
        if (wr == 1) PG8_BAR;
        PG8_WAIT_V(4); PG8_BAR;
        PG8_STAGE(PG8_SB(1, 0), cB + kstep, voffB); PG8_STAGE(PG8_SA(1, 0), cA + kstep, voffA); PG8_STAGE(PG8_SB(1, 1), cB + hstep + kstep, voffB);
        PG8_WAIT_V(6); PG8_BAR;
    }
    for (;;) {
        const bool has_next = S.next(ui + 1, nxt);
        const char* nA = has_next ? (const char*)g.A + (size_t)nxt.pm * tstep : cA; const char* nB = has_next ? (const char*)g.Bt + (size_t)nxt.pn * tstep : cB;
        for (int t = 0; t < nt; t += 2) {
            const bool last = (t == nt - 2);
            const char* a1 = cA + (size_t)(t + 1) * kstep;
            const char* a2 = last ? nA : cA + (size_t)(t + 2) * kstep; const char* b2 = last ? nB : cB + (size_t)(t + 2) * kstep;
            const char* a3 = a2 + kstep; const char* b3 = b2 + kstep;
            if (last && has_next) S.a_ready(nxt);
            if constexpr (SP2) {
            PG8_LDB(B0, 0, 0); PG8_LDB(B1, 0, 1); PG8_SCHED; PG8_LDA(At, 0, 0); PG8_STAGE(PG8_SA(1, 1), a1 + hstep, voffA);
            PG8_WAIT_V(8); PG8_WAIT_L(0); PG8_BAR; PG8_MMA(0, 0, At, B0); PG8_MMA(0, 1, At, B1); PG8_BAR; PG8_SCHED;
            PG8_LDA(At, 0, 1); PG8_STAGE(PG8_SB(0, 0), b2, voffB); PG8_STAGE(PG8_SB(0, 1), b2 + hstep, voffB); PG8_STAGE(PG8_SA(0, 0), a2, voffA);
            PG8_WAIT_V(8); PG8_WAIT_L(0); PG8_BAR; PG8_MMA(1, 0, At, B0); PG8_MMA(1, 1, At, B1); PG8_BAR; PG8_SCHED;
            PG8_LDB(B0, 1, 0); PG8_LDB(B1, 1, 1); PG8_SCHED; PG8_LDA(At, 1, 0); PG8_STAGE(PG8_SA(0, 1), a2 + hstep, voffA);
            PG8_WAIT_V(8); PG8_WAIT_L(0); PG8_BAR; PG8_MMA(0, 0, At, B0); PG8_MMA(0, 1, At, B1); PG8_BAR; PG8_SCHED;
            PG8_LDA(At, 1, 1); PG8_STAGE(PG8_SB(1, 0), b3, voffB); PG8_STAGE(PG8_SB(1, 1), b3 + hstep, voffB); PG8_STAGE(PG8_SA(1, 0), a3, voffA);
            PG8_WAIT_V(8); PG8_WAIT_L(0); PG8_BAR; PG8_MMA(1, 0, At, B0); PG8_MMA(1, 1, At, B1); PG8_BAR; PG8_SCHED;
            } else {
            PG8_LDB(B0, 0, 0); PG8_SCHED; PG8_LDA(At, 0, 0); PG8_STAGE(PG8_SA(1, 1), a1 + hstep, voffA);
            PG8_WAIT_L(8); PG8_BAR; PG8_WAIT_L(0); PG8_MMA(0, 0, At, B0); PG8_BAR; PG8_SCHED;
            PG8_LDB(B1, 0, 1); PG8_STAGE(PG8_SB(0, 0), b2, voffB);
            PG8_BAR; PG8_WAIT_L(0); PG8_MMA(0, 1, At, B1); PG8_BAR;
            PG8_LDA(At, 0, 1); PG8_STAGE(PG8_SA(0, 0), a2, voffA);
            PG8_BAR; PG8_WAIT_L(0); PG8_MMA(1, 0, At, B0); PG8_BAR; PG8_SCHED;
            PG8_STAGE(PG8_SB(0, 1), b2 + hstep, voffB);
            PG8_WAIT_V(6); PG8_BAR; PG8_MMA(1, 1, At, B1); PG8_BAR;
            PG8_LDB(B0, 1, 0); PG8_SCHED; PG8_LDA(At, 1, 0); PG8_STAGE(PG8_SA(0, 1), a2 + hstep, voffA);
            PG8_WAIT_L(8); PG8_BAR; PG8_WAIT_L(0); PG8_MMA(0, 0, At, B0); PG8_BAR; PG8_SCHED;
            PG8_LDB(B1, 1, 1); PG8_STAGE(PG8_SB(1, 0), b3, voffB);
            PG8_BAR; PG8_WAIT_L(0); PG8_MMA(0, 1, At, B1); PG8_BAR;
            PG8_LDA(At, 1, 1); PG8_STAGE(PG8_SA(1, 0), a3, voffA);
            PG8_BAR; PG8_WAIT_L(0); PG8_MMA(1, 0, At, B0); PG8_BAR; PG8_SCHED;
            PG8_STAGE(PG8_SB(1, 1), b3 + hstep, voffB);
            PG8_WAIT_V(6); PG8_BAR; PG8_MMA(1, 1, At, B1); PG8_BAR;
            }
        }
        if constexpr (ALIGN_EPI) { if (wr == 0) PG8_BAR; }
        if constexpr (!Epi::AFTER_DRAIN) { E(acc, cur, wr, wc, fr, fq); S.done(cur); }
        if (!has_next) break;
#pragma unroll
        for (int a = 0; a < 2; ++a)
#pragma unroll
            for (int b = 0; b < 2; ++b)
#pragma unroll
                for (int m = 0; m < 4; ++m)
#pragma unroll
                    for (int n = 0; n < 2; ++n) acc[a][b][m][n] = (f32x4){0.f, 0.f, 0.f, 0.f};
        cur = nxt; cA = nA; cB = nB; ++ui;
        if constexpr (ALIGN_EPI) { if (wr == 1) PG8_BAR; }
    }
    PG8_WAIT_V(0);
    if constexpr (!ALIGN_EPI) { if (wr == 0) PG8_BAR; }
    PG8_BAR;
    if constexpr (Epi::AFTER_DRAIN) { E.fused(acc, cur, wr, wc, fr, fq, lds, wid, lane); S.done(cur); }
#undef PG8_SA
#undef PG8_SB
#undef PG8_STAGE
#undef PG8_LDA
#undef PG8_LDB
#undef PG8_MMA
#undef PG8_WAIT_V
#undef PG8_WAIT_L
#undef PG8_BAR
#undef PG8_SCHED
}
}

constexpr int D = 1024, NB = 4, SEQ = 8192, DB = 8, DT = 16, PAST = 4096;
constexpr int MP = NB * SEQ;
constexpr int MS = DB * DT;
constexpr int MR = MP + MS;
constexpr int M = 33024;
constexpr int LW = 512, NLB = 8, LBW = 64;
constexpr int KVW = 128;
constexpr int DIN = 2376, NIN = 2560;
constexpr int DFF = 2816;
constexpr int SKEYS = PAST + DT;
constexpr float EPS = 1e-6f;
constexpr float WI_SCALE = 0.044194173824159216f;

constexpr size_t O_YP = 0;
constexpr size_t O_YS = O_YP + (size_t)MP * D;
constexpr size_t O_KP = O_YS + (size_t)MS * D;
constexpr size_t O_VP = O_KP + (size_t)MP * KVW;
constexpr size_t O_KIP = O_VP + (size_t)MP * KVW;
constexpr size_t O_HP = O_KIP + (size_t)MP * 64;
constexpr size_t O_CP = O_HP + (size_t)NB * LW;
constexpr size_t O_KS = O_CP + (size_t)NB * 3 * LW;
constexpr size_t O_VS = O_KS + (size_t)MS * KVW;
constexpr size_t O_KIS = O_VS + (size_t)MS * KVW;
constexpr size_t O_HS = O_KIS + (size_t)MS * 64;
constexpr size_t O_CS = O_HS + (size_t)DB * LW;
constexpr size_t O_END = O_CS + (size_t)DB * 3 * LW;
static_assert(O_END == 44236800, "output size");

constexpr size_t al256(size_t x) { return (x + 255) & ~(size_t)255; }
constexpr size_t WS_CTL = 0, CTL_BYTES = 1u << 20;
constexpr size_t WS_WIN = WS_CTL + CTL_BYTES;
constexpr size_t WS_WOUT = WS_WIN + al256((size_t)NIN * D * 2);
constexpr size_t WS_WFI = WS_WOUT + al256((size_t)D * D * 2);
constexpr size_t WS_WFO = WS_WFI + al256((size_t)2 * DFF * D * 2);
constexpr size_t WS_WG = WS_WFO + al256((size_t)D * DFF * 2);
constexpr size_t WS_RCOS = WS_WG + al256((size_t)2 * 8 * 64 * 64 * 2);
constexpr size_t WS_RSIN = WS_RCOS + al256((size_t)8192 * 32 * 4);
constexpr size_t WS_SP = WS_RSIN + al256((size_t)8192 * 32 * 4);
constexpr size_t WS_RSTD = WS_SP + al256(512 * 4);
constexpr size_t WS_SSQ = WS_RSTD + al256((size_t)M * 4);
constexpr size_t WS_WI = WS_SSQ + al256((size_t)M * 4);
constexpr size_t WS_AGG = WS_WI + al256((size_t)M * 8 * 4);
constexpr size_t WS_XB = WS_AGG + al256((size_t)12 * 64 * 512 * 8);
constexpr size_t WS_YC = WS_XB + al256((size_t)M * D * 2);
constexpr size_t WS_KB = WS_YC + al256((size_t)M * D * 2);
constexpr size_t WS_VB = WS_KB + al256((size_t)MP * KVW * 2);
constexpr size_t WS_KIB = WS_VB + al256((size_t)MP * KVW * 2);
constexpr size_t WS_KS = WS_KIB + al256((size_t)MP * 64 * 2);
constexpr size_t WS_VS = WS_KS + al256((size_t)DB * SKEYS * KVW * 2);
constexpr size_t WS_KIS = WS_VS + al256((size_t)DB * SKEYS * KVW * 2);
constexpr size_t WS_R1 = WS_KIS + al256((size_t)DB * SKEYS * 64 * 2);
constexpr size_t WS_XR = WS_R1;
constexpr size_t WS_GG = WS_XR + al256((size_t)M * LW * 2);
constexpr size_t WS_Q = WS_GG + al256((size_t)M * LW * 2);
constexpr size_t WS_QI = WS_Q + al256((size_t)M * LW * 2);
constexpr size_t WS_ACUM = WS_QI + al256((size_t)M * LW * 2);
constexpr size_t WS_BCUM = WS_ACUM + al256((size_t)M * LW * 4);
constexpr size_t WS_R1_END = WS_BCUM + al256((size_t)M * LW * 4);
constexpr size_t WS_H = WS_R1;
static_assert(WS_H + (size_t)M * DFF * 2 <= WS_R1_END, "H overlay fits");
constexpr size_t WS_CANDG = WS_ACUM;
static_assert(WS_CANDG + (size_t)M * 1024 * 4 <= WS_R1_END, "candidate lists fit");
constexpr size_t WS_SEL = WS_R1_END;
constexpr size_t WS_NSEL = WS_SEL + al256((size_t)M * 256 * 2);
constexpr size_t WS_END = WS_NSEL + al256((size_t)M * 4);

#ifndef DUPMASK
#define DUPMASK 0
#endif
#define DUP(k) ((DUPMASK >> (k)) & 1)
#ifndef USE_CG_SYNC
#define USE_CG_SYNC 0
#endif
constexpr int CW_QUEUE = 2048;
constexpr int CW_BAR = 4096;
constexpr int LDSCTL_OFF = 131072 + 1024;
#ifndef FORCE_SAFE_MODE
#define FORCE_SAFE_MODE 0
#endif
#ifndef TSEG
#define TSEG 0
#endif
#define TIC(id) unsigned long long tic_##id = (TSEG == (id)) ? __builtin_amdgcn_s_memrealtime() : 0ull
#define TOC(id) do { if (TSEG == (id) && F.bid == 0 && F.wave == 0) { const unsigned d_ = (unsigned)(__builtin_amdgcn_s_memrealtime() - tic_##id); if (F.lane == 0) { LAS unsigned* a_ = (LAS unsigned*)(F.lds + LDSCTL_OFF + 128); *a_ += d_; } } } while (0)
constexpr int LDS_BYTES = 147456;

#define LAS __attribute__((address_space(3)))
typedef unsigned short bf16;
typedef float f32x4 __attribute__((ext_vector_type(4)));
typedef float f32x2 __attribute__((ext_vector_type(2)));
typedef unsigned u32x4 __attribute__((ext_vector_type(4)));
typedef unsigned u32x2 __attribute__((ext_vector_type(2)));
typedef short bf16x8 __attribute__((ext_vector_type(8)));

__device__ __forceinline__ unsigned pk2(float lo, float hi) { unsigned r; asm("v_cvt_pk_bf16_f32 %0, %1, %2" : "=v"(r) : "v"(lo), "v"(hi)); return r; }
__device__ __forceinline__ unsigned f2bf(float f) { return pk2(f, 0.f) & 0xffffu; }
__device__ __forceinline__ float bf2f(unsigned b) { return __builtin_bit_cast(float, b << 16); }
__device__ __forceinline__ float bflo(unsigned w) { return __builtin_bit_cast(float, w << 16); }
__device__ __forceinline__ float bfhi(unsigned w) { return __builtin_bit_cast(float, w & 0xffff0000u); }
__device__ __forceinline__ void store_bf16x8(bf16* p, f32x4 lo, f32x4 hi) {
    u32x4 w; w.x = pg8::cvt_pk_bf16(lo[0], lo[1]); w.y = pg8::cvt_pk_bf16(lo[2], lo[3]); w.z = pg8::cvt_pk_bf16(hi[0], hi[1]); w.w = pg8::cvt_pk_bf16(hi[2], hi[3]);
    *(u32x4*)p = w;
}
typedef unsigned char fp8;
__device__ __forceinline__ unsigned pk4_fp8(float a, float b, float c, float d) { int w = __builtin_amdgcn_cvt_pk_fp8_f32(a, b, 0, false); w = __builtin_amdgcn_cvt_pk_fp8_f32(c, d, w, true); return (unsigned)w; }
__device__ __forceinline__ void store_fp8x8(fp8* p, f32x4 lo, f32x4 hi) { u32x2 w; w.x = pk4_fp8(lo[0], lo[1], lo[2], lo[3]); w.y = pk4_fp8(hi[0], hi[1], hi[2], hi[3]); *(u32x2*)p = w; }
__device__ __forceinline__ u32x2 fp8x4_bf16x4(unsigned w) {
    const f32x2 a = __builtin_amdgcn_cvt_pk_f32_fp8((int)w, false); const f32x2 b = __builtin_amdgcn_cvt_pk_f32_fp8((int)w, true);
    const float a0 = a.x, a1 = a.y, b0 = b.x, b1 = b.y;
    u32x2 o; o.x = __builtin_amdgcn_perm(__float_as_uint(a1), __float_as_uint(a0), 0x07060302u); o.y = __builtin_amdgcn_perm(__float_as_uint(b1), __float_as_uint(b0), 0x07060302u);
    return o;
}
__device__ __forceinline__ float gelu_tanh(float x) {
    const float u = 0.7978845608028654f * (x + 0.044715f * x * x * x);
    const float e = __expf(2.0f * u);
    const float th = 1.0f - 2.0f * __builtin_amdgcn_rcpf(e + 1.0f);
    return 0.5f * x * (1.0f + th);
}
__device__ __forceinline__ float sigmoidf_(float x) { return __builtin_amdgcn_rcpf(1.0f + __expf(-x)); }

#define XB_TMO      128
#define XB_XCNT(j)  (256  + 64 * (j))
#define XB_XSUB(j)  (1280 + 64 * (j))
#define XB_XGEN(j)  (2304 + 64 * (j))
#define XB_TOP      3328
#define XB_TOPGEN   3392
#define XCD_BAR_WORDS 3456
#define XB_SPIN_CAP (1u << 18)

__device__ __forceinline__ unsigned xb_ld(unsigned* p)              { return __hip_atomic_load(p, __ATOMIC_RELAXED, __HIP_MEMORY_SCOPE_AGENT); }
__device__ __forceinline__ unsigned xb_add(unsigned* p, unsigned v) { return __hip_atomic_fetch_add(p, v, __ATOMIC_RELAXED, __HIP_MEMORY_SCOPE_AGENT); }
__device__ __forceinline__ unsigned xb_xcc_id() { return (unsigned)__builtin_amdgcn_s_getreg((3 << 11) | 20) & 0xFu; }
#define XB_SPIN(cond, bar) do { unsigned _sp = 0; while (cond) { __builtin_amdgcn_s_sleep(1); \
    if ((++_sp & 255u) == 0u) { if (xb_ld(&(bar)[XB_TMO])) break; if (_sp > XB_SPIN_CAP) { atomicAdd(&(bar)[XB_TMO], 1u); break; } } } } while (0)

struct XcdBarrier {
    unsigned* bar; unsigned x;
    volatile LAS unsigned* st;
};

__device__ __forceinline__ XcdBarrier xcd_barrier_post(unsigned* bar, volatile LAS unsigned* st) {
    XcdBarrier b; b.bar = bar; b.x = xb_xcc_id(); b.st = st;
    if (threadIdx.x == 0) (void)xb_add(&bar[XB_XCNT(b.x)], 1u);
    return b;
}
__device__ __forceinline__ void xcd_barrier_complete(unsigned* bar, unsigned x, unsigned& nloc, unsigned& nx) {
    const unsigned G = gridDim.x * gridDim.y * gridDim.z;
    unsigned sum, cnt, mine, sp = 0u;
    for (;;) {
        sum = 0u; cnt = 0u; mine = 0u;
#pragma unroll
        for (unsigned j = 0; j < 16; ++j) { const unsigned c = xb_ld(&bar[XB_XCNT(j)]); sum += c; cnt += (c > 0u) ? 1u : 0u; mine = (j == x) ? c : mine; }
        if (sum == G) break;
        __builtin_amdgcn_s_sleep(1);
        if ((++sp & 255u) == 0u) { if (xb_ld(&bar[XB_TMO])) break; if (sp > XB_SPIN_CAP) { atomicAdd(&bar[XB_TMO], 1u); break; } }
    }
    nloc = mine > 0u ? mine : 1u; nx = cnt > 0u ? cnt : 1u;
}

__device__ __forceinline__ void xcd_barrier(const XcdBarrier& b) {
    asm volatile("s_waitcnt vmcnt(0)" ::: "memory");
    __syncthreads();
    if (threadIdx.x == 0) {
        unsigned* bar = b.bar;
        __builtin_amdgcn_s_waitcnt(0);
        unsigned nloc = b.st[0], nx = b.st[1];
        if (nloc == 0u) { xcd_barrier_complete(bar, b.x, nloc, nx); b.st[0] = nloc; b.st[1] = nx; }
        const unsigned old = xb_add(&bar[XB_XSUB(b.x)], 1u);
        const unsigned gen = old / nloc;
        if (old + 1u == (gen + 1u) * nloc) {
            __builtin_amdgcn_fence(__ATOMIC_RELEASE, "agent");
            asm volatile("s_waitcnt vmcnt(0)" ::: "memory");
            const unsigned og = xb_add(&bar[XB_TOP], 1u);
            const unsigned tg = og / nx;
            if (og + 1u == (tg + 1u) * nx) xb_add(&bar[XB_TOPGEN], 1u);
            else XB_SPIN(xb_ld(&bar[XB_TOPGEN]) == tg, bar);
            __builtin_amdgcn_fence(__ATOMIC_ACQUIRE, "agent");
            xb_add(&bar[XB_XGEN(b.x)], 1u);
            asm volatile("s_waitcnt vmcnt(0)" ::: "memory");
        } else {
            XB_SPIN(xb_ld(&bar[XB_XGEN(b.x)]) == gen, bar);
            __builtin_amdgcn_fence(__ATOMIC_ACQUIRE, "agent");
            asm volatile("s_waitcnt vmcnt(0)" ::: "memory");
        }
    }
    __syncthreads();
}
struct EpiInProj {
    static constexpr bool PERM = false, AFTER_DRAIN = false;
    const float* rstd; const float* rcos; const float* rsin; const float* gq; const float* gk;
    bf16* XR; bf16* GG; bf16* Q; bf16* QI; fp8* KB; fp8* VB; bf16* KIB; fp8* KS; fp8* VS; bf16* KIS; float* WI; float* out;

    template <bool NORM> __device__ __forceinline__ void head_rope(f32x4 (&v)[2][2], const float* g, int pos, int fq) const {
        if (NORM) {
            float ss = 0.f;
#pragma unroll
            for (int bj = 0; bj < 2; ++bj)
#pragma unroll
                for (int n = 0; n < 2; ++n) ss += (v[bj][n][0] * v[bj][n][0] + v[bj][n][1] * v[bj][n][1]) + (v[bj][n][2] * v[bj][n][2] + v[bj][n][3] * v[bj][n][3]);
            ss += __shfl_xor(ss, 16); ss += __shfl_xor(ss, 32);
            const float inv = rsqrtf(ss * (1.0f / 64.0f) + EPS);
#pragma unroll
            for (int bj = 0; bj < 2; ++bj)
#pragma unroll
                for (int n = 0; n < 2; ++n) { const f32x4 g4 = *(const f32x4*)(g + 32 * bj + 8 * fq + 4 * n); v[bj][n] = v[bj][n] * inv * g4; }
        }
#pragma unroll
        for (int n = 0; n < 2; ++n) {
            const f32x4 c4 = *(const f32x4*)(rcos + pos * 32 + 8 * fq + 4 * n), s4 = *(const f32x4*)(rsin + pos * 32 + 8 * fq + 4 * n);
            const f32x4 x1 = v[0][n], x2 = v[1][n];
            v[0][n] = x1 * c4 - x2 * s4; v[1][n] = x2 * c4 + x1 * s4;
        }
    }
    __device__ __forceinline__ void operator()(const f32x4 (&acc)[2][2][4][2], const pg8::Unit& u, int wr, int wc, int fr, int fq) const {
        const int pn = u.pn;
#pragma unroll
        for (int ai = 0; ai < 2; ++ai) {
            const int rbase = u.pm * 256 + ai * 128;
            if (rbase >= MR) continue;
            const bool samp = rbase >= MP;
#pragma unroll
            for (int m = 0; m < 4; ++m) {
                const int r = rbase + wr * 64 + m * 16 + fr;
                int sb, t, pos;
                if (!samp) { sb = r >> 13; t = r & 8191; pos = t; } else { const int rs = r - MP; sb = rs >> 4; t = rs & 15; pos = PAST + t; }
                const float rsd = rstd[r];
                f32x4 v[2][2];
#pragma unroll
                for (int bj = 0; bj < 2; ++bj)
#pragma unroll
                    for (int n = 0; n < 2; ++n) v[bj][n] = acc[ai][bj][m][n] * rsd;
                if (pn < 2) {
#pragma unroll
                    for (int bj = 0; bj < 2; ++bj) {
                        const int c = 256 * pn + 64 * wc + 32 * bj + 8 * fq;
                        store_bf16x8(XR + (size_t)r * LW + c, v[bj][0], v[bj][1]);
                        const int tl = samp ? DT - 3 : SEQ - 3;
                        if (t >= tl) {
                            float* o = samp ? out + O_CS + ((size_t)(sb * 3 + (t - tl))) * LW + c : out + O_CP + ((size_t)(sb * 3 + (t - tl))) * LW + c;
                            *(f32x4*)o = v[bj][0]; *(f32x4*)(o + 4) = v[bj][1];
                        }
                    }
                } else if (pn < 4) {
#pragma unroll
                    for (int bj = 0; bj < 2; ++bj) {
                        const int c = 256 * (pn - 2) + 64 * wc + 32 * bj + 8 * fq;
                        f32x4 a = v[bj][0], b = v[bj][1];
#pragma unroll
                        for (int j = 0; j < 4; ++j) { a[j] = gelu_tanh(a[j]); b[j] = gelu_tanh(b[j]); }
                        store_bf16x8(GG + (size_t)r * LW + c, a, b);
                    }
                } else if (pn < 6) {
                    head_rope<true>(v, gq, pos, fq);
                    const int head = 4 * (pn - 4) + wc;
#pragma unroll
                    for (int bj = 0; bj < 2; ++bj) store_bf16x8(Q + (size_t)r * 512 + head * 64 + 32 * bj + 8 * fq, v[bj][0], v[bj][1]);
                } else if (pn == 6) {
                    if (wc < 2) head_rope<true>(v, gk, pos, fq);
                    const int hh = wc & 1;
                    float* of; fp8* ob;
                    if (wc < 2) { of = samp ? out + O_KS + (size_t)(r - MP) * KVW : out + O_KP + (size_t)r * KVW; ob = samp ? KS + ((size_t)sb * SKEYS + PAST + t) * KVW : KB + (size_t)r * KVW; }
                    else        { of = samp ? out + O_VS + (size_t)(r - MP) * KVW : out + O_VP + (size_t)r * KVW; ob = samp ? VS + ((size_t)sb * SKEYS + PAST + t) * KVW : VB + (size_t)r * KVW; }
#pragma unroll
                    for (int bj = 0; bj < 2; ++bj) {
                        const int c = hh * 64 + 32 * bj + 8 * fq;
                        *(f32x4*)(of + c) = v[bj][0]; *(f32x4*)(of + c + 4) = v[bj][1];
                        store_fp8x8(ob + c, v[bj][0], v[bj][1]);
                    }
                } else if (pn < 9) {
                    head_rope<false>(v, nullptr, pos, fq);
                    const int head = 4 * (pn - 7) + wc;
#pragma unroll
                    for (int bj = 0; bj < 2; ++bj) store_bf16x8(QI + (size_t)r * 512 + head * 64 + 32 * bj + 8 * fq, v[bj][0], v[bj][1]);
                } else {
                    if (wc == 0) {
                        head_rope<false>(v, nullptr, pos, fq);
                        float* of = samp ? out + O_KIS + (size_t)(r - MP) * 64 : out + O_KIP + (size_t)r * 64;
                        bf16* ob = samp ? KIS + ((size_t)sb * SKEYS + PAST + t) * 64 : KIB + (size_t)r * 64;
#pragma unroll
                        for (int bj = 0; bj < 2; ++bj) {
                            const int c = 32 * bj + 8 * fq;
                            *(f32x4*)(of + c) = v[bj][0]; *(f32x4*)(of + c + 4) = v[bj][1];
                            store_bf16x8(ob + c, v[bj][0], v[bj][1]);
                        }
                    } else if (wc == 1) {
                        if (fq == 0) { *(f32x4*)(WI + (size_t)r * 8) = v[0][0] * WI_SCALE; *(f32x4*)(WI + (size_t)r * 8 + 4) = v[0][1] * WI_SCALE; }
                    }
                }
            }
        }
    }
};

struct EpiOutProj {
    static constexpr bool PERM = false, AFTER_DRAIN = false;
    const float* xp; const float* xs; float* out; bf16* XB2; float* ssq;
    __device__ __forceinline__ void operator()(const f32x4 (&acc)[2][2][4][2], const pg8::Unit& u, int wr, int wc, int fr, int fq) const {
        const int col0 = u.pn * 256 + wc * 32 + 4 * fq;
#pragma unroll
        for (int ai = 0; ai < 2; ++ai) {
            const int rbase = u.pm * 256 + ai * 128;
            if (rbase >= MR) continue;
            const bool samp = rbase >= MP;
#pragma unroll
            for (int m = 0; m < 4; ++m) {
                const int r = rbase + wr * 64 + m * 16 + fr;
                const float* xrow = samp ? xs + (size_t)(r - MP) * D : xp + (size_t)r * D;
                float* yrow = samp ? out + O_YS + (size_t)(r - MP) * D : out + O_YP + (size_t)r * D;
                float ss = 0.f;
#pragma unroll
                for (int bj = 0; bj < 2; ++bj)
#pragma unroll
                    for (int n = 0; n < 2; ++n) {
                        const int c = col0 + bj * 128 + n * 16;
                        const f32x4 y = *(const f32x4*)(xrow + c) + acc[ai][bj][m][n];
                        if (samp) *(f32x4*)(yrow + c) = y;
                        ss += (y[0] * y[0] + y[1] * y[1]) + (y[2] * y[2] + y[3] * y[3]);
                        u32x2 w; w.x = pg8::cvt_pk_bf16(y[0], y[1]); w.y = pg8::cvt_pk_bf16(y[2], y[3]);
                        *(u32x2*)(XB2 + (size_t)r * D + c) = w;
                    }
                ss += __shfl_xor(ss, 16); ss += __shfl_xor(ss, 32);
                if (fq == 0) atomicAdd(ssq + r, ss);
            }
        }
    }
};

struct EpiFfnIn {
    static constexpr bool PERM = false, AFTER_DRAIN = false;
    const float* ssq; bf16* H;
    __device__ __forceinline__ void operator()(const f32x4 (&acc)[2][2][4][2], const pg8::Unit& u, int wr, int wc, int fr, int fq) const {
        const int c = 128 * u.pn + 32 * wc + 8 * fq;
#pragma unroll
        for (int ai = 0; ai < 2; ++ai) {
            const int rbase = u.pm * 256 + ai * 128;
            if (rbase >= MR) continue;
#pragma unroll
            for (int m = 0; m < 4; ++m) {
                const int r = rbase + wr * 64 + m * 16 + fr;
                const float rs2 = rsqrtf(ssq[r] * (1.0f / 1024.0f) + EPS);
                f32x4 h[2];
#pragma unroll
                for (int n = 0; n < 2; ++n) {
                    const f32x4 g = acc[ai][0][m][n] * rs2, up = acc[ai][1][m][n] * rs2;
#pragma unroll
                    for (int j = 0; j < 4; ++j) h[n][j] = g[j] * sigmoidf_(g[j]) * up[j];
                }
                store_bf16x8(H + (size_t)r * DFF + c, h[0], h[1]);
            }
        }
    }
};

struct EpiFfnOut {
    static constexpr bool PERM = false, AFTER_DRAIN = false;
    float* out; const bf16* XB2;
    __device__ __forceinline__ void operator()(const f32x4 (&acc)[2][2][4][2], const pg8::Unit& u, int wr, int wc, int fr, int fq) const {
        const int col0 = u.pn * 256 + wc * 32 + 4 * fq;
#pragma unroll
        for (int ai = 0; ai < 2; ++ai) {
            const int rbase = u.pm * 256 + ai * 128;
            if (rbase >= MP) continue;
#pragma unroll
            for (int m = 0; m < 4; ++m) {
                const int r = rbase + wr * 64 + m * 16 + fr;
                float* yrow = out + O_YP + (size_t)r * D;
#pragma unroll
                for (int bj = 0; bj < 2; ++bj)
#pragma unroll
                    for (int n = 0; n < 2; ++n) { const int c = col0 + bj * 128 + n * 16; const u32x2 xw = *(const u32x2*)(XB2 + (size_t)r * D + c);
                        const f32x4 x1 = {bflo(xw.x), bfhi(xw.x), bflo(xw.y), bfhi(xw.y)}; *(f32x4*)(yrow + c) = x1 + acc[ai][bj][m][n]; }
            }
        }
    }
};

struct Params {
    const float* in[22];
    float* out;
    unsigned char* ws;
    double invf[32];
    int ph_lo, ph_hi;
};
enum { I_XP = 0, I_XS, I_CK, I_CV, I_CKI, I_SH, I_SC, I_NM, I_WIN, I_CW, I_CB, I_WRG, I_BRG, I_WIG, I_BIG, I_LAM, I_QN, I_KN, I_WOUT, I_NF, I_WFI, I_WFO };

struct Frame { LAS unsigned char* lds; int tid, lane, wave, G, bid; };

template <int NB, int KSTEPS, class BRow, class Epi>
__device__ __forceinline__ void skinny_gemm(Frame& F, const bf16* A, int lda, const bf16* Bt, int K, int nct, BRow brow, Epi epi) {
    const int lane = F.lane, qc = lane & 15, kq = lane >> 4, w = F.wave;
    LAS f32x4* red = (LAS f32x4*)F.lds;
    for (int item = F.bid; item < 4 * nct; item += F.G) {
        const int rb = item & 3, ct = item >> 2;
        const bf16* a0 = A + (size_t)(rb * 32 + qc) * lda + 8 * kq + w * (KSTEPS * 32); const bf16* a1 = a0 + (size_t)16 * lda;
        const bf16* bp[NB];
#pragma unroll
        for (int nb = 0; nb < NB; ++nb) bp[nb] = Bt + (size_t)brow(ct, nb, qc) * K + 8 * kq + w * (KSTEPS * 32);
        f32x4 acc[2][NB];
#pragma unroll
        for (int m = 0; m < 2; ++m)
#pragma unroll
            for (int nb = 0; nb < NB; ++nb) acc[m][nb] = (f32x4){0.f, 0.f, 0.f, 0.f};
#pragma unroll
        for (int ks = 0; ks < KSTEPS; ++ks) {
            const bf16x8 fa0 = *(const bf16x8*)(a0 + 32 * ks), fa1 = *(const bf16x8*)(a1 + 32 * ks);
#pragma unroll
            for (int nb = 0; nb < NB; ++nb) {
                const bf16x8 fb = *(const bf16x8*)(bp[nb] + 32 * ks);
                acc[0][nb] = __builtin_amdgcn_mfma_f32_16x16x32_bf16(fb, fa0, acc[0][nb], 0, 0, 0);
                acc[1][nb] = __builtin_amdgcn_mfma_f32_16x16x32_bf16(fb, fa1, acc[1][nb], 0, 0, 0);
            }
        }
#pragma unroll
        for (int m = 0; m < 2; ++m)
#pragma unroll
            for (int nb = 0; nb < NB; ++nb) red[(w * 2 * NB + m * NB + nb) * 64 + lane] = acc[m][nb];
        __syncthreads();
        if (w < 2) {
            f32x4 s[NB];
#pragma unroll
            for (int nb = 0; nb < NB; ++nb) { s[nb] = red[(w * NB + nb) * 64 + lane];
#pragma unroll
                for (int w2 = 1; w2 < 8; ++w2) s[nb] += red[(w2 * 2 * NB + w * NB + nb) * 64 + lane]; }
            epi(s, rb * 32 + w * 16 + qc, 16 * ct + 4 * kq, kq);
        }
        __syncthreads();
    }
}

__device__ __forceinline__ float wave_sum(float v) {
#pragma unroll
    for (int o = 1; o < 64; o <<= 1) v += __shfl_xor(v, o);
    return v;
}

__device__ __forceinline__ void transpose_item(const float* W, int K, int N, int nvalid, const float* gain, bf16* WT, int k0, int row0, int lcol0, bool perm, LAS float* scr, int lane) {
    const int c4 = (lane & 7) * 4, col = lcol0 + c4; const bool ok = col < nvalid;
    f32x4 v[8];
#pragma unroll
    for (int i = 0; i < 8; ++i) { const int kk = (lane >> 3) + 8 * i; v[i] = ok ? *(const f32x4*)(W + (size_t)(k0 + kk) * N + col) : (f32x4){0.f, 0.f, 0.f, 0.f}; }
#pragma unroll
    for (int i = 0; i < 8; ++i) { const int kk = (lane >> 3) + 8 * i; const float g = gain ? gain[k0 + kk] : 1.0f; *(LAS f32x4*)(scr + kk * 36 + c4) = v[i] * g; }
    asm volatile("s_waitcnt lgkmcnt(0)" ::: "memory");
    const int c = lane & 7;
#pragma unroll
    for (int j = 0; j < 4; ++j) {
        const int n = (lane >> 3) + 8 * j, src = perm ? pg8::perm32(n) : n;
        const LAS float* s = scr + (8 * c) * 36 + src;
        u32x4 o; o.x = pk2(s[0 * 36], s[1 * 36]); o.y = pk2(s[2 * 36], s[3 * 36]); o.z = pk2(s[4 * 36], s[5 * 36]); o.w = pk2(s[6 * 36], s[7 * 36]);
        *(u32x4*)(WT + (size_t)(row0 + n) * K + k0 + 8 * c) = o;
    }
    asm volatile("s_waitcnt lgkmcnt(0)" ::: "memory");
}

__device__ __forceinline__ void phase0(const Params& p, Frame& F) {
    unsigned char* ws = p.ws;
    LAS float* scr = (LAS float*)(F.lds + F.wave * 16384);
    const int gw = F.bid * 8 + F.wave, NGW = F.G * 8;
    TIC(50);
    constexpr int I_IN = 16 * (NIN / 32), I_OUT = 16 * (D / 32), I_FI = 16 * (2 * DFF / 32), I_FO = (DFF / 64) * (D / 32);
    constexpr int NITEMS = I_IN + I_OUT + I_FI + I_FO;
    for (int it = gw; it < NITEMS; it += NGW) {
        int r = it;
        if (r < I_IN) { const int kb = r / (NIN / 32), g = r % (NIN / 32), pn = g >> 3, sub = g & 7, bj = sub >> 2, wc = sub & 3;
            transpose_item(p.in[I_WIN], D, DIN, DIN, p.in[I_NM], (bf16*)(ws + WS_WIN), 64 * kb, 32 * g, 256 * pn + 64 * wc + 32 * bj, true, scr, F.lane); continue; }
        r -= I_IN;
        if (r < I_OUT) { const int kb = r / (D / 32), g = r % (D / 32);
            transpose_item(p.in[I_WOUT], D, D, D, nullptr, (bf16*)(ws + WS_WOUT), 64 * kb, 32 * g, 32 * g, false, scr, F.lane); continue; }
        r -= I_OUT;
        if (r < I_FI) { const int kb = r / (2 * DFF / 32), g = r % (2 * DFF / 32), pn = g >> 3, sub = g & 7, bj = sub >> 2, wc = sub & 3;
            transpose_item(p.in[I_WFI], D, 2 * DFF, 2 * DFF, p.in[I_NF], (bf16*)(ws + WS_WFI), 64 * kb, 32 * g, (bj ? DFF : 0) + 128 * pn + 32 * wc, true, scr, F.lane); continue; }
        r -= I_FI;
        { const int kb = r / (D / 32), g = r % (D / 32);
            transpose_item(p.in[I_WFO], DFF, D, D, nullptr, (bf16*)(ws + WS_WFO), 64 * kb, 32 * g, 32 * g, false, scr, F.lane); }
    }
    TOC(50);
    TIC(51);
    {
        bf16* XB = (bf16*)(ws + WS_XB); float* rstd = (float*)(ws + WS_RSTD);
        for (int m0 = gw; m0 < M; m0 += 4 * NGW) {
            f32x4 v[4][4];
#pragma unroll
            for (int rr = 0; rr < 4; ++rr) {
                const int m = m0 + rr * NGW;
                const bool real = m < MR;
                const float* xrow = (m < MP) ? p.in[I_XP] + (size_t)m * D : p.in[I_XS] + (size_t)((real ? m : MP) - MP) * D;
                const f32x4* xr = (const f32x4*)xrow + F.lane;
#pragma unroll
                for (int j = 0; j < 4; ++j) v[rr][j] = real ? xr[64 * j] : (f32x4){0.f, 0.f, 0.f, 0.f};
            }
#pragma unroll
            for (int rr = 0; rr < 4; ++rr) {
                const int m = m0 + rr * NGW;
                if (m >= M) continue;
                float s = 0.f;
#pragma unroll
                for (int j = 0; j < 4; ++j) s += (v[rr][j][0] * v[rr][j][0] + v[rr][j][1] * v[rr][j][1]) + (v[rr][j][2] * v[rr][j][2] + v[rr][j][3] * v[rr][j][3]);
                s = wave_sum(s);
                if (F.lane == 0) rstd[m] = (m < MR) ? rsqrtf(s * (1.0f / D) + EPS) : 0.f;
                unsigned long long* o8 = (unsigned long long*)(XB + (size_t)m * D) + F.lane;
#pragma unroll
                for (int j = 0; j < 4; ++j) o8[64 * j] = (unsigned long long)pk2(v[rr][j][0], v[rr][j][1]) | ((unsigned long long)pk2(v[rr][j][2], v[rr][j][3]) << 32);
            }
        }
    }
    TOC(51);
    TIC(52);
    const size_t gt = (size_t)F.bid * 512 + F.tid, GS = (size_t)F.G * 512;
    {
        fp8* KS = (fp8*)(ws + WS_KS); fp8* VS = (fp8*)(ws + WS_VS); bf16* KIS = (bf16*)(ws + WS_KIS);
        constexpr size_t NKV8 = (size_t)DB * PAST * KVW / 8, NKI8 = (size_t)DB * PAST * 64 / 8;
        for (size_t i = gt; i < 2 * NKV8 + NKI8; i += GS) {
            if (i < 2 * NKV8) {
                const bool isv = i >= NKV8; const size_t e = (isv ? i - NKV8 : i) * 8, b = e / ((size_t)PAST * KVW), rem = e % ((size_t)PAST * KVW);
                const float* src = (isv ? p.in[I_CV] : p.in[I_CK]) + e; fp8* dst = (isv ? VS : KS) + b * SKEYS * KVW + rem;
                store_fp8x8(dst, *(const f32x4*)src, *(const f32x4*)(src + 4));
            } else {
                const size_t e = (i - 2 * NKV8) * 8, b = e / ((size_t)PAST * 64), rem = e % ((size_t)PAST * 64);
                const float* src = p.in[I_CKI] + e;
                store_bf16x8(KIS + b * SKEYS * 64 + rem, *(const f32x4*)src, *(const f32x4*)(src + 4));
            }
        }
    }
    {
        float* rc = (float*)(ws + WS_RCOS); float* rsn = (float*)(ws + WS_RSIN);
        for (size_t i = gt; i < (size_t)8192 * 32; i += GS) {
            const int pos = (int)(i >> 5), fi = (int)(i & 31);
            const double ang = (double)pos * p.invf[fi];
            const double kq = rint(ang * 0.63661977236758134308);
            double r = fma(-kq, 1.57079632679489655800e+00, ang); r = fma(-kq, 6.12323399573676603587e-17, r);
            const double r2 = r * r;
            double sn = -1.0 / 1307674368000.0; sn = sn * r2 + 1.0 / 6227020800.0; sn = sn * r2 - 1.0 / 39916800.0; sn = sn * r2 + 1.0 / 362880.0; sn = sn * r2 - 1.0 / 5040.0; sn = sn * r2 + 1.0 / 120.0; sn = sn * r2 - 1.0 / 6.0; sn = sn * r2 + 1.0; sn *= r;
            double cs = 1.0 / 20922789888000.0; cs = cs * r2 - 1.0 / 87178291200.0; cs = cs * r2 + 1.0 / 479001600.0; cs = cs * r2 - 1.0 / 3628800.0; cs = cs * r2 + 1.0 / 40320.0; cs = cs * r2 - 1.0 / 720.0; cs = cs * r2 + 1.0 / 24.0; cs = cs * r2 - 0.5; cs = cs * r2 + 1.0;
            const int q = (int)((long long)kq & 3);
            const double sv = (q == 0) ? sn : (q == 1) ? cs : (q == 2) ? -sn : -cs;
            const double cv = (q == 0) ? cs : (q == 1) ? -sn : (q == 2) ? -cs : sn;
            rc[i] = (float)cv; rsn[i] = (float)sv;
        }
    }
    {
        float* ssq = (float*)(ws + WS_SSQ);
        for (size_t i = gt; i < (size_t)M; i += GS) ssq[i] = 0.f;
        float* sp = (float*)(ws + WS_SP);
        for (size_t i = gt; i < 512; i += GS) sp[i] = log1pf(__expf(-p.in[I_LAM][i]));
        bf16* WG = (bf16*)(ws + WS_WG);
        for (size_t i = gt; i < (size_t)2 * 8 * 64 * 64; i += GS) {
            const int ii = (int)(i & 63), j = (int)((i >> 6) & 63), nb = (int)((i >> 12) & 7), gsel = (int)(i >> 15);
            const float* W = gsel ? p.in[I_WIG] : p.in[I_WRG];
            WG[i] = (bf16)f2bf(W[(nb * 64 + ii) * 64 + j]);
        }
    }
    TOC(52);
}

constexpr int LRU_WLDS = 14848;
template <int PASS> __device__ __forceinline__ void lru_unit(const Params& p, Frame& F, int sbi  , int nb, int sg) {
    unsigned char* ws = p.ws;
    const bool samp = sbi >= NB; const int b = samp ? sbi - NB : sbi;
    const int T = samp ? DT : 128, t0 = samp ? 0 : sg * 128;
    const size_t r0 = samp ? (size_t)MP + b * DT : (size_t)b * SEQ + t0;
    const int lane = F.lane, qc = lane & 15, kq = lane >> 4, ch = nb * 64 + lane;
    LAS unsigned char* wl = F.lds + F.wave * LRU_WLDS;
    LAS bf16* xcb = (LAS bf16*)wl; LAS float* xcf = (LAS float*)(wl + 2304); LAS float* av = (LAS float*)(wl + 2304 + 4096); LAS float* bv = (LAS float*)(wl + 2304 + 8192);
    const bf16* XR = (const bf16*)(ws + WS_XR) + r0 * LW + ch;
    const float cb = p.in[I_CB][ch], w0 = p.in[I_CW][ch], w1 = p.in[I_CW][LW + ch], w2 = p.in[I_CW][2 * LW + ch], w3 = p.in[I_CW][3 * LW + ch];
    float x1, x2, x3;
    if (t0 > 0) { x1 = bf2f(XR[-3 * LW]); x2 = bf2f(XR[-2 * LW]); x3 = bf2f(XR[-1 * LW]); }
    else if (samp) { const float* sc = p.in[I_SC] + (size_t)b * 3 * LW + ch; x1 = sc[0]; x2 = sc[LW]; x3 = sc[2 * LW]; }
    else { x1 = 0.f; x2 = 0.f; x3 = 0.f; }
    const bf16* GG = (const bf16*)(ws + WS_GG) + r0 * LW + ch; bf16* YC = (bf16*)(ws + WS_YC) + r0 * D + ch;
    unsigned short xn[16], gn2[16];
#pragma unroll
    for (int k = 0; k < 16; ++k) { xn[k] = XR[(size_t)k * LW]; gn2[k] = (PASS == 1) ? GG[(size_t)k * LW] : (unsigned short)0; }
    float Ac = 1.f, h = 0.f;
    if (PASS == 1) {
        h = samp ? p.in[I_SH][b * LW + ch] : 0.f;
        const f32x2* AGG = (const f32x2*)(ws + WS_AGG) + (size_t)sbi * 64 * LW + ch;
        f32x2 gn[8];
#pragma unroll
        for (int j = 0; j < 8; ++j) gn[j] = AGG[(size_t)(j < sg ? j : 0) * LW];
        for (int s0 = 0; s0 < sg; s0 += 8) {
            f32x2 g[8];
#pragma unroll
            for (int j = 0; j < 8; ++j) g[j] = gn[j];
            if (s0 + 8 < sg) {
#pragma unroll
                for (int j = 0; j < 8; ++j) gn[j] = AGG[(size_t)(s0 + 8 + j < sg ? s0 + 8 + j : 0) * LW];
            }
#pragma unroll
            for (int j = 0; j < 8; ++j) h = (s0 + j < sg) ? g[j].x * h + g[j].y : h;
        }
    }
    asm volatile("" ::: "memory");
    const bf16* WG = (const bf16*)(ws + WS_WG); const float* sp = (const float*)(ws + WS_SP);
    bf16x8 Wr[4][2], Wi[4][2]; float brg[4], big[4], spv[4];
#pragma unroll
    for (int jt = 0; jt < 4; ++jt) {
        const int j = 16 * jt + qc;
        const bf16* wr_ = WG + ((size_t)(0 * 8 + nb) * 64 + j) * 64 + 8 * kq; const bf16* wi_ = WG + ((size_t)(1 * 8 + nb) * 64 + j) * 64 + 8 * kq;
        Wr[jt][0] = *(const bf16x8*)wr_; Wr[jt][1] = *(const bf16x8*)(wr_ + 32); Wi[jt][0] = *(const bf16x8*)wi_; Wi[jt][1] = *(const bf16x8*)(wi_ + 32);
        brg[jt] = p.in[I_BRG][nb * 64 + j]; big[jt] = p.in[I_BIG][nb * 64 + j]; spv[jt] = sp[nb * 64 + j];
    }
    for (int st = 0; st < T; st += 16) {
        float xv[16], gg[16];
#pragma unroll
        for (int k = 0; k < 16; ++k) { xv[k] = bf2f(xn[k]); if (PASS == 1) gg[k] = bf2f(gn2[k]); }
        if (st + 16 < T) {
#pragma unroll
            for (int k = 0; k < 16; ++k) { xn[k] = XR[(size_t)(st + 16 + k) * LW]; if (PASS == 1) gn2[k] = GG[(size_t)(st + 16 + k) * LW]; }
        }
#pragma unroll
        for (int k = 0; k < 16; ++k) {
            const float xc = cb + w0 * x1 + w1 * x2 + w2 * x3 + w3 * xv[k];
            x1 = x2; x2 = x3; x3 = xv[k];
            xcf[k * 64 + lane] = xc; xcb[k * 72 + lane] = (bf16)f2bf(xc);
        }
        asm volatile("s_waitcnt lgkmcnt(0)" ::: "memory");
        const bf16x8 A0 = *(const LAS bf16x8*)(xcb + qc * 72 + 8 * kq), A1 = *(const LAS bf16x8*)(xcb + qc * 72 + 32 + 8 * kq);
#pragma unroll
        for (int jt = 0; jt < 4; ++jt) {
            const int j = 16 * jt + qc;
            f32x4 ar = {0.f, 0.f, 0.f, 0.f}, ai = {0.f, 0.f, 0.f, 0.f};
            ar = __builtin_amdgcn_mfma_f32_16x16x32_bf16(A0, Wr[jt][0], ar, 0, 0, 0); ar = __builtin_amdgcn_mfma_f32_16x16x32_bf16(A1, Wr[jt][1], ar, 0, 0, 0);
            ai = __builtin_amdgcn_mfma_f32_16x16x32_bf16(A0, Wi[jt][0], ai, 0, 0, 0); ai = __builtin_amdgcn_mfma_f32_16x16x32_bf16(A1, Wi[jt][1], ai, 0, 0, 0);
#pragma unroll
            for (int ii = 0; ii < 4; ++ii) {
                const int t = 4 * kq + ii;
                const float rg = sigmoidf_(ar[ii] + brg[jt]), ig = sigmoidf_(ai[ii] + big[jt]);
                const float a = __expf(-8.0f * rg * spv[jt]);
                float mult = sqrtf(fmaxf(1.0f - a * a, 0.f));
                if (!samp && (t0 + st + t) == 0) mult = 1.0f;
                av[t * 64 + j] = a; bv[t * 64 + j] = mult * ig * xcf[t * 64 + j];
            }
        }
        asm volatile("s_waitcnt lgkmcnt(0)" ::: "memory");
#pragma unroll
        for (int k = 0; k < 16; ++k) {
            const float a = av[k * 64 + lane], bb = bv[k * 64 + lane];
            h = a * h + bb;
            if (PASS == 0) Ac *= a;
            else YC[(size_t)(st + k) * D] = (bf16)f2bf(h * gg[k]);
        }
        asm volatile("s_waitcnt lgkmcnt(0)" ::: "memory");
    }
    if (PASS == 0) ((f32x2*)(ws + WS_AGG))[((size_t)sbi * 64 + sg) * LW + ch] = (f32x2){Ac, h};
    else { if (samp) p.out[O_HS + b * LW + ch] = h; else if (sg == 63) p.out[O_HP + b * LW + ch] = h; }
}
template <int PASS> __device__ __forceinline__ void lru_phase(const Params& p, Frame& F) {
    for (int u = F.bid * 8 + F.wave; u < 2048 + 64; u += F.G * 8) {
        if (u < 2048) lru_unit<PASS>(p, F, u >> 9, u & 7, (u >> 3) & 63);
        else lru_unit<PASS>(p, F, NB + ((u - 2048) >> 3), (u - 2048) & 7, 0);
    }
}

constexpr int A_CAND = 0, A_CNT = 131072, A_THR = 131072 + 128, A_FLAG = 131072 + 256, A_CNT0 = 131072 + 384, A_HBAR = 131072 + 512, A_TICK = 131072 + 576, CAP = 1024;
constexpr int VPITCH = 288;
extern "C" __device__ unsigned __ockl_wfred_max_u32(unsigned);
extern "C" __device__ unsigned __ockl_wfred_min_u32(unsigned);
typedef short v4i16_t __attribute__((ext_vector_type(4)));
typedef int v2i32_t __attribute__((ext_vector_type(2)));
constexpr int KV8P = 144;

__device__ __forceinline__ unsigned pack_key(float s, int key) {
    unsigned u = __float_as_uint(s);
    u = (u & 0x80000000u) ? ~u : (u | 0x80000000u);
    return (u & 0xFFFFE000u) | (unsigned)(8191 - key);
}
extern "C" __device__ unsigned __ockl_wfred_add_u32(unsigned);
extern "C" __device__ unsigned __ockl_wfscan_add_u32(unsigned, bool);
struct SelRes { unsigned thr; int cnt; };
__device__ __forceinline__ SelRes select_rank(LAS unsigned* cq, int n, int rlo, int rhi, int lane) {
    unsigned e[16]; unsigned mx = 0u, mn = 0xFFFFFFFFu;
#pragma unroll
    for (int i = 0; i < 16; ++i) { const int idx = i * 64 + lane; const unsigned x = cq[idx]; const bool v = idx < n; e[i] = v ? x : 0u; mx = e[i] > mx ? e[i] : mx; const unsigned y = v ? x : 0xFFFFFFFFu; mn = y < mn ? y : mn; }
    unsigned lo = (unsigned)__builtin_amdgcn_readfirstlane((int)__ockl_wfred_min_u32(mn));
    unsigned hi = (unsigned)__builtin_amdgcn_readfirstlane((int)__ockl_wfred_max_u32(mx)); hi = hi == 0xFFFFFFFFu ? hi : hi + 1u;
    int clo = n;
    for (int it = 0; it < 40 && clo > rhi; ++it) {
        const unsigned piv = lo + ((hi - lo) >> 1);
        int c = 0;
#pragma unroll
        for (int i = 0; i < 16; ++i) c += __popcll(__ballot(e[i] >= piv));
        if (c >= rlo) { lo = piv; clo = c; } else hi = piv;
    }
    unsigned cl = 0u;
#pragma unroll
    for (int i = 0; i < 16; ++i) cl += (e[i] >= lo) ? 1u : 0u;
    unsigned pos = __ockl_wfscan_add_u32(cl, false);
#pragma unroll
    for (int i = 0; i < 16; ++i) { const bool k = e[i] >= lo; if (k) cq[pos] = e[i]; pos += k ? 1u : 0u; }
    SelRes r; r.thr = lo; r.cnt = clo; return r;
}

__device__ __forceinline__ void half_barrier(LAS unsigned* hb, int lane) {
    asm volatile("s_waitcnt vmcnt(0) lgkmcnt(0)" ::: "memory");
    if (lane == 0) {
        const unsigned gen = __hip_atomic_load(hb + 1, __ATOMIC_RELAXED, __HIP_MEMORY_SCOPE_WORKGROUP);
        const unsigned old = __hip_atomic_fetch_add(hb, 1u, __ATOMIC_RELAXED, __HIP_MEMORY_SCOPE_WORKGROUP);
        if (old == 3u) { __hip_atomic_store(hb, 0u, __ATOMIC_RELAXED, __HIP_MEMORY_SCOPE_WORKGROUP); __hip_atomic_store(hb + 1, gen + 1u, __ATOMIC_RELAXED, __HIP_MEMORY_SCOPE_WORKGROUP); }
        else { while (__hip_atomic_load(hb + 1, __ATOMIC_RELAXED, __HIP_MEMORY_SCOPE_WORKGROUP) == gen) __builtin_amdgcn_s_sleep(1); }
    }
    asm volatile("s_waitcnt lgkmcnt(0)" ::: "memory");
}
__device__ __forceinline__ void select_unit(const Params& p, Frame& F, size_t q0row, int L, const bf16* KI) {
    unsigned char* ws = p.ws;
    const bf16* QI = (const bf16*)(ws + WS_QI); const float* WI = (const float*)(ws + WS_WI);
    const int lane = F.lane, half = F.wave >> 2, wid = F.wave & 3, htid = F.tid & 255, qc = lane & 15, kq = lane >> 4;
    LAS unsigned* cand = (LAS unsigned*)(F.lds + A_CAND + half * 65536); LAS unsigned* cntp = (LAS unsigned*)(F.lds + A_CNT + half * 64); LAS unsigned* thrp = (LAS unsigned*)(F.lds + A_THR + half * 64);
    LAS unsigned* flagp = (LAS unsigned*)(F.lds + A_FLAG + half * 16); LAS unsigned* hb = (LAS unsigned*)(F.lds + A_HBAR + half * 16);
    constexpr int nq = 16;
    constexpr int nslots = 4; const int slot = wid;
    const int ql = qc;
    TIC(1);
    bf16x8 Bq[8][2]; float sinf_[8];
    {
        const size_t qrow = q0row + ql;
#pragma unroll
        for (int h = 0; h < 8; ++h) {
            const float w = WI[qrow * 8 + h];
            sinf_[h] = (w < 0.f) ? -INFINITY : INFINITY;
#pragma unroll
            for (int s = 0; s < 2; ++s) {
                const u32x4 raw = *(const u32x4*)(QI + qrow * 512 + h * 64 + 32 * s + 8 * kq);
                u32x4 o; o.x = pk2(bflo(raw.x) * w, bfhi(raw.x) * w); o.y = pk2(bflo(raw.y) * w, bfhi(raw.y) * w); o.z = pk2(bflo(raw.z) * w, bfhi(raw.z) * w); o.w = pk2(bflo(raw.w) * w, bfhi(raw.w) * w);
                Bq[h][s] = __builtin_bit_cast(bf16x8, o);
            }
        }
    }
    half_barrier(hb, lane);
    TOC(1);
    TIC(2);
    for (int arep_ = 0; arep_ <= DUP(8); ++arep_) {
    const int NG = (L + 63) >> 6; const bool tail = (L & 63) != 0;
    LAS unsigned* cnt0 = (LAS unsigned*)(F.lds + A_CNT0 + half * 64);
    int rk = (600 * 1024) / L; rk = rk < 48 ? 48 : (rk > 256 ? 256 : rk);
#if FORCE_SAFE_MODE
    const int mode0 = 1;
#else
    const int mode0 = 0;
#endif
    bf16x8 An[2][2];
#define LOAD_A(DST, G, T0, T1) do { int g_ = (G); g_ = g_ < NG ? g_ : NG - 1; _Pragma("unroll") for (int tl = T0; tl < T1; ++tl) { int arow = g_ * 64 + tl * 16 + qc; arow = arow < L ? arow : L - 1; \
        DST[tl - T0][0] = *(const bf16x8*)(KI + (size_t)arow * 64 + 8 * kq); DST[tl - T0][1] = *(const bf16x8*)(KI + (size_t)arow * 64 + 32 + 8 * kq); } } while (0)
#define LOAD_AN(G) LOAD_A(An, G, 0, 2)
    for (int mode = mode0; mode < 2; ++mode) {
    bool redo = false;
    if (htid < 16) { cntp[htid] = 0u; thrp[htid] = 0u; cnt0[htid] = 0u; }
    if (htid == 32) flagp[1] = 0u;
    int g0 = 0, KG = 16;
    LOAD_AN(slot);
    while (g0 < NG) {
        const int gend = (g0 + KG < NG) ? g0 + KG : NG;
        if (htid == 32) flagp[0] = 0u;
        half_barrier(hb, lane);
        const unsigned thr = thrp[ql];
        LAS unsigned* cq = cand + ql * CAP;
        TIC(3);
        for (int g = g0 + slot; g < gend; g += nslots) {
            TIC(7);
            bf16x8 Ah[2][2]; LOAD_A(Ah, g, 2, 4);
            unsigned pk[16];
#define TILE(TL, A0_, A1_) do { f32x4 s0 = {0.f, 0.f, 0.f, 0.f}; \
                _Pragma("unroll") for (int h = 0; h < 8; ++h) { f32x4 acc = {0.f, 0.f, 0.f, 0.f}; \
                    acc = __builtin_amdgcn_mfma_f32_16x16x32_bf16(A0_, Bq[h][0], acc, 0, 0, 0); acc = __builtin_amdgcn_mfma_f32_16x16x32_bf16(A1_, Bq[h][1], acc, 0, 0, 0); \
                    _Pragma("unroll") for (int i = 0; i < 4; ++i) s0[i] += __builtin_amdgcn_fmed3f(acc[i], 0.f, sinf_[h]); } \
                _Pragma("unroll") for (int i = 0; i < 4; ++i) pk[(TL) * 4 + i] = pack_key(s0[i], g * 64 + (TL) * 16 + 4 * kq + i); } while (0)
            TILE(0, An[0][0], An[0][1]); TILE(1, An[1][0], An[1][1]);
            __builtin_amdgcn_sched_barrier(0);
            { const int gn = g + nslots; LOAD_AN(gn < gend ? gn : gend + slot); }
            TILE(2, Ah[0][0], Ah[0][1]); TILE(3, Ah[1][0], Ah[1][1]);
#undef TILE
            if (tail && g == NG - 1) {
                int vt = L - g * 64 - 4 * kq; asm volatile("" : "+v"(vt));
#pragma unroll
                for (int j = 0; j < 16; ++j) pk[j] = ((j >> 2) * 16 + (j & 3) < vt) ? pk[j] : 0u;
            }
            TOC(7);
            TIC(8);
            int n = 0;
#pragma unroll
            for (int j = 0; j < 16; ++j) n += (pk[j] > thr) ? 1 : 0;
            if (n) {
                unsigned base = __hip_atomic_fetch_add(cntp + ql, (unsigned)n, __ATOMIC_RELAXED, __HIP_MEMORY_SCOPE_WORKGROUP);
                if (base + (unsigned)n > (unsigned)CAP) flagp[0] = 1u;
                else {
#pragma unroll
                    for (int j = 0; j < 16; ++j) if (pk[j] > thr) cq[base++] = pk[j];
                }
            }
            TOC(8);
        }
        TOC(3);
        TIC(4);
        half_barrier(hb, lane);
        TOC(4);
        TIC(5);
        const bool ovf = flagp[0] != 0u;
        if (ovf && mode == 0) { redo = true; break; }
        if (ovf) { if (htid < 16) cntp[htid] = cnt0[htid]; half_barrier(hb, lane); }
        const bool last = !ovf && gend == NG;
        if (!last) {
            const int plim = ovf ? 256 : (mode == 0 ? rk + (rk >> 2) : 512), rlo = mode == 0 ? rk : 256, rhi = mode == 0 ? rk + (rk >> 2) : 256;
#pragma unroll 1
            for (int i2 = 0; i2 < 4; ++i2) {
                const int qq = wid * 4 + i2;
                if (qq < nq) {
                    int n = __builtin_amdgcn_readfirstlane((int)cntp[qq]);
                    if (n > plim) { const SelRes r = select_rank(cand + qq * CAP, n, rlo, rhi, lane); n = r.cnt; if (lane == 0) { cntp[qq] = (unsigned)n; thrp[qq] = r.thr; } }
                    if (lane == 0) cnt0[qq] = (unsigned)n;
                }
            }
        }
        TOC(5);
        if (ovf) { KG = (KG >> 1) > nslots ? (KG >> 1) : nslots; LOAD_AN(g0 + slot); }
        else { g0 = gend; KG = mode == 0 ? NG : ((KG * 2 < 32) ? KG * 2 : 32); }
    }
    if (!redo && mode == 0 && L > 1024) {
        if (lane < 4) { const int qq = wid * 4 + lane; if (qq < nq && cntp[qq] < 256u) flagp[1] = 1u; }
        half_barrier(hb, lane);
        redo = flagp[1] != 0u;
    }
    half_barrier(hb, lane);
    if (!redo) break;
    }
    TOC(2);
#undef LOAD_AN
#undef LOAD_A
    }
    TIC(6);
    {
        int lane_b = lane; asm volatile("" : "+v"(lane_b));
        unsigned short* SEL = (unsigned short*)(ws + WS_SEL); int* NSEL = (int*)(ws + WS_NSEL);
#pragma unroll 1
        for (int i2 = 0; i2 < 4; ++i2) {
            const int qq = wid * 4 + i2;
            if (qq >= nq) continue;
            int n = __builtin_amdgcn_readfirstlane((int)cntp[qq]);
            if (n > 256) { select_rank(cand + qq * CAP, n, 256, 256, lane_b); n = 256; }
            asm volatile("s_waitcnt lgkmcnt(0)" ::: "memory");
            const LAS unsigned* cq = cand + qq * CAP;
            const size_t row = q0row + qq;
            u32x2 w;
            { const int k = 4 * lane_b; const unsigned e0 = k < n ? cq[k] : 8191u, e1 = k + 1 < n ? cq[k + 1] : 8191u, e2 = k + 2 < n ? cq[k + 2] : 8191u, e3 = k + 3 < n ? cq[k + 3] : 8191u;
              w.x = (8191u - (e0 & 8191u)) | ((8191u - (e1 & 8191u)) << 16); w.y = (8191u - (e2 & 8191u)) | ((8191u - (e3 & 8191u)) << 16); }
            *(u32x2*)(SEL + row * 256 + 4 * lane_b) = w;
            if (lane_b == 0) NSEL[row] = n;
        }
    }
    half_barrier(hb, lane);
    TOC(6);
}

__device__ __forceinline__ void attend_query(const Params& p, Frame& F, size_t qrow, const fp8* Kb, const fp8* Vb) {
    unsigned char* ws = p.ws;
    const bf16* Qb = (const bf16*)(ws + WS_Q); bf16* YC = (bf16*)(ws + WS_YC);
    const int lane_b = F.lane, qc_b = lane_b & 15, kq_b = lane_b >> 4, wid = F.wave;
    const int wb = wid * LRU_WLDS;
    LAS unsigned short* ix = (LAS unsigned short*)(F.lds + wb);
    LAS unsigned char* vst = F.lds + wb + 512;
    const int n = __builtin_amdgcn_readfirstlane(((const int*)(ws + WS_NSEL))[qrow]);
    *(LAS u32x2*)(ix + 4 * lane_b) = __builtin_nontemporal_load((const u32x2*)((const unsigned short*)(ws + WS_SEL) + qrow * 256 + 4 * lane_b));
    asm volatile("s_waitcnt lgkmcnt(0)" ::: "memory");
    const int h = lane_b & 15;
    long Bh8[4];
#pragma unroll
    for (int s = 0; s < 4; ++s) {
        const bool v = (h < 8) && ((h >> 2) == (kq_b >> 1));
        u32x4 raw = {0u, 0u, 0u, 0u};
        if (v) raw = __builtin_nontemporal_load((const u32x4*)(Qb + qrow * 512 + h * 64 + 32 * (kq_b & 1) + 8 * s));
        const unsigned lo = pk4_fp8(bflo(raw.x), bfhi(raw.x), bflo(raw.y), bfhi(raw.y)), hi = pk4_fp8(bflo(raw.z), bfhi(raw.z), bflo(raw.w), bfhi(raw.w));
        Bh8[s] = (long)(((unsigned long long)hi << 32) | lo);
    }
    float sc[64];
    u32x4 Kn[4][2];
#pragma unroll
    for (int t4 = 0; t4 < 4; ++t4) { const fp8* kr = Kb + (size_t)ix[t4 * 16 + qc_b] * KVW + 32 * kq_b; Kn[t4][0] = *(const u32x4*)kr; Kn[t4][1] = *(const u32x4*)(kr + 16); }
#pragma unroll
    for (int g4 = 0; g4 < 4; ++g4) {
        u32x4 Ka[4][2];
#pragma unroll
        for (int t4 = 0; t4 < 4; ++t4) { Ka[t4][0] = Kn[t4][0]; Ka[t4][1] = Kn[t4][1]; }
        if (g4 < 3) {
#pragma unroll
            for (int t4 = 0; t4 < 4; ++t4) { const fp8* kr = Kb + (size_t)ix[(g4 + 1) * 64 + t4 * 16 + qc_b] * KVW + 32 * kq_b; Kn[t4][0] = *(const u32x4*)kr; Kn[t4][1] = *(const u32x4*)(kr + 16); }
        }
#pragma unroll
        for (int t4 = 0; t4 < 4; ++t4) {
            f32x4 acc = {0.f, 0.f, 0.f, 0.f};
#pragma unroll
            for (int s = 0; s < 4; ++s) {
                const u32x4 kw = Ka[t4][s >> 1];
                const long a8 = (long)(((unsigned long long)((s & 1) ? kw.w : kw.y) << 32) | ((s & 1) ? kw.z : kw.x));
                acc = __builtin_amdgcn_mfma_f32_16x16x32_fp8_fp8(a8, Bh8[s], acc, 0, 0, 0);
            }
#pragma unroll
            for (int ii = 0; ii < 4; ++ii) { const int key = (g4 * 4 + t4) * 16 + 4 * kq_b + ii; sc[(g4 * 4 + t4) * 4 + ii] = key < n ? acc[ii] * 0.125f : -INFINITY; }
        }
        __builtin_amdgcn_sched_barrier(0);
    }
    float mx = sc[0];
#pragma unroll
    for (int j = 1; j < 64; ++j) mx = fmaxf(mx, sc[j]);
    mx = fmaxf(mx, __shfl_xor(mx, 16)); mx = fmaxf(mx, __shfl_xor(mx, 32));
    float sum = 0.f;
#pragma unroll
    for (int j = 0; j < 64; ++j) { sc[j] = __expf(sc[j] - mx); sum += sc[j]; }
    sum += __shfl_xor(sum, 16); sum += __shfl_xor(sum, 32);
    const float rl = 1.0f / sum;
    long pb8[8];
#pragma unroll
    for (int b = 0; b < 8; ++b) { const unsigned lo = pk4_fp8(sc[b * 8 + 0], sc[b * 8 + 1], sc[b * 8 + 2], sc[b * 8 + 3]), hi = pk4_fp8(sc[b * 8 + 4], sc[b * 8 + 5], sc[b * 8 + 6], sc[b * 8 + 7]);
        pb8[b] = (long)(((unsigned long long)hi << 32) | lo); }
    f32x4 oacc[8];
#pragma unroll
    for (int dt = 0; dt < 8; ++dt) oacc[dt] = (f32x4){0.f, 0.f, 0.f, 0.f};
    u32x4 vr[4], vr2[4];
    const int vrow = lane_b >> 3, vch = lane_b & 7;
#pragma unroll
    for (int i = 0; i < 4; ++i) { vr[i] = *(const u32x4*)(Vb + (size_t)ix[8 * i + vrow] * KVW + vch * 16); vr2[i] = *(const u32x4*)(Vb + (size_t)ix[32 + 8 * i + vrow] * KVW + vch * 16); }
    const int tq = qc_b >> 1, trow = (tq < 4) ? 4 * kq_b + tq : 16 + 4 * kq_b + (tq - 4);
    const LAS unsigned char* trb = vst + trow * KV8P + (qc_b & 1) * 8;
#pragma unroll
    for (int b = 0; b < 8; ++b) {
#pragma unroll
        for (int i = 0; i < 4; ++i) *(LAS u32x4*)(vst + (8 * i + vrow) * KV8P + vch * 16) = vr[i];
#pragma unroll
        for (int i = 0; i < 4; ++i) vr[i] = vr2[i];
        if (b < 6) {
#pragma unroll
            for (int i = 0; i < 4; ++i) vr2[i] = *(const u32x4*)(Vb + (size_t)ix[32 * (b + 2) + 8 * i + vrow] * KVW + vch * 16);
        }
        asm volatile("s_waitcnt lgkmcnt(0)" ::: "memory");
#pragma unroll
        for (int dt = 0; dt < 8; ++dt) {
            const v2i32_t t8 = __builtin_amdgcn_ds_read_tr8_b64_v2i32((LAS v2i32_t*)(trb + dt * 16));
            const long Av = (long)(((unsigned long long)(unsigned)t8[1] << 32) | (unsigned)t8[0]);
            oacc[dt] = __builtin_amdgcn_mfma_f32_16x16x32_fp8_fp8(Av, pb8[b], oacc[dt], 0, 0, 0);
        }
        asm volatile("s_waitcnt lgkmcnt(0)" ::: "memory");
        __builtin_amdgcn_sched_barrier(0);
    }
    if (h < 4) {
#pragma unroll
        for (int dd = 0; dd < 4; ++dd) { const f32x4 o = oacc[dd] * rl; u32x2 w; w.x = pk2(o[0], o[1]); w.y = pk2(o[2], o[3]); __builtin_nontemporal_store(w, (u32x2*)(YC + qrow * D + 512 + h * 64 + dd * 16 + 4 * kq_b)); }
    } else if (h < 8) {
#pragma unroll
        for (int dd = 0; dd < 4; ++dd) { const f32x4 o = oacc[4 + dd] * rl; u32x2 w; w.x = pk2(o[0], o[1]); w.y = pk2(o[2], o[3]); __builtin_nontemporal_store(w, (u32x2*)(YC + qrow * D + 512 + h * 64 + dd * 16 + 4 * kq_b)); }
    }
}

__device__ __forceinline__ void phase3(const Params& p, Frame& F) {
    unsigned char* ws = p.ws;
    lru_phase<0>(p, F);
    __syncthreads();
    TIC(9);
    TOC(9);
    {
        const int half = F.wave >> 2, htid = F.tid & 255;
        LAS unsigned* hb = (LAS unsigned*)(F.lds + A_HBAR + half * 16); LAS int* tick = (LAS int*)(F.lds + A_TICK + half * 16);
        if (htid == 0) { hb[0] = 0u; hb[1] = 0u; }
        __syncthreads();
        unsigned* ctr = (unsigned*)(ws + WS_CTL) + CW_QUEUE;
        for (int q = 2 * F.bid + half;;) {
            if (q >= 2048 + DB) break;
            size_t q0row; int L; const bf16* KI;
            const bool is_s = q >= 1024 && q < 1024 + DB;
            if (!is_s) {
                const int u = q < 1024 ? q : q - DB, chunk = 127 - (u >> 4), b = (u & 15) >> 2, quarter = u & 3;
                q0row = (size_t)b * SEQ + chunk * 64 + quarter * 16; L = 64 * (chunk + 1);
                KI = (const bf16*)(ws + WS_KIB) + (size_t)b * SEQ * 64;
            } else {
                const int s = q - 1024;
                q0row = (size_t)MP + s * DT; L = SKEYS;
                KI = (const bf16*)(ws + WS_KIS) + (size_t)s * SKEYS * 64;
            }
            select_unit(p, F, q0row, L, KI);
            if (htid == 0) *tick = (int)(2 * F.G + __hip_atomic_fetch_add(ctr, 1u, __ATOMIC_RELAXED, __HIP_MEMORY_SCOPE_AGENT));
            half_barrier(hb, F.lane);
            q = *tick;
            half_barrier(hb, F.lane);
        }
    }
}

__device__ __forceinline__ void phase4(const Params& p, Frame& F) {
    unsigned char* ws = p.ws;
    if (F.wave < 4) {
        for (int u = F.bid * 4 + F.wave; u < 2048 + 64; u += F.G * 4) {
            if (u < 2048) lru_unit<1>(p, F, u >> 9, u & 7, (u >> 3) & 63);
            else lru_unit<1>(p, F, NB + ((u - 2048) >> 3), (u - 2048) & 7, 0);
        }
    }
    const bool aff = (F.G & 7) == 0;
    const int x = F.bid & 7, b = aff ? (x >> 1) : (F.bid & 3);
    const int nwv = aff ? (F.G >> 2) * 8 : ((F.G + 3 - (F.bid & 3)) / 4) * 8;
    const int wv = aff ? ((F.bid >> 3) * 2 + (x & 1)) * 8 + F.wave : (F.bid >> 2) * 8 + F.wave;
    unsigned* ctr = (unsigned*)(ws + WS_CTL) + CW_QUEUE + 64 * (1 + b);
    const fp8* Kb = (const fp8*)(ws + WS_KB) + (size_t)b * SEQ * KVW; const fp8* Vb = (const fp8*)(ws + WS_VB) + (size_t)b * SEQ * KVW;
    for (int q = wv;;) {
        if (q >= SEQ + 2 * DT) break;
        if (q < SEQ) attend_query(p, F, (size_t)b * SEQ + q, Kb, Vb);
        else { const int qs = q - SEQ, s = 2 * b + (qs >> 4);
            attend_query(p, F, (size_t)MP + s * DT + (qs & 15), (const fp8*)(ws + WS_KS) + (size_t)s * SKEYS * KVW, (const fp8*)(ws + WS_VS) + (size_t)s * SKEYS * KVW); }
        unsigned t = 0u;
        if (F.lane == 0) t = __hip_atomic_fetch_add(ctr, 1u, __ATOMIC_RELAXED, __HIP_MEMORY_SCOPE_AGENT);
        q = nwv + __builtin_amdgcn_readfirstlane((int)t);
    }
}

__global__ void __launch_bounds__(512, 2) fwd_kernel(Params p) {
    extern __shared__ __attribute__((aligned(16))) unsigned char lds_raw[];
    Frame F; F.lds = (LAS unsigned char*)lds_raw; F.tid = threadIdx.x; F.lane = F.tid & 63; F.wave = __builtin_amdgcn_readfirstlane(F.tid >> 6); F.G = gridDim.x; F.bid = blockIdx.x;
    unsigned char* ws = p.ws;
    const int lo = p.ph_lo, hi = p.ph_hi;
#if !USE_CG_SYNC
    if (F.tid < 64) ((LAS unsigned*)(F.lds + LDSCTL_OFF))[F.tid] = 0u;
    __syncthreads();
    XcdBarrier xbar = xcd_barrier_post((unsigned*)(ws + WS_CTL) + CW_BAR, (volatile LAS unsigned*)(F.lds + LDSCTL_OFF));
#endif
#define IN(k) (lo <= (k) && (k) < hi)
#ifndef SKIPMASK
#define SKIPMASK 0
#endif
#define SKIP(k) ((SKIPMASK >> (k)) & 1)
#define REPS(k) for (int rep_ = 0; rep_ <= DUP(k); ++rep_, (rep_ <= DUP(k) ? GSYNC() : (void)0))
#if USE_CG_SYNC
#define GSYNC() cg::this_grid().sync()
#else
#define GSYNC() xcd_barrier(xbar)
#endif
#define SEAM(k) do { if (IN(k) && IN((k) + 1)) { GSYNC(); } } while (0)
    { TIC(20); if (IN(0) && !SKIP(0)) REPS(0) phase0(p, F); TOC(20); }
    { TIC(40); SEAM(0); TOC(40); }
    if (IN(1) && !SKIP(1)) REPS(1) {
        pg8::Gemm g{(const pg8::bf16_t*)(ws + WS_XB), (const pg8::bf16_t*)(ws + WS_WIN), MP, NIN, D};
        pg8::StaticOrder S; S.init(MP, NIN, F.G, F.bid);
        EpiInProj E{(const float*)(ws + WS_RSTD), (const float*)(ws + WS_RCOS), (const float*)(ws + WS_RSIN), p.in[I_QN], p.in[I_KN],
                    (bf16*)(ws + WS_XR), (bf16*)(ws + WS_GG), (bf16*)(ws + WS_Q), (bf16*)(ws + WS_QI), (fp8*)(ws + WS_KB), (fp8*)(ws + WS_VB), (bf16*)(ws + WS_KIB),
                    (fp8*)(ws + WS_KS), (fp8*)(ws + WS_VS), (bf16*)(ws + WS_KIS), (float*)(ws + WS_WI), p.out};
        { TIC(21); pg8::gemm_phase<EpiInProj, pg8::StaticOrder, true, true>(F.lds, g, S, E); TOC(21); }
        TIC(31);
        {
            const float* rstd = E.rstd + MP; const float* rcos = E.rcos; const float* rsin = E.rsin; const float* gq = E.gq; const float* gk = E.gk; float* out = p.out;
            bf16* XR = E.XR + (size_t)MP * LW; bf16* GG = E.GG + (size_t)MP * LW; bf16* Q = E.Q + (size_t)MP * 512; bf16* QI = E.QI + (size_t)MP * 512;
            fp8* KS = E.KS; fp8* VS = E.VS; bf16* KIS = E.KIS; float* WI = E.WI + (size_t)MP * 8;
            skinny_gemm<4, 4>(F, (const bf16*)(ws + WS_XB) + (size_t)MP * D, D, (const bf16*)(ws + WS_WIN), D, 38,
                [](int hb_, int nb, int r) { const int c = 64 * hb_ + 16 * nb + r, pn = c >> 8, wc = (c >> 6) & 3, bj = (c >> 5) & 1, w32 = c & 31, fq = w32 >> 3, n = (w32 >> 2) & 1, j = w32 & 3;
                                             return 256 * pn + 128 * bj + 32 * wc + 16 * n + 4 * fq + j; },
                [=](const f32x4 (&acc)[4], int r, int c0, int kq) {
                    const int hbk = c0 >> 4, sb = r >> 4, t = r & 15, pos = PAST + t;
                    const float rsd = rstd[r];
                    f32x4 v[4];
#pragma unroll
                    for (int nb = 0; nb < 4; ++nb) v[nb] = acc[nb] * rsd;
                    const bool norm = (hbk >= 16 && hbk < 26), rope = norm || (hbk >= 28 && hbk < 37);
                    if (norm) {
                        float ss = 0.f;
#pragma unroll
                        for (int nb = 0; nb < 4; ++nb) ss += (v[nb][0] * v[nb][0] + v[nb][1] * v[nb][1]) + (v[nb][2] * v[nb][2] + v[nb][3] * v[nb][3]);
                        ss += __shfl_xor(ss, 16); ss += __shfl_xor(ss, 32);
                        const float inv = rsqrtf(ss * (1.0f / 64.0f) + EPS); const float* g = hbk < 24 ? gq : gk;
#pragma unroll
                        for (int nb = 0; nb < 4; ++nb) v[nb] = v[nb] * inv * *(const f32x4*)(g + 16 * nb + 4 * kq);
                    }
                    if (rope) {
#pragma unroll
                        for (int nb = 0; nb < 2; ++nb) {
                            const f32x4 c4 = *(const f32x4*)(rcos + pos * 32 + 16 * nb + 4 * kq), s4 = *(const f32x4*)(rsin + pos * 32 + 16 * nb + 4 * kq);
                            const f32x4 x1 = v[nb], x2 = v[nb + 2];
                            v[nb] = x1 * c4 - x2 * s4; v[nb + 2] = x2 * c4 + x1 * s4;
                        }
                    }
#pragma unroll
                    for (int nb = 0; nb < 4; ++nb) {
                        const int d = 16 * nb + 4 * kq; const f32x4 x = v[nb];
                        u32x2 wb; wb.x = pg8::cvt_pk_bf16(x[0], x[1]); wb.y = pg8::cvt_pk_bf16(x[2], x[3]);
                        if (hbk < 8) {
                            const int c = 64 * hbk + d; *(u32x2*)(XR + (size_t)r * LW + c) = wb;
                            if (t >= DT - 3) *(f32x4*)(out + O_CS + ((size_t)(sb * 3 + (t - (DT - 3)))) * LW + c) = x;
                        } else if (hbk < 16) {
                            f32x4 gl; gl[0] = gelu_tanh(x[0]); gl[1] = gelu_tanh(x[1]); gl[2] = gelu_tanh(x[2]); gl[3] = gelu_tanh(x[3]);
                            u32x2 wg; wg.x = pg8::cvt_pk_bf16(gl[0], gl[1]); wg.y = pg8::cvt_pk_bf16(gl[2], gl[3]);
                            *(u32x2*)(GG + (size_t)r * LW + 64 * (hbk - 8) + d) = wg;
                        } else if (hbk < 24) { *(u32x2*)(Q + (size_t)r * 512 + 64 * (hbk - 16) + d) = wb;
                        } else if (hbk < 28) {
                            const int kvh = hbk & 1; const bool isk = hbk < 26;
                            *(f32x4*)(out + (isk ? O_KS : O_VS) + (size_t)r * KVW + kvh * 64 + d) = x;
                            *(unsigned*)((isk ? KS : VS) + ((size_t)sb * SKEYS + PAST + t) * KVW + kvh * 64 + d) = pk4_fp8(x[0], x[1], x[2], x[3]);
                        } else if (hbk < 36) { *(u32x2*)(QI + (size_t)r * 512 + 64 * (hbk - 28) + d) = wb;
                        } else if (hbk == 36) {
                            *(f32x4*)(out + O_KIS + (size_t)r * 64 + d) = x;
                            *(u32x2*)(KIS + ((size_t)sb * SKEYS + PAST + t) * 64 + d) = wb;
                        } else if (d < 8) { *(f32x4*)(WI + (size_t)r * 8 + d) = x * WI_SCALE; }
                    }
                });
        }
        TOC(31);
    }
    { TIC(41); SEAM(1); TOC(41); }
    { TIC(23); if (IN(2) && !SKIP(2)) REPS(2) phase3(p, F); TOC(23); }
    { TIC(43); SEAM(2); TOC(43); }
    { TIC(24); if (IN(3) && !SKIP(3)) REPS(3) phase4(p, F); TOC(24); }
    { TIC(44); SEAM(3); TOC(44); }
    if (IN(4) && !SKIP(4)) REPS(4) {
        pg8::Gemm g{(const pg8::bf16_t*)(ws + WS_YC), (const pg8::bf16_t*)(ws + WS_WOUT), MP, D, D};
        pg8::StaticOrder S; S.init(MP, D, F.G, F.bid);
        EpiOutProj E{p.in[I_XP], p.in[I_XS], p.out, (bf16*)(ws + WS_XB), (rep_ < DUP(4)) ? (float*)(ws + WS_CTL + 65536) : (float*)(ws + WS_SSQ)};
        { TIC(25); pg8::gemm_phase<EpiOutProj, pg8::StaticOrder, true, true>(F.lds, g, S, E); TOC(25); }
        TIC(35);
        {
            const float* xs = p.in[I_XS]; float* ys = p.out + O_YS; bf16* XB2 = (bf16*)(ws + WS_XB) + (size_t)MP * D; float* ssq = E.ssq + MP;
            skinny_gemm<1, 4>(F, (const bf16*)(ws + WS_YC) + (size_t)MP * D, D, (const bf16*)(ws + WS_WOUT), D, D / 16,
                [](int ct, int, int r) { return 16 * ct + r; },
                [=](const f32x4 (&acc)[1], int r, int c0, int) {
                    const f32x4 y = *(const f32x4*)(xs + (size_t)r * D + c0) + acc[0];
                    *(f32x4*)(ys + (size_t)r * D + c0) = y;
                    u32x2 w; w.x = pg8::cvt_pk_bf16(y[0], y[1]); w.y = pg8::cvt_pk_bf16(y[2], y[3]); *(u32x2*)(XB2 + (size_t)r * D + c0) = w;
                    float ss = (y[0] * y[0] + y[1] * y[1]) + (y[2] * y[2] + y[3] * y[3]);
                    ss += __shfl_xor(ss, 16); ss += __shfl_xor(ss, 32);
                    if ((threadIdx.x & 48) == 0) atomicAdd(ssq + r, ss);
                });
        }
        TOC(35);
    }
    { TIC(45); SEAM(4); TOC(45); }
    if (IN(5) && !SKIP(5)) REPS(5) {
        pg8::Gemm g{(const pg8::bf16_t*)(ws + WS_XB), (const pg8::bf16_t*)(ws + WS_WFI), MP, 2 * DFF, D};
        pg8::StaticOrder S; S.init(MP, 2 * DFF, F.G, F.bid);
        EpiFfnIn E{(const float*)(ws + WS_SSQ), (bf16*)(ws + WS_H)};
        { TIC(26); pg8::gemm_phase<EpiFfnIn, pg8::StaticOrder, true, true>(F.lds, g, S, E); TOC(26); }
        TIC(36);
        {
            const float* ssq = (const float*)(ws + WS_SSQ) + MP; bf16* H = (bf16*)(ws + WS_H) + (size_t)MP * DFF;
            skinny_gemm<2, 4>(F, (const bf16*)(ws + WS_XB) + (size_t)MP * D, D, (const bf16*)(ws + WS_WFI), D, DFF / 16,
                [](int ct, int nb, int r) { const int c = 16 * ct + r, pn = c >> 7, wc = (c >> 5) & 3, w32 = c & 31, fq = w32 >> 3, n = (w32 >> 2) & 1, j = w32 & 3; return 256 * pn + 128 * nb + 32 * wc + 16 * n + 4 * fq + j; },
                [=](const f32x4 (&acc)[2], int r, int c0, int) {
                    const float rs2 = rsqrtf(ssq[r] * (1.0f / 1024.0f) + EPS);
                    const f32x4 g = acc[0] * rs2, up = acc[1] * rs2; f32x4 h;
#pragma unroll
                    for (int j = 0; j < 4; ++j) h[j] = g[j] * sigmoidf_(g[j]) * up[j];
                    u32x2 w; w.x = pg8::cvt_pk_bf16(h[0], h[1]); w.y = pg8::cvt_pk_bf16(h[2], h[3]); *(u32x2*)(H + (size_t)r * DFF + c0) = w;
                });
        }
        TOC(36);
    }
    { TIC(46); SEAM(5); TOC(46); }
    if (IN(6) && !SKIP(6)) {
        pg8::Gemm g{(const pg8::bf16_t*)(ws + WS_H), (const pg8::bf16_t*)(ws + WS_WFO), MP, D, DFF};
        pg8::StaticOrder S; S.init(MP, D, F.G, F.bid);
        EpiFfnOut E{p.out, (const bf16*)(ws + WS_XB)};
        { TIC(27); pg8::gemm_phase<EpiFfnOut, pg8::StaticOrder, true, true>(F.lds, g, S, E); TOC(27); }
        TIC(37);
        {
            float* ys = p.out + O_YS;
            skinny_gemm<1, 11>(F, (const bf16*)(ws + WS_H) + (size_t)MP * DFF, DFF, (const bf16*)(ws + WS_WFO), DFF, D / 16,
                [](int ct, int, int r) { return 16 * ct + r; },
                [=](const f32x4 (&acc)[1], int r, int c0, int) { float* y = ys + (size_t)r * D + c0; *(f32x4*)y = *(const f32x4*)y + acc[0]; });
        }
        TOC(37);
    }
    if (TSEG && F.bid == 0 && F.tid == 0) { const unsigned acc_ = *(LAS unsigned*)(F.lds + LDSCTL_OFF + 128); const unsigned long long t0_ = __builtin_amdgcn_s_memrealtime(); while ((unsigned)(__builtin_amdgcn_s_memrealtime() - t0_) < acc_) __builtin_amdgcn_s_sleep(8); }
#undef IN
#undef SEAM
}

#ifndef N_LAUNCHES
#define N_LAUNCHES 1
#endif
constexpr int NPHASE = 7;
extern "C" void kernel_launch(void* const* d_in, const int* in_sizes, int n_in, void* d_out, int out_size, void* d_ws, size_t ws_size, hipStream_t stream) {
    static int grid = 0;
    if (grid == 0) {
        if (n_in != 22 || out_size != (int)O_END || ws_size < WS_END) { fprintf(stderr, "kernel_launch: unexpected shapes: n_in %d out %d ws %zu (need %zu)\n", n_in, out_size, ws_size, (size_t)WS_END); grid = -1; return; }
        int dev = 0, cus = 0, per_cu = 0;
        if (hipGetDevice(&dev) != hipSuccess || hipDeviceGetAttribute(&cus, hipDeviceAttributeMultiprocessorCount, dev) != hipSuccess) { grid = -1; return; }
        if (hipFuncSetAttribute((const void*)fwd_kernel, hipFuncAttributeMaxDynamicSharedMemorySize, LDS_BYTES) != hipSuccess) { fprintf(stderr, "kernel_launch: hipFuncSetAttribute failed\n"); grid = -1; return; }
        if (hipOccupancyMaxActiveBlocksPerMultiprocessor(&per_cu, (const void*)fwd_kernel, 512, LDS_BYTES) != hipSuccess || per_cu < 1) { fprintf(stderr, "kernel_launch: occupancy query says %d blocks/CU\n", per_cu); per_cu = 1; }
        (void)hipGetLastError();
        grid = cus;
    }
    if (grid < 0) return;
    if (!USE_CG_SYNC) { if (hipMemsetAsync((char*)d_ws + WS_CTL, 0, 65536, stream) != hipSuccess) { fprintf(stderr, "kernel_launch: memset failed\n"); return; } }
    Params p{};
    for (int i = 0; i < 22; ++i) p.in[i] = (const float*)d_in[i];
    p.out = (float*)d_out; p.ws = (unsigned char*)d_ws;
    for (int i = 0; i < 32; ++i) p.invf[i] = pow(10000.0, -(double)i / 32.0);
    if (N_LAUNCHES == 1) {
        p.ph_lo = 0; p.ph_hi = NPHASE;
        void* args[] = {&p};
        hipError_t e = hipLaunchCooperativeKernel((const void*)fwd_kernel, dim3(grid), dim3(512), args, LDS_BYTES, stream);
        if (e != hipSuccess) fprintf(stderr, "kernel_launch: cooperative launch failed: %s (grid %d)\n", hipGetErrorString(e), grid);
    } else {
        for (int k = 0; k < NPHASE; ++k) { p.ph_lo = k; p.ph_hi = k + 1; hipLaunchKernelGGL(fwd_kernel, dim3(grid), dim3(512), LDS_BYTES, stream, p); }
    }
}
```

```cpp
#include <hip/hip_runtime.h>
#include <hip/hip_cooperative_groups.h>
#include <cstdio>
#include <cstdint>
#include <cmath>
namespace cg = cooperative_groups;
namespace pg8 {
#define PG8_LAS __attribute__((address_space(3)))
typedef unsigned short bf16_t;
typedef short bf16x8 __attribute__((ext_vector_type(8)));
typedef float f32x4 __attribute__((ext_vector_type(4)));
typedef unsigned u32x4 __attribute__((ext_vector_type(4)));
constexpr int BM = 256, BK = 64, HALF = 128, HTB = HALF * BK * 2  , STAGE_BYTES = 8 * HTB, NXCD = 8, WGM = 8;

__host__ __device__ __forceinline__ int lds_byte(int r, int c) { const int st = (r >> 4) * 2 + (c >> 5), rr = r & 15, cc = c & 31, ob = rr * 64 + cc * 2; return st * 1024 + (ob ^ (((ob >> 9) & 1) << 5)); }
__host__ __device__ __forceinline__ void stage_rc(int b, int& R, int& C) { const int st = b / 1024, sb = b % 1024, swz = sb ^ (((sb >> 9) & 1) << 5); R = (st >> 1) * 16 + swz / 64; C = (st & 1) * 32 + (swz % 64) / 2; }
__host__ __device__ __forceinline__ int perm32(int rho) { const int n = rho >> 4, i = rho & 15; return 8 * (i >> 2) + 4 * n + (i & 3); }

struct Unit { int pm, pn; };
struct Gemm { const bf16_t* A; const bf16_t* Bt; int M, N, K; };

struct StaticOrder {
    int nM, nN, nwg, G, c;
    __host__ __device__ void init(int M, int N, int G_, int c_) { nM = M / BM; nN = N / BM; nwg = nM * nN; G = G_; c = c_; }
    __host__ __device__ bool next(int i, Unit& u) const {
        const long L = (long)i * G + c; if (L >= nwg) return false;
        int wgid = (int)L; { const int q = nwg / NXCD, r = nwg % NXCD, xcd = wgid % NXCD, off = wgid / NXCD; wgid = (xcd < r ? xcd * (q + 1) : r * (q + 1) + (xcd - r) * q) + off; }
        const int nig = WGM * nN, gid = wgid / nig, fm = gid * WGM, gsz = (nM - fm) < WGM ? (nM - fm) : WGM;
        u.pm = fm + ((wgid % nig) % gsz); u.pn = (wgid % nig) / gsz; return true;
    }
    __device__ __forceinline__ void a_ready(const Unit&) const {}
    __device__ __forceinline__ void done(const Unit&) const {}
};
__device__ __forceinline__ unsigned cvt_pk_bf16(float lo, float hi) { unsigned r; asm volatile("v_cvt_pk_bf16_f32 %0, %1, %2" : "=v"(r) : "v"(lo), "v"(hi)); return r; }
template <class Epi, class Sched, bool ALIGN_EPI = false, bool SP2 = false>
__device__ __forceinline__ void gemm_phase(PG8_LAS unsigned char* lds, const Gemm g, const Sched& S, const Epi& E) {
    const int tid = threadIdx.x, wid = __builtin_amdgcn_readfirstlane(tid >> 6), lane = tid & 63, wr = wid >> 2, wc = wid & 3, fr = lane & 15, fq = lane >> 4;
    const int K = g.K, nt = K / BK;
    unsigned voffA[2], voffB[2];
#pragma unroll
    for (int i = 0; i < 2; ++i) { int R, C; stage_rc(tid * 16 + i * 8192, R, C); const int Rb = Epi::PERM ? ((R & ~31) + perm32(R & 31)) : R;
        voffA[i] = (unsigned)(R * K + C) * 2u; voffB[i] = (unsigned)(Rb * K + C) * 2u; }
    const size_t kstep = (size_t)(BK * 2);
    const size_t hstep = (size_t)HALF * K * 2;
    const size_t tstep = 2 * hstep;
    const unsigned ldsw = (unsigned)wid * 1024u;
    const int aoff = lds_byte(wr * 64 + fr, fq * 8), boff = lds_byte(wc * 32 + fr, fq * 8);
#define PG8_SA(b, h) (((b) * 2 + (h)) * HTB)
#define PG8_SB(b, h) ((4 + (b) * 2 + (h)) * HTB)
#define PG8_STAGE(bufoff, gbase, voff) do { _Pragma("unroll") for (int _i = 0; _i < 2; ++_i) \
        __builtin_amdgcn_global_load_lds((const unsigned*)((const char*)(gbase) + (voff)[_i]), (PG8_LAS unsigned*)(lds + (bufoff) + ldsw + _i * 8192), 16, 0, 0); } while (0)
#define PG8_LDA(dst, b, h) do { _Pragma("unroll") for (int m = 0; m < 4; ++m) _Pragma("unroll") for (int k = 0; k < 2; ++k) dst[m][k] = *(const PG8_LAS bf16x8*)(lds + PG8_SA(b, h) + aoff + m * 2048 + k * 1024); } while (0)
#define PG8_LDB(dst, b, h) do { _Pragma("unroll") for (int n = 0; n < 2; ++n) _Pragma("unroll") for (int k = 0; k < 2; ++k) dst[n][k] = *(const PG8_LAS bf16x8*)(lds + PG8_SB(b, h) + boff + n * 2048 + k * 1024); } while (0)
#define PG8_MMA(ai, bj, At, Bt) do { __builtin_amdgcn_s_setprio(1); _Pragma("unroll") for (int m = 0; m < 4; ++m) _Pragma("unroll") for (int n = 0; n < 2; ++n) _Pragma("unroll") for (int k = 0; k < 2; ++k) \
        acc[ai][bj][m][n] = __builtin_amdgcn_mfma_f32_16x16x32_bf16(Bt[n][k], At[m][k], acc[ai][bj][m][n], 0, 0, 0); __builtin_amdgcn_s_setprio(0); } while (0)
#define PG8_WAIT_V(n) asm volatile("s_waitcnt vmcnt(" #n ")" ::: "memory")
#define PG8_WAIT_L(n) asm volatile("s_waitcnt lgkmcnt(" #n ")" ::: "memory")
#define PG8_BAR __builtin_amdgcn_s_barrier()
#define PG8_SCHED __builtin_amdgcn_sched_barrier(0)
    Unit cur, nxt; int ui = 0;
    if (!S.next(0, cur)) return;
    f32x4 acc[2][2][4][2];
#pragma unroll
    for (int a = 0; a < 2; ++a)
#pragma unroll
        for (int b = 0; b < 2; ++b)
#pragma unroll
            for (int m = 0; m < 4; ++m)
#pragma unroll
                for (int n = 0; n < 2; ++n) acc[a][b][m][n] = (f32x4){0.f, 0.f, 0.f, 0.f};
    bf16x8 At[4][2], B0[2][2], B1[2][2];
    const char* cA = (const char*)g.A + (size_t)cur.pm * tstep; const char* cB = (const char*)g.Bt + (size_t)cur.pn * tstep;
    S.a_ready(cur);
    if constexpr (SP2) {
        PG8_STAGE(PG8_SB(0, 0), cB, voffB); PG8_STAGE(PG8_SB(0, 1), cB + hstep, voffB); PG8_STAGE(PG8_SA(0, 0), cA, voffA); PG8_STAGE(PG8_SA(0, 1), cA + hstep, voffA);
        if (wr == 1) PG8_BAR;
        PG8_WAIT_V(2); PG8_BAR;
        PG8_STAGE(PG8_SB(1, 0), cB + kstep, voffB); PG8_STAGE(PG8_SA(1, 0), cA + kstep, voffA); PG8_STAGE(PG8_SB(1, 1), cB + hstep + kstep, voffB);
        PG8_WAIT_V(6); PG8_BAR;
    } else {
        PG8_STAGE(PG8_SB(0, 0), cB, voffB); PG8_STAGE(PG8_SA(0, 0), cA, voffA); PG8_STAGE(PG8_SB(0, 1), cB + hstep, voffB); PG8_STAGE(PG8_SA(0, 1), cA + hstep, voffA);
        if (wr == 1) PG8_BAR;
        PG8_WAIT_V(4); PG8_BAR;
        PG8_STAGE(PG8_SB(1, 0), cB + kstep, voffB); PG8_STAGE(PG8_SA(1, 0), cA + kstep, voffA); PG8_STAGE(PG8_SB(1, 1), cB + hstep + kstep, voffB);
        PG8_WAIT_V(6); PG8_BAR;
    }
    for (;;) {
        const bool has_next = S.next(ui + 1, nxt);
        const char* nA = has_next ? (const char*)g.A + (size_t)nxt.pm * tstep : cA; const char* nB = has_next ? (const char*)g.Bt + (size_t)nxt.pn * tstep : cB;
        for (int t = 0; t < nt; t += 2) {
            const bool last = (t == nt - 2);
            const char* a1 = cA + (size_t)(t + 1) * kstep;
            const char* a2 = last ? nA : cA + (size_t)(t + 2) * kstep; const char* b2 = last ? nB : cB + (size_t)(t + 2) * kstep;
            const char* a3 = a2 + kstep; const char* b3 = b2 + kstep;
            if (last && has_next) S.a_ready(nxt);
            if constexpr (SP2) {
            PG8_LDB(B0, 0, 0); PG8_LDB(B1, 0, 1); PG8_SCHED; PG8_LDA(At, 0, 0); PG8_STAGE(PG8_SA(1, 1), a1 + hstep, voffA);
            PG8_WAIT_V(8); PG8_WAIT_L(0); PG8_BAR; PG8_MMA(0, 0, At, B0); PG8_MMA(0, 1, At, B1); PG8_BAR; PG8_SCHED;
            PG8_LDA(At, 0, 1); PG8_STAGE(PG8_SB(0, 0), b2, voffB); PG8_STAGE(PG8_SB(0, 1), b2 + hstep, voffB); PG8_STAGE(PG8_SA(0, 0), a2, voffA);
            PG8_WAIT_V(8); PG8_WAIT_L(0); PG8_BAR; PG8_MMA(1, 0, At, B0); PG8_MMA(1, 1, At, B1); PG8_BAR; PG8_SCHED;
            PG8_LDB(B0, 1, 0); PG8_LDB(B1, 1, 1); PG8_SCHED; PG8_LDA(At, 1, 0); PG8_STAGE(PG8_SA(0, 1), a2 + hstep, voffA);
            PG8_WAIT_V(8); PG8_WAIT_L(0); PG8_BAR; PG8_MMA(0, 0, At, B0); PG8_MMA(0, 1, At, B1); PG8_BAR; PG8_SCHED;
            PG8_LDA(At, 1, 1); PG8_STAGE(PG8_SB(1, 0), b3, voffB); PG8_STAGE(PG8_SB(1, 1), b3 + hstep, voffB); PG8_STAGE(PG8_SA(1, 0), a3, voffA);
            PG8_WAIT_V(8); PG8_WAIT_L(0); PG8_BAR; PG8_MMA(1, 0, At, B0); PG8_MMA(1, 1, At, B1); PG8_BAR; PG8_SCHED;
            } else {
            PG8_LDB(B0, 0, 0); PG8_SCHED; PG8_LDA(At, 0, 0); PG8_STAGE(PG8_SA(1, 1), a1 + hstep, voffA);
            PG8_WAIT_L(8); PG8_BAR; PG8_WAIT_L(0); PG8_MMA(0, 0, At, B0); PG8_BAR; PG8_SCHED;
            PG8_LDB(B1, 0, 1); PG8_STAGE(PG8_SB(0, 0), b2, voffB);
            PG8_BAR; PG8_WAIT_L(0); PG8_MMA(0, 1, At, B1); PG8_BAR;
            PG8_LDA(At, 0, 1); PG8_STAGE(PG8_SA(0, 0), a2, voffA);
            PG8_BAR; PG8_WAIT_L(0); PG8_MMA(1, 0, At, B0); PG8_BAR; PG8_SCHED;
            PG8_STAGE(PG8_SB(0, 1), b2 + hstep, voffB);
            PG8_WAIT_V(6); PG8_BAR; PG8_MMA(1, 1, At, B1); PG8_BAR;
            PG8_LDB(B0, 1, 0); PG8_SCHED; PG8_LDA(At, 1, 0); PG8_STAGE(PG8_SA(0, 1), a2 + hstep, voffA);
            PG8_WAIT_L(8); PG8_BAR; PG8_WAIT_L(0); PG8_MMA(0, 0, At, B0); PG8_BAR; PG8_SCHED;
            PG8_LDB(B1, 1, 1); PG8_STAGE(PG8_SB(1, 0), b3, voffB);
            PG8_BAR; PG8_WAIT_L(0); PG8_MMA(0, 1, At, B1); PG8_BAR;
            PG8_LDA(At, 1, 1); PG8_STAGE(PG8_SA(1, 0), a3, voffA);
            PG8_BAR; PG8_WAIT_L(0); PG8_MMA(1, 0, At, B0); PG8_BAR; PG8_SCHED;
            PG8_STAGE(PG8_SB(1, 1), b3 + hstep, voffB);
            PG8_WAIT_V(6); PG8_BAR; PG8_MMA(1, 1, At, B1); PG8_BAR;
            }
        }
        if constexpr (ALIGN_EPI) { if (wr == 0) PG8_BAR; }
        if constexpr (!Epi::AFTER_DRAIN) { E(acc, cur, wr, wc, fr, fq); S.done(cur); }
        if (!has_next) break;
#pragma unroll
        for (int a = 0; a < 2; ++a)
#pragma unroll
            for (int b = 0; b < 2; ++b)
#pragma unroll
                for (int m = 0; m < 4; ++m)
#pragma unroll
                    for (int n = 0; n < 2; ++n) acc[a][b][m][n] = (f32x4){0.f, 0.f, 0.f, 0.f};
        cur = nxt; cA = nA; cB = nB; ++ui;
        if constexpr (ALIGN_EPI) { if (wr == 1) PG8_BAR; }
    }
    PG8_WAIT_V(0);
    if constexpr (!ALIGN_EPI) { if (wr == 0) PG8_BAR; }
    PG8_BAR;
    if constexpr (Epi::AFTER_DRAIN) { E.fused(acc, cur, wr, wc, fr, fq, lds, wid, lane); S.done(cur); }
#undef PG8_SA
#undef PG8_SB
#undef PG8_STAGE
#undef PG8_LDA
#undef PG8_LDB
#undef PG8_MMA
#undef PG8_WAIT_V
#undef PG8_WAIT_L
#undef PG8_BAR
#undef PG8_SCHED
}
}

constexpr int D = 1024, NB = 4, SEQ = 8192, DB = 8, DT = 16, PAST = 4096;
constexpr int MP = NB * SEQ;
constexpr int MS = DB * DT;
constexpr int MR = MP + MS;
constexpr int M = 33024;
constexpr int LW = 512, NLB = 8, LBW = 64;
constexpr int KVW = 128;
constexpr int DIN = 2376, NIN = 2560;
constexpr int DFF = 2816;
constexpr int SKEYS = PAST + DT;
constexpr float EPS = 1e-6f;
constexpr float WI_SCALE = 0.044194173824159216f;

constexpr size_t O_YP = 0;
constexpr size_t O_YS = O_YP + (size_t)MP * D;
constexpr size_t O_KP = O_YS + (size_t)MS * D;
constexpr size_t O_VP = O_KP + (size_t)MP * KVW;
constexpr size_t O_KIP = O_VP + (size_t)MP * KVW;
constexpr size_t O_HP = O_KIP + (size_t)MP * 64;
constexpr size_t O_CP = O_HP + (size_t)NB * LW;
constexpr size_t O_KS = O_CP + (size_t)NB * 3 * LW;
constexpr size_t O_VS = O_KS + (size_t)MS * KVW;
constexpr size_t O_KIS = O_VS + (size_t)MS * KVW;
constexpr size_t O_HS = O_KIS + (size_t)MS * 64;
constexpr size_t O_CS = O_HS + (size_t)DB * LW;
constexpr size_t O_END = O_CS + (size_t)DB * 3 * LW;
static_assert(O_END == 44236800, "output size");

constexpr size_t al256(size_t x) { return (x + 255) & ~(size_t)255; }
constexpr size_t WS_CTL = 0, CTL_BYTES = 1u << 20;
constexpr size_t WS_WIN = WS_CTL + CTL_BYTES;
constexpr size_t WS_WOUT = WS_WIN + al256((size_t)NIN * D * 2);
constexpr size_t WS_WFI = WS_WOUT + al256((size_t)D * D * 2);
constexpr size_t WS_WFO = WS_WFI + al256((size_t)2 * DFF * D * 2);
constexpr size_t WS_WG = WS_WFO + al256((size_t)D * DFF * 2);
constexpr size_t WS_RCOS = WS_WG + al256((size_t)2 * 8 * 64 * 64 * 2);
constexpr size_t WS_RSIN = WS_RCOS + al256((size_t)8192 * 32 * 4);
constexpr size_t WS_SP = WS_RSIN + al256((size_t)8192 * 32 * 4);
constexpr size_t WS_RSTD = WS_SP + al256(512 * 4);
constexpr size_t WS_SSQ = WS_RSTD + al256((size_t)M * 4);
constexpr size_t WS_WI = WS_SSQ + al256((size_t)M * 4);
constexpr size_t WS_AGG = WS_WI + al256((size_t)M * 8 * 4);
constexpr size_t WS_XB = WS_AGG + al256((size_t)12 * 64 * 512 * 8);
constexpr size_t WS_YC = WS_XB + al256((size_t)M * D * 2);
constexpr size_t WS_KB = WS_YC + al256((size_t)M * D * 2);
constexpr size_t WS_VB = WS_KB + al256((size_t)MP * KVW * 2);
constexpr size_t WS_KIB = WS_VB + al256((size_t)MP * KVW * 2);
constexpr size_t WS_KS = WS_KIB + al256((size_t)MP * 64 * 2);
constexpr size_t WS_VS = WS_KS + al256((size_t)DB * SKEYS * KVW * 2);
constexpr size_t WS_KIS = WS_VS + al256((size_t)DB * SKEYS * KVW * 2);
constexpr size_t WS_R1 = WS_KIS + al256((size_t)DB * SKEYS * 64 * 2);
constexpr size_t WS_XR = WS_R1;
constexpr size_t WS_GG = WS_XR + al256((size_t)M * LW * 2);
constexpr size_t WS_Q = WS_GG + al256((size_t)M * LW * 2);
constexpr size_t WS_QI = WS_Q + al256((size_t)M * LW * 2);
constexpr size_t WS_ACUM = WS_QI + al256((size_t)M * LW * 2);
constexpr size_t WS_BCUM = WS_ACUM + al256((size_t)M * LW * 4);
constexpr size_t WS_R1_END = WS_BCUM + al256((size_t)M * LW * 4);
constexpr size_t WS_H = WS_R1;
static_assert(WS_H + (size_t)M * DFF * 2 <= WS_R1_END, "H overlay fits");
constexpr size_t WS_CANDG = WS_ACUM;
static_assert(WS_CANDG + (size_t)M * 1024 * 4 <= WS_R1_END, "candidate lists fit");
constexpr size_t WS_SEL = WS_R1_END;
constexpr size_t WS_NSEL = WS_SEL + al256((size_t)M * 256 * 2);
constexpr size_t WS_END = WS_NSEL + al256((size_t)M * 4);

#ifndef DUPMASK
#define DUPMASK 0
#endif
#define DUP(k) ((DUPMASK >> (k)) & 1)
#ifndef USE_CG_SYNC
#define USE_CG_SYNC 0
#endif
constexpr int CW_QUEUE = 2048;
constexpr int CW_BAR = 4096;
constexpr int LDSCTL_OFF = 131072 + 1024;
#ifndef FORCE_FALLBACK
#define FORCE_FALLBACK 0
#endif
#ifndef FORCE_SAFE_MODE
#define FORCE_SAFE_MODE 0
#endif
#ifndef TSEG
#define TSEG 0
#endif
#define TIC(id) unsigned long long tic_##id = (TSEG == (id)) ? __builtin_amdgcn_s_memrealtime() : 0ull
#define TOC(id) do { if (TSEG == (id) && F.bid == 0 && F.wave == 0) { const unsigned d_ = (unsigned)(__builtin_amdgcn_s_memrealtime() - tic_##id); if (F.lane == 0) { LAS unsigned* a_ = (LAS unsigned*)(F.lds + LDSCTL_OFF + 128); *a_ += d_; } } } while (0)
constexpr int LDS_BYTES = 147456;

#define LAS __attribute__((address_space(3)))
typedef unsigned short bf16;
typedef float f32x4 __attribute__((ext_vector_type(4)));
typedef float f32x2 __attribute__((ext_vector_type(2)));
typedef unsigned u32x4 __attribute__((ext_vector_type(4)));
typedef unsigned u32x2 __attribute__((ext_vector_type(2)));
typedef short bf16x8 __attribute__((ext_vector_type(8)));

__device__ __forceinline__ unsigned pk2(float lo, float hi) { unsigned r; asm("v_cvt_pk_bf16_f32 %0, %1, %2" : "=v"(r) : "v"(lo), "v"(hi)); return r; }
__device__ __forceinline__ unsigned f2bf(float f) { return pk2(f, 0.f) & 0xffffu; }
__device__ __forceinline__ float bf2f(unsigned b) { return __builtin_bit_cast(float, b << 16); }
__device__ __forceinline__ float bflo(unsigned w) { return __builtin_bit_cast(float, w << 16); }
__device__ __forceinline__ float bfhi(unsigned w) { return __builtin_bit_cast(float, w & 0xffff0000u); }
__device__ __forceinline__ void store_bf16x8(bf16* p, f32x4 lo, f32x4 hi) {
    u32x4 w; w.x = pg8::cvt_pk_bf16(lo[0], lo[1]); w.y = pg8::cvt_pk_bf16(lo[2], lo[3]); w.z = pg8::cvt_pk_bf16(hi[0], hi[1]); w.w = pg8::cvt_pk_bf16(hi[2], hi[3]);
    *(u32x4*)p = w;
}
typedef unsigned char fp8;
__device__ __forceinline__ unsigned pk4_fp8(float a, float b, float c, float d) { int w = __builtin_amdgcn_cvt_pk_fp8_f32(a, b, 0, false); w = __builtin_amdgcn_cvt_pk_fp8_f32(c, d, w, true); return (unsigned)w; }
__device__ __forceinline__ void store_fp8x8(fp8* p, f32x4 lo, f32x4 hi) { u32x2 w; w.x = pk4_fp8(lo[0], lo[1], lo[2], lo[3]); w.y = pk4_fp8(hi[0], hi[1], hi[2], hi[3]); *(u32x2*)p = w; }
__device__ __forceinline__ u32x2 fp8x4_bf16x4(unsigned w) {
    const f32x2 a = __builtin_amdgcn_cvt_pk_f32_fp8((int)w, false); const f32x2 b = __builtin_amdgcn_cvt_pk_f32_fp8((int)w, true);
    const float a0 = a.x, a1 = a.y, b0 = b.x, b1 = b.y;
    u32x2 o; o.x = __builtin_amdgcn_perm(__float_as_uint(a1), __float_as_uint(a0), 0x07060302u); o.y = __builtin_amdgcn_perm(__float_as_uint(b1), __float_as_uint(b0), 0x07060302u);
    return o;
}
__device__ __forceinline__ float gelu_tanh(float x) {
    const float u = 0.7978845608028654f * (x + 0.044715f * x * x * x);
    const float e = __expf(2.0f * u);
    const float th = 1.0f - 2.0f * __builtin_amdgcn_rcpf(e + 1.0f);
    return 0.5f * x * (1.0f + th);
}
__device__ __forceinline__ float sigmoidf_(float x) { return __builtin_amdgcn_rcpf(1.0f + __expf(-x)); }

#define XB_TMO      128
#define XB_XCNT(j)  (256  + 64 * (j))
#define XB_XSUB(j)  (1280 + 64 * (j))
#define XB_XGEN(j)  (2304 + 64 * (j))
#define XB_TOP      3328
#define XB_TOPGEN   3392
#define XCD_BAR_WORDS 3456
#define XB_SPIN_CAP (1u << 18)

__device__ __forceinline__ unsigned xb_ld(unsigned* p)              { return __hip_atomic_load(p, __ATOMIC_RELAXED, __HIP_MEMORY_SCOPE_AGENT); }
__device__ __forceinline__ unsigned xb_add(unsigned* p, unsigned v) { return __hip_atomic_fetch_add(p, v, __ATOMIC_RELAXED, __HIP_MEMORY_SCOPE_AGENT); }
__device__ __forceinline__ unsigned xb_xcc_id() { return (unsigned)__builtin_amdgcn_s_getreg((3 << 11) | 20) & 0xFu; }
#define XB_SPIN(cond, bar) do { unsigned _sp = 0; while (cond) { __builtin_amdgcn_s_sleep(1); \
    if ((++_sp & 255u) == 0u) { if (xb_ld(&(bar)[XB_TMO])) break; if (_sp > XB_SPIN_CAP) { atomicAdd(&(bar)[XB_TMO], 1u); break; } } } } while (0)

struct XcdBarrier {
    unsigned* bar; unsigned x;
    volatile LAS unsigned* st;
};

__device__ __forceinline__ XcdBarrier xcd_barrier_post(unsigned* bar, volatile LAS unsigned* st) {
    XcdBarrier b; b.bar = bar; b.x = xb_xcc_id(); b.st = st;
    if (threadIdx.x == 0) (void)xb_add(&bar[XB_XCNT(b.x)], 1u);
    return b;
}
__device__ __forceinline__ void xcd_barrier_complete(unsigned* bar, unsigned x, unsigned& nloc, unsigned& nx) {
    const unsigned G = gridDim.x * gridDim.y * gridDim.z;
    unsigned sum, cnt, mine, sp = 0u;
    for (;;) {
        sum = 0u; cnt = 0u; mine = 0u;
#pragma unroll
        for (unsigned j = 0; j < 16; ++j) { const unsigned c = xb_ld(&bar[XB_XCNT(j)]); sum += c; cnt += (c > 0u) ? 1u : 0u; mine = (j == x) ? c : mine; }
        if (sum == G) break;
        __builtin_amdgcn_s_sleep(1);
        if ((++sp & 255u) == 0u) { if (xb_ld(&bar[XB_TMO])) break; if (sp > XB_SPIN_CAP) { atomicAdd(&bar[XB_TMO], 1u); break; } }
    }
    nloc = mine > 0u ? mine : 1u; nx = cnt > 0u ? cnt : 1u;
}

__device__ __forceinline__ void xcd_barrier(const XcdBarrier& b) {
    asm volatile("s_waitcnt vmcnt(0)" ::: "memory");
    __syncthreads();
    if (threadIdx.x == 0) {
        unsigned* bar = b.bar;
        __builtin_amdgcn_s_waitcnt(0);
        unsigned nloc = b.st[0], nx = b.st[1];
        if (nloc == 0u) { xcd_barrier_complete(bar, b.x, nloc, nx); b.st[0] = nloc; b.st[1] = nx; }
        const unsigned old = xb_add(&bar[XB_XSUB(b.x)], 1u);
        const unsigned gen = old / nloc;
        if (old + 1u == (gen + 1u) * nloc) {
            __builtin_amdgcn_fence(__ATOMIC_RELEASE, "agent");
            asm volatile("s_waitcnt vmcnt(0)" ::: "memory");
            const unsigned og = xb_add(&bar[XB_TOP], 1u);
            const unsigned tg = og / nx;
            if (og + 1u == (tg + 1u) * nx) xb_add(&bar[XB_TOPGEN], 1u);
            else XB_SPIN(xb_ld(&bar[XB_TOPGEN]) == tg, bar);
            __builtin_amdgcn_fence(__ATOMIC_ACQUIRE, "agent");
            xb_add(&bar[XB_XGEN(b.x)], 1u);
            asm volatile("s_waitcnt vmcnt(0)" ::: "memory");
        } else {
            XB_SPIN(xb_ld(&bar[XB_XGEN(b.x)]) == gen, bar);
            __builtin_amdgcn_fence(__ATOMIC_ACQUIRE, "agent");
            asm volatile("s_waitcnt vmcnt(0)" ::: "memory");
        }
    }
    __syncthreads();
}
struct EpiInProj {
    static constexpr bool PERM = false, AFTER_DRAIN = false;
    const float* rstd; const float* rcos; const float* rsin; const float* gq; const float* gk;
    bf16* XR; bf16* GG; bf16* Q; bf16* QI; fp8* KB; fp8* VB; bf16* KIB; fp8* KS; fp8* VS; bf16* KIS; float* WI; float* out;

    template <bool NORM> __device__ __forceinline__ void head_rope(f32x4 (&v)[2][2], const float* g, int pos, int fq) const {
        if (NORM) {
            float ss = 0.f;
#pragma unroll
            for (int bj = 0; bj < 2; ++bj)
#pragma unroll
                for (int n = 0; n < 2; ++n) ss += (v[bj][n][0] * v[bj][n][0] + v[bj][n][1] * v[bj][n][1]) + (v[bj][n][2] * v[bj][n][2] + v[bj][n][3] * v[bj][n][3]);
            ss += __shfl_xor(ss, 16); ss += __shfl_xor(ss, 32);
            const float inv = rsqrtf(ss * (1.0f / 64.0f) + EPS);
#pragma unroll
            for (int bj = 0; bj < 2; ++bj)
#pragma unroll
                for (int n = 0; n < 2; ++n) { const f32x4 g4 = *(const f32x4*)(g + 32 * bj + 8 * fq + 4 * n); v[bj][n] = v[bj][n] * inv * g4; }
        }
#pragma unroll
        for (int n = 0; n < 2; ++n) {
            const f32x4 c4 = *(const f32x4*)(rcos + pos * 32 + 8 * fq + 4 * n), s4 = *(const f32x4*)(rsin + pos * 32 + 8 * fq + 4 * n);
            const f32x4 x1 = v[0][n], x2 = v[1][n];
            v[0][n] = x1 * c4 - x2 * s4; v[1][n] = x2 * c4 + x1 * s4;
        }
    }
    __device__ __forceinline__ void operator()(const f32x4 (&acc)[2][2][4][2], const pg8::Unit& u, int wr, int wc, int fr, int fq) const {
        const int pn = u.pn;
#pragma unroll
        for (int ai = 0; ai < 2; ++ai) {
            const int rbase = u.pm * 256 + ai * 128;
            if (rbase >= MR) continue;
            const bool samp = rbase >= MP;
#pragma unroll
            for (int m = 0; m < 4; ++m) {
                const int r = rbase + wr * 64 + m * 16 + fr;
                int sb, t, pos;
                if (!samp) { sb = r >> 13; t = r & 8191; pos = t; } else { const int rs = r - MP; sb = rs >> 4; t = rs & 15; pos = PAST + t; }
                const float rsd = rstd[r];
                f32x4 v[2][2];
#pragma unroll
                for (int bj = 0; bj < 2; ++bj)
#pragma unroll
                    for (int n = 0; n < 2; ++n) v[bj][n] = acc[ai][bj][m][n] * rsd;
                if (pn < 2) {
#pragma unroll
                    for (int bj = 0; bj < 2; ++bj) {
                        const int c = 256 * pn + 64 * wc + 32 * bj + 8 * fq;
                        store_bf16x8(XR + (size_t)r * LW + c, v[bj][0], v[bj][1]);
                        const int tl = samp ? DT - 3 : SEQ - 3;
                        if (t >= tl) {
                            float* o = samp ? out + O_CS + ((size_t)(sb * 3 + (t - tl))) * LW + c : out + O_CP + ((size_t)(sb * 3 + (t - tl))) * LW + c;
                            *(f32x4*)o = v[bj][0]; *(f32x4*)(o + 4) = v[bj][1];
                        }
                    }
                } else if (pn < 4) {
#pragma unroll
                    for (int bj = 0; bj < 2; ++bj) {
                        const int c = 256 * (pn - 2) + 64 * wc + 32 * bj + 8 * fq;
                        f32x4 a = v[bj][0], b = v[bj][1];
#pragma unroll
                        for (int j = 0; j < 4; ++j) { a[j] = gelu_tanh(a[j]); b[j] = gelu_tanh(b[j]); }
                        store_bf16x8(GG + (size_t)r * LW + c, a, b);
                    }
                } else if (pn < 6) {
                    head_rope<true>(v, gq, pos, fq);
                    const int head = 4 * (pn - 4) + wc;
#pragma unroll
                    for (int bj = 0; bj < 2; ++bj) store_bf16x8(Q + (size_t)r * 512 + head * 64 + 32 * bj + 8 * fq, v[bj][0], v[bj][1]);
                } else if (pn == 6) {
                    if (wc < 2) head_rope<true>(v, gk, pos, fq);
                    const int hh = wc & 1;
                    float* of; fp8* ob;
                    if (wc < 2) { of = samp ? out + O_KS + (size_t)(r - MP) * KVW : out + O_KP + (size_t)r * KVW; ob = samp ? KS + ((size_t)sb * SKEYS + PAST + t) * KVW : KB + (size_t)r * KVW; }
                    else        { of = samp ? out + O_VS + (size_t)(r - MP) * KVW : out + O_VP + (size_t)r * KVW; ob = samp ? VS + ((size_t)sb * SKEYS + PAST + t) * KVW : VB + (size_t)r * KVW; }
#pragma unroll
                    for (int bj = 0; bj < 2; ++bj) {
                        const int c = hh * 64 + 32 * bj + 8 * fq;
                        *(f32x4*)(of + c) = v[bj][0]; *(f32x4*)(of + c + 4) = v[bj][1];
                        store_fp8x8(ob + c, v[bj][0], v[bj][1]);
                    }
                } else if (pn < 9) {
                    head_rope<false>(v, nullptr, pos, fq);
                    const int head = 4 * (pn - 7) + wc;
#pragma unroll
                    for (int bj = 0; bj < 2; ++bj) store_bf16x8(QI + (size_t)r * 512 + head * 64 + 32 * bj + 8 * fq, v[bj][0], v[bj][1]);
                } else {
                    if (wc == 0) {
                        head_rope<false>(v, nullptr, pos, fq);
                        float* of = samp ? out + O_KIS + (size_t)(r - MP) * 64 : out + O_KIP + (size_t)r * 64;
                        bf16* ob = samp ? KIS + ((size_t)sb * SKEYS + PAST + t) * 64 : KIB + (size_t)r * 64;
#pragma unroll
                        for (int bj = 0; bj < 2; ++bj) {
                            const int c = 32 * bj + 8 * fq;
                            *(f32x4*)(of + c) = v[bj][0]; *(f32x4*)(of + c + 4) = v[bj][1];
                            store_bf16x8(ob + c, v[bj][0], v[bj][1]);
                        }
                    } else if (wc == 1) {
                        if (fq == 0) { *(f32x4*)(WI + (size_t)r * 8) = v[0][0] * WI_SCALE; *(f32x4*)(WI + (size_t)r * 8 + 4) = v[0][1] * WI_SCALE; }
                    }
                }
            }
        }
    }
};

struct EpiOutProj {
    static constexpr bool PERM = false, AFTER_DRAIN = false;
    const float* xp; const float* xs; float* out; bf16* XB2; float* ssq;
    __device__ __forceinline__ void operator()(const f32x4 (&acc)[2][2][4][2], const pg8::Unit& u, int wr, int wc, int fr, int fq) const {
        const int col0 = u.pn * 256 + wc * 32 + 4 * fq;
#pragma unroll
        for (int ai = 0; ai < 2; ++ai) {
            const int rbase = u.pm * 256 + ai * 128;
            if (rbase >= MR) continue;
            const bool samp = rbase >= MP;
#pragma unroll
            for (int m = 0; m < 4; ++m) {
                const int r = rbase + wr * 64 + m * 16 + fr;
                const float* xrow = samp ? xs + (size_t)(r - MP) * D : xp + (size_t)r * D;
                float* yrow = samp ? out + O_YS + (size_t)(r - MP) * D : out + O_YP + (size_t)r * D;
                float ss = 0.f;
#pragma unroll
                for (int bj = 0; bj < 2; ++bj)
#pragma unroll
                    for (int n = 0; n < 2; ++n) {
                        const int c = col0 + bj * 128 + n * 16;
                        const f32x4 y = *(const f32x4*)(xrow + c) + acc[ai][bj][m][n];
                        if (samp) *(f32x4*)(yrow + c) = y;
                        ss += (y[0] * y[0] + y[1] * y[1]) + (y[2] * y[2] + y[3] * y[3]);
                        u32x2 w; w.x = pg8::cvt_pk_bf16(y[0], y[1]); w.y = pg8::cvt_pk_bf16(y[2], y[3]);
                        *(u32x2*)(XB2 + (size_t)r * D + c) = w;
                    }
                ss += __shfl_xor(ss, 16); ss += __shfl_xor(ss, 32);
                if (fq == 0) atomicAdd(ssq + r, ss);
            }
        }
    }
};

struct EpiFfnIn {
    static constexpr bool PERM = false, AFTER_DRAIN = false;
    const float* ssq; bf16* H;
    __device__ __forceinline__ void operator()(const f32x4 (&acc)[2][2][4][2], const pg8::Unit& u, int wr, int wc, int fr, int fq) const {
        const int c = 128 * u.pn + 32 * wc + 8 * fq;
#pragma unroll
        for (int ai = 0; ai < 2; ++ai) {
            const int rbase = u.pm * 256 + ai * 128;
            if (rbase >= MR) continue;
#pragma unroll
            for (int m = 0; m < 4; ++m) {
                const int r = rbase + wr * 64 + m * 16 + fr;
                const float rs2 = rsqrtf(ssq[r] * (1.0f / 1024.0f) + EPS);
                f32x4 h[2];
#pragma unroll
                for (int n = 0; n < 2; ++n) {
                    const f32x4 g = acc[ai][0][m][n] * rs2, up = acc[ai][1][m][n] * rs2;
#pragma unroll
                    for (int j = 0; j < 4; ++j) h[n][j] = g[j] * sigmoidf_(g[j]) * up[j];
                }
                store_bf16x8(H + (size_t)r * DFF + c, h[0], h[1]);
            }
        }
    }
};

struct EpiFfnOut {
    static constexpr bool PERM = false, AFTER_DRAIN = false;
    float* out; const bf16* XB2;
    __device__ __forceinline__ void operator()(const f32x4 (&acc)[2][2][4][2], const pg8::Unit& u, int wr, int wc, int fr, int fq) const {
        const int col0 = u.pn * 256 + wc * 32 + 4 * fq;
#pragma unroll
        for (int ai = 0; ai < 2; ++ai) {
            const int rbase = u.pm * 256 + ai * 128;
            if (rbase >= MP) continue;
#pragma unroll
            for (int m = 0; m < 4; ++m) {
                const int r = rbase + wr * 64 + m * 16 + fr;
                float* yrow = out + O_YP + (size_t)r * D;
#pragma unroll
                for (int bj = 0; bj < 2; ++bj)
#pragma unroll
                    for (int n = 0; n < 2; ++n) { const int c = col0 + bj * 128 + n * 16; const u32x2 xw = *(const u32x2*)(XB2 + (size_t)r * D + c);
                        const f32x4 x1 = {bflo(xw.x), bfhi(xw.x), bflo(xw.y), bfhi(xw.y)}; *(f32x4*)(yrow + c) = x1 + acc[ai][bj][m][n]; }
            }
        }
    }
};

struct Params {
    const float* in[22];
    float* out;
    unsigned char* ws;
    double invf[32];
    int ph_lo, ph_hi;
};
enum { I_XP = 0, I_XS, I_CK, I_CV, I_CKI, I_SH, I_SC, I_NM, I_WIN, I_CW, I_CB, I_WRG, I_BRG, I_WIG, I_BIG, I_LAM, I_QN, I_KN, I_WOUT, I_NF, I_WFI, I_WFO };

struct Frame { LAS unsigned char* lds; int tid, lane, wave, G, bid; };

template <int NB, int KSTEPS, class BRow, class Epi>
__device__ __forceinline__ void skinny_gemm(Frame& F, const bf16* A, int lda, const bf16* Bt, int K, int nct, BRow brow, Epi epi) {
    const int lane = F.lane, qc = lane & 15, kq = lane >> 4, w = F.wave;
    LAS f32x4* red = (LAS f32x4*)F.lds;
    for (int item = F.bid; item < 4 * nct; item += F.G) {
        const int rb = item & 3, ct = item >> 2;
        const bf16* a0 = A + (size_t)(rb * 32 + qc) * lda + 8 * kq + w * (KSTEPS * 32); const bf16* a1 = a0 + (size_t)16 * lda;
        const bf16* bp[NB];
#pragma unroll
        for (int nb = 0; nb < NB; ++nb) bp[nb] = Bt + (size_t)brow(ct, nb, qc) * K + 8 * kq + w * (KSTEPS * 32);
        f32x4 acc[2][NB];
#pragma unroll
        for (int m = 0; m < 2; ++m)
#pragma unroll
            for (int nb = 0; nb < NB; ++nb) acc[m][nb] = (f32x4){0.f, 0.f, 0.f, 0.f};
#pragma unroll
        for (int ks = 0; ks < KSTEPS; ++ks) {
            const bf16x8 fa0 = *(const bf16x8*)(a0 + 32 * ks), fa1 = *(const bf16x8*)(a1 + 32 * ks);
#pragma unroll
            for (int nb = 0; nb < NB; ++nb) {
                const bf16x8 fb = *(const bf16x8*)(bp[nb] + 32 * ks);
                acc[0][nb] = __builtin_amdgcn_mfma_f32_16x16x32_bf16(fb, fa0, acc[0][nb], 0, 0, 0);
                acc[1][nb] = __builtin_amdgcn_mfma_f32_16x16x32_bf16(fb, fa1, acc[1][nb], 0, 0, 0);
            }
        }
#pragma unroll
        for (int m = 0; m < 2; ++m)
#pragma unroll
            for (int nb = 0; nb < NB; ++nb) red[(w * 2 * NB + m * NB + nb) * 64 + lane] = acc[m][nb];
        __syncthreads();
        if (w < 2) {
            f32x4 s[NB];
#pragma unroll
            for (int nb = 0; nb < NB; ++nb) { s[nb] = red[(w * NB + nb) * 64 + lane];
#pragma unroll
                for (int w2 = 1; w2 < 8; ++w2) s[nb] += red[(w2 * 2 * NB + w * NB + nb) * 64 + lane]; }
            epi(s, rb * 32 + w * 16 + qc, 16 * ct + 4 * kq, kq);
        }
        __syncthreads();
    }
}

__device__ __forceinline__ float wave_sum(float v) {
#pragma unroll
    for (int o = 1; o < 64; o <<= 1) v += __shfl_xor(v, o);
    return v;
}

__device__ __forceinline__ void transpose_item(const float* W, int K, int N, int nvalid, const float* gain, bf16* WT, int k0, int row0, int lcol0, bool perm, LAS float* scr, int lane) {
    const int c4 = (lane & 7) * 4, col = lcol0 + c4; const bool ok = col < nvalid;
    f32x4 v[8];
#pragma unroll
    for (int i = 0; i < 8; ++i) { const int kk = (lane >> 3) + 8 * i; v[i] = ok ? *(const f32x4*)(W + (size_t)(k0 + kk) * N + col) : (f32x4){0.f, 0.f, 0.f, 0.f}; }
#pragma unroll
    for (int i = 0; i < 8; ++i) { const int kk = (lane >> 3) + 8 * i; const float g = gain ? gain[k0 + kk] : 1.0f; *(LAS f32x4*)(scr + kk * 36 + c4) = v[i] * g; }
    asm volatile("s_waitcnt lgkmcnt(0)" ::: "memory");
    const int c = lane & 7;
#pragma unroll
    for (int j = 0; j < 4; ++j) {
        const int n = (lane >> 3) + 8 * j, src = perm ? pg8::perm32(n) : n;
        const LAS float* s = scr + (8 * c) * 36 + src;
        u32x4 o; o.x = pk2(s[0 * 36], s[1 * 36]); o.y = pk2(s[2 * 36], s[3 * 36]); o.z = pk2(s[4 * 36], s[5 * 36]); o.w = pk2(s[6 * 36], s[7 * 36]);
        *(u32x4*)(WT + (size_t)(row0 + n) * K + k0 + 8 * c) = o;
    }
    asm volatile("s_waitcnt lgkmcnt(0)" ::: "memory");
}

__device__ __forceinline__ void phase0(const Params& p, Frame& F) {
    unsigned char* ws = p.ws;
    LAS float* scr = (LAS float*)(F.lds + F.wave * 16384);
    const int gw = F.bid * 8 + F.wave, NGW = F.G * 8;
    TIC(50);
    constexpr int I_IN = 16 * (NIN / 32), I_OUT = 16 * (D / 32), I_FI = 16 * (2 * DFF / 32), I_FO = (DFF / 64) * (D / 32);
    constexpr int NITEMS = I_IN + I_OUT + I_FI + I_FO;
    for (int it = gw; it < NITEMS; it += NGW) {
        int r = it;
        if (r < I_IN) { const int kb = r / (NIN / 32), g = r % (NIN / 32), pn = g >> 3, sub = g & 7, bj = sub >> 2, wc = sub & 3;
            transpose_item(p.in[I_WIN], D, DIN, DIN, p.in[I_NM], (bf16*)(ws + WS_WIN), 64 * kb, 32 * g, 256 * pn + 64 * wc + 32 * bj, true, scr, F.lane); continue; }
        r -= I_IN;
        if (r < I_OUT) { const int kb = r / (D / 32), g = r % (D / 32);
            transpose_item(p.in[I_WOUT], D, D, D, nullptr, (bf16*)(ws + WS_WOUT), 64 * kb, 32 * g, 32 * g, false, scr, F.lane); continue; }
        r -= I_OUT;
        if (r < I_FI) { const int kb = r / (2 * DFF / 32), g = r % (2 * DFF / 32), pn = g >> 3, sub = g & 7, bj = sub >> 2, wc = sub & 3;
            transpose_item(p.in[I_WFI], D, 2 * DFF, 2 * DFF, p.in[I_NF], (bf16*)(ws + WS_WFI), 64 * kb, 32 * g, (bj ? DFF : 0) + 128 * pn + 32 * wc, true, scr, F.lane); continue; }
        r -= I_FI;
        { const int kb = r / (D / 32), g = r % (D / 32);
            transpose_item(p.in[I_WFO], DFF, D, D, nullptr, (bf16*)(ws + WS_WFO), 64 * kb, 32 * g, 32 * g, false, scr, F.lane); }
    }
    TOC(50);
    TIC(51);
    {
        bf16* XB = (bf16*)(ws + WS_XB); float* rstd = (float*)(ws + WS_RSTD);
        for (int m0 = gw; m0 < M; m0 += 4 * NGW) {
            f32x4 v[4][4];
#pragma unroll
            for (int rr = 0; rr < 4; ++rr) {
                const int m = m0 + rr * NGW;
                const bool real = m < MR;
                const float* xrow = (m < MP) ? p.in[I_XP] + (size_t)m * D : p.in[I_XS] + (size_t)((real ? m : MP) - MP) * D;
                const f32x4* xr = (const f32x4*)xrow + F.lane;
#pragma unroll
                for (int j = 0; j < 4; ++j) v[rr][j] = real ? xr[64 * j] : (f32x4){0.f, 0.f, 0.f, 0.f};
            }
#pragma unroll
            for (int rr = 0; rr < 4; ++rr) {
                const int m = m0 + rr * NGW;
                if (m >= M) continue;
                float s = 0.f;
#pragma unroll
                for (int j = 0; j < 4; ++j) s += (v[rr][j][0] * v[rr][j][0] + v[rr][j][1] * v[rr][j][1]) + (v[rr][j][2] * v[rr][j][2] + v[rr][j][3] * v[rr][j][3]);
                s = wave_sum(s);
                if (F.lane == 0) rstd[m] = (m < MR) ? rsqrtf(s * (1.0f / D) + EPS) : 0.f;
                unsigned long long* o8 = (unsigned long long*)(XB + (size_t)m * D) + F.lane;
#pragma unroll
                for (int j = 0; j < 4; ++j) o8[64 * j] = (unsigned long long)pk2(v[rr][j][0], v[rr][j][1]) | ((unsigned long long)pk2(v[rr][j][2], v[rr][j][3]) << 32);
            }
        }
    }
    TOC(51);
    TIC(52);
    const size_t gt = (size_t)F.bid * 512 + F.tid, GS = (size_t)F.G * 512;
    {
        fp8* KS = (fp8*)(ws + WS_KS); fp8* VS = (fp8*)(ws + WS_VS); bf16* KIS = (bf16*)(ws + WS_KIS);
        constexpr size_t NKV8 = (size_t)DB * PAST * KVW / 8, NKI8 = (size_t)DB * PAST * 64 / 8;
        for (size_t i = gt; i < 2 * NKV8 + NKI8; i += GS) {
            if (i < 2 * NKV8) {
                const bool isv = i >= NKV8; const size_t e = (isv ? i - NKV8 : i) * 8, b = e / ((size_t)PAST * KVW), rem = e % ((size_t)PAST * KVW);
                const float* src = (isv ? p.in[I_CV] : p.in[I_CK]) + e; fp8* dst = (isv ? VS : KS) + b * SKEYS * KVW + rem;
                store_fp8x8(dst, *(const f32x4*)src, *(const f32x4*)(src + 4));
            } else {
                const size_t e = (i - 2 * NKV8) * 8, b = e / ((size_t)PAST * 64), rem = e % ((size_t)PAST * 64);
                const float* src = p.in[I_CKI] + e;
                store_bf16x8(KIS + b * SKEYS * 64 + rem, *(const f32x4*)src, *(const f32x4*)(src + 4));
            }
        }
    }
    {
        float* rc = (float*)(ws + WS_RCOS); float* rsn = (float*)(ws + WS_RSIN);
        for (size_t i = gt; i < (size_t)8192 * 32; i += GS) {
            const int pos = (int)(i >> 5), fi = (int)(i & 31);
            const double ang = (double)pos * p.invf[fi];
            const double kq = rint(ang * 0.63661977236758134308);
            double r = fma(-kq, 1.57079632679489655800e+00, ang); r = fma(-kq, 6.12323399573676603587e-17, r);
            const double r2 = r * r;
            double sn = -1.0 / 1307674368000.0; sn = sn * r2 + 1.0 / 6227020800.0; sn = sn * r2 - 1.0 / 39916800.0; sn = sn * r2 + 1.0 / 362880.0; sn = sn * r2 - 1.0 / 5040.0; sn = sn * r2 + 1.0 / 120.0; sn = sn * r2 - 1.0 / 6.0; sn = sn * r2 + 1.0; sn *= r;
            double cs = 1.0 / 20922789888000.0; cs = cs * r2 - 1.0 / 87178291200.0; cs = cs * r2 + 1.0 / 479001600.0; cs = cs * r2 - 1.0 / 3628800.0; cs = cs * r2 + 1.0 / 40320.0; cs = cs * r2 - 1.0 / 720.0; cs = cs * r2 + 1.0 / 24.0; cs = cs * r2 - 0.5; cs = cs * r2 + 1.0;
            const int q = (int)((long long)kq & 3);
            const double sv = (q == 0) ? sn : (q == 1) ? cs : (q == 2) ? -sn : -cs;
            const double cv = (q == 0) ? cs : (q == 1) ? -sn : (q == 2) ? -cs : sn;
            rc[i] = (float)cv; rsn[i] = (float)sv;
        }
    }
    {
        float* ssq = (float*)(ws + WS_SSQ);
        for (size_t i = gt; i < (size_t)M; i += GS) ssq[i] = 0.f;
        float* sp = (float*)(ws + WS_SP);
        for (size_t i = gt; i < 512; i += GS) sp[i] = log1pf(__expf(-p.in[I_LAM][i]));
        bf16* WG = (bf16*)(ws + WS_WG);
        for (size_t i = gt; i < (size_t)2 * 8 * 64 * 64; i += GS) {
            const int ii = (int)(i & 63), j = (int)((i >> 6) & 63), nb = (int)((i >> 12) & 7), gsel = (int)(i >> 15);
            const float* W = gsel ? p.in[I_WIG] : p.in[I_WRG];
            WG[i] = (bf16)f2bf(W[(nb * 64 + ii) * 64 + j]);
        }
    }
    TOC(52);
}

constexpr int LRU_WLDS = 14848;
template <int PASS> __device__ __forceinline__ void lru_unit(const Params& p, Frame& F, int sbi  , int nb, int sg) {
    unsigned char* ws = p.ws;
    const bool samp = sbi >= NB; const int b = samp ? sbi - NB : sbi;
    const int T = samp ? DT : 128, t0 = samp ? 0 : sg * 128;
    const size_t r0 = samp ? (size_t)MP + b * DT : (size_t)b * SEQ + t0;
    const int lane = F.lane, qc = lane & 15, kq = lane >> 4, ch = nb * 64 + lane;
    LAS unsigned char* wl = F.lds + F.wave * LRU_WLDS;
    LAS bf16* xcb = (LAS bf16*)wl; LAS float* xcf = (LAS float*)(wl + 2304); LAS float* av = (LAS float*)(wl + 2304 + 4096); LAS float* bv = (LAS float*)(wl + 2304 + 8192);
    const bf16* XR = (const bf16*)(ws + WS_XR) + r0 * LW + ch;
    const float cb = p.in[I_CB][ch], w0 = p.in[I_CW][ch], w1 = p.in[I_CW][LW + ch], w2 = p.in[I_CW][2 * LW + ch], w3 = p.in[I_CW][3 * LW + ch];
    float x1, x2, x3;
    if (t0 > 0) { x1 = bf2f(XR[-3 * LW]); x2 = bf2f(XR[-2 * LW]); x3 = bf2f(XR[-1 * LW]); }
    else if (samp) { const float* sc = p.in[I_SC] + (size_t)b * 3 * LW + ch; x1 = sc[0]; x2 = sc[LW]; x3 = sc[2 * LW]; }
    else { x1 = 0.f; x2 = 0.f; x3 = 0.f; }
    const bf16* GG = (const bf16*)(ws + WS_GG) + r0 * LW + ch; bf16* YC = (bf16*)(ws + WS_YC) + r0 * D + ch;
    unsigned short xn[16], gn2[16];
#pragma unroll
    for (int k = 0; k < 16; ++k) { xn[k] = XR[(size_t)k * LW]; gn2[k] = (PASS == 1) ? GG[(size_t)k * LW] : (unsigned short)0; }
    float Ac = 1.f, h = 0.f;
    if (PASS == 1) {
        h = samp ? p.in[I_SH][b * LW + ch] : 0.f;
        const f32x2* AGG = (const f32x2*)(ws + WS_AGG) + (size_t)sbi * 64 * LW + ch;
        f32x2 gn[8];
#pragma unroll
        for (int j = 0; j < 8; ++j) gn[j] = AGG[(size_t)(j < sg ? j : 0) * LW];
        for (int s0 = 0; s0 < sg; s0 += 8) {
            f32x2 g[8];
#pragma unroll
            for (int j = 0; j < 8; ++j) g[j] = gn[j];
            if (s0 + 8 < sg) {
#pragma unroll
                for (int j = 0; j < 8; ++j) gn[j] = AGG[(size_t)(s0 + 8 + j < sg ? s0 + 8 + j : 0) * LW];
            }
#pragma unroll
            for (int j = 0; j < 8; ++j) h = (s0 + j < sg) ? g[j].x * h + g[j].y : h;
        }
    }
    asm volatile("" ::: "memory");
    const bf16* WG = (const bf16*)(ws + WS_WG); const float* sp = (const float*)(ws + WS_SP);
    bf16x8 Wr[4][2], Wi[4][2]; float brg[4], big[4], spv[4];
#pragma unroll
    for (int jt = 0; jt < 4; ++jt) {
        const int j = 16 * jt + qc;
        const bf16* wr_ = WG + ((size_t)(0 * 8 + nb) * 64 + j) * 64 + 8 * kq; const bf16* wi_ = WG + ((size_t)(1 * 8 + nb) * 64 + j) * 64 + 8 * kq;
        Wr[jt][0] = *(const bf16x8*)wr_; Wr[jt][1] = *(const bf16x8*)(wr_ + 32); Wi[jt][0] = *(const bf16x8*)wi_; Wi[jt][1] = *(const bf16x8*)(wi_ + 32);
        brg[jt] = p.in[I_BRG][nb * 64 + j]; big[jt] = p.in[I_BIG][nb * 64 + j]; spv[jt] = sp[nb * 64 + j];
    }
    for (int st = 0; st < T; st += 16) {
        float xv[16], gg[16];
#pragma unroll
        for (int k = 0; k < 16; ++k) { xv[k] = bf2f(xn[k]); if (PASS == 1) gg[k] = bf2f(gn2[k]); }
        if (st + 16 < T) {
#pragma unroll
            for (int k = 0; k < 16; ++k) { xn[k] = XR[(size_t)(st + 16 + k) * LW]; if (PASS == 1) gn2[k] = GG[(size_t)(st + 16 + k) * LW]; }
        }
#pragma unroll
        for (int k = 0; k < 16; ++k) {
            const float xc = cb + w0 * x1 + w1 * x2 + w2 * x3 + w3 * xv[k];
            x1 = x2; x2 = x3; x3 = xv[k];
            xcf[k * 64 + lane] = xc; xcb[k * 72 + lane] = (bf16)f2bf(xc);
        }
        asm volatile("s_waitcnt lgkmcnt(0)" ::: "memory");
        const bf16x8 A0 = *(const LAS bf16x8*)(xcb + qc * 72 + 8 * kq), A1 = *(const LAS bf16x8*)(xcb + qc * 72 + 32 + 8 * kq);
#pragma unroll
        for (int jt = 0; jt < 4; ++jt) {
            const int j = 16 * jt + qc;
            f32x4 ar = {0.f, 0.f, 0.f, 0.f}, ai = {0.f, 0.f, 0.f, 0.f};
            ar = __builtin_amdgcn_mfma_f32_16x16x32_bf16(A0, Wr[jt][0], ar, 0, 0, 0); ar = __builtin_amdgcn_mfma_f32_16x16x32_bf16(A1, Wr[jt][1], ar, 0, 0, 0);
            ai = __builtin_amdgcn_mfma_f32_16x16x32_bf16(A0, Wi[jt][0], ai, 0, 0, 0); ai = __builtin_amdgcn_mfma_f32_16x16x32_bf16(A1, Wi[jt][1], ai, 0, 0, 0);
#pragma unroll
            for (int ii = 0; ii < 4; ++ii) {
                const int t = 4 * kq + ii;
                const float rg = sigmoidf_(ar[ii] + brg[jt]), ig = sigmoidf_(ai[ii] + big[jt]);
                const float a = __expf(-8.0f * rg * spv[jt]);
                float mult = sqrtf(fmaxf(1.0f - a * a, 0.f));
                if (!samp && (t0 + st + t) == 0) mult = 1.0f;
                av[t * 64 + j] = a; bv[t * 64 + j] = mult * ig * xcf[t * 64 + j];
            }
        }
        asm volatile("s_waitcnt lgkmcnt(0)" ::: "memory");
#pragma unroll
        for (int k = 0; k < 16; ++k) {
            const float a = av[k * 64 + lane], bb = bv[k * 64 + lane];
            h = a * h + bb;
            if (PASS == 0) Ac *= a;
            else YC[(size_t)(st + k) * D] = (bf16)f2bf(h * gg[k]);
        }
        asm volatile("s_waitcnt lgkmcnt(0)" ::: "memory");
    }
    if (PASS == 0) ((f32x2*)(ws + WS_AGG))[((size_t)sbi * 64 + sg) * LW + ch] = (f32x2){Ac, h};
    else { if (samp) p.out[O_HS + b * LW + ch] = h; else if (sg == 63) p.out[O_HP + b * LW + ch] = h; }
}
template <int PASS> __device__ __forceinline__ void lru_phase(const Params& p, Frame& F) {
    for (int u = F.bid * 8 + F.wave; u < 2048 + 64; u += F.G * 8) {
        if (u < 2048) lru_unit<PASS>(p, F, u >> 9, u & 7, (u >> 3) & 63);
        else lru_unit<PASS>(p, F, NB + ((u - 2048) >> 3), (u - 2048) & 7, 0);
    }
}

constexpr int A_CAND = 0, A_CNT = 131072, A_THR = 131072 + 128, A_FLAG = 131072 + 256, A_CNT0 = 131072 + 384, A_HBAR = 131072 + 512, A_TICK = 131072 + 576, CAP = 1024;
constexpr int VPITCH = 288;
extern "C" __device__ unsigned __ockl_wfred_max_u32(unsigned);
extern "C" __device__ unsigned __ockl_wfred_min_u32(unsigned);
typedef short v4i16_t __attribute__((ext_vector_type(4)));
typedef int v2i32_t __attribute__((ext_vector_type(2)));
constexpr int KV8P = 144;

__device__ __forceinline__ unsigned pack_key(float s, int key) {
    unsigned u = __float_as_uint(s);
    u = (u & 0x80000000u) ? ~u : (u | 0x80000000u);
    return (u & 0xFFFFE000u) | (unsigned)(8191 - key);
}
extern "C" __device__ unsigned __ockl_wfred_add_u32(unsigned);
extern "C" __device__ unsigned __ockl_wfscan_add_u32(unsigned, bool);
struct SelRes { unsigned thr; int cnt; };
template <int ROWS> __device__ __forceinline__ SelRes select_rank_rows(LAS unsigned* cq, int n, int rlo, int rhi, int lane) {
    unsigned e[ROWS]; unsigned mx = 0u, mn = 0xFFFFFFFFu;
#pragma unroll
    for (int i = 0; i < ROWS; ++i) { const int idx = i * 64 + lane; const unsigned x = cq[idx]; const bool v = idx < n; e[i] = v ? x : 0u; mx = e[i] > mx ? e[i] : mx; const unsigned y = v ? x : 0xFFFFFFFFu; mn = y < mn ? y : mn; }
    unsigned lo = (unsigned)__builtin_amdgcn_readfirstlane((int)__ockl_wfred_min_u32(mn));
    unsigned hi = (unsigned)__builtin_amdgcn_readfirstlane((int)__ockl_wfred_max_u32(mx)); hi = hi == 0xFFFFFFFFu ? hi : hi + 1u;
    int clo = n;
    for (int it = 0; it < 40 && clo > rhi; ++it) {
        const unsigned piv = lo + ((hi - lo) >> 1);
        int c = 0;
#pragma unroll
        for (int i = 0; i < ROWS; ++i) c += __popcll(__ballot(e[i] >= piv));
        if (c >= rlo) { lo = piv; clo = c; } else hi = piv;
    }
    unsigned cl = 0u;
#pragma unroll
    for (int i = 0; i < ROWS; ++i) cl += (e[i] >= lo) ? 1u : 0u;
    unsigned pos = __ockl_wfscan_add_u32(cl, false);
#pragma unroll
    for (int i = 0; i < ROWS; ++i) { const bool k = e[i] >= lo; if (k) cq[pos] = e[i]; pos += k ? 1u : 0u; }
    SelRes r; r.thr = lo; r.cnt = clo; return r;
}
__device__ __forceinline__ SelRes select_rank(LAS unsigned* cq, int n, int rlo, int rhi, int lane) {
    if (n <= 768) return select_rank_rows<12>(cq, n, rlo, rhi, lane);
    return select_rank_rows<16>(cq, n, rlo, rhi, lane);
}

__device__ __forceinline__ void half_barrier(LAS unsigned* hb, int lane) {
    asm volatile("s_waitcnt vmcnt(0) lgkmcnt(0)" ::: "memory");
    if (lane == 0) {
        const unsigned gen = __hip_atomic_load(hb + 1, __ATOMIC_RELAXED, __HIP_MEMORY_SCOPE_WORKGROUP);
        const unsigned old = __hip_atomic_fetch_add(hb, 1u, __ATOMIC_RELAXED, __HIP_MEMORY_SCOPE_WORKGROUP);
        if (old == 3u) { __hip_atomic_store(hb, 0u, __ATOMIC_RELAXED, __HIP_MEMORY_SCOPE_WORKGROUP); __hip_atomic_store(hb + 1, gen + 1u, __ATOMIC_RELAXED, __HIP_MEMORY_SCOPE_WORKGROUP); }
        else { while (__hip_atomic_load(hb + 1, __ATOMIC_RELAXED, __HIP_MEMORY_SCOPE_WORKGROUP) == gen) __builtin_amdgcn_s_sleep(1); }
    }
    asm volatile("s_waitcnt lgkmcnt(0)" ::: "memory");
}
__device__ __forceinline__ void select_unit(const Params& p, Frame& F, size_t q0row, int L, const bf16* KI) {
    unsigned char* ws = p.ws;
    const bf16* QI = (const bf16*)(ws + WS_QI); const float* WI = (const float*)(ws + WS_WI);
    const int lane = F.lane, half = F.wave >> 2, wid = F.wave & 3, htid = F.tid & 255, qc = lane & 15, kq = lane >> 4;
    LAS unsigned* cand = (LAS unsigned*)(F.lds + A_CAND + half * 65536); LAS unsigned* cntp = (LAS unsigned*)(F.lds + A_CNT + half * 64); LAS unsigned* thrp = (LAS unsigned*)(F.lds + A_THR + half * 64);
    LAS unsigned* flagp = (LAS unsigned*)(F.lds + A_FLAG + half * 16); LAS unsigned* hb = (LAS unsigned*)(F.lds + A_HBAR + half * 16);
    constexpr int nq = 16;
    constexpr int nslots = 4; const int slot = wid;
    const int ql = qc;
    TIC(1);
    bf16x8 Bq[8][2]; float sinf_[8];
    {
        const size_t qrow = q0row + ql;
#pragma unroll
        for (int h = 0; h < 8; ++h) {
            const float w = WI[qrow * 8 + h];
            sinf_[h] = (w < 0.f) ? -INFINITY : INFINITY;
#pragma unroll
            for (int s = 0; s < 2; ++s) {
                const u32x4 raw = *(const u32x4*)(QI + qrow * 512 + h * 64 + 32 * s + 8 * kq);
                u32x4 o; o.x = pk2(bflo(raw.x) * w, bfhi(raw.x) * w); o.y = pk2(bflo(raw.y) * w, bfhi(raw.y) * w); o.z = pk2(bflo(raw.z) * w, bfhi(raw.z) * w); o.w = pk2(bflo(raw.w) * w, bfhi(raw.w) * w);
                Bq[h][s] = __builtin_bit_cast(bf16x8, o);
            }
        }
    }
    half_barrier(hb, lane);
    TOC(1);
    TIC(2);
    for (int arep_ = 0; arep_ <= DUP(8); ++arep_) {
    const int NG = (L + 63) >> 6; const bool tail = (L & 63) != 0;
    LAS unsigned* cnt0 = (LAS unsigned*)(F.lds + A_CNT0 + half * 64);
    int rk = (600 * 1024) / L; rk = rk < 48 ? 48 : (rk > 256 ? 256 : rk);
#if FORCE_FALLBACK
    rk = 8;
#endif
#if FORCE_SAFE_MODE
    const int mode0 = 1;
#else
    const int mode0 = 0;
#endif
    bf16x8 An[2][2];
#define LOAD_A(DST, G, T0, T1) do { int g_ = (G); g_ = g_ < NG ? g_ : NG - 1; _Pragma("unroll") for (int tl = T0; tl < T1; ++tl) { int arow = g_ * 64 + tl * 16 + qc; arow = arow < L ? arow : L - 1; \
        DST[tl - T0][0] = *(const bf16x8*)(KI + (size_t)arow * 64 + 8 * kq); DST[tl - T0][1] = *(const bf16x8*)(KI + (size_t)arow * 64 + 32 + 8 * kq); } } while (0)
#define LOAD_AN(G) LOAD_A(An, G, 0, 2)
    for (int mode = mode0; mode < 2; ++mode) {
    bool redo = false;
    if (htid < 16) { cntp[htid] = 0u; thrp[htid] = 0u; cnt0[htid] = 0u; }
    if (htid == 32) flagp[1] = 0u;
    int g0 = 0, KG = 16;
    LOAD_AN(slot);
    while (g0 < NG) {
        const int gend = (g0 + KG < NG) ? g0 + KG : NG;
        if (htid == 32) flagp[0] = 0u;
        half_barrier(hb, lane);
        const unsigned thr = thrp[ql];
        LAS unsigned* cq = cand + ql * CAP;
        TIC(3);
        for (int g = g0 + slot; g < gend; g += nslots) {
            TIC(7);
            bf16x8 Ah[2][2]; LOAD_A(Ah, g, 2, 4);
            unsigned pk[16];
#define TILE(TL, A0_, A1_) do { f32x4 s0 = {0.f, 0.f, 0.f, 0.f}; \
                _Pragma("unroll") for (int h = 0; h < 8; ++h) { f32x4 acc = {0.f, 0.f, 0.f, 0.f}; \
                    acc = __builtin_amdgcn_mfma_f32_16x16x32_bf16(A0_, Bq[h][0], acc, 0, 0, 0); acc = __builtin_amdgcn_mfma_f32_16x16x32_bf16(A1_, Bq[h][1], acc, 0, 0, 0); \
                    _Pragma("unroll") for (int i = 0; i < 4; ++i) s0[i] += __builtin_amdgcn_fmed3f(acc[i], 0.f, sinf_[h]); } \
                _Pragma("unroll") for (int i = 0; i < 4; ++i) pk[(TL) * 4 + i] = pack_key(s0[i], g * 64 + (TL) * 16 + 4 * kq + i); } while (0)
            TILE(0, An[0][0], An[0][1]); TILE(1, An[1][0], An[1][1]);
            __builtin_amdgcn_sched_barrier(0);
            { const int gn = g + nslots; LOAD_AN(gn < gend ? gn : gend + slot); }
            TILE(2, Ah[0][0], Ah[0][1]); TILE(3, Ah[1][0], Ah[1][1]);
#undef TILE
            if (tail && g == NG - 1) {
                int vt = L - g * 64 - 4 * kq; asm volatile("" : "+v"(vt));
#pragma unroll
                for (int j = 0; j < 16; ++j) pk[j] = ((j >> 2) * 16 + (j & 3) < vt) ? pk[j] : 0u;
            }
            TOC(7);
            TIC(8);
            int n = 0;
#pragma unroll
            for (int j = 0; j < 16; ++j) n += (pk[j] > thr) ? 1 : 0;
            if (n) {
                unsigned base = __hip_atomic_fetch_add(cntp + ql, (unsigned)n, __ATOMIC_RELAXED, __HIP_MEMORY_SCOPE_WORKGROUP);
                if (base + (unsigned)n > (unsigned)CAP) flagp[0] = 1u;
                else {
#pragma unroll
                    for (int j = 0; j < 16; ++j) if (pk[j] > thr) cq[base++] = pk[j];
                }
            }
            TOC(8);
        }
        TOC(3);
        TIC(4);
        half_barrier(hb, lane);
        TOC(4);
        TIC(5);
        const bool ovf = flagp[0] != 0u;
        if (ovf && mode == 0) { redo = true; break; }
        if (ovf) { if (htid < 16) cntp[htid] = cnt0[htid]; half_barrier(hb, lane); }
        const bool last = !ovf && gend == NG;
        if (!last) {
            const int plim = ovf ? 256 : (mode == 0 ? rk + (rk >> 2) : 512), rlo = mode == 0 ? rk : 256, rhi = mode == 0 ? rk + (rk >> 2) : 256;
#pragma unroll 1
            for (int i2 = 0; i2 < 4; ++i2) {
                const int qq = wid * 4 + i2;
                if (qq < nq) {
                    int n = __builtin_amdgcn_readfirstlane((int)cntp[qq]);
                    if (n > plim) { const SelRes r = select_rank(cand + qq * CAP, n, rlo, rhi, lane); n = r.cnt; if (lane == 0) { cntp[qq] = (unsigned)n; thrp[qq] = r.thr; } }
                    if (lane == 0) cnt0[qq] = (unsigned)n;
                }
            }
        }
        TOC(5);
        if (ovf) { KG = (KG >> 1) > nslots ? (KG >> 1) : nslots; LOAD_AN(g0 + slot); }
        else { g0 = gend; KG = mode == 0 ? NG : ((KG * 2 < 32) ? KG * 2 : 32); }
    }
    if (!redo && mode == 0 && L > 1024) {
        if (lane < 4) { const int qq = wid * 4 + lane; if (qq < nq && cntp[qq] < 256u) flagp[1] = 1u; }
        half_barrier(hb, lane);
        redo = flagp[1] != 0u;
    }
    half_barrier(hb, lane);
    if (!redo) break;
    }
    TOC(2);
#undef LOAD_AN
#undef LOAD_A
    }
    TIC(6);
    {
        int lane_b = lane; asm volatile("" : "+v"(lane_b));
        unsigned short* SEL = (unsigned short*)(ws + WS_SEL); int* NSEL = (int*)(ws + WS_NSEL);
#pragma unroll 1
        for (int i2 = 0; i2 < 4; ++i2) {
            const int qq = wid * 4 + i2;
            if (qq >= nq) continue;
            int n = __builtin_amdgcn_readfirstlane((int)cntp[qq]);
            if (n > 256) { select_rank(cand + qq * CAP, n, 256, 256, lane_b); n = 256; }
            asm volatile("s_waitcnt lgkmcnt(0)" ::: "memory");
            const LAS unsigned* cq = cand + qq * CAP;
            const size_t row = q0row + qq;
            u32x2 w;
            { const int k = 4 * lane_b; const unsigned e0 = k < n ? cq[k] : 8191u, e1 = k + 1 < n ? cq[k + 1] : 8191u, e2 = k + 2 < n ? cq[k + 2] : 8191u, e3 = k + 3 < n ? cq[k + 3] : 8191u;
              w.x = (8191u - (e0 & 8191u)) | ((8191u - (e1 & 8191u)) << 16); w.y = (8191u - (e2 & 8191u)) | ((8191u - (e3 & 8191u)) << 16); }
            *(u32x2*)(SEL + row * 256 + 4 * lane_b) = w;
            if (lane_b == 0) NSEL[row] = n;
        }
    }
    half_barrier(hb, lane);
    TOC(6);
}

__device__ __forceinline__ void attend_query(const Params& p, Frame& F, size_t qrow, const fp8* Kb, const fp8* Vb) {
    unsigned char* ws = p.ws;
    const bf16* Qb = (const bf16*)(ws + WS_Q); bf16* YC = (bf16*)(ws + WS_YC);
    const int lane_b = F.lane, qc_b = lane_b & 15, kq_b = lane_b >> 4, wid = F.wave;
    const int wb = wid * LRU_WLDS;
    LAS unsigned short* ix = (LAS unsigned short*)(F.lds + wb);
    LAS unsigned char* vst = F.lds + wb + 512;
    const int n = __builtin_amdgcn_readfirstlane(((const int*)(ws + WS_NSEL))[qrow]);
    *(LAS u32x2*)(ix + 4 * lane_b) = __builtin_nontemporal_load((const u32x2*)((const unsigned short*)(ws + WS_SEL) + qrow * 256 + 4 * lane_b));
    asm volatile("s_waitcnt lgkmcnt(0)" ::: "memory");
    const int h = lane_b & 15;
    long Bh8[4];
#pragma unroll
    for (int s = 0; s < 4; ++s) {
        const bool v = (h < 8) && ((h >> 2) == (kq_b >> 1));
        u32x4 raw = {0u, 0u, 0u, 0u};
        if (v) raw = __builtin_nontemporal_load((const u32x4*)(Qb + qrow * 512 + h * 64 + 32 * (kq_b & 1) + 8 * s));
        const unsigned lo = pk4_fp8(bflo(raw.x), bfhi(raw.x), bflo(raw.y), bfhi(raw.y)), hi = pk4_fp8(bflo(raw.z), bfhi(raw.z), bflo(raw.w), bfhi(raw.w));
        Bh8[s] = (long)(((unsigned long long)hi << 32) | lo);
    }
    float sc[64];
    u32x4 Kn[4][2];
#pragma unroll
    for (int t4 = 0; t4 < 4; ++t4) { const fp8* kr = Kb + (size_t)ix[t4 * 16 + qc_b] * KVW + 32 * kq_b; Kn[t4][0] = *(const u32x4*)kr; Kn[t4][1] = *(const u32x4*)(kr + 16); }
#pragma unroll
    for (int g4 = 0; g4 < 4; ++g4) {
        u32x4 Ka[4][2];
#pragma unroll
        for (int t4 = 0; t4 < 4; ++t4) { Ka[t4][0] = Kn[t4][0]; Ka[t4][1] = Kn[t4][1]; }
        if (g4 < 3) {
#pragma unroll
            for (int t4 = 0; t4 < 4; ++t4) { const fp8* kr = Kb + (size_t)ix[(g4 + 1) * 64 + t4 * 16 + qc_b] * KVW + 32 * kq_b; Kn[t4][0] = *(const u32x4*)kr; Kn[t4][1] = *(const u32x4*)(kr + 16); }
        }
#pragma unroll
        for (int t4 = 0; t4 < 4; ++t4) {
            f32x4 acc = {0.f, 0.f, 0.f, 0.f};
#pragma unroll
            for (int s = 0; s < 4; ++s) {
                const u32x4 kw = Ka[t4][s >> 1];
                const long a8 = (long)(((unsigned long long)((s & 1) ? kw.w : kw.y) << 32) | ((s & 1) ? kw.z : kw.x));
                acc = __builtin_amdgcn_mfma_f32_16x16x32_fp8_fp8(a8, Bh8[s], acc, 0, 0, 0);
            }
#pragma unroll
            for (int ii = 0; ii < 4; ++ii) { const int key = (g4 * 4 + t4) * 16 + 4 * kq_b + ii; sc[(g4 * 4 + t4) * 4 + ii] = key < n ? acc[ii] * 0.125f : -INFINITY; }
        }
        __builtin_amdgcn_sched_barrier(0);
    }
    float mx = sc[0];
#pragma unroll
    for (int j = 1; j < 64; ++j) mx = fmaxf(mx, sc[j]);
    mx = fmaxf(mx, __shfl_xor(mx, 16)); mx = fmaxf(mx, __shfl_xor(mx, 32));
    float sum = 0.f;
#pragma unroll
    for (int j = 0; j < 64; ++j) { sc[j] = __expf(sc[j] - mx); sum += sc[j]; }
    sum += __shfl_xor(sum, 16); sum += __shfl_xor(sum, 32);
    const float rl = 1.0f / sum;
    long pb8[8];
#pragma unroll
    for (int b = 0; b < 8; ++b) { const unsigned lo = pk4_fp8(sc[b * 8 + 0], sc[b * 8 + 1], sc[b * 8 + 2], sc[b * 8 + 3]), hi = pk4_fp8(sc[b * 8 + 4], sc[b * 8 + 5], sc[b * 8 + 6], sc[b * 8 + 7]);
        pb8[b] = (long)(((unsigned long long)hi << 32) | lo); }
    f32x4 oacc[8];
#pragma unroll
    for (int dt = 0; dt < 8; ++dt) oacc[dt] = (f32x4){0.f, 0.f, 0.f, 0.f};
    u32x4 vr[4], vr2[4];
    const int vrow = lane_b >> 3, vch = lane_b & 7;
#pragma unroll
    for (int i = 0; i < 4; ++i) { vr[i] = *(const u32x4*)(Vb + (size_t)ix[8 * i + vrow] * KVW + vch * 16); vr2[i] = *(const u32x4*)(Vb + (size_t)ix[32 + 8 * i + vrow] * KVW + vch * 16); }
    const int tq = qc_b >> 1, trow = (tq < 4) ? 4 * kq_b + tq : 16 + 4 * kq_b + (tq - 4);
    const LAS unsigned char* trb = vst + trow * KV8P + (qc_b & 1) * 8;
#pragma unroll
    for (int b = 0; b < 8; ++b) {
#pragma unroll
        for (int i = 0; i < 4; ++i) *(LAS u32x4*)(vst + (8 * i + vrow) * KV8P + vch * 16) = vr[i];
#pragma unroll
        for (int i = 0; i < 4; ++i) vr[i] = vr2[i];
        if (b < 6) {
#pragma unroll
            for (int i = 0; i < 4; ++i) vr2[i] = *(const u32x4*)(Vb + (size_t)ix[32 * (b + 2) + 8 * i + vrow] * KVW + vch * 16);
        }
        asm volatile("s_waitcnt lgkmcnt(0)" ::: "memory");
#pragma unroll
        for (int dt = 0; dt < 8; ++dt) {
            const v2i32_t t8 = __builtin_amdgcn_ds_read_tr8_b64_v2i32((LAS v2i32_t*)(trb + dt * 16));
            const long Av = (long)(((unsigned long long)(unsigned)t8[1] << 32) | (unsigned)t8[0]);
            oacc[dt] = __builtin_amdgcn_mfma_f32_16x16x32_fp8_fp8(Av, pb8[b], oacc[dt], 0, 0, 0);
        }
        asm volatile("s_waitcnt lgkmcnt(0)" ::: "memory");
        __builtin_amdgcn_sched_barrier(0);
    }
    if (h < 4) {
#pragma unroll
        for (int dd = 0; dd < 4; ++dd) { const f32x4 o = oacc[dd] * rl; u32x2 w; w.x = pk2(o[0], o[1]); w.y = pk2(o[2], o[3]); __builtin_nontemporal_store(w, (u32x2*)(YC + qrow * D + 512 + h * 64 + dd * 16 + 4 * kq_b)); }
    } else if (h < 8) {
#pragma unroll
        for (int dd = 0; dd < 4; ++dd) { const f32x4 o = oacc[4 + dd] * rl; u32x2 w; w.x = pk2(o[0], o[1]); w.y = pk2(o[2], o[3]); __builtin_nontemporal_store(w, (u32x2*)(YC + qrow * D + 512 + h * 64 + dd * 16 + 4 * kq_b)); }
    }
}

__device__ __forceinline__ void phase3(const Params& p, Frame& F) {
    unsigned char* ws = p.ws;
    lru_phase<0>(p, F);
    __syncthreads();
    TIC(9);
    TOC(9);
    {
        const int half = F.wave >> 2, htid = F.tid & 255;
        LAS unsigned* hb = (LAS unsigned*)(F.lds + A_HBAR + half * 16); LAS int* tick = (LAS int*)(F.lds + A_TICK + half * 16);
        if (htid == 0) { hb[0] = 0u; hb[1] = 0u; }
        __syncthreads();
        unsigned* ctr = (unsigned*)(ws + WS_CTL) + CW_QUEUE;
        for (int q = 2 * F.bid + half;;) {
            if (q >= 2048 + DB) break;
            size_t q0row; int L; const bf16* KI;
            const bool is_s = q >= 1024 && q < 1024 + DB;
            if (!is_s) {
                const int u = q < 1024 ? q : q - DB, chunk = 127 - (u >> 4), b = (u & 15) >> 2, quarter = u & 3;
                q0row = (size_t)b * SEQ + chunk * 64 + quarter * 16; L = 64 * (chunk + 1);
                KI = (const bf16*)(ws + WS_KIB) + (size_t)b * SEQ * 64;
            } else {
                const int s = q - 1024;
                q0row = (size_t)MP + s * DT; L = SKEYS;
                KI = (const bf16*)(ws + WS_KIS) + (size_t)s * SKEYS * 64;
            }
            select_unit(p, F, q0row, L, KI);
            if (htid == 0) *tick = (int)(2 * F.G + __hip_atomic_fetch_add(ctr, 1u, __ATOMIC_RELAXED, __HIP_MEMORY_SCOPE_AGENT));
            half_barrier(hb, F.lane);
            q = *tick;
            half_barrier(hb, F.lane);
        }
    }
}

__device__ __forceinline__ void phase4(const Params& p, Frame& F) {
    unsigned char* ws = p.ws;
    if (F.wave < 4) {
        for (int u = F.bid * 4 + F.wave; u < 2048 + 64; u += F.G * 4) {
            if (u < 2048) lru_unit<1>(p, F, u >> 9, u & 7, (u >> 3) & 63);
            else lru_unit<1>(p, F, NB + ((u - 2048) >> 3), (u - 2048) & 7, 0);
        }
    }
    const bool aff = (F.G & 7) == 0;
    const int x = F.bid & 7, b = aff ? (x >> 1) : (F.bid & 3);
    const int nwv = aff ? (F.G >> 2) * 8 : ((F.G + 3 - (F.bid & 3)) / 4) * 8;
    const int wv = aff ? ((F.bid >> 3) * 2 + (x & 1)) * 8 + F.wave : (F.bid >> 2) * 8 + F.wave;
    unsigned* ctr = (unsigned*)(ws + WS_CTL) + CW_QUEUE + 64 * (1 + b);
    const fp8* Kb = (const fp8*)(ws + WS_KB) + (size_t)b * SEQ * KVW; const fp8* Vb = (const fp8*)(ws + WS_VB) + (size_t)b * SEQ * KVW;
    for (int q = wv;;) {
        if (q >= SEQ + 2 * DT) break;
        if (q < SEQ) attend_query(p, F, (size_t)b * SEQ + q, Kb, Vb);
        else { const int qs = q - SEQ, s = 2 * b + (qs >> 4);
            attend_query(p, F, (size_t)MP + s * DT + (qs & 15), (const fp8*)(ws + WS_KS) + (size_t)s * SKEYS * KVW, (const fp8*)(ws + WS_VS) + (size_t)s * SKEYS * KVW); }
        unsigned t = 0u;
        if (F.lane == 0) t = __hip_atomic_fetch_add(ctr, 1u, __ATOMIC_RELAXED, __HIP_MEMORY_SCOPE_AGENT);
        q = nwv + __builtin_amdgcn_readfirstlane((int)t);
    }
}

__global__ void __launch_bounds__(512, 2) fwd_kernel(Params p) {
    extern __shared__ __attribute__((aligned(16))) unsigned char lds_raw[];
    Frame F; F.lds = (LAS unsigned char*)lds_raw; F.tid = threadIdx.x; F.lane = F.tid & 63; F.wave = __builtin_amdgcn_readfirstlane(F.tid >> 6); F.G = gridDim.x; F.bid = blockIdx.x;
    unsigned char* ws = p.ws;
    const int lo = p.ph_lo, hi = p.ph_hi;
#if !USE_CG_SYNC
    if (F.tid < 64) ((LAS unsigned*)(F.lds + LDSCTL_OFF))[F.tid] = 0u;
    __syncthreads();
    XcdBarrier xbar = xcd_barrier_post((unsigned*)(ws + WS_CTL) + CW_BAR, (volatile LAS unsigned*)(F.lds + LDSCTL_OFF));
#endif
#define IN(k) (lo <= (k) && (k) < hi)
#ifndef SKIPMASK
#define SKIPMASK 0
#endif
#define SKIP(k) ((SKIPMASK >> (k)) & 1)
#define REPS(k) for (int rep_ = 0; rep_ <= DUP(k); ++rep_, (rep_ <= DUP(k) ? GSYNC() : (void)0))
#if USE_CG_SYNC
#define GSYNC() cg::this_grid().sync()
#else
#define GSYNC() xcd_barrier(xbar)
#endif
#define SEAM(k) do { if (IN(k) && IN((k) + 1)) { GSYNC(); } } while (0)
    { TIC(20); if (IN(0) && !SKIP(0)) REPS(0) phase0(p, F); TOC(20); }
    { TIC(40); SEAM(0); TOC(40); }
    if (IN(1) && !SKIP(1)) REPS(1) {
        pg8::Gemm g{(const pg8::bf16_t*)(ws + WS_XB), (const pg8::bf16_t*)(ws + WS_WIN), MP, NIN, D};
        pg8::StaticOrder S; S.init(MP, NIN, F.G, F.bid);
        EpiInProj E{(const float*)(ws + WS_RSTD), (const float*)(ws + WS_RCOS), (const float*)(ws + WS_RSIN), p.in[I_QN], p.in[I_KN],
                    (bf16*)(ws + WS_XR), (bf16*)(ws + WS_GG), (bf16*)(ws + WS_Q), (bf16*)(ws + WS_QI), (fp8*)(ws + WS_KB), (fp8*)(ws + WS_VB), (bf16*)(ws + WS_KIB),
                    (fp8*)(ws + WS_KS), (fp8*)(ws + WS_VS), (bf16*)(ws + WS_KIS), (float*)(ws + WS_WI), p.out};
        { TIC(21); pg8::gemm_phase<EpiInProj, pg8::StaticOrder, true, true>(F.lds, g, S, E); TOC(21); }
        TIC(31);
        {
            const float* rstd = E.rstd + MP; const float* rcos = E.rcos; const float* rsin = E.rsin; const float* gq = E.gq; const float* gk = E.gk; float* out = p.out;
            bf16* XR = E.XR + (size_t)MP * LW; bf16* GG = E.GG + (size_t)MP * LW; bf16* Q = E.Q + (size_t)MP * 512; bf16* QI = E.QI + (size_t)MP * 512;
            fp8* KS = E.KS; fp8* VS = E.VS; bf16* KIS = E.KIS; float* WI = E.WI + (size_t)MP * 8;
            skinny_gemm<4, 4>(F, (const bf16*)(ws + WS_XB) + (size_t)MP * D, D, (const bf16*)(ws + WS_WIN), D, 38,
                [](int hb_, int nb, int r) { const int c = 64 * hb_ + 16 * nb + r, pn = c >> 8, wc = (c >> 6) & 3, bj = (c >> 5) & 1, w32 = c & 31, fq = w32 >> 3, n = (w32 >> 2) & 1, j = w32 & 3;
                                             return 256 * pn + 128 * bj + 32 * wc + 16 * n + 4 * fq + j; },
                [=](const f32x4 (&acc)[4], int r, int c0, int kq) {
                    const int hbk = c0 >> 4, sb = r >> 4, t = r & 15, pos = PAST + t;
                    const float rsd = rstd[r];
                    f32x4 v[4];
#pragma unroll
                    for (int nb = 0; nb < 4; ++nb) v[nb] = acc[nb] * rsd;
                    const bool norm = (hbk >= 16 && hbk < 26), rope = norm || (hbk >= 28 && hbk < 37);
                    if (norm) {
                        float ss = 0.f;
#pragma unroll
                        for (int nb = 0; nb < 4; ++nb) ss += (v[nb][0] * v[nb][0] + v[nb][1] * v[nb][1]) + (v[nb][2] * v[nb][2] + v[nb][3] * v[nb][3]);
                        ss += __shfl_xor(ss, 16); ss += __shfl_xor(ss, 32);
                        const float inv = rsqrtf(ss * (1.0f / 64.0f) + EPS); const float* g = hbk < 24 ? gq : gk;
#pragma unroll
                        for (int nb = 0; nb < 4; ++nb) v[nb] = v[nb] * inv * *(const f32x4*)(g + 16 * nb + 4 * kq);
                    }
                    if (rope) {
#pragma unroll
                        for (int nb = 0; nb < 2; ++nb) {
                            const f32x4 c4 = *(const f32x4*)(rcos + pos * 32 + 16 * nb + 4 * kq), s4 = *(const f32x4*)(rsin + pos * 32 + 16 * nb + 4 * kq);
                            const f32x4 x1 = v[nb], x2 = v[nb + 2];
                            v[nb] = x1 * c4 - x2 * s4; v[nb + 2] = x2 * c4 + x1 * s4;
                        }
                    }
#pragma unroll
                    for (int nb = 0; nb < 4; ++nb) {
                        const int d = 16 * nb + 4 * kq; const f32x4 x = v[nb];
                        u32x2 wb; wb.x = pg8::cvt_pk_bf16(x[0], x[1]); wb.y = pg8::cvt_pk_bf16(x[2], x[3]);
                        if (hbk < 8) {
                            const int c = 64 * hbk + d; *(u32x2*)(XR + (size_t)r * LW + c) = wb;
                            if (t >= DT - 3) *(f32x4*)(out + O_CS + ((size_t)(sb * 3 + (t - (DT - 3)))) * LW + c) = x;
                        } else if (hbk < 16) {
                            f32x4 gl; gl[0] = gelu_tanh(x[0]); gl[1] = gelu_tanh(x[1]); gl[2] = gelu_tanh(x[2]); gl[3] = gelu_tanh(x[3]);
                            u32x2 wg; wg.x = pg8::cvt_pk_bf16(gl[0], gl[1]); wg.y = pg8::cvt_pk_bf16(gl[2], gl[3]);
                            *(u32x2*)(GG + (size_t)r * LW + 64 * (hbk - 8) + d) = wg;
                        } else if (hbk < 24) { *(u32x2*)(Q + (size_t)r * 512 + 64 * (hbk - 16) + d) = wb;
                        } else if (hbk < 28) {
                            const int kvh = hbk & 1; const bool isk = hbk < 26;
                            *(f32x4*)(out + (isk ? O_KS : O_VS) + (size_t)r * KVW + kvh * 64 + d) = x;
                            *(unsigned*)((isk ? KS : VS) + ((size_t)sb * SKEYS + PAST + t) * KVW + kvh * 64 + d) = pk4_fp8(x[0], x[1], x[2], x[3]);
                        } else if (hbk < 36) { *(u32x2*)(QI + (size_t)r * 512 + 64 * (hbk - 28) + d) = wb;
                        } else if (hbk == 36) {
                            *(f32x4*)(out + O_KIS + (size_t)r * 64 + d) = x;
                            *(u32x2*)(KIS + ((size_t)sb * SKEYS + PAST + t) * 64 + d) = wb;
                        } else if (d < 8) { *(f32x4*)(WI + (size_t)r * 8 + d) = x * WI_SCALE; }
                    }
                });
        }
        TOC(31);
    }
    { TIC(41); SEAM(1); TOC(41); }
    { TIC(23); if (IN(2) && !SKIP(2)) REPS(2) phase3(p, F); TOC(23); }
    { TIC(43); SEAM(2); TOC(43); }
    { TIC(24); if (IN(3) && !SKIP(3)) REPS(3) phase4(p, F); TOC(24); }
    { TIC(44); SEAM(3); TOC(44); }
    if (IN(4) && !SKIP(4)) REPS(4) {
        pg8::Gemm g{(const pg8::bf16_t*)(ws + WS_YC), (const pg8::bf16_t*)(ws + WS_WOUT), MP, D, D};
        pg8::StaticOrder S; S.init(MP, D, F.G, F.bid);
        EpiOutProj E{p.in[I_XP], p.in[I_XS], p.out, (bf16*)(ws + WS_XB), (rep_ < DUP(4)) ? (float*)(ws + WS_CTL + 65536) : (float*)(ws + WS_SSQ)};
        { TIC(25); pg8::gemm_phase<EpiOutProj, pg8::StaticOrder, true, true>(F.lds, g, S, E); TOC(25); }
        TIC(35);
        {
            const float* xs = p.in[I_XS]; float* ys = p.out + O_YS; bf16* XB2 = (bf16*)(ws + WS_XB) + (size_t)MP * D; float* ssq = E.ssq + MP;
            skinny_gemm<1, 4>(F, (const bf16*)(ws + WS_YC) + (size_t)MP * D, D, (const bf16*)(ws + WS_WOUT), D, D / 16,
                [](int ct, int, int r) { return 16 * ct + r; },
                [=](const f32x4 (&acc)[1], int r, int c0, int) {
                    const f32x4 y = *(const f32x4*)(xs + (size_t)r * D + c0) + acc[0];
                    *(f32x4*)(ys + (size_t)r * D + c0) = y;
                    u32x2 w; w.x = pg8::cvt_pk_bf16(y[0], y[1]); w.y = pg8::cvt_pk_bf16(y[2], y[3]); *(u32x2*)(XB2 + (size_t)r * D + c0) = w;
                    float ss = (y[0] * y[0] + y[1] * y[1]) + (y[2] * y[2] + y[3] * y[3]);
                    ss += __shfl_xor(ss, 16); ss += __shfl_xor(ss, 32);
                    if ((threadIdx.x & 48) == 0) atomicAdd(ssq + r, ss);
                });
        }
        TOC(35);
    }
    { TIC(45); SEAM(4); TOC(45); }
    if (IN(5) && !SKIP(5)) REPS(5) {
        pg8::Gemm g{(const pg8::bf16_t*)(ws + WS_XB), (const pg8::bf16_t*)(ws + WS_WFI), MP, 2 * DFF, D};
        pg8::StaticOrder S; S.init(MP, 2 * DFF, F.G, F.bid);
        EpiFfnIn E{(const float*)(ws + WS_SSQ), (bf16*)(ws + WS_H)};
        { TIC(26); pg8::gemm_phase<EpiFfnIn, pg8::StaticOrder, true, true>(F.lds, g, S, E); TOC(26); }
        TIC(36);
        {
            const float* ssq = (const float*)(ws + WS_SSQ) + MP; bf16* H = (bf16*)(ws + WS_H) + (size_t)MP * DFF;
            skinny_gemm<2, 4>(F, (const bf16*)(ws + WS_XB) + (size_t)MP * D, D, (const bf16*)(ws + WS_WFI), D, DFF / 16,
                [](int ct, int nb, int r) { const int c = 16 * ct + r, pn = c >> 7, wc = (c >> 5) & 3, w32 = c & 31, fq = w32 >> 3, n = (w32 >> 2) & 1, j = w32 & 3; return 256 * pn + 128 * nb + 32 * wc + 16 * n + 4 * fq + j; },
                [=](const f32x4 (&acc)[2], int r, int c0, int) {
                    const float rs2 = rsqrtf(ssq[r] * (1.0f / 1024.0f) + EPS);
                    const f32x4 g = acc[0] * rs2, up = acc[1] * rs2; f32x4 h;
#pragma unroll
                    for (int j = 0; j < 4; ++j) h[j] = g[j] * sigmoidf_(g[j]) * up[j];
                    u32x2 w; w.x = pg8::cvt_pk_bf16(h[0], h[1]); w.y = pg8::cvt_pk_bf16(h[2], h[3]); *(u32x2*)(H + (size_t)r * DFF + c0) = w;
                });
        }
        TOC(36);
    }
    { TIC(46); SEAM(5); TOC(46); }
    if (IN(6) && !SKIP(6)) {
        pg8::Gemm g{(const pg8::bf16_t*)(ws + WS_H), (const pg8::bf16_t*)(ws + WS_WFO), MP, D, DFF};
        pg8::StaticOrder S; S.init(MP, D, F.G, F.bid);
        EpiFfnOut E{p.out, (const bf16*)(ws + WS_XB)};
        { TIC(27); pg8::gemm_phase<EpiFfnOut, pg8::StaticOrder, true, true>(F.lds, g, S, E); TOC(27); }
        TIC(37);
        {
            float* ys = p.out + O_YS;
            skinny_gemm<1, 11>(F, (const bf16*)(ws + WS_H) + (size_t)MP * DFF, DFF, (const bf16*)(ws + WS_WFO), DFF, D / 16,
                [](int ct, int, int r) { return 16 * ct + r; },
                [=](const f32x4 (&acc)[1], int r, int c0, int) { float* y = ys + (size_t)r * D + c0; *(f32x4*)y = *(const f32x4*)y + acc[0]; });
        }
        TOC(37);
    }
    if (TSEG && F.bid == 0 && F.tid == 0) { const unsigned acc_ = *(LAS unsigned*)(F.lds + LDSCTL_OFF + 128); const unsigned long long t0_ = __builtin_amdgcn_s_memrealtime(); while ((unsigned)(__builtin_amdgcn_s_memrealtime() - t0_) < acc_) __builtin_amdgcn_s_sleep(8); }
#undef IN
#undef SEAM
}

#ifndef N_LAUNCHES
#define N_LAUNCHES 1
#endif
constexpr int NPHASE = 7;
extern "C" void kernel_launch(void* const* d_in, const int* in_sizes, int n_in, void* d_out, int out_size, void* d_ws, size_t ws_size, hipStream_t stream) {
    static int grid = 0;
    if (grid == 0) {
        if (n_in != 22 || out_size != (int)O_END || ws_size < WS_END) { fprintf(stderr, "kernel_launch: unexpected shapes: n_in %d out %d ws %zu (need %zu)\n", n_in, out_size, ws_size, (size_t)WS_END); grid = -1; return; }
        int dev = 0, cus = 0, per_cu = 0;
        if (hipGetDevice(&dev) != hipSuccess || hipDeviceGetAttribute(&cus, hipDeviceAttributeMultiprocessorCount, dev) != hipSuccess) { grid = -1; return; }
        if (hipFuncSetAttribute((const void*)fwd_kernel, hipFuncAttributeMaxDynamicSharedMemorySize, LDS_BYTES) != hipSuccess) { fprintf(stderr, "kernel_launch: hipFuncSetAttribute failed\n"); grid = -1; return; }
        if (hipOccupancyMaxActiveBlocksPerMultiprocessor(&per_cu, (const void*)fwd_kernel, 512, LDS_BYTES) != hipSuccess || per_cu < 1) { fprintf(stderr, "kernel_launch: occupancy query says %d blocks/CU\n", per_cu); per_cu = 1; }
        (void)hipGetLastError();
        grid = cus;
    }
    if (grid < 0) return;
    if (!USE_CG_SYNC) { if (hipMemsetAsync((char*)d_ws + WS_CTL, 0, 65536, stream) != hipSuccess) { fprintf(stderr, "kernel_launch: memset failed\n"); return; } }
    Params p{};
    for (int i = 0; i < 22; ++i) p.in[i] = (const float*)d_in[i];
    p.out = (float*)d_out; p.ws = (unsigned char*)d_ws;
    for (int i = 0; i < 32; ++i) p.invf[i] = pow(10000.0, -(double)i / 32.0);
    if (N_LAUNCHES == 1) {
        p.ph_lo = 0; p.ph_hi = NPHASE;
        void* args[] = {&p};
        hipError_t e = hipLaunchCooperativeKernel((const void*)fwd_kernel, dim3(grid), dim3(512), args, LDS_BYTES, stream);
        if (e != hipSuccess) fprintf(stderr, "kernel_launch: cooperative launch failed: %s (grid %d)\n", hipGetErrorString(e), grid);
    } else {
        for (int k = 0; k < NPHASE; ++k) { p.ph_lo = k; p.ph_hi = k + 1; hipLaunchKernelGGL(fwd_kernel, dim3(grid), dim3(512), LDS_BYTES, stream, p); }
    }
}
```

```cpp
#include <hip/hip_runtime.h>
#include <hip/hip_cooperative_groups.h>
#include <cstdio>
#include <cstdint>
#include <cmath>
namespace cg = cooperative_groups;
namespace pg8 {
#define PG8_LAS __attribute__((address_space(3)))
typedef unsigned short bf16_t;
typedef short bf16x8 __attribute__((ext_vector_type(8)));
typedef float f32x4 __attribute__((ext_vector_type(4)));
typedef unsigned u32x4 __attribute__((ext_vector_type(4)));
constexpr int BM = 256, BK = 64, HALF = 128, HTB = HALF * BK * 2  , STAGE_BYTES = 8 * HTB, NXCD = 8, WGM = 8;

__host__ __device__ __forceinline__ int lds_byte(int r, int c) { const int st = (r >> 4) * 2 + (c >> 5), rr = r & 15, cc = c & 31, ob = rr * 64 + cc * 2; return st * 1024 + (ob ^ (((ob >> 9) & 1) << 5)); }
__host__ __device__ __forceinline__ void stage_rc(int b, int& R, int& C) { const int st = b / 1024, sb = b % 1024, swz = sb ^ (((sb >> 9) & 1) << 5); R = (st >> 1) * 16 + swz / 64; C = (st & 1) * 32 + (swz % 64) / 2; }
__host__ __device__ __forceinline__ int perm32(int rho) { const int n = rho >> 4, i = rho & 15; return 8 * (i >> 2) + 4 * n + (i & 3); }

struct Unit { int pm, pn; };
struct Gemm { const bf16_t* A; const bf16_t* Bt; int M, N, K; };

struct StaticOrder {
    int nM, nN, nwg, G, c;
    __host__ __device__ void init(int M, int N, int G_, int c_) { nM = M / BM; nN = N / BM; nwg = nM * nN; G = G_; c = c_; }
    __host__ __device__ bool next(int i, Unit& u) const {
        const long L = (long)i * G + c; if (L >= nwg) return false;
        int wgid = (int)L; { const int q = nwg / NXCD, r = nwg % NXCD, xcd = wgid % NXCD, off = wgid / NXCD; wgid = (xcd < r ? xcd * (q + 1) : r * (q + 1) + (xcd - r) * q) + off; }
        const int nig = WGM * nN, gid = wgid / nig, fm = gid * WGM, gsz = (nM - fm) < WGM ? (nM - fm) : WGM;
        u.pm = fm + ((wgid % nig) % gsz); u.pn = (wgid % nig) / gsz; return true;
    }
    __device__ __forceinline__ void a_ready(const Unit&) const {}
    __device__ __forceinline__ void done(const Unit&) const {}
};
__device__ __forceinline__ unsigned cvt_pk_bf16(float lo, float hi) { unsigned r; asm volatile("v_cvt_pk_bf16_f32 %0, %1, %2" : "=v"(r) : "v"(lo), "v"(hi)); return r; }
template <class Epi, class Sched, bool ALIGN_EPI = false, bool SP2 = false>
__device__ __forceinline__ void gemm_phase(PG8_LAS unsigned char* lds, const Gemm g, const Sched& S, const Epi& E) {
    const int tid = threadIdx.x, wid = __builtin_amdgcn_readfirstlane(tid >> 6), lane = tid & 63, wr = wid >> 2, wc = wid & 3, fr = lane & 15, fq = lane >> 4;
    const int K = g.K, nt = K / BK;
    unsigned voffA[2], voffB[2];
#pragma unroll
    for (int i = 0; i < 2; ++i) { int R, C; stage_rc(tid * 16 + i * 8192, R, C); const int Rb = Epi::PERM ? ((R & ~31) + perm32(R & 31)) : R;
        voffA[i] = (unsigned)(R * K + C) * 2u; voffB[i] = (unsigned)(Rb * K + C) * 2u; }
    const size_t kstep = (size_t)(BK * 2);
    const size_t hstep = (size_t)HALF * K * 2;
    const size_t tstep = 2 * hstep;
    const unsigned ldsw = (unsigned)wid * 1024u;
    const int aoff = lds_byte(wr * 64 + fr, fq * 8), boff = lds_byte(wc * 32 + fr, fq * 8);
#define PG8_SA(b, h) (((b) * 2 + (h)) * HTB)
#define PG8_SB(b, h) ((4 + (b) * 2 + (h)) * HTB)
#define PG8_STAGE(bufoff, gbase, voff) do { _Pragma("unroll") for (int _i = 0; _i < 2; ++_i) \
        __builtin_amdgcn_global_load_lds((const unsigned*)((const char*)(gbase) + (voff)[_i]), (PG8_LAS unsigned*)(lds + (bufoff) + ldsw + _i * 8192), 16, 0, 0); } while (0)
#define PG8_LDA(dst, b, h) do { _Pragma("unroll") for (int m = 0; m < 4; ++m) _Pragma("unroll") for (int k = 0; k < 2; ++k) dst[m][k] = *(const PG8_LAS bf16x8*)(lds + PG8_SA(b, h) + aoff + m * 2048 + k * 1024); } while (0)
#define PG8_LDB(dst, b, h) do { _Pragma("unroll") for (int n = 0; n < 2; ++n) _Pragma("unroll") for (int k = 0; k < 2; ++k) dst[n][k] = *(const PG8_LAS bf16x8*)(lds + PG8_SB(b, h) + boff + n * 2048 + k * 1024); } while (0)
#define PG8_MMA(ai, bj, At, Bt) do { __builtin_amdgcn_s_setprio(1); _Pragma("unroll") for (int m = 0; m < 4; ++m) _Pragma("unroll") for (int n = 0; n < 2; ++n) _Pragma("unroll") for (int k = 0; k < 2; ++k) \
        acc[ai][bj][m][n] = __builtin_amdgcn_mfma_f32_16x16x32_bf16(Bt[n][k], At[m][k], acc[ai][bj][m][n], 0, 0, 0); __builtin_amdgcn_s_setprio(0); } while (0)
#define PG8_WAIT_V(n) asm volatile("s_waitcnt vmcnt(" #n ")" ::: "memory")
#define PG8_WAIT_L(n) asm volatile("s_waitcnt lgkmcnt(" #n ")" ::: "memory")
#define PG8_BAR __builtin_amdgcn_s_barrier()
#define PG8_SCHED __builtin_amdgcn_sched_barrier(0)
    Unit cur, nxt; int ui = 0;
    if (!S.next(0, cur)) return;
    f32x4 acc[2][2][4][2];
#pragma unroll
    for (int a = 0; a < 2; ++a)
#pragma unroll
        for (int b = 0; b < 2; ++b)
#pragma unroll
            for (int m = 0; m < 4; ++m)
#pragma unroll
                for (int n = 0; n < 2; ++n) acc[a][b][m][n] = (f32x4){0.f, 0.f, 0.f, 0.f};
    bf16x8 At[4][2], B0[2][2], B1[2][2];
    const char* cA = (const char*)g.A + (size_t)cur.pm * tstep; const char* cB = (const char*)g.Bt + (size_t)cur.pn * tstep;
    S.a_ready(cur);
    if constexpr (SP2) {
        PG8_STAGE(PG8_SB(0, 0), cB, voffB); PG8_STAGE(PG8_SB(0, 1), cB + hstep, voffB); PG8_STAGE(PG8_SA(0, 0), cA, voffA); PG8_STAGE(PG8_SA(0, 1), cA + hstep, voffA);
        if (wr == 1) PG8_BAR;
        PG8_WAIT_V(2); PG8_BAR;
        PG8_STAGE(PG8_SB(1, 0), cB + kstep, voffB); PG8_STAGE(PG8_SA(1, 0), cA + kstep, voffA); PG8_STAGE(PG8_SB(1, 1), cB + hstep + kstep, voffB);
        PG8_WAIT_V(6); PG8_BAR;
    } else {
        PG8_STAGE(PG8_SB(0, 0), cB, voffB); PG8_STAGE(PG8_SA(0, 0), cA, voffA); PG8_STAGE(PG8_SB(0, 1), cB + hstep, voffB); PG8_STAGE(PG8_SA(0, 1), cA + hstep, voffA);
        if (wr == 1) PG8_BAR;
        PG8_WAIT_V(4); PG8_BAR;
        PG8_STAGE(PG8_SB(1, 0), cB + kstep, voffB); PG8_STAGE(PG8_SA(1, 0), cA + kstep, voffA); PG8_STAGE(PG8_SB(1, 1), cB + hstep + kstep, voffB);
        PG8_WAIT_V(6); PG8_BAR;
    }
    for (;;) {
        const bool has_next = S.next(ui + 1, nxt);
        const char* nA = has_next ? (const char*)g.A + (size_t)nxt.pm * tstep : cA; const char* nB = has_next ? (const char*)g.Bt + (size_t)nxt.pn * tstep : cB;
        for (int t = 0; t < nt; t += 2) {
            const bool last = (t == nt - 2);
            const char* a1 = cA + (size_t)(t + 1) * kstep;
            const char* a2 = last ? nA : cA + (size_t)(t + 2) * kstep; const char* b2 = last ? nB : cB + (size_t)(t + 2) * kstep;
            const char* a3 = a2 + kstep; const char* b3 = b2 + kstep;
            if (last && has_next) S.a_ready(nxt);
            if constexpr (SP2) {
            PG8_LDB(B0, 0, 0); PG8_LDB(B1, 0, 1); PG8_SCHED; PG8_LDA(At, 0, 0); PG8_STAGE(PG8_SA(1, 1), a1 + hstep, voffA);
            PG8_WAIT_V(8); PG8_WAIT_L(0); PG8_BAR; PG8_MMA(0, 0, At, B0); PG8_MMA(0, 1, At, B1); PG8_BAR; PG8_SCHED;
            PG8_LDA(At, 0, 1); PG8_STAGE(PG8_SB(0, 0), b2, voffB); PG8_STAGE(PG8_SB(0, 1), b2 + hstep, voffB); PG8_STAGE(PG8_SA(0, 0), a2, voffA);
            PG8_WAIT_V(8); PG8_WAIT_L(0); PG8_BAR; PG8_MMA(1, 0, At, B0); PG8_MMA(1, 1, At, B1); PG8_BAR; PG8_SCHED;
            PG8_LDB(B0, 1, 0); PG8_LDB(B1, 1, 1); PG8_SCHED; PG8_LDA(At, 1, 0); PG8_STAGE(PG8_SA(0, 1), a2 + hstep, voffA);
            PG8_WAIT_V(8); PG8_WAIT_L(0); PG8_BAR; PG8_MMA(0, 0, At, B0); PG8_MMA(0, 1, At, B1); PG8_BAR; PG8_SCHED;
            PG8_LDA(At, 1, 1); PG8_STAGE(PG8_SB(1, 0), b3, voffB); PG8_STAGE(PG8_SB(1, 1), b3 + hstep, voffB); PG8_STAGE(PG8_SA(1, 0), a3, voffA);
            PG8_WAIT_V(8); PG8_WAIT_L(0); PG8_BAR; PG8_MMA(1, 0, At, B0); PG8_MMA(1, 1, At, B1); PG8_BAR; PG8_SCHED;
            } else {
            PG8_LDB(B0, 0, 0); PG8_SCHED; PG8_LDA(At, 0, 0); PG8_STAGE(PG8_SA(1, 1), a1 + hstep, voffA);
            PG8_WAIT_L(8); PG8_BAR; PG8_WAIT_L(0); PG8_MMA(0, 0, At, B0); PG8_BAR; PG8_SCHED;
            PG8_LDB(B1, 0, 1); PG8_STAGE(PG8_SB(0, 0), b2, voffB);
            PG8_BAR; PG8_WAIT_L(0); PG8_MMA(0, 1, At, B1); PG8_BAR;
            PG8_LDA(At, 0, 1); PG8_STAGE(PG8_SA(0, 0), a2, voffA);
            PG8_BAR; PG8_WAIT_L(0); PG8_MMA(1, 0, At, B0); PG8_BAR; PG8_SCHED;
            PG8_STAGE(PG8_SB(0, 1), b2 + hstep, voffB);
            PG8_WAIT_V(6); PG8_BAR; PG8_MMA(1, 1, At, B1); PG8_BAR;
            PG8_LDB(B0, 1, 0); PG8_SCHED; PG8_LDA(At, 1, 0); PG8_STAGE(PG8_SA(0, 1), a2 + hstep, voffA);
            PG8_WAIT_L(8); PG8_BAR; PG8_WAIT_L(0); PG8_MMA(0, 0, At, B0); PG8_BAR; PG8_SCHED;
            PG8_LDB(B1, 1, 1); PG8_STAGE(PG8_SB(1, 0), b3, voffB);
            PG8_BAR; PG8_WAIT_L(0); PG8_MMA(0, 1, At, B1); PG8_BAR;
            PG8_LDA(At, 1, 1); PG8_STAGE(PG8_SA(1, 0), a3, voffA);
            PG8_BAR; PG8_WAIT_L(0); PG8_MMA(1, 0, At, B0); PG8_BAR; PG8_SCHED;
            PG8_STAGE(PG8_SB(1, 1), b3 + hstep, voffB);
            PG8_WAIT_V(6); PG8_BAR; PG8_MMA(1, 1, At, B1); PG8_BAR;
            }
        }
        if constexpr (ALIGN_EPI) { if (wr == 0) PG8_BAR; }
        if constexpr (!Epi::AFTER_DRAIN) { E(acc, cur, wr, wc, fr, fq); S.done(cur); }
        if (!has_next) break;
#pragma unroll
        for (int a = 0; a < 2; ++a)
#pragma unroll
            for (int b = 0; b < 2; ++b)
#pragma unroll
                for (int m = 0; m < 4; ++m)
#pragma unroll
                    for (int n = 0; n < 2; ++n) acc[a][b][m][n] = (f32x4){0.f, 0.f, 0.f, 0.f};
        cur = nxt; cA = nA; cB = nB; ++ui;
        if constexpr (ALIGN_EPI) { if (wr == 1) PG8_BAR; }
    }
    PG8_WAIT_V(0);
    if constexpr (!ALIGN_EPI) { if (wr == 0) PG8_BAR; }
    PG8_BAR;
    if constexpr (Epi::AFTER_DRAIN) { E.fused(acc, cur, wr, wc, fr, fq, lds, wid, lane); S.done(cur); }
#undef PG8_SA
#undef PG8_SB
#undef PG8_STAGE
#undef PG8_LDA
#undef PG8_LDB
#undef PG8_MMA
#undef PG8_WAIT_V
#undef PG8_WAIT_L
#undef PG8_BAR
#undef PG8_SCHED
}
}

constexpr int D = 1024, NB = 4, SEQ = 8192, DB = 8, DT = 16, PAST = 4096;
constexpr int MP = NB * SEQ;
constexpr int MS = DB * DT;
constexpr int MR = MP + MS;
constexpr int M = 33024;
constexpr int LW = 512, NLB = 8, LBW = 64;
constexpr int KVW = 128;
constexpr int DIN = 2376, NIN = 2560;
constexpr int DFF = 2816;
constexpr int SKEYS = PAST + DT;
constexpr float EPS = 1e-6f;
constexpr float WI_SCALE = 0.044194173824159216f;

constexpr size_t O_YP = 0;
constexpr size_t O_YS = O_YP + (size_t)MP * D;
constexpr size_t O_KP = O_YS + (size_t)MS * D;
constexpr size_t O_VP = O_KP + (size_t)MP * KVW;
constexpr size_t O_KIP = O_VP + (size_t)MP * KVW;
constexpr size_t O_HP = O_KIP + (size_t)MP * 64;
constexpr size_t O_CP = O_HP + (size_t)NB * LW;
constexpr size_t O_KS = O_CP + (size_t)NB * 3 * LW;
constexpr size_t O_VS = O_KS + (size_t)MS * KVW;
constexpr size_t O_KIS = O_VS + (size_t)MS * KVW;
constexpr size_t O_HS = O_KIS + (size_t)MS * 64;
constexpr size_t O_CS = O_HS + (size_t)DB * LW;
constexpr size_t O_END = O_CS + (size_t)DB * 3 * LW;
static_assert(O_END == 44236800, "output size");

constexpr size_t al256(size_t x) { return (x + 255) & ~(size_t)255; }
constexpr size_t WS_CTL = 0, CTL_BYTES = 1u << 20;
constexpr size_t WS_WIN = WS_CTL + CTL_BYTES;
constexpr size_t WS_WOUT = WS_WIN + al256((size_t)NIN * D * 2);
constexpr size_t WS_WFI = WS_WOUT + al256((size_t)D * D * 2);
constexpr size_t WS_WFO = WS_WFI + al256((size_t)2 * DFF * D * 2);
constexpr size_t WS_WG = WS_WFO + al256((size_t)D * DFF * 2);
constexpr size_t WS_RCOS = WS_WG + al256((size_t)2 * 8 * 64 * 64 * 2);
constexpr size_t WS_RSIN = WS_RCOS + al256((size_t)8192 * 32 * 4);
constexpr size_t WS_SP = WS_RSIN + al256((size_t)8192 * 32 * 4);
constexpr size_t WS_RSTD = WS_SP + al256(512 * 4);
constexpr size_t WS_SSQ = WS_RSTD + al256((size_t)M * 4);
constexpr size_t WS_WI = WS_SSQ + al256((size_t)M * 4);
constexpr size_t WS_AGG = WS_WI + al256((size_t)M * 8 * 4);
constexpr size_t WS_XB = WS_AGG + al256((size_t)12 * 64 * 512 * 8);
constexpr size_t WS_YC = WS_XB + al256((size_t)M * D * 2);
constexpr size_t WS_KB = WS_YC + al256((size_t)M * D * 2);
constexpr size_t WS_VB = WS_KB + al256((size_t)MP * KVW * 2);
constexpr size_t WS_KIB = WS_VB + al256((size_t)MP * KVW * 2);
constexpr size_t WS_KS = WS_KIB + al256((size_t)MP * 64 * 2);
constexpr size_t WS_VS = WS_KS + al256((size_t)DB * SKEYS * KVW * 2);
constexpr size_t WS_KIS = WS_VS + al256((size_t)DB * SKEYS * KVW * 2);
constexpr size_t WS_R1 = WS_KIS + al256((size_t)DB * SKEYS * 64 * 2);
constexpr size_t WS_XR = WS_R1;
constexpr size_t WS_GG = WS_XR + al256((size_t)M * LW * 2);
constexpr size_t WS_Q = WS_GG + al256((size_t)M * LW * 2);
constexpr size_t WS_QI = WS_Q + al256((size_t)M * LW * 2);
constexpr size_t WS_ACUM = WS_QI + al256((size_t)M * LW * 2);
constexpr size_t WS_BCUM = WS_ACUM + al256((size_t)M * LW * 4);
constexpr size_t WS_R1_END = WS_BCUM + al256((size_t)M * LW * 4);
constexpr size_t WS_H = WS_R1;
static_assert(WS_H + (size_t)M * DFF * 2 <= WS_R1_END, "H overlay fits");
constexpr size_t WS_CANDG = WS_ACUM;
static_assert(WS_CANDG + (size_t)M * 1024 * 4 <= WS_R1_END, "candidate lists fit");
constexpr size_t WS_SEL = WS_R1_END;
constexpr size_t WS_NSEL = WS_SEL + al256((size_t)M * 256 * 2);
constexpr size_t WS_END = WS_NSEL + al256((size_t)M * 4);

#ifndef DUPMASK
#define DUPMASK 0
#endif
#define DUP(k) ((DUPMASK >> (k)) & 1)
#ifndef USE_CG_SYNC
#define USE_CG_SYNC 0
#endif
constexpr int CW_QUEUE = 2048;
constexpr int CW_BAR = 4096;
constexpr int LDSCTL_OFF = 131072 + 1024;
#ifndef FORCE_FALLBACK
#define FORCE_FALLBACK 0
#endif
#ifndef FORCE_SAFE_MODE
#define FORCE_SAFE_MODE 0
#endif
#ifndef TSEG
#define TSEG 0
#endif
#define TIC(id) unsigned long long tic_##id = (TSEG == (id)) ? __builtin_amdgcn_s_memrealtime() : 0ull
#define TOC(id) do { if (TSEG == (id) && F.bid == 0 && F.wave == 0) { const unsigned d_ = (unsigned)(__builtin_amdgcn_s_memrealtime() - tic_##id); if (F.lane == 0) { LAS unsigned* a_ = (LAS unsigned*)(F.lds + LDSCTL_OFF + 128); *a_ += d_; } } } while (0)
constexpr int LDS_BYTES = 147456;

#define LAS __attribute__((address_space(3)))
typedef unsigned short bf16;
typedef float f32x4 __attribute__((ext_vector_type(4)));
typedef float f32x2 __attribute__((ext_vector_type(2)));
typedef unsigned u32x4 __attribute__((ext_vector_type(4)));
typedef unsigned u32x2 __attribute__((ext_vector_type(2)));
typedef short bf16x8 __attribute__((ext_vector_type(8)));

__device__ __forceinline__ unsigned pk2(float lo, float hi) { unsigned r; asm("v_cvt_pk_bf16_f32 %0, %1, %2" : "=v"(r) : "v"(lo), "v"(hi)); return r; }
__device__ __forceinline__ unsigned f2bf(float f) { return pk2(f, 0.f) & 0xffffu; }
__device__ __forceinline__ float bf2f(unsigned b) { return __builtin_bit_cast(float, b << 16); }
__device__ __forceinline__ float bflo(unsigned w) { return __builtin_bit_cast(float, w << 16); }
__device__ __forceinline__ float bfhi(unsigned w) { return __builtin_bit_cast(float, w & 0xffff0000u); }
__device__ __forceinline__ void store_bf16x8(bf16* p, f32x4 lo, f32x4 hi) {
    u32x4 w; w.x = pg8::cvt_pk_bf16(lo[0], lo[1]); w.y = pg8::cvt_pk_bf16(lo[2], lo[3]); w.z = pg8::cvt_pk_bf16(hi[0], hi[1]); w.w = pg8::cvt_pk_bf16(hi[2], hi[3]);
    *(u32x4*)p = w;
}
typedef unsigned char fp8;
__device__ __forceinline__ unsigned pk4_fp8(float a, float b, float c, float d) { int w = __builtin_amdgcn_cvt_pk_fp8_f32(a, b, 0, false); w = __builtin_amdgcn_cvt_pk_fp8_f32(c, d, w, true); return (unsigned)w; }
__device__ __forceinline__ void store_fp8x8(fp8* p, f32x4 lo, f32x4 hi) { u32x2 w; w.x = pk4_fp8(lo[0], lo[1], lo[2], lo[3]); w.y = pk4_fp8(hi[0], hi[1], hi[2], hi[3]); *(u32x2*)p = w; }
__device__ __forceinline__ u32x2 fp8x4_bf16x4(unsigned w) {
    const f32x2 a = __builtin_amdgcn_cvt_pk_f32_fp8((int)w, false); const f32x2 b = __builtin_amdgcn_cvt_pk_f32_fp8((int)w, true);
    const float a0 = a.x, a1 = a.y, b0 = b.x, b1 = b.y;
    u32x2 o; o.x = __builtin_amdgcn_perm(__float_as_uint(a1), __float_as_uint(a0), 0x07060302u); o.y = __builtin_amdgcn_perm(__float_as_uint(b1), __float_as_uint(b0), 0x07060302u);
    return o;
}
__device__ __forceinline__ float gelu_tanh(float x) {
    const float u = 0.7978845608028654f * (x + 0.044715f * x * x * x);
    const float e = __expf(2.0f * u);
    const float th = 1.0f - 2.0f * __builtin_amdgcn_rcpf(e + 1.0f);
    return 0.5f * x * (1.0f + th);
}
__device__ __forceinline__ float sigmoidf_(float x) { return __builtin_amdgcn_rcpf(1.0f + __expf(-x)); }

#define XB_TMO      128
#define XB_XCNT(j)  (256  + 64 * (j))
#define XB_XSUB(j)  (1280 + 64 * (j))
#define XB_XGEN(j)  (2304 + 64 * (j))
#define XB_TOP      3328
#define XB_TOPGEN   3392
#define XCD_BAR_WORDS 3456
#define XB_SPIN_CAP (1u << 18)

__device__ __forceinline__ unsigned xb_ld(unsigned* p)              { return __hip_atomic_load(p, __ATOMIC_RELAXED, __HIP_MEMORY_SCOPE_AGENT); }
__device__ __forceinline__ unsigned xb_add(unsigned* p, unsigned v) { return __hip_atomic_fetch_add(p, v, __ATOMIC_RELAXED, __HIP_MEMORY_SCOPE_AGENT); }
__device__ __forceinline__ unsigned xb_xcc_id() { return (unsigned)__builtin_amdgcn_s_getreg((3 << 11) | 20) & 0xFu; }
#define XB_SPIN(cond, bar) do { unsigned _sp = 0; while (cond) { __builtin_amdgcn_s_sleep(1); \
    if ((++_sp & 255u) == 0u) { if (xb_ld(&(bar)[XB_TMO])) break; if (_sp > XB_SPIN_CAP) { atomicAdd(&(bar)[XB_TMO], 1u); break; } } } } while (0)

struct XcdBarrier {
    unsigned* bar; unsigned x;
    volatile LAS unsigned* st;
};

__device__ __forceinline__ XcdBarrier xcd_barrier_post(unsigned* bar, volatile LAS unsigned* st) {
    XcdBarrier b; b.bar = bar; b.x = xb_xcc_id(); b.st = st;
    if (threadIdx.x == 0) (void)xb_add(&bar[XB_XCNT(b.x)], 1u);
    return b;
}
__device__ __forceinline__ void xcd_barrier_complete(unsigned* bar, unsigned x, unsigned& nloc, unsigned& nx) {
    const unsigned G = gridDim.x * gridDim.y * gridDim.z;
    unsigned sum, cnt, mine, sp = 0u;
    for (;;) {
        sum = 0u; cnt = 0u; mine = 0u;
#pragma unroll
        for (unsigned j = 0; j < 16; ++j) { const unsigned c = xb_ld(&bar[XB_XCNT(j)]); sum += c; cnt += (c > 0u) ? 1u : 0u; mine = (j == x) ? c : mine; }
        if (sum == G) break;
        __builtin_amdgcn_s_sleep(1);
        if ((++sp & 255u) == 0u) { if (xb_ld(&bar[XB_TMO])) break; if (sp > XB_SPIN_CAP) { atomicAdd(&bar[XB_TMO], 1u); break; } }
    }
    nloc = mine > 0u ? mine : 1u; nx = cnt > 0u ? cnt : 1u;
}

__device__ __forceinline__ void xcd_barrier(const XcdBarrier& b) {
    asm volatile("s_waitcnt vmcnt(0)" ::: "memory");
    __syncthreads();
    if (threadIdx.x == 0) {
        unsigned* bar = b.bar;
        __builtin_amdgcn_s_waitcnt(0);
        unsigned nloc = b.st[0], nx = b.st[1];
        if (nloc == 0u) { xcd_barrier_complete(bar, b.x, nloc, nx); b.st[0] = nloc; b.st[1] = nx; }
        const unsigned old = xb_add(&bar[XB_XSUB(b.x)], 1u);
        const unsigned gen = old / nloc;
        if (old + 1u == (gen + 1u) * nloc) {
            __builtin_amdgcn_fence(__ATOMIC_RELEASE, "agent");
            asm volatile("s_waitcnt vmcnt(0)" ::: "memory");
            const unsigned og = xb_add(&bar[XB_TOP], 1u);
            const unsigned tg = og / nx;
            if (og + 1u == (tg + 1u) * nx) xb_add(&bar[XB_TOPGEN], 1u);
            else XB_SPIN(xb_ld(&bar[XB_TOPGEN]) == tg, bar);
            __builtin_amdgcn_fence(__ATOMIC_ACQUIRE, "agent");
            xb_add(&bar[XB_XGEN(b.x)], 1u);
            asm volatile("s_waitcnt vmcnt(0)" ::: "memory");
        } else {
            XB_SPIN(xb_ld(&bar[XB_XGEN(b.x)]) == gen, bar);
            __builtin_amdgcn_fence(__ATOMIC_ACQUIRE, "agent");
            asm volatile("s_waitcnt vmcnt(0)" ::: "memory");
        }
    }
    __syncthreads();
}
struct EpiInProj {
    static constexpr bool PERM = false, AFTER_DRAIN = false;
    const float* rstd; const float* rcos; const float* rsin; const float* gq; const float* gk;
    bf16* XR; bf16* GG; bf16* Q; bf16* QI; fp8* KB; fp8* VB; bf16* KIB; fp8* KS; fp8* VS; bf16* KIS; float* WI; float* out;

    template <bool NORM> __device__ __forceinline__ void head_rope(f32x4 (&v)[2][2], const float* g, int pos, int fq) const {
        if (NORM) {
            float ss = 0.f;
#pragma unroll
            for (int bj = 0; bj < 2; ++bj)
#pragma unroll
                for (int n = 0; n < 2; ++n) ss += (v[bj][n][0] * v[bj][n][0] + v[bj][n][1] * v[bj][n][1]) + (v[bj][n][2] * v[bj][n][2] + v[bj][n][3] * v[bj][n][3]);
            ss += __shfl_xor(ss, 16); ss += __shfl_xor(ss, 32);
            const float inv = rsqrtf(ss * (1.0f / 64.0f) + EPS);
#pragma unroll
            for (int bj = 0; bj < 2; ++bj)
#pragma unroll
                for (int n = 0; n < 2; ++n) { const f32x4 g4 = *(const f32x4*)(g + 32 * bj + 8 * fq + 4 * n); v[bj][n] = v[bj][n] * inv * g4; }
        }
#pragma unroll
        for (int n = 0; n < 2; ++n) {
            const f32x4 c4 = *(const f32x4*)(rcos + pos * 32 + 8 * fq + 4 * n), s4 = *(const f32x4*)(rsin + pos * 32 + 8 * fq + 4 * n);
            const f32x4 x1 = v[0][n], x2 = v[1][n];
            v[0][n] = x1 * c4 - x2 * s4; v[1][n] = x2 * c4 + x1 * s4;
        }
    }
    __device__ __forceinline__ void operator()(const f32x4 (&acc)[2][2][4][2], const pg8::Unit& u, int wr, int wc, int fr, int fq) const {
        const int pn = u.pn;
#pragma unroll
        for (int ai = 0; ai < 2; ++ai) {
            const int rbase = u.pm * 256 + ai * 128;
            if (rbase >= MR) continue;
            const bool samp = rbase >= MP;
#pragma unroll
            for (int m = 0; m < 4; ++m) {
                const int r = rbase + wr * 64 + m * 16 + fr;
                int sb, t, pos;
                if (!samp) { sb = r >> 13; t = r & 8191; pos = t; } else { const int rs = r - MP; sb = rs >> 4; t = rs & 15; pos = PAST + t; }
                const float rsd = rstd[r];
                f32x4 v[2][2];
#pragma unroll
                for (int bj = 0; bj < 2; ++bj)
#pragma unroll
                    for (int n = 0; n < 2; ++n) v[bj][n] = acc[ai][bj][m][n] * rsd;
                if (pn < 2) {
#pragma unroll
                    for (int bj = 0; bj < 2; ++bj) {
                        const int c = 256 * pn + 64 * wc + 32 * bj + 8 * fq;
                        store_bf16x8(XR + (size_t)r * LW + c, v[bj][0], v[bj][1]);
                        const int tl = samp ? DT - 3 : SEQ - 3;
                        if (t >= tl) {
                            float* o = samp ? out + O_CS + ((size_t)(sb * 3 + (t - tl))) * LW + c : out + O_CP + ((size_t)(sb * 3 + (t - tl))) * LW + c;
                            *(f32x4*)o = v[bj][0]; *(f32x4*)(o + 4) = v[bj][1];
                        }
                    }
                } else if (pn < 4) {
#pragma unroll
                    for (int bj = 0; bj < 2; ++bj) {
                        const int c = 256 * (pn - 2) + 64 * wc + 32 * bj + 8 * fq;
                        f32x4 a = v[bj][0], b = v[bj][1];
#pragma unroll
                        for (int j = 0; j < 4; ++j) { a[j] = gelu_tanh(a[j]); b[j] = gelu_tanh(b[j]); }
                        store_bf16x8(GG + (size_t)r * LW + c, a, b);
                    }
                } else if (pn < 6) {
                    head_rope<true>(v, gq, pos, fq);
                    const int head = 4 * (pn - 4) + wc;
#pragma unroll
                    for (int bj = 0; bj < 2; ++bj) store_bf16x8(Q + (size_t)r * 512 + head * 64 + 32 * bj + 8 * fq, v[bj][0], v[bj][1]);
                } else if (pn == 6) {
                    if (wc < 2) head_rope<true>(v, gk, pos, fq);
                    const int hh = wc & 1;
                    float* of; fp8* ob;
                    if (wc < 2) { of = samp ? out + O_KS + (size_t)(r - MP) * KVW : out + O_KP + (size_t)r * KVW; ob = samp ? KS + ((size_t)sb * SKEYS + PAST + t) * KVW : KB + (size_t)r * KVW; }
                    else        { of = samp ? out + O_VS + (size_t)(r - MP) * KVW : out + O_VP + (size_t)r * KVW; ob = samp ? VS + ((size_t)sb * SKEYS + PAST + t) * KVW : VB + (size_t)r * KVW; }
#pragma unroll
                    for (int bj = 0; bj < 2; ++bj) {
                        const int c = hh * 64 + 32 * bj + 8 * fq;
                        *(f32x4*)(of + c) = v[bj][0]; *(f32x4*)(of + c + 4) = v[bj][1];
                        store_fp8x8(ob + c, v[bj][0], v[bj][1]);
                    }
                } else if (pn < 9) {
                    head_rope<false>(v, nullptr, pos, fq);
                    const int head = 4 * (pn - 7) + wc;
#pragma unroll
                    for (int bj = 0; bj < 2; ++bj) store_bf16x8(QI + (size_t)r * 512 + head * 64 + 32 * bj + 8 * fq, v[bj][0], v[bj][1]);
                } else {
                    if (wc == 0) {
                        head_rope<false>(v, nullptr, pos, fq);
                        float* of = samp ? out + O_KIS + (size_t)(r - MP) * 64 : out + O_KIP + (size_t)r * 64;
                        bf16* ob = samp ? KIS + ((size_t)sb * SKEYS + PAST + t) * 64 : KIB + (size_t)r * 64;
#pragma unroll
                        for (int bj = 0; bj < 2; ++bj) {
                            const int c = 32 * bj + 8 * fq;
                            *(f32x4*)(of + c) = v[bj][0]; *(f32x4*)(of + c + 4) = v[bj][1];
                            store_bf16x8(ob + c, v[bj][0], v[bj][1]);
                        }
                    } else if (wc == 1) {
                        if (fq == 0) { *(f32x4*)(WI + (size_t)r * 8) = v[0][0] * WI_SCALE; *(f32x4*)(WI + (size_t)r * 8 + 4) = v[0][1] * WI_SCALE; }
                    }
                }
            }
        }
    }
};

struct EpiOutProj {
    static constexpr bool PERM = false, AFTER_DRAIN = false;
    const float* xp; const float* xs; float* out; bf16* XB2; float* ssq;
    __device__ __forceinline__ void operator()(const f32x4 (&acc)[2][2][4][2], const pg8::Unit& u, int wr, int wc, int fr, int fq) const {
        const int col0 = u.pn * 256 + wc * 32 + 4 * fq;
#pragma unroll
        for (int ai = 0; ai < 2; ++ai) {
            const int rbase = u.pm * 256 + ai * 128;
            if (rbase >= MR) continue;
            const bool samp = rbase >= MP;
#pragma unroll
            for (int m = 0; m < 4; ++m) {
                const int r = rbase + wr * 64 + m * 16 + fr;
                const float* xrow = samp ? xs + (size_t)(r - MP) * D : xp + (size_t)r * D;
                float* yrow = samp ? out + O_YS + (size_t)(r - MP) * D : out + O_YP + (size_t)r * D;
                float ss = 0.f;
#pragma unroll
                for (int bj = 0; bj < 2; ++bj)
#pragma unroll
                    for (int n = 0; n < 2; ++n) {
                        const int c = col0 + bj * 128 + n * 16;
                        const f32x4 y = *(const f32x4*)(xrow + c) + acc[ai][bj][m][n];
                        if (samp) *(f32x4*)(yrow + c) = y;
                        ss += (y[0] * y[0] + y[1] * y[1]) + (y[2] * y[2] + y[3] * y[3]);
                        u32x2 w; w.x = pg8::cvt_pk_bf16(y[0], y[1]); w.y = pg8::cvt_pk_bf16(y[2], y[3]);
                        *(u32x2*)(XB2 + (size_t)r * D + c) = w;
                    }
                ss += __shfl_xor(ss, 16); ss += __shfl_xor(ss, 32);
                if (fq == 0) atomicAdd(ssq + r, ss);
            }
        }
    }
};

struct EpiFfnIn {
    static constexpr bool PERM = false, AFTER_DRAIN = false;
    const float* ssq; bf16* H;
    __device__ __forceinline__ void operator()(const f32x4 (&acc)[2][2][4][2], const pg8::Unit& u, int wr, int wc, int fr, int fq) const {
        const int c = 128 * u.pn + 32 * wc + 8 * fq;
#pragma unroll
        for (int ai = 0; ai < 2; ++ai) {
            const int rbase = u.pm * 256 + ai * 128;
            if (rbase >= MR) continue;
#pragma unroll
            for (int m = 0; m < 4; ++m) {
                const int r = rbase + wr * 64 + m * 16 + fr;
                const float rs2 = rsqrtf(ssq[r] * (1.0f / 1024.0f) + EPS);
                f32x4 h[2];
#pragma unroll
                for (int n = 0; n < 2; ++n) {
                    const f32x4 g = acc[ai][0][m][n] * rs2, up = acc[ai][1][m][n] * rs2;
#pragma unroll
                    for (int j = 0; j < 4; ++j) h[n][j] = g[j] * sigmoidf_(g[j]) * up[j];
                }
                store_bf16x8(H + (size_t)r * DFF + c, h[0], h[1]);
            }
        }
    }
};

struct EpiFfnOut {
    static constexpr bool PERM = false, AFTER_DRAIN = false;
    float* out; const bf16* XB2;
    __device__ __forceinline__ void operator()(const f32x4 (&acc)[2][2][4][2], const pg8::Unit& u, int wr, int wc, int fr, int fq) const {
        const int col0 = u.pn * 256 + wc * 32 + 4 * fq;
#pragma unroll
        for (int ai = 0; ai < 2; ++ai) {
            const int rbase = u.pm * 256 + ai * 128;
            if (rbase >= MP) continue;
#pragma unroll
            for (int m = 0; m < 4; ++m) {
                const int r = rbase + wr * 64 + m * 16 + fr;
                float* yrow = out + O_YP + (size_t)r * D;
#pragma unroll
                for (int bj = 0; bj < 2; ++bj)
#pragma unroll
                    for (int n = 0; n < 2; ++n) { const int c = col0 + bj * 128 + n * 16; const u32x2 xw = *(const u32x2*)(XB2 + (size_t)r * D + c);
                        const f32x4 x1 = {bflo(xw.x), bfhi(xw.x), bflo(xw.y), bfhi(xw.y)}; *(f32x4*)(yrow + c) = x1 + acc[ai][bj][m][n]; }
            }
        }
    }
};

struct Params {
    const float* in[22];
    float* out;
    unsigned char* ws;
    double invf[32];
    int ph_lo, ph_hi;
};
enum { I_XP = 0, I_XS, I_CK, I_CV, I_CKI, I_SH, I_SC, I_NM, I_WIN, I_CW, I_CB, I_WRG, I_BRG, I_WIG, I_BIG, I_LAM, I_QN, I_KN, I_WOUT, I_NF, I_WFI, I_WFO };

struct Frame { LAS unsigned char* lds; int tid, lane, wave, G, bid; };

template <int NB, int KSTEPS, class BRow, class Epi>
__device__ __forceinline__ void skinny_gemm(Frame& F, const bf16* A, int lda, const bf16* Bt, int K, int nct, BRow brow, Epi epi) {
    const int lane = F.lane, qc = lane & 15, kq = lane >> 4, w = F.wave;
    LAS f32x4* red = (LAS f32x4*)F.lds;
    for (int item = F.bid; item < 4 * nct; item += F.G) {
        const int rb = item & 3, ct = item >> 2;
        const bf16* a0 = A + (size_t)(rb * 32 + qc) * lda + 8 * kq + w * (KSTEPS * 32); const bf16* a1 = a0 + (size_t)16 * lda;
        const bf16* bp[NB];
#pragma unroll
        for (int nb = 0; nb < NB; ++nb) bp[nb] = Bt + (size_t)brow(ct, nb, qc) * K + 8 * kq + w * (KSTEPS * 32);
        f32x4 acc[2][NB];
#pragma unroll
        for (int m = 0; m < 2; ++m)
#pragma unroll
            for (int nb = 0; nb < NB; ++nb) acc[m][nb] = (f32x4){0.f, 0.f, 0.f, 0.f};
#pragma unroll
        for (int ks = 0; ks < KSTEPS; ++ks) {
            const bf16x8 fa0 = *(const bf16x8*)(a0 + 32 * ks), fa1 = *(const bf16x8*)(a1 + 32 * ks);
#pragma unroll
            for (int nb = 0; nb < NB; ++nb) {
                const bf16x8 fb = *(const bf16x8*)(bp[nb] + 32 * ks);
                acc[0][nb] = __builtin_amdgcn_mfma_f32_16x16x32_bf16(fb, fa0, acc[0][nb], 0, 0, 0);
                acc[1][nb] = __builtin_amdgcn_mfma_f32_16x16x32_bf16(fb, fa1, acc[1][nb], 0, 0, 0);
            }
        }
#pragma unroll
        for (int m = 0; m < 2; ++m)
#pragma unroll
            for (int nb = 0; nb < NB; ++nb) red[(w * 2 * NB + m * NB + nb) * 64 + lane] = acc[m][nb];
        __syncthreads();
        if (w < 2) {
            f32x4 s[NB];
#pragma unroll
            for (int nb = 0; nb < NB; ++nb) { s[nb] = red[(w * NB + nb) * 64 + lane];
#pragma unroll
                for (int w2 = 1; w2 < 8; ++w2) s[nb] += red[(w2 * 2 * NB + w * NB + nb) * 64 + lane]; }
            epi(s, rb * 32 + w * 16 + qc, 16 * ct + 4 * kq, kq);
        }
        __syncthreads();
    }
}

__device__ __forceinline__ float wave_sum(float v) {
#pragma unroll
    for (int o = 1; o < 64; o <<= 1) v += __shfl_xor(v, o);
    return v;
}

__device__ __forceinline__ void transpose_item(const float* W, int K, int N, int nvalid, const float* gain, bf16* WT, int k0, int row0, int lcol0, bool perm, LAS float* scr, int lane) {
    const int c4 = (lane & 7) * 4, col = lcol0 + c4; const bool ok = col < nvalid;
    f32x4 v[8];
#pragma unroll
    for (int i = 0; i < 8; ++i) { const int kk = (lane >> 3) + 8 * i; v[i] = ok ? *(const f32x4*)(W + (size_t)(k0 + kk) * N + col) : (f32x4){0.f, 0.f, 0.f, 0.f}; }
#pragma unroll
    for (int i = 0; i < 8; ++i) { const int kk = (lane >> 3) + 8 * i; const float g = gain ? gain[k0 + kk] : 1.0f; *(LAS f32x4*)(scr + kk * 36 + c4) = v[i] * g; }
    asm volatile("s_waitcnt lgkmcnt(0)" ::: "memory");
    const int c = lane & 7;
#pragma unroll
    for (int j = 0; j < 4; ++j) {
        const int n = (lane >> 3) + 8 * j, src = perm ? pg8::perm32(n) : n;
        const LAS float* s = scr + (8 * c) * 36 + src;
        u32x4 o; o.x = pk2(s[0 * 36], s[1 * 36]); o.y = pk2(s[2 * 36], s[3 * 36]); o.z = pk2(s[4 * 36], s[5 * 36]); o.w = pk2(s[6 * 36], s[7 * 36]);
        *(u32x4*)(WT + (size_t)(row0 + n) * K + k0 + 8 * c) = o;
    }
    asm volatile("s_waitcnt lgkmcnt(0)" ::: "memory");
}

__device__ __forceinline__ void phase0(const Params& p, Frame& F) {
    unsigned char* ws = p.ws;
    LAS float* scr = (LAS float*)(F.lds + F.wave * 16384);
    const int gw = F.bid * 8 + F.wave, NGW = F.G * 8;
    TIC(50);
    constexpr int I_IN = 16 * (NIN / 32), I_OUT = 16 * (D / 32), I_FI = 16 * (2 * DFF / 32), I_FO = (DFF / 64) * (D / 32);
    constexpr int NITEMS = I_IN + I_OUT + I_FI + I_FO;
    for (int it = gw; it < NITEMS; it += NGW) {
        int r = it;
        if (r < I_IN) { const int kb = r / (NIN / 32), g = r % (NIN / 32), pn = g >> 3, sub = g & 7, bj = sub >> 2, wc = sub & 3;
            transpose_item(p.in[I_WIN], D, DIN, DIN, p.in[I_NM], (bf16*)(ws + WS_WIN), 64 * kb, 32 * g, 256 * pn + 64 * wc + 32 * bj, true, scr, F.lane); continue; }
        r -= I_IN;
        if (r < I_OUT) { const int kb = r / (D / 32), g = r % (D / 32);
            transpose_item(p.in[I_WOUT], D, D, D, nullptr, (bf16*)(ws + WS_WOUT), 64 * kb, 32 * g, 32 * g, false, scr, F.lane); continue; }
        r -= I_OUT;
        if (r < I_FI) { const int kb = r / (2 * DFF / 32), g = r % (2 * DFF / 32), pn = g >> 3, sub = g & 7, bj = sub >> 2, wc = sub & 3;
            transpose_item(p.in[I_WFI], D, 2 * DFF, 2 * DFF, p.in[I_NF], (bf16*)(ws + WS_WFI), 64 * kb, 32 * g, (bj ? DFF : 0) + 128 * pn + 32 * wc, true, scr, F.lane); continue; }
        r -= I_FI;
        { const int kb = r / (D / 32), g = r % (D / 32);
            transpose_item(p.in[I_WFO], DFF, D, D, nullptr, (bf16*)(ws + WS_WFO), 64 * kb, 32 * g, 32 * g, false, scr, F.lane); }
    }
    TOC(50);
    TIC(51);
    {
        bf16* XB = (bf16*)(ws + WS_XB); float* rstd = (float*)(ws + WS_RSTD);
        for (int m0 = gw; m0 < M; m0 += 4 * NGW) {
            f32x4 v[4][4];
#pragma unroll
            for (int rr = 0; rr < 4; ++rr) {
                const int m = m0 + rr * NGW;
                const bool real = m < MR;
                const float* xrow = (m < MP) ? p.in[I_XP] + (size_t)m * D : p.in[I_XS] + (size_t)((real ? m : MP) - MP) * D;
                const f32x4* xr = (const f32x4*)xrow + F.lane;
#pragma unroll
                for (int j = 0; j < 4; ++j) v[rr][j] = real ? xr[64 * j] : (f32x4){0.f, 0.f, 0.f, 0.f};
            }
#pragma unroll
            for (int rr = 0; rr < 4; ++rr) {
                const int m = m0 + rr * NGW;
                if (m >= M) continue;
                float s = 0.f;
#pragma unroll
                for (int j = 0; j < 4; ++j) s += (v[rr][j][0] * v[rr][j][0] + v[rr][j][1] * v[rr][j][1]) + (v[rr][j][2] * v[rr][j][2] + v[rr][j][3] * v[rr][j][3]);
                s = wave_sum(s);
                if (F.lane == 0) rstd[m] = (m < MR) ? rsqrtf(s * (1.0f / D) + EPS) : 0.f;
                unsigned long long* o8 = (unsigned long long*)(XB + (size_t)m * D) + F.lane;
#pragma unroll
                for (int j = 0; j < 4; ++j) o8[64 * j] = (unsigned long long)pk2(v[rr][j][0], v[rr][j][1]) | ((unsigned long long)pk2(v[rr][j][2], v[rr][j][3]) << 32);
            }
        }
    }
    TOC(51);
    TIC(52);
    const size_t gt = (size_t)F.bid * 512 + F.tid, GS = (size_t)F.G * 512;
    {
        fp8* KS = (fp8*)(ws + WS_KS); fp8* VS = (fp8*)(ws + WS_VS); bf16* KIS = (bf16*)(ws + WS_KIS);
        constexpr size_t NKV8 = (size_t)DB * PAST * KVW / 8, NKI8 = (size_t)DB * PAST * 64 / 8;
        for (size_t i = gt; i < 2 * NKV8 + NKI8; i += GS) {
            if (i < 2 * NKV8) {
                const bool isv = i >= NKV8; const size_t e = (isv ? i - NKV8 : i) * 8, b = e / ((size_t)PAST * KVW), rem = e % ((size_t)PAST * KVW);
                const float* src = (isv ? p.in[I_CV] : p.in[I_CK]) + e; fp8* dst = (isv ? VS : KS) + b * SKEYS * KVW + rem;
                store_fp8x8(dst, *(const f32x4*)src, *(const f32x4*)(src + 4));
            } else {
                const size_t e = (i - 2 * NKV8) * 8, b = e / ((size_t)PAST * 64), rem = e % ((size_t)PAST * 64);
                const float* src = p.in[I_CKI] + e;
                store_bf16x8(KIS + b * SKEYS * 64 + rem, *(const f32x4*)src, *(const f32x4*)(src + 4));
            }
        }
    }
    {
        float* rc = (float*)(ws + WS_RCOS); float* rsn = (float*)(ws + WS_RSIN);
        for (size_t i = gt; i < (size_t)8192 * 32; i += GS) {
            const int pos = (int)(i >> 5), fi = (int)(i & 31);
            const double ang = (double)pos * p.invf[fi];
            const double kq = rint(ang * 0.63661977236758134308);
            double r = fma(-kq, 1.57079632679489655800e+00, ang); r = fma(-kq, 6.12323399573676603587e-17, r);
            const double r2 = r * r;
            double sn = -1.0 / 1307674368000.0; sn = sn * r2 + 1.0 / 6227020800.0; sn = sn * r2 - 1.0 / 39916800.0; sn = sn * r2 + 1.0 / 362880.0; sn = sn * r2 - 1.0 / 5040.0; sn = sn * r2 + 1.0 / 120.0; sn = sn * r2 - 1.0 / 6.0; sn = sn * r2 + 1.0; sn *= r;
            double cs = 1.0 / 20922789888000.0; cs = cs * r2 - 1.0 / 87178291200.0; cs = cs * r2 + 1.0 / 479001600.0; cs = cs * r2 - 1.0 / 3628800.0; cs = cs * r2 + 1.0 / 40320.0; cs = cs * r2 - 1.0 / 720.0; cs = cs * r2 + 1.0 / 24.0; cs = cs * r2 - 0.5; cs = cs * r2 + 1.0;
            const int q = (int)((long long)kq & 3);
            const double sv = (q == 0) ? sn : (q == 1) ? cs : (q == 2) ? -sn : -cs;
            const double cv = (q == 0) ? cs : (q == 1) ? -sn : (q == 2) ? -cs : sn;
            rc[i] = (float)cv; rsn[i] = (float)sv;
        }
    }
    {
        float* ssq = (float*)(ws + WS_SSQ);
        for (size_t i = gt; i < (size_t)M; i += GS) ssq[i] = 0.f;
        float* sp = (float*)(ws + WS_SP);
        for (size_t i = gt; i < 512; i += GS) sp[i] = log1pf(__expf(-p.in[I_LAM][i]));
        bf16* WG = (bf16*)(ws + WS_WG);
        for (size_t i = gt; i < (size_t)2 * 8 * 64 * 64; i += GS) {
            const int ii = (int)(i & 63), j = (int)((i >> 6) & 63), nb = (int)((i >> 12) & 7), gsel = (int)(i >> 15);
            const float* W = gsel ? p.in[I_WIG] : p.in[I_WRG];
            WG[i] = (bf16)f2bf(W[(nb * 64 + ii) * 64 + j]);
        }
    }
    TOC(52);
}

constexpr int LRU_WLDS = 16384;
template <int PASS> __device__ __forceinline__ void lru_unit(const Params& p, Frame& F, int sbi  , int nb, int sg) {
    unsigned char* ws = p.ws;
    const bool samp = sbi >= NB; const int b = samp ? sbi - NB : sbi;
    const int T = samp ? DT : 128, t0 = samp ? 0 : sg * 128;
    const size_t r0 = samp ? (size_t)MP + b * DT : (size_t)b * SEQ + t0;
    const int lane = F.lane, qc = lane & 15, kq = lane >> 4, ch = nb * 64 + lane;
    LAS unsigned char* wl = F.lds + F.wave * LRU_WLDS;
    LAS bf16* xcb = (LAS bf16*)wl; LAS float* xcf = (LAS float*)(wl + 2304); LAS float* av = (LAS float*)(wl + 2304 + 4096); LAS float* bv = (LAS float*)(wl + 2304 + 8192);
    const bf16* XR = (const bf16*)(ws + WS_XR) + r0 * LW + ch;
    const float cb = p.in[I_CB][ch], w0 = p.in[I_CW][ch], w1 = p.in[I_CW][LW + ch], w2 = p.in[I_CW][2 * LW + ch], w3 = p.in[I_CW][3 * LW + ch];
    float x1, x2, x3;
    if (t0 > 0) { x1 = bf2f(XR[-3 * LW]); x2 = bf2f(XR[-2 * LW]); x3 = bf2f(XR[-1 * LW]); }
    else if (samp) { const float* sc = p.in[I_SC] + (size_t)b * 3 * LW + ch; x1 = sc[0]; x2 = sc[LW]; x3 = sc[2 * LW]; }
    else { x1 = 0.f; x2 = 0.f; x3 = 0.f; }
    const bf16* GG = (const bf16*)(ws + WS_GG) + r0 * LW + ch; bf16* YC = (bf16*)(ws + WS_YC) + r0 * D + ch;
    unsigned short xn[16], gn2[16];
#pragma unroll
    for (int k = 0; k < 16; ++k) { xn[k] = XR[(size_t)k * LW]; gn2[k] = (PASS == 1) ? GG[(size_t)k * LW] : (unsigned short)0; }
    float Ac = 1.f, h = 0.f;
    if (PASS == 1) {
        h = samp ? p.in[I_SH][b * LW + ch] : 0.f;
        const f32x2* AGG = (const f32x2*)(ws + WS_AGG) + (size_t)sbi * 64 * LW + ch;
        f32x2 gn[8];
#pragma unroll
        for (int j = 0; j < 8; ++j) gn[j] = AGG[(size_t)(j < sg ? j : 0) * LW];
        for (int s0 = 0; s0 < sg; s0 += 8) {
            f32x2 g[8];
#pragma unroll
            for (int j = 0; j < 8; ++j) g[j] = gn[j];
            if (s0 + 8 < sg) {
#pragma unroll
                for (int j = 0; j < 8; ++j) gn[j] = AGG[(size_t)(s0 + 8 + j < sg ? s0 + 8 + j : 0) * LW];
            }
#pragma unroll
            for (int j = 0; j < 8; ++j) h = (s0 + j < sg) ? g[j].x * h + g[j].y : h;
        }
    }
    asm volatile("" ::: "memory");
    const bf16* WG = (const bf16*)(ws + WS_WG); const float* sp = (const float*)(ws + WS_SP);
    bf16x8 Wr[4][2], Wi[4][2]; float brg[4], big[4], spv[4];
#pragma unroll
    for (int jt = 0; jt < 4; ++jt) {
        const int j = 16 * jt + qc;
        const bf16* wr_ = WG + ((size_t)(0 * 8 + nb) * 64 + j) * 64 + 8 * kq; const bf16* wi_ = WG + ((size_t)(1 * 8 + nb) * 64 + j) * 64 + 8 * kq;
        Wr[jt][0] = *(const bf16x8*)wr_; Wr[jt][1] = *(const bf16x8*)(wr_ + 32); Wi[jt][0] = *(const bf16x8*)wi_; Wi[jt][1] = *(const bf16x8*)(wi_ + 32);
        brg[jt] = p.in[I_BRG][nb * 64 + j]; big[jt] = p.in[I_BIG][nb * 64 + j]; spv[jt] = sp[nb * 64 + j];
    }
    for (int st = 0; st < T; st += 16) {
        float xv[16], gg[16];
#pragma unroll
        for (int k = 0; k < 16; ++k) { xv[k] = bf2f(xn[k]); if (PASS == 1) gg[k] = bf2f(gn2[k]); }
        if (st + 16 < T) {
#pragma unroll
            for (int k = 0; k < 16; ++k) { xn[k] = XR[(size_t)(st + 16 + k) * LW]; if (PASS == 1) gn2[k] = GG[(size_t)(st + 16 + k) * LW]; }
        }
#pragma unroll
        for (int k = 0; k < 16; ++k) {
            const float xc = cb + w0 * x1 + w1 * x2 + w2 * x3 + w3 * xv[k];
            x1 = x2; x2 = x3; x3 = xv[k];
            xcf[k * 64 + lane] = xc; xcb[k * 72 + lane] = (bf16)f2bf(xc);
        }
        asm volatile("s_waitcnt lgkmcnt(0)" ::: "memory");
        const bf16x8 A0 = *(const LAS bf16x8*)(xcb + qc * 72 + 8 * kq), A1 = *(const LAS bf16x8*)(xcb + qc * 72 + 32 + 8 * kq);
#pragma unroll
        for (int jt = 0; jt < 4; ++jt) {
            const int j = 16 * jt + qc;
            f32x4 ar = {0.f, 0.f, 0.f, 0.f}, ai = {0.f, 0.f, 0.f, 0.f};
            ar = __builtin_amdgcn_mfma_f32_16x16x32_bf16(A0, Wr[jt][0], ar, 0, 0, 0); ar = __builtin_amdgcn_mfma_f32_16x16x32_bf16(A1, Wr[jt][1], ar, 0, 0, 0);
            ai = __builtin_amdgcn_mfma_f32_16x16x32_bf16(A0, Wi[jt][0], ai, 0, 0, 0); ai = __builtin_amdgcn_mfma_f32_16x16x32_bf16(A1, Wi[jt][1], ai, 0, 0, 0);
#pragma unroll
            for (int ii = 0; ii < 4; ++ii) {
                const int t = 4 * kq + ii;
                const float rg = sigmoidf_(ar[ii] + brg[jt]), ig = sigmoidf_(ai[ii] + big[jt]);
                const float a = __expf(-8.0f * rg * spv[jt]);
                float mult = sqrtf(fmaxf(1.0f - a * a, 0.f));
                if (!samp && (t0 + st + t) == 0) mult = 1.0f;
                av[t * 64 + j] = a; bv[t * 64 + j] = mult * ig * xcf[t * 64 + j];
            }
        }
        asm volatile("s_waitcnt lgkmcnt(0)" ::: "memory");
#pragma unroll
        for (int k = 0; k < 16; ++k) {
            const float a = av[k * 64 + lane], bb = bv[k * 64 + lane];
            h = a * h + bb;
            if (PASS == 0) Ac *= a;
            else YC[(size_t)(st + k) * D] = (bf16)f2bf(h * gg[k]);
        }
        asm volatile("s_waitcnt lgkmcnt(0)" ::: "memory");
    }
    if (PASS == 0) ((f32x2*)(ws + WS_AGG))[((size_t)sbi * 64 + sg) * LW + ch] = (f32x2){Ac, h};
    else { if (samp) p.out[O_HS + b * LW + ch] = h; else if (sg == 63) p.out[O_HP + b * LW + ch] = h; }
}
template <int PASS> __device__ __forceinline__ void lru_phase(const Params& p, Frame& F) {
    for (int u = F.bid * 8 + F.wave; u < 2048 + 64; u += F.G * 8) {
        if (u < 2048) lru_unit<PASS>(p, F, u >> 9, u & 7, (u >> 3) & 63);
        else lru_unit<PASS>(p, F, NB + ((u - 2048) >> 3), (u - 2048) & 7, 0);
    }
}

constexpr int A_CAND = 0, A_CNT = 131072, A_THR = 131072 + 128, A_FLAG = 131072 + 256, A_CNT0 = 131072 + 384, A_HBAR = 131072 + 512, A_TICK = 131072 + 576, CAP = 1024;
constexpr int VPITCH = 288;
extern "C" __device__ unsigned __ockl_wfred_max_u32(unsigned);
extern "C" __device__ unsigned __ockl_wfred_min_u32(unsigned);
typedef short v4i16_t __attribute__((ext_vector_type(4)));
typedef int v2i32_t __attribute__((ext_vector_type(2)));
constexpr int KV8P = 144;

__device__ __forceinline__ unsigned pack_key(float s, int key) {
    unsigned u = __float_as_uint(s);
    u = (u & 0x80000000u) ? ~u : (u | 0x80000000u);
    return (u & 0xFFFFE000u) | (unsigned)(8191 - key);
}
extern "C" __device__ unsigned __ockl_wfred_add_u32(unsigned);
extern "C" __device__ unsigned __ockl_wfscan_add_u32(unsigned, bool);
struct SelRes { unsigned thr; int cnt; };
template <int ROWS> __device__ __forceinline__ SelRes select_rank_rows(LAS unsigned* cq, int n, int rlo, int rhi, int lane) {
    unsigned e[ROWS]; unsigned mx = 0u, mn = 0xFFFFFFFFu;
#pragma unroll
    for (int i = 0; i < ROWS; ++i) { const int idx = i * 64 + lane; const unsigned x = cq[idx]; const bool v = idx < n; e[i] = v ? x : 0u; mx = e[i] > mx ? e[i] : mx; const unsigned y = v ? x : 0xFFFFFFFFu; mn = y < mn ? y : mn; }
    unsigned lo = (unsigned)__builtin_amdgcn_readfirstlane((int)__ockl_wfred_min_u32(mn));
    unsigned hi = (unsigned)__builtin_amdgcn_readfirstlane((int)__ockl_wfred_max_u32(mx)); hi = hi == 0xFFFFFFFFu ? hi : hi + 1u;
    int clo = n;
    for (int it = 0; it < 40 && clo > rhi; ++it) {
        const unsigned piv = lo + ((hi - lo) >> 1);
        int c = 0;
#pragma unroll
        for (int i = 0; i < ROWS; ++i) c += __popcll(__ballot(e[i] >= piv));
        if (c >= rlo) { lo = piv; clo = c; } else hi = piv;
    }
    unsigned cl = 0u;
#pragma unroll
    for (int i = 0; i < ROWS; ++i) cl += (e[i] >= lo) ? 1u : 0u;
    unsigned pos = __ockl_wfscan_add_u32(cl, false);
#pragma unroll
    for (int i = 0; i < ROWS; ++i) { const bool k = e[i] >= lo; if (k) cq[pos] = e[i]; pos += k ? 1u : 0u; }
    SelRes r; r.thr = lo; r.cnt = clo; return r;
}
__device__ __forceinline__ SelRes select_rank(LAS unsigned* cq, int n, int rlo, int rhi, int lane) {
    if (n <= 768) return select_rank_rows<12>(cq, n, rlo, rhi, lane);
    return select_rank_rows<16>(cq, n, rlo, rhi, lane);
}

__device__ __forceinline__ void half_barrier(LAS unsigned* hb, int lane) {
    asm volatile("s_waitcnt vmcnt(0) lgkmcnt(0)" ::: "memory");
    if (lane == 0) {
        const unsigned gen = __hip_atomic_load(hb + 1, __ATOMIC_RELAXED, __HIP_MEMORY_SCOPE_WORKGROUP);
        const unsigned old = __hip_atomic_fetch_add(hb, 1u, __ATOMIC_RELAXED, __HIP_MEMORY_SCOPE_WORKGROUP);
        if (old == 3u) { __hip_atomic_store(hb, 0u, __ATOMIC_RELAXED, __HIP_MEMORY_SCOPE_WORKGROUP); __hip_atomic_store(hb + 1, gen + 1u, __ATOMIC_RELAXED, __HIP_MEMORY_SCOPE_WORKGROUP); }
        else { while (__hip_atomic_load(hb + 1, __ATOMIC_RELAXED, __HIP_MEMORY_SCOPE_WORKGROUP) == gen) __builtin_amdgcn_s_sleep(1); }
    }
    asm volatile("s_waitcnt lgkmcnt(0)" ::: "memory");
}
__device__ __forceinline__ void select_unit(const Params& p, Frame& F, size_t q0row, int L, const bf16* KI) {
    unsigned char* ws = p.ws;
    const bf16* QI = (const bf16*)(ws + WS_QI); const float* WI = (const float*)(ws + WS_WI);
    const int lane = F.lane, half = F.wave >> 2, wid = F.wave & 3, htid = F.tid & 255, qc = lane & 15, kq = lane >> 4;
    LAS unsigned* cand = (LAS unsigned*)(F.lds + A_CAND + half * 65536); LAS unsigned* cntp = (LAS unsigned*)(F.lds + A_CNT + half * 64); LAS unsigned* thrp = (LAS unsigned*)(F.lds + A_THR + half * 64);
    LAS unsigned* flagp = (LAS unsigned*)(F.lds + A_FLAG + half * 16); LAS unsigned* hb = (LAS unsigned*)(F.lds + A_HBAR + half * 16);
    constexpr int nq = 16;
    constexpr int nslots = 4; const int slot = wid;
    const int ql = qc;
    TIC(1);
    bf16x8 Bq[8][2]; float sinf_[8];
    {
        const size_t qrow = q0row + ql;
#pragma unroll
        for (int h = 0; h < 8; ++h) {
            const float w = WI[qrow * 8 + h];
            sinf_[h] = (w < 0.f) ? -INFINITY : INFINITY;
#pragma unroll
            for (int s = 0; s < 2; ++s) {
                const u32x4 raw = *(const u32x4*)(QI + qrow * 512 + h * 64 + 32 * s + 8 * kq);
                u32x4 o; o.x = pk2(bflo(raw.x) * w, bfhi(raw.x) * w); o.y = pk2(bflo(raw.y) * w, bfhi(raw.y) * w); o.z = pk2(bflo(raw.z) * w, bfhi(raw.z) * w); o.w = pk2(bflo(raw.w) * w, bfhi(raw.w) * w);
                Bq[h][s] = __builtin_bit_cast(bf16x8, o);
            }
        }
    }
    half_barrier(hb, lane);
    TOC(1);
    TIC(2);
    for (int arep_ = 0; arep_ <= DUP(8); ++arep_) {
    const int NG = (L + 63) >> 6; const bool tail = (L & 63) != 0;
    LAS unsigned* cnt0 = (LAS unsigned*)(F.lds + A_CNT0 + half * 64);
    int rk = (600 * 1024) / L; rk = rk < 48 ? 48 : (rk > 256 ? 256 : rk);
#if FORCE_FALLBACK
    rk = 8;
#endif
#if FORCE_SAFE_MODE
    const int mode0 = 1;
#else
    const int mode0 = 0;
#endif
    bf16x8 An[2][2];
#define LOAD_A(DST, G, T0, T1) do { int g_ = (G); g_ = g_ < NG ? g_ : NG - 1; _Pragma("unroll") for (int tl = T0; tl < T1; ++tl) { int arow = g_ * 64 + tl * 16 + qc; arow = arow < L ? arow : L - 1; \
        DST[tl - T0][0] = *(const bf16x8*)(KI + (size_t)arow * 64 + 8 * kq); DST[tl - T0][1] = *(const bf16x8*)(KI + (size_t)arow * 64 + 32 + 8 * kq); } } while (0)
#define LOAD_AN(G) LOAD_A(An, G, 0, 2)
    for (int mode = mode0; mode < 2; ++mode) {
    bool redo = false;
    if (htid < 16) { cntp[htid] = 0u; thrp[htid] = 0u; cnt0[htid] = 0u; }
    if (htid == 32) flagp[1] = 0u;
    int g0 = 0, KG = 16;
    LOAD_AN(slot);
    while (g0 < NG) {
        const int gend = (g0 + KG < NG) ? g0 + KG : NG;
        if (htid == 32) flagp[0] = 0u;
        half_barrier(hb, lane);
        const unsigned thr = thrp[ql];
        LAS unsigned* cq = cand + ql * CAP;
        TIC(3);
        for (int g = g0 + slot; g < gend; g += nslots) {
            TIC(7);
            bf16x8 Ah[2][2]; LOAD_A(Ah, g, 2, 4);
            unsigned pk[16];
#define TILE(TL, A0_, A1_) do { f32x4 s0 = {0.f, 0.f, 0.f, 0.f}; \
                _Pragma("unroll") for (int h = 0; h < 8; ++h) { f32x4 acc = {0.f, 0.f, 0.f, 0.f}; \
                    acc = __builtin_amdgcn_mfma_f32_16x16x32_bf16(A0_, Bq[h][0], acc, 0, 0, 0); acc = __builtin_amdgcn_mfma_f32_16x16x32_bf16(A1_, Bq[h][1], acc, 0, 0, 0); \
                    _Pragma("unroll") for (int i = 0; i < 4; ++i) s0[i] += __builtin_amdgcn_fmed3f(acc[i], 0.f, sinf_[h]); } \
                _Pragma("unroll") for (int i = 0; i < 4; ++i) pk[(TL) * 4 + i] = pack_key(s0[i], g * 64 + (TL) * 16 + 4 * kq + i); } while (0)
            TILE(0, An[0][0], An[0][1]); TILE(1, An[1][0], An[1][1]);
            __builtin_amdgcn_sched_barrier(0);
            { const int gn = g + nslots; LOAD_AN(gn < gend ? gn : gend + slot); }
            TILE(2, Ah[0][0], Ah[0][1]); TILE(3, Ah[1][0], Ah[1][1]);
#undef TILE
            if (tail && g == NG - 1) {
                int vt = L - g * 64 - 4 * kq; asm volatile("" : "+v"(vt));
#pragma unroll
                for (int j = 0; j < 16; ++j) pk[j] = ((j >> 2) * 16 + (j & 3) < vt) ? pk[j] : 0u;
            }
            TOC(7);
            TIC(8);
            int n = 0;
#pragma unroll
            for (int j = 0; j < 16; ++j) n += (pk[j] > thr) ? 1 : 0;
            if (n) {
                unsigned base = __hip_atomic_fetch_add(cntp + ql, (unsigned)n, __ATOMIC_RELAXED, __HIP_MEMORY_SCOPE_WORKGROUP);
                if (base + (unsigned)n > (unsigned)CAP) flagp[0] = 1u;
                else {
#pragma unroll
                    for (int j = 0; j < 16; ++j) if (pk[j] > thr) cq[base++] = pk[j];
                }
            }
            TOC(8);
        }
        TOC(3);
        TIC(4);
        half_barrier(hb, lane);
        TOC(4);
        TIC(5);
        const bool ovf = flagp[0] != 0u;
        if (ovf && mode == 0) { redo = true; break; }
        if (ovf) { if (htid < 16) cntp[htid] = cnt0[htid]; half_barrier(hb, lane); }
        const bool last = !ovf && gend == NG;
        if (!last) {
            const int plim = ovf ? 256 : (mode == 0 ? rk + (rk >> 2) : 512), rlo = mode == 0 ? rk : 256, rhi = mode == 0 ? rk + (rk >> 2) : 256;
#pragma unroll 1
            for (int i2 = 0; i2 < 4; ++i2) {
                const int qq = wid * 4 + i2;
                if (qq < nq) {
                    int n = __builtin_amdgcn_readfirstlane((int)cntp[qq]);
                    if (n > plim) { const SelRes r = select_rank(cand + qq * CAP, n, rlo, rhi, lane); n = r.cnt; if (lane == 0) { cntp[qq] = (unsigned)n; thrp[qq] = r.thr; } }
                    if (lane == 0) cnt0[qq] = (unsigned)n;
                }
            }
        }
        TOC(5);
        if (ovf) { KG = (KG >> 1) > nslots ? (KG >> 1) : nslots; LOAD_AN(g0 + slot); }
        else { g0 = gend; KG = mode == 0 ? NG : ((KG * 2 < 32) ? KG * 2 : 32); }
    }
    if (!redo && mode == 0 && L > 1024) {
        if (lane < 4) { const int qq = wid * 4 + lane; if (qq < nq && cntp[qq] < 256u) flagp[1] = 1u; }
        half_barrier(hb, lane);
        redo = flagp[1] != 0u;
    }
    half_barrier(hb, lane);
    if (!redo) break;
    }
    TOC(2);
#undef LOAD_AN
#undef LOAD_A
    }
    TIC(6);
    {
        int lane_b = lane; asm volatile("" : "+v"(lane_b));
        unsigned short* SEL = (unsigned short*)(ws + WS_SEL); int* NSEL = (int*)(ws + WS_NSEL);
#pragma unroll 1
        for (int i2 = 0; i2 < 4; ++i2) {
            const int qq = wid * 4 + i2;
            if (qq >= nq) continue;
            int n = __builtin_amdgcn_readfirstlane((int)cntp[qq]);
            if (n > 256) { select_rank(cand + qq * CAP, n, 256, 256, lane_b); n = 256; }
            asm volatile("s_waitcnt lgkmcnt(0)" ::: "memory");
            const LAS unsigned* cq = cand + qq * CAP;
            const size_t row = q0row + qq;
            u32x2 w;
            { const int k = 4 * lane_b; const unsigned e0 = k < n ? cq[k] : 8191u, e1 = k + 1 < n ? cq[k + 1] : 8191u, e2 = k + 2 < n ? cq[k + 2] : 8191u, e3 = k + 3 < n ? cq[k + 3] : 8191u;
              w.x = (8191u - (e0 & 8191u)) | ((8191u - (e1 & 8191u)) << 16); w.y = (8191u - (e2 & 8191u)) | ((8191u - (e3 & 8191u)) << 16); }
            *(u32x2*)(SEL + row * 256 + 4 * lane_b) = w;
            if (lane_b == 0) NSEL[row] = n;
        }
    }
    half_barrier(hb, lane);
    TOC(6);
}

__device__ __forceinline__ void attend_query(const Params& p, Frame& F, size_t qrow, const fp8* Kb, const fp8* Vb) {
    unsigned char* ws = p.ws;
    const bf16* Qb = (const bf16*)(ws + WS_Q); bf16* YC = (bf16*)(ws + WS_YC);
    const int lane_b = F.lane, qc_b = lane_b & 15, kq_b = lane_b >> 4, wid = F.wave;
    const int wb = wid * LRU_WLDS;
    LAS unsigned short* ix = (LAS unsigned short*)(F.lds + wb);
    LAS unsigned char* vst = F.lds + wb + 512;
    const int n = __builtin_amdgcn_readfirstlane(((const int*)(ws + WS_NSEL))[qrow]);
    *(LAS u32x2*)(ix + 4 * lane_b) = __builtin_nontemporal_load((const u32x2*)((const unsigned short*)(ws + WS_SEL) + qrow * 256 + 4 * lane_b));
    asm volatile("s_waitcnt lgkmcnt(0)" ::: "memory");
    const int h = lane_b & 15;
    long Bh8[4];
#pragma unroll
    for (int s = 0; s < 4; ++s) {
        const bool v = (h < 8) && ((h >> 2) == (kq_b >> 1));
        u32x4 raw = {0u, 0u, 0u, 0u};
        if (v) raw = __builtin_nontemporal_load((const u32x4*)(Qb + qrow * 512 + h * 64 + 32 * (kq_b & 1) + 8 * s));
        const unsigned lo = pk4_fp8(bflo(raw.x), bfhi(raw.x), bflo(raw.y), bfhi(raw.y)), hi = pk4_fp8(bflo(raw.z), bfhi(raw.z), bflo(raw.w), bfhi(raw.w));
        Bh8[s] = (long)(((unsigned long long)hi << 32) | lo);
    }
    float sc[64];
    u32x4 Kn[4][2];
#pragma unroll
    for (int t4 = 0; t4 < 4; ++t4) { const fp8* kr = Kb + (size_t)ix[t4 * 16 + qc_b] * KVW + 32 * kq_b; Kn[t4][0] = *(const u32x4*)kr; Kn[t4][1] = *(const u32x4*)(kr + 16); }
#pragma unroll
    for (int g4 = 0; g4 < 4; ++g4) {
        u32x4 Ka[4][2];
#pragma unroll
        for (int t4 = 0; t4 < 4; ++t4) { Ka[t4][0] = Kn[t4][0]; Ka[t4][1] = Kn[t4][1]; }
        if (g4 < 3) {
#pragma unroll
            for (int t4 = 0; t4 < 4; ++t4) { const fp8* kr = Kb + (size_t)ix[(g4 + 1) * 64 + t4 * 16 + qc_b] * KVW + 32 * kq_b; Kn[t4][0] = *(const u32x4*)kr; Kn[t4][1] = *(const u32x4*)(kr + 16); }
        }
#pragma unroll
        for (int t4 = 0; t4 < 4; ++t4) {
            f32x4 acc = {0.f, 0.f, 0.f, 0.f};
#pragma unroll
            for (int s = 0; s < 4; ++s) {
                const u32x4 kw = Ka[t4][s >> 1];
                const long a8 = (long)(((unsigned long long)((s & 1) ? kw.w : kw.y) << 32) | ((s & 1) ? kw.z : kw.x));
                acc = __builtin_amdgcn_mfma_f32_16x16x32_fp8_fp8(a8, Bh8[s], acc, 0, 0, 0);
            }
#pragma unroll
            for (int ii = 0; ii < 4; ++ii) { const int key = (g4 * 4 + t4) * 16 + 4 * kq_b + ii; sc[(g4 * 4 + t4) * 4 + ii] = key < n ? acc[ii] * 0.125f : -INFINITY; }
        }
        __builtin_amdgcn_sched_barrier(0);
    }
    float mx = sc[0];
#pragma unroll
    for (int j = 1; j < 64; ++j) mx = fmaxf(mx, sc[j]);
    mx = fmaxf(mx, __shfl_xor(mx, 16)); mx = fmaxf(mx, __shfl_xor(mx, 32));
    float sum = 0.f;
#pragma unroll
    for (int j = 0; j < 64; ++j) { sc[j] = __expf(sc[j] - mx); sum += sc[j]; }
    sum += __shfl_xor(sum, 16); sum += __shfl_xor(sum, 32);
    const float rl = 1.0f / sum;
    long pb8[8];
#pragma unroll
    for (int b = 0; b < 8; ++b) { const unsigned lo = pk4_fp8(sc[b * 8 + 0], sc[b * 8 + 1], sc[b * 8 + 2], sc[b * 8 + 3]), hi = pk4_fp8(sc[b * 8 + 4], sc[b * 8 + 5], sc[b * 8 + 6], sc[b * 8 + 7]);
        pb8[b] = (long)(((unsigned long long)hi << 32) | lo); }
    f32x4 oacc[8];
#pragma unroll
    for (int dt = 0; dt < 8; ++dt) oacc[dt] = (f32x4){0.f, 0.f, 0.f, 0.f};
    u32x4 vr[4], vr2[4];
    const int vrow = lane_b >> 3, vch = lane_b & 7;
#pragma unroll
    for (int i = 0; i < 4; ++i) { vr[i] = *(const u32x4*)(Vb + (size_t)ix[8 * i + vrow] * KVW + vch * 16); vr2[i] = *(const u32x4*)(Vb + (size_t)ix[32 + 8 * i + vrow] * KVW + vch * 16); }
    const int tq = qc_b >> 1, trow = (tq < 4) ? 4 * kq_b + tq : 16 + 4 * kq_b + (tq - 4);
    const LAS unsigned char* trb = vst + trow * KV8P + (qc_b & 1) * 8;
#pragma unroll
    for (int b = 0; b < 8; ++b) {
#pragma unroll
        for (int i = 0; i < 4; ++i) *(LAS u32x4*)(vst + (8 * i + vrow) * KV8P + vch * 16) = vr[i];
#pragma unroll
        for (int i = 0; i < 4; ++i) vr[i] = vr2[i];
        if (b < 6) {
#pragma unroll
            for (int i = 0; i < 4; ++i) vr2[i] = *(const u32x4*)(Vb + (size_t)ix[32 * (b + 2) + 8 * i + vrow] * KVW + vch * 16);
        }
        asm volatile("s_waitcnt lgkmcnt(0)" ::: "memory");
#pragma unroll
        for (int dt = 0; dt < 8; ++dt) {
            const v2i32_t t8 = __builtin_amdgcn_ds_read_tr8_b64_v2i32((LAS v2i32_t*)(trb + dt * 16));
            const long Av = (long)(((unsigned long long)(unsigned)t8[1] << 32) | (unsigned)t8[0]);
            oacc[dt] = __builtin_amdgcn_mfma_f32_16x16x32_fp8_fp8(Av, pb8[b], oacc[dt], 0, 0, 0);
        }
        asm volatile("s_waitcnt lgkmcnt(0)" ::: "memory");
        __builtin_amdgcn_sched_barrier(0);
    }
    if (h < 4) {
#pragma unroll
        for (int dd = 0; dd < 4; ++dd) { const f32x4 o = oacc[dd] * rl; u32x2 w; w.x = pk2(o[0], o[1]); w.y = pk2(o[2], o[3]); __builtin_nontemporal_store(w, (u32x2*)(YC + qrow * D + 512 + h * 64 + dd * 16 + 4 * kq_b)); }
    } else if (h < 8) {
#pragma unroll
        for (int dd = 0; dd < 4; ++dd) { const f32x4 o = oacc[4 + dd] * rl; u32x2 w; w.x = pk2(o[0], o[1]); w.y = pk2(o[2], o[3]); __builtin_nontemporal_store(w, (u32x2*)(YC + qrow * D + 512 + h * 64 + dd * 16 + 4 * kq_b)); }
    }
}

__device__ __forceinline__ void phase3(const Params& p, Frame& F) {
    unsigned char* ws = p.ws;
    TIC(9);
    TOC(9);
    {
        const int half = F.wave >> 2, htid = F.tid & 255;
        LAS unsigned* hb = (LAS unsigned*)(F.lds + A_HBAR + half * 16); LAS int* tick = (LAS int*)(F.lds + A_TICK + half * 16);
        if (htid == 0) { hb[0] = 0u; hb[1] = 0u; }
        __syncthreads();
        if (half == 1) {
            for (int u = F.bid * 4 + (F.wave & 3); u < 2048 + 64; u += F.G * 4) {
                if (u < 2048) lru_unit<0>(p, F, u >> 9, u & 7, (u >> 3) & 63);
                else lru_unit<0>(p, F, NB + ((u - 2048) >> 3), (u - 2048) & 7, 0);
            }
            half_barrier(hb, F.lane);
        }
        unsigned* ctr = (unsigned*)(ws + WS_CTL) + CW_QUEUE;
        for (int q = 2 * F.bid + half;;) {
            if (q >= 2048 + DB) break;
            size_t q0row; int L; const bf16* KI;
            const bool is_s = q >= 1024 && q < 1024 + DB;
            if (!is_s) {
                const int u = q < 1024 ? q : q - DB, chunk = 127 - (u >> 4), b = (u & 15) >> 2, quarter = u & 3;
                q0row = (size_t)b * SEQ + chunk * 64 + quarter * 16; L = 64 * (chunk + 1);
                KI = (const bf16*)(ws + WS_KIB) + (size_t)b * SEQ * 64;
            } else {
                const int s = q - 1024;
                q0row = (size_t)MP + s * DT; L = SKEYS;
                KI = (const bf16*)(ws + WS_KIS) + (size_t)s * SKEYS * 64;
            }
            select_unit(p, F, q0row, L, KI);
            if (htid == 0) *tick = (int)(2 * F.G + __hip_atomic_fetch_add(ctr, 1u, __ATOMIC_RELAXED, __HIP_MEMORY_SCOPE_AGENT));
            half_barrier(hb, F.lane);
            q = *tick;
            half_barrier(hb, F.lane);
        }
    }
}

__device__ __forceinline__ void phase4(const Params& p, Frame& F) {
    unsigned char* ws = p.ws;
    if (F.wave < 4) {
        for (int u = F.bid * 4 + F.wave; u < 2048 + 64; u += F.G * 4) {
            if (u < 2048) lru_unit<1>(p, F, u >> 9, u & 7, (u >> 3) & 63);
            else lru_unit<1>(p, F, NB + ((u - 2048) >> 3), (u - 2048) & 7, 0);
        }
    }
    const bool aff = (F.G & 7) == 0;
    const int x = F.bid & 7, b = aff ? (x >> 1) : (F.bid & 3);
    const int nwv = aff ? (F.G >> 2) * 8 : ((F.G + 3 - (F.bid & 3)) / 4) * 8;
    const int wv = aff ? ((F.bid >> 3) * 2 + (x & 1)) * 8 + F.wave : (F.bid >> 2) * 8 + F.wave;
    unsigned* ctr = (unsigned*)(ws + WS_CTL) + CW_QUEUE + 64 * (1 + b);
    const fp8* Kb = (const fp8*)(ws + WS_KB) + (size_t)b * SEQ * KVW; const fp8* Vb = (const fp8*)(ws + WS_VB) + (size_t)b * SEQ * KVW;
    for (int q = wv;;) {
        if (q >= SEQ + 2 * DT) break;
        if (q < SEQ) attend_query(p, F, (size_t)b * SEQ + q, Kb, Vb);
        else { const int qs = q - SEQ, s = 2 * b + (qs >> 4);
            attend_query(p, F, (size_t)MP + s * DT + (qs & 15), (const fp8*)(ws + WS_KS) + (size_t)s * SKEYS * KVW, (const fp8*)(ws + WS_VS) + (size_t)s * SKEYS * KVW); }
        unsigned t = 0u;
        if (F.lane == 0) t = __hip_atomic_fetch_add(ctr, 1u, __ATOMIC_RELAXED, __HIP_MEMORY_SCOPE_AGENT);
        q = nwv + __builtin_amdgcn_readfirstlane((int)t);
    }
}

__global__ void __launch_bounds__(512, 2) fwd_kernel(Params p) {
    extern __shared__ __attribute__((aligned(16))) unsigned char lds_raw[];
    Frame F; F.lds = (LAS unsigned char*)lds_raw; F.tid = threadIdx.x; F.lane = F.tid & 63; F.wave = __builtin_amdgcn_readfirstlane(F.tid >> 6); F.G = gridDim.x; F.bid = blockIdx.x;
    unsigned char* ws = p.ws;
    const int lo = p.ph_lo, hi = p.ph_hi;
#if !USE_CG_SYNC
    if (F.tid < 64) ((LAS unsigned*)(F.lds + LDSCTL_OFF))[F.tid] = 0u;
    __syncthreads();
    XcdBarrier xbar = xcd_barrier_post((unsigned*)(ws + WS_CTL) + CW_BAR, (volatile LAS unsigned*)(F.lds + LDSCTL_OFF));
#endif
#define IN(k) (lo <= (k) && (k) < hi)
#ifndef SKIPMASK
#define SKIPMASK 0
#endif
#define SKIP(k) ((SKIPMASK >> (k)) & 1)
#define REPS(k) for (int rep_ = 0; rep_ <= DUP(k); ++rep_, (rep_ <= DUP(k) ? GSYNC() : (void)0))
#if USE_CG_SYNC
#define GSYNC() cg::this_grid().sync()
#else
#define GSYNC() xcd_barrier(xbar)
#endif
#define SEAM(k) do { if (IN(k) && IN((k) + 1)) { GSYNC(); } } while (0)
    { TIC(20); if (IN(0) && !SKIP(0)) REPS(0) phase0(p, F); TOC(20); }
    { TIC(40); SEAM(0); TOC(40); }
    if (IN(1) && !SKIP(1)) REPS(1) {
        pg8::Gemm g{(const pg8::bf16_t*)(ws + WS_XB), (const pg8::bf16_t*)(ws + WS_WIN), MP, NIN, D};
        pg8::StaticOrder S; S.init(MP, NIN, F.G, F.bid);
        EpiInProj E{(const float*)(ws + WS_RSTD), (const float*)(ws + WS_RCOS), (const float*)(ws + WS_RSIN), p.in[I_QN], p.in[I_KN],
                    (bf16*)(ws + WS_XR), (bf16*)(ws + WS_GG), (bf16*)(ws + WS_Q), (bf16*)(ws + WS_QI), (fp8*)(ws + WS_KB), (fp8*)(ws + WS_VB), (bf16*)(ws + WS_KIB),
                    (fp8*)(ws + WS_KS), (fp8*)(ws + WS_VS), (bf16*)(ws + WS_KIS), (float*)(ws + WS_WI), p.out};
        { TIC(21); pg8::gemm_phase<EpiInProj, pg8::StaticOrder, true, true>(F.lds, g, S, E); TOC(21); }
        TIC(31);
        {
            const float* rstd = E.rstd + MP; const float* rcos = E.rcos; const float* rsin = E.rsin; const float* gq = E.gq; const float* gk = E.gk; float* out = p.out;
            bf16* XR = E.XR + (size_t)MP * LW; bf16* GG = E.GG + (size_t)MP * LW; bf16* Q = E.Q + (size_t)MP * 512; bf16* QI = E.QI + (size_t)MP * 512;
            fp8* KS = E.KS; fp8* VS = E.VS; bf16* KIS = E.KIS; float* WI = E.WI + (size_t)MP * 8;
            skinny_gemm<4, 4>(F, (const bf16*)(ws + WS_XB) + (size_t)MP * D, D, (const bf16*)(ws + WS_WIN), D, 38,
                [](int hb_, int nb, int r) { const int c = 64 * hb_ + 16 * nb + r, pn = c >> 8, wc = (c >> 6) & 3, bj = (c >> 5) & 1, w32 = c & 31, fq = w32 >> 3, n = (w32 >> 2) & 1, j = w32 & 3;
                                             return 256 * pn + 128 * bj + 32 * wc + 16 * n + 4 * fq + j; },
                [=](const f32x4 (&acc)[4], int r, int c0, int kq) {
                    const int hbk = c0 >> 4, sb = r >> 4, t = r & 15, pos = PAST + t;
                    const float rsd = rstd[r];
                    f32x4 v[4];
#pragma unroll
                    for (int nb = 0; nb < 4; ++nb) v[nb] = acc[nb] * rsd;
                    const bool norm = (hbk >= 16 && hbk < 26), rope = norm || (hbk >= 28 && hbk < 37);
                    if (norm) {
                        float ss = 0.f;
#pragma unroll
                        for (int nb = 0; nb < 4; ++nb) ss += (v[nb][0] * v[nb][0] + v[nb][1] * v[nb][1]) + (v[nb][2] * v[nb][2] + v[nb][3] * v[nb][3]);
                        ss += __shfl_xor(ss, 16); ss += __shfl_xor(ss, 32);
                        const float inv = rsqrtf(ss * (1.0f / 64.0f) + EPS); const float* g = hbk < 24 ? gq : gk;
#pragma unroll
                        for (int nb = 0; nb < 4; ++nb) v[nb] = v[nb] * inv * *(const f32x4*)(g + 16 * nb + 4 * kq);
                    }
                    if (rope) {
#pragma unroll
                        for (int nb = 0; nb < 2; ++nb) {
                            const f32x4 c4 = *(const f32x4*)(rcos + pos * 32 + 16 * nb + 4 * kq), s4 = *(const f32x4*)(rsin + pos * 32 + 16 * nb + 4 * kq);
                            const f32x4 x1 = v[nb], x2 = v[nb + 2];
                            v[nb] = x1 * c4 - x2 * s4; v[nb + 2] = x2 * c4 + x1 * s4;
                        }
                    }
#pragma unroll
                    for (int nb = 0; nb < 4; ++nb) {
                        const int d = 16 * nb + 4 * kq; const f32x4 x = v[nb];
                        u32x2 wb; wb.x = pg8::cvt_pk_bf16(x[0], x[1]); wb.y = pg8::cvt_pk_bf16(x[2], x[3]);
                        if (hbk < 8) {
                            const int c = 64 * hbk + d; *(u32x2*)(XR + (size_t)r * LW + c) = wb;
                            if (t >= DT - 3) *(f32x4*)(out + O_CS + ((size_t)(sb * 3 + (t - (DT - 3)))) * LW + c) = x;
                        } else if (hbk < 16) {
                            f32x4 gl; gl[0] = gelu_tanh(x[0]); gl[1] = gelu_tanh(x[1]); gl[2] = gelu_tanh(x[2]); gl[3] = gelu_tanh(x[3]);
                            u32x2 wg; wg.x = pg8::cvt_pk_bf16(gl[0], gl[1]); wg.y = pg8::cvt_pk_bf16(gl[2], gl[3]);
                            *(u32x2*)(GG + (size_t)r * LW + 64 * (hbk - 8) + d) = wg;
                        } else if (hbk < 24) { *(u32x2*)(Q + (size_t)r * 512 + 64 * (hbk - 16) + d) = wb;
                        } else if (hbk < 28) {
                            const int kvh = hbk & 1; const bool isk = hbk < 26;
                            *(f32x4*)(out + (isk ? O_KS : O_VS) + (size_t)r * KVW + kvh * 64 + d) = x;
                            *(unsigned*)((isk ? KS : VS) + ((size_t)sb * SKEYS + PAST + t) * KVW + kvh * 64 + d) = pk4_fp8(x[0], x[1], x[2], x[3]);
                        } else if (hbk < 36) { *(u32x2*)(QI + (size_t)r * 512 + 64 * (hbk - 28) + d) = wb;
                        } else if (hbk == 36) {
                            *(f32x4*)(out + O_KIS + (size_t)r * 64 + d) = x;
                            *(u32x2*)(KIS + ((size_t)sb * SKEYS + PAST + t) * 64 + d) = wb;
                        } else if (d < 8) { *(f32x4*)(WI + (size_t)r * 8 + d) = x * WI_SCALE; }
                    }
                });
        }
        TOC(31);
    }
    { TIC(41); SEAM(1); TOC(41); }
    { TIC(23); if (IN(2) && !SKIP(2)) REPS(2) phase3(p, F); TOC(23); }
    { TIC(43); SEAM(2); TOC(43); }
    { TIC(24); if (IN(3) && !SKIP(3)) REPS(3) phase4(p, F); TOC(24); }
    { TIC(44); SEAM(3); TOC(44); }
    if (IN(4) && !SKIP(4)) REPS(4) {
        pg8::Gemm g{(const pg8::bf16_t*)(ws + WS_YC), (const pg8::bf16_t*)(ws + WS_WOUT), MP, D, D};
        pg8::StaticOrder S; S.init(MP, D, F.G, F.bid);
        EpiOutProj E{p.in[I_XP], p.in[I_XS], p.out, (bf16*)(ws + WS_XB), (rep_ < DUP(4)) ? (float*)(ws + WS_CTL + 65536) : (float*)(ws + WS_SSQ)};
        { TIC(25); pg8::gemm_phase<EpiOutProj, pg8::StaticOrder, true, true>(F.lds, g, S, E); TOC(25); }
        TIC(35);
        {
            const float* xs = p.in[I_XS]; float* ys = p.out + O_YS; bf16* XB2 = (bf16*)(ws + WS_XB) + (size_t)MP * D; float* ssq = E.ssq + MP;
            skinny_gemm<1, 4>(F, (const bf16*)(ws + WS_YC) + (size_t)MP * D, D, (const bf16*)(ws + WS_WOUT), D, D / 16,
                [](int ct, int, int r) { return 16 * ct + r; },
                [=](const f32x4 (&acc)[1], int r, int c0, int) {
                    const f32x4 y = *(const f32x4*)(xs + (size_t)r * D + c0) + acc[0];
                    *(f32x4*)(ys + (size_t)r * D + c0) = y;
                    u32x2 w; w.x = pg8::cvt_pk_bf16(y[0], y[1]); w.y = pg8::cvt_pk_bf16(y[2], y[3]); *(u32x2*)(XB2 + (size_t)r * D + c0) = w;
                    float ss = (y[0] * y[0] + y[1] * y[1]) + (y[2] * y[2] + y[3] * y[3]);
                    ss += __shfl_xor(ss, 16); ss += __shfl_xor(ss, 32);
                    if ((threadIdx.x & 48) == 0) atomicAdd(ssq + r, ss);
                });
        }
        TOC(35);
    }
    { TIC(45); SEAM(4); TOC(45); }
    if (IN(5) && !SKIP(5)) REPS(5) {
        pg8::Gemm g{(const pg8::bf16_t*)(ws + WS_XB), (const pg8::bf16_t*)(ws + WS_WFI), MP, 2 * DFF, D};
        pg8::StaticOrder S; S.init(MP, 2 * DFF, F.G, F.bid);
        EpiFfnIn E{(const float*)(ws + WS_SSQ), (bf16*)(ws + WS_H)};
        { TIC(26); pg8::gemm_phase<EpiFfnIn, pg8::StaticOrder, true, true>(F.lds, g, S, E); TOC(26); }
        TIC(36);
        {
            const float* ssq = (const float*)(ws + WS_SSQ) + MP; bf16* H = (bf16*)(ws + WS_H) + (size_t)MP * DFF;
            skinny_gemm<2, 4>(F, (const bf16*)(ws + WS_XB) + (size_t)MP * D, D, (const bf16*)(ws + WS_WFI), D, DFF / 16,
                [](int ct, int nb, int r) { const int c = 16 * ct + r, pn = c >> 7, wc = (c >> 5) & 3, w32 = c & 31, fq = w32 >> 3, n = (w32 >> 2) & 1, j = w32 & 3; return 256 * pn + 128 * nb + 32 * wc + 16 * n + 4 * fq + j; },
                [=](const f32x4 (&acc)[2], int r, int c0, int) {
                    const float rs2 = rsqrtf(ssq[r] * (1.0f / 1024.0f) + EPS);
                    const f32x4 g = acc[0] * rs2, up = acc[1] * rs2; f32x4 h;
#pragma unroll
                    for (int j = 0; j < 4; ++j) h[j] = g[j] * sigmoidf_(g[j]) * up[j];
                    u32x2 w; w.x = pg8::cvt_pk_bf16(h[0], h[1]); w.y = pg8::cvt_pk_bf16(h[2], h[3]); *(u32x2*)(H + (size_t)r * DFF + c0) = w;
                });
        }
        TOC(36);
    }
    { TIC(46); SEAM(5); TOC(46); }
    if (IN(6) && !SKIP(6)) {
        pg8::Gemm g{(const pg8::bf16_t*)(ws + WS_H), (const pg8::bf16_t*)(ws + WS_WFO), MP, D, DFF};
        pg8::StaticOrder S; S.init(MP, D, F.G, F.bid);
        EpiFfnOut E{p.out, (const bf16*)(ws + WS_XB)};
        { TIC(27); pg8::gemm_phase<EpiFfnOut, pg8::StaticOrder, true, true>(F.lds, g, S, E); TOC(27); }
        TIC(37);
        {
            float* ys = p.out + O_YS;
            skinny_gemm<1, 11>(F, (const bf16*)(ws + WS_H) + (size_t)MP * DFF, DFF, (const bf16*)(ws + WS_WFO), DFF, D / 16,
                [](int ct, int, int r) { return 16 * ct + r; },
                [=](const f32x4 (&acc)[1], int r, int c0, int) { float* y = ys + (size_t)r * D + c0; *(f32x4*)y = *(const f32x4*)y + acc[0]; });
        }
        TOC(37);
    }
    if (TSEG && F.bid == 0 && F.tid == 0) { const unsigned acc_ = *(LAS unsigned*)(F.lds + LDSCTL_OFF + 128); const unsigned long long t0_ = __builtin_amdgcn_s_memrealtime(); while ((unsigned)(__builtin_amdgcn_s_memrealtime() - t0_) < acc_) __builtin_amdgcn_s_sleep(8); }
#undef IN
#undef SEAM
}

#ifndef N_LAUNCHES
#define N_LAUNCHES 1
#endif
constexpr int NPHASE = 7;
extern "C" void kernel_launch(void* const* d_in, const int* in_sizes, int n_in, void* d_out, int out_size, void* d_ws, size_t ws_size, hipStream_t stream) {
    static int grid = 0;
    if (grid == 0) {
        if (n_in != 22 || out_size != (int)O_END || ws_size < WS_END) { fprintf(stderr, "kernel_launch: unexpected shapes: n_in %d out %d ws %zu (need %zu)\n", n_in, out_size, ws_size, (size_t)WS_END); grid = -1; return; }
        int dev = 0, cus = 0, per_cu = 0;
        if (hipGetDevice(&dev) != hipSuccess || hipDeviceGetAttribute(&cus, hipDeviceAttributeMultiprocessorCount, dev) != hipSuccess) { grid = -1; return; }
        if (hipFuncSetAttribute((const void*)fwd_kernel, hipFuncAttributeMaxDynamicSharedMemorySize, LDS_BYTES) != hipSuccess) { fprintf(stderr, "kernel_launch: hipFuncSetAttribute failed\n"); grid = -1; return; }
        if (hipOccupancyMaxActiveBlocksPerMultiprocessor(&per_cu, (const void*)fwd_kernel, 512, LDS_BYTES) != hipSuccess || per_cu < 1) { fprintf(stderr, "kernel_launch: occupancy query says %d blocks/CU\n", per_cu); per_cu = 1; }
        (void)hipGetLastError();
        grid = cus;
    }
    if (grid < 0) return;
    if (!USE_CG_SYNC) { if (hipMemsetAsync((char*)d_ws + WS_CTL, 0, 65536, stream) != hipSuccess) { fprintf(stderr, "kernel_launch: memset failed\n"); return; } }
    Params p{};
    for (int i = 0; i < 22; ++i) p.in[i] = (const float*)d_in[i];
    p.out = (float*)d_out; p.ws = (unsigned char*)d_ws;
    for (int i = 0; i < 32; ++i) p.invf[i] = pow(10000.0, -(double)i / 32.0);
    if (N_LAUNCHES == 1) {
        p.ph_lo = 0; p.ph_hi = NPHASE;
        void* args[] = {&p};
        hipError_t e = hipLaunchCooperativeKernel((const void*)fwd_kernel, dim3(grid), dim3(512), args, LDS_BYTES, stream);
        if (e != hipSuccess) fprintf(stderr, "kernel_launch: cooperative launch failed: %s (grid %d)\n", hipGetErrorString(e), grid);
    } else {
        for (int k = 0; k < NPHASE; ++k) { p.ph_lo = k; p.ph_hi = k + 1; hipLaunchKernelGGL(fwd_kernel, dim3(grid), dim3(512), LDS_BYTES, stream, p); }
    }
}
```

```cpp
#include <hip/hip_runtime.h>
#include <hip/hip_cooperative_groups.h>
#include <cstdio>
#include <cstdint>
#include <cmath>
namespace cg = cooperative_groups;
namespace pg8 {
#define PG8_LAS __attribute__((address_space(3)))
typedef unsigned short bf16_t;
typedef short bf16x8 __attribute__((ext_vector_type(8)));
typedef float f32x4 __attribute__((ext_vector_type(4)));
typedef unsigned u32x4 __attribute__((ext_vector_type(4)));
constexpr int BM = 256, BK = 64, HALF = 128, HTB = HALF * BK * 2  , STAGE_BYTES = 8 * HTB, NXCD = 8, WGM = 8;

__host__ __device__ __forceinline__ int lds_byte(int r, int c) { const int st = (r >> 4) * 2 + (c >> 5), rr = r & 15, cc = c & 31, ob = rr * 64 + cc * 2; return st * 1024 + (ob ^ (((ob >> 9) & 1) << 5)); }
__host__ __device__ __forceinline__ void stage_rc(int b, int& R, int& C) { const int st = b / 1024, sb = b % 1024, swz = sb ^ (((sb >> 9) & 1) << 5); R = (st >> 1) * 16 + swz / 64; C = (st & 1) * 32 + (swz % 64) / 2; }
__host__ __device__ __forceinline__ int perm32(int rho) { const int n = rho >> 4, i = rho & 15; return 8 * (i >> 2) + 4 * n + (i & 3); }

struct Unit { int pm, pn; };
struct Gemm { const bf16_t* A; const bf16_t* Bt; int M, N, K; };

struct StaticOrder {
    int nM, nN, nwg, G, c, wgm;
    __host__ __device__ void init(int M, int N, int G_, int c_, int wgm_ = WGM) { nM = M / BM; nN = N / BM; nwg = nM * nN; G = G_; c = c_; wgm = wgm_; }
    __host__ __device__ bool next(int i, Unit& u) const {
        const long L = (long)i * G + c; if (L >= nwg) return false;
        int wgid = (int)L; { const int q = nwg / NXCD, r = nwg % NXCD, xcd = wgid % NXCD, off = wgid / NXCD; wgid = (xcd < r ? xcd * (q + 1) : r * (q + 1) + (xcd - r) * q) + off; }
        const int nig = wgm * nN, gid = wgid / nig, fm = gid * wgm, gsz = (nM - fm) < wgm ? (nM - fm) : wgm;
        u.pm = fm + ((wgid % nig) % gsz); u.pn = (wgid % nig) / gsz; return true;
    }
    __device__ __forceinline__ void a_ready(const Unit&) const {}
    __device__ __forceinline__ void done(const Unit&) const {}
};
__device__ __forceinline__ unsigned cvt_pk_bf16(float lo, float hi) { unsigned r; asm volatile("v_cvt_pk_bf16_f32 %0, %1, %2" : "=v"(r) : "v"(lo), "v"(hi)); return r; }
template <class Epi, class Sched, bool ALIGN_EPI = false, bool SP2 = false>
__device__ __forceinline__ void gemm_phase(PG8_LAS unsigned char* lds, const Gemm g, const Sched& S, const Epi& E) {
    const int tid = threadIdx.x, wid = __builtin_amdgcn_readfirstlane(tid >> 6), lane = tid & 63, wr = wid >> 2, wc = wid & 3, fr = lane & 15, fq = lane >> 4;
    const int K = g.K, nt = K / BK;
    unsigned voffA[2], voffB[2];
#pragma unroll
    for (int i = 0; i < 2; ++i) { int R, C; stage_rc(tid * 16 + i * 8192, R, C); const int Rb = Epi::PERM ? ((R & ~31) + perm32(R & 31)) : R;
        voffA[i] = (unsigned)(R * K + C) * 2u; voffB[i] = (unsigned)(Rb * K + C) * 2u; }
    const size_t kstep = (size_t)(BK * 2);
    const size_t hstep = (size_t)HALF * K * 2;
    const size_t tstep = 2 * hstep;
    const unsigned ldsw = (unsigned)wid * 1024u;
    const int aoff = lds_byte(wr * 64 + fr, fq * 8), boff = lds_byte(wc * 32 + fr, fq * 8);
#define PG8_SA(b, h) (((b) * 2 + (h)) * HTB)
#define PG8_SB(b, h) ((4 + (b) * 2 + (h)) * HTB)
#define PG8_STAGE(bufoff, gbase, voff) do { _Pragma("unroll") for (int _i = 0; _i < 2; ++_i) \
        __builtin_amdgcn_global_load_lds((const unsigned*)((const char*)(gbase) + (voff)[_i]), (PG8_LAS unsigned*)(lds + (bufoff) + ldsw + _i * 8192), 16, 0, 0); } while (0)
#define PG8_LDA(dst, b, h) do { _Pragma("unroll") for (int m = 0; m < 4; ++m) _Pragma("unroll") for (int k = 0; k < 2; ++k) dst[m][k] = *(const PG8_LAS bf16x8*)(lds + PG8_SA(b, h) + aoff + m * 2048 + k * 1024); } while (0)
#define PG8_LDB(dst, b, h) do { _Pragma("unroll") for (int n = 0; n < 2; ++n) _Pragma("unroll") for (int k = 0; k < 2; ++k) dst[n][k] = *(const PG8_LAS bf16x8*)(lds + PG8_SB(b, h) + boff + n * 2048 + k * 1024); } while (0)
#define PG8_MMA(ai, bj, At, Bt) do { __builtin_amdgcn_s_setprio(1); _Pragma("unroll") for (int m = 0; m < 4; ++m) _Pragma("unroll") for (int n = 0; n < 2; ++n) _Pragma("unroll") for (int k = 0; k < 2; ++k) \
        acc[ai][bj][m][n] = __builtin_amdgcn_mfma_f32_16x16x32_bf16(Bt[n][k], At[m][k], acc[ai][bj][m][n], 0, 0, 0); __builtin_amdgcn_s_setprio(0); } while (0)
#define PG8_WAIT_V(n) asm volatile("s_waitcnt vmcnt(" #n ")" ::: "memory")
#define PG8_WAIT_L(n) asm volatile("s_waitcnt lgkmcnt(" #n ")" ::: "memory")
#define PG8_BAR __builtin_amdgcn_s_barrier()
#define PG8_SCHED __builtin_amdgcn_sched_barrier(0)
    Unit cur, nxt; int ui = 0;
    if (!S.next(0, cur)) return;
    f32x4 acc[2][2][4][2];
#pragma unroll
    for (int a = 0; a < 2; ++a)
#pragma unroll
        for (int b = 0; b < 2; ++b)
#pragma unroll
            for (int m = 0; m < 4; ++m)
#pragma unroll
                for (int n = 0; n < 2; ++n) acc[a][b][m][n] = (f32x4){0.f, 0.f, 0.f, 0.f};
    bf16x8 At[4][2], B0[2][2], B1[2][2];
    const char* cA = (const char*)g.A + (size_t)cur.pm * tstep; const char* cB = (const char*)g.Bt + (size_t)cur.pn * tstep;
    S.a_ready(cur);
    if constexpr (SP2) {
        PG8_STAGE(PG8_SB(0, 0), cB, voffB); PG8_STAGE(PG8_SB(0, 1), cB + hstep, voffB); PG8_STAGE(PG8_SA(0, 0), cA, voffA); PG8_STAGE(PG8_SA(0, 1), cA + hstep, voffA);
        if (wr == 1) PG8_BAR;
        PG8_WAIT_V(2); PG8_BAR;
        PG8_STAGE(PG8_SB(1, 0), cB + kstep, voffB); PG8_STAGE(PG8_SA(1, 0), cA + kstep, voffA); PG8_STAGE(PG8_SB(1, 1), cB + hstep + kstep, voffB);
        PG8_WAIT_V(6); PG8_BAR;
    } else {
        PG8_STAGE(PG8_SB(0, 0), cB, voffB); PG8_STAGE(PG8_SA(0, 0), cA, voffA); PG8_STAGE(PG8_SB(0, 1), cB + hstep, voffB); PG8_STAGE(PG8_SA(0, 1), cA + hstep, voffA);
        if (wr == 1) PG8_BAR;
        PG8_WAIT_V(4); PG8_BAR;
        PG8_STAGE(PG8_SB(1, 0), cB + kstep, voffB); PG8_STAGE(PG8_SA(1, 0), cA + kstep, voffA); PG8_STAGE(PG8_SB(1, 1), cB + hstep + kstep, voffB);
        PG8_WAIT_V(6); PG8_BAR;
    }
    for (;;) {
        const bool has_next = S.next(ui + 1, nxt);
        const char* nA = has_next ? (const char*)g.A + (size_t)nxt.pm * tstep : cA; const char* nB = has_next ? (const char*)g.Bt + (size_t)nxt.pn * tstep : cB;
        for (int t = 0; t < nt; t += 2) {
            const bool last = (t == nt - 2);
            const char* a1 = cA + (size_t)(t + 1) * kstep;
            const char* a2 = last ? nA : cA + (size_t)(t + 2) * kstep; const char* b2 = last ? nB : cB + (size_t)(t + 2) * kstep;
            const char* a3 = a2 + kstep; const char* b3 = b2 + kstep;
            if (last && has_next) S.a_ready(nxt);
            if constexpr (SP2) {
            PG8_LDB(B0, 0, 0); PG8_LDB(B1, 0, 1); PG8_SCHED; PG8_LDA(At, 0, 0); PG8_STAGE(PG8_SA(1, 1), a1 + hstep, voffA);
            PG8_WAIT_V(8); PG8_WAIT_L(0); PG8_BAR; PG8_MMA(0, 0, At, B0); PG8_MMA(0, 1, At, B1); PG8_BAR; PG8_SCHED;
            PG8_LDA(At, 0, 1); PG8_STAGE(PG8_SB(0, 0), b2, voffB); PG8_STAGE(PG8_SB(0, 1), b2 + hstep, voffB); PG8_STAGE(PG8_SA(0, 0), a2, voffA);
            PG8_WAIT_V(8); PG8_WAIT_L(0); PG8_BAR; PG8_MMA(1, 0, At, B0); PG8_MMA(1, 1, At, B1); PG8_BAR; PG8_SCHED;
            PG8_LDB(B0, 1, 0); PG8_LDB(B1, 1, 1); PG8_SCHED; PG8_LDA(At, 1, 0); PG8_STAGE(PG8_SA(0, 1), a2 + hstep, voffA);
            PG8_WAIT_V(8); PG8_WAIT_L(0); PG8_BAR; PG8_MMA(0, 0, At, B0); PG8_MMA(0, 1, At, B1); PG8_BAR; PG8_SCHED;
            PG8_LDA(At, 1, 1); PG8_STAGE(PG8_SB(1, 0), b3, voffB); PG8_STAGE(PG8_SB(1, 1), b3 + hstep, voffB); PG8_STAGE(PG8_SA(1, 0), a3, voffA);
            PG8_WAIT_V(8); PG8_WAIT_L(0); PG8_BAR; PG8_MMA(1, 0, At, B0); PG8_MMA(1, 1, At, B1); PG8_BAR; PG8_SCHED;
            } else {
            PG8_LDB(B0, 0, 0); PG8_SCHED; PG8_LDA(At, 0, 0); PG8_STAGE(PG8_SA(1, 1), a1 + hstep, voffA);
            PG8_WAIT_L(8); PG8_BAR; PG8_WAIT_L(0); PG8_MMA(0, 0, At, B0); PG8_BAR; PG8_SCHED;
            PG8_LDB(B1, 0, 1); PG8_STAGE(PG8_SB(0, 0), b2, voffB);
            PG8_BAR; PG8_WAIT_L(0); PG8_MMA(0, 1, At, B1); PG8_BAR;
            PG8_LDA(At, 0, 1); PG8_STAGE(PG8_SA(0, 0), a2, voffA);
            PG8_BAR; PG8_WAIT_L(0); PG8_MMA(1, 0, At, B0); PG8_BAR; PG8_SCHED;
            PG8_STAGE(PG8_SB(0, 1), b2 + hstep, voffB);
            PG8_WAIT_V(6); PG8_BAR; PG8_MMA(1, 1, At, B1); PG8_BAR;
            PG8_LDB(B0, 1, 0); PG8_SCHED; PG8_LDA(At, 1, 0); PG8_STAGE(PG8_SA(0, 1), a2 + hstep, voffA);
            PG8_WAIT_L(8); PG8_BAR; PG8_WAIT_L(0); PG8_MMA(0, 0, At, B0); PG8_BAR; PG8_SCHED;
            PG8_LDB(B1, 1, 1); PG8_STAGE(PG8_SB(1, 0), b3, voffB);
            PG8_BAR; PG8_WAIT_L(0); PG8_MMA(0, 1, At, B1); PG8_BAR;
            PG8_LDA(At, 1, 1); PG8_STAGE(PG8_SA(1, 0), a3, voffA);
            PG8_BAR; PG8_WAIT_L(0); PG8_MMA(1, 0, At, B0); PG8_BAR; PG8_SCHED;
            PG8_STAGE(PG8_SB(1, 1), b3 + hstep, voffB);
            PG8_WAIT_V(6); PG8_BAR; PG8_MMA(1, 1, At, B1); PG8_BAR;
            }
        }
        if constexpr (ALIGN_EPI) { if (wr == 0) PG8_BAR; }
        if constexpr (!Epi::AFTER_DRAIN) { E(acc, cur, wr, wc, fr, fq); if constexpr (Epi::DUPE) { __builtin_amdgcn_sched_barrier(0); E(acc, cur, wr, wc, fr, fq); } S.done(cur); }
        if (!has_next) break;
#pragma unroll
        for (int a = 0; a < 2; ++a)
#pragma unroll
            for (int b = 0; b < 2; ++b)
#pragma unroll
                for (int m = 0; m < 4; ++m)
#pragma unroll
                    for (int n = 0; n < 2; ++n) acc[a][b][m][n] = (f32x4){0.f, 0.f, 0.f, 0.f};
        cur = nxt; cA = nA; cB = nB; ++ui;
        if constexpr (ALIGN_EPI) { if (wr == 1) PG8_BAR; }
    }
    PG8_WAIT_V(0);
    if constexpr (!ALIGN_EPI) { if (wr == 0) PG8_BAR; }
    PG8_BAR;
    if constexpr (Epi::AFTER_DRAIN) { E.fused(acc, cur, wr, wc, fr, fq, lds, wid, lane); S.done(cur); }
#undef PG8_SA
#undef PG8_SB
#undef PG8_STAGE
#undef PG8_LDA
#undef PG8_LDB
#undef PG8_MMA
#undef PG8_WAIT_V
#undef PG8_WAIT_L
#undef PG8_BAR
#undef PG8_SCHED
}
}

constexpr int D = 1024, NB = 4, SEQ = 8192, DB = 8, DT = 16, PAST = 4096;
constexpr int MP = NB * SEQ;
constexpr int MS = DB * DT;
constexpr int MR = MP + MS;
constexpr int M = 33024;
constexpr int LW = 512, NLB = 8, LBW = 64;
constexpr int KVW = 128;
constexpr int DIN = 2376, NIN = 2560;
constexpr int DFF = 2816;
constexpr int SKEYS = PAST + DT;
constexpr float EPS = 1e-6f;
constexpr float WI_SCALE = 0.044194173824159216f;

constexpr size_t O_YP = 0;
constexpr size_t O_YS = O_YP + (size_t)MP * D;
constexpr size_t O_KP = O_YS + (size_t)MS * D;
constexpr size_t O_VP = O_KP + (size_t)MP * KVW;
constexpr size_t O_KIP = O_VP + (size_t)MP * KVW;
constexpr size_t O_HP = O_KIP + (size_t)MP * 64;
constexpr size_t O_CP = O_HP + (size_t)NB * LW;
constexpr size_t O_KS = O_CP + (size_t)NB * 3 * LW;
constexpr size_t O_VS = O_KS + (size_t)MS * KVW;
constexpr size_t O_KIS = O_VS + (size_t)MS * KVW;
constexpr size_t O_HS = O_KIS + (size_t)MS * 64;
constexpr size_t O_CS = O_HS + (size_t)DB * LW;
constexpr size_t O_END = O_CS + (size_t)DB * 3 * LW;
static_assert(O_END == 44236800, "output size");

constexpr size_t al256(size_t x) { return (x + 255) & ~(size_t)255; }
constexpr size_t WS_CTL = 0, CTL_BYTES = 1u << 20;
constexpr size_t WS_WIN = WS_CTL + CTL_BYTES;
constexpr size_t WS_WOUT = WS_WIN + al256((size_t)NIN * D * 2);
constexpr size_t WS_WFI = WS_WOUT + al256((size_t)D * D * 2);
constexpr size_t WS_WFO = WS_WFI + al256((size_t)2 * DFF * D * 2);
constexpr size_t WS_WG = WS_WFO + al256((size_t)D * DFF * 2);
constexpr size_t WS_RCOS = WS_WG + al256((size_t)2 * 8 * 64 * 64 * 2);
constexpr size_t WS_RSIN = WS_RCOS + al256((size_t)8192 * 32 * 4);
constexpr size_t WS_SP = WS_RSIN + al256((size_t)8192 * 32 * 4);
constexpr size_t WS_RSTD = WS_SP + al256(512 * 4);
constexpr size_t WS_SSQ = WS_RSTD + al256((size_t)M * 4);
constexpr size_t WS_WI = WS_SSQ + al256((size_t)M * 4);
constexpr size_t WS_AGG = WS_WI + al256((size_t)M * 8 * 4);
constexpr size_t WS_XB = WS_AGG + al256((size_t)12 * 64 * 512 * 8);
constexpr size_t WS_YC = WS_XB + al256((size_t)M * D * 2);
constexpr size_t WS_KB = WS_YC + al256((size_t)M * D * 2);
constexpr size_t WS_VB = WS_KB + al256((size_t)MP * KVW * 2);
constexpr size_t WS_KIB = WS_VB + al256((size_t)MP * KVW * 2);
constexpr size_t WS_KS = WS_KIB + al256((size_t)MP * 64 * 2);
constexpr size_t WS_VS = WS_KS + al256((size_t)DB * SKEYS * KVW * 2);
constexpr size_t WS_KIS = WS_VS + al256((size_t)DB * SKEYS * KVW * 2);
constexpr size_t WS_R1 = WS_KIS + al256((size_t)DB * SKEYS * 64 * 2);
constexpr size_t WS_XR = WS_R1;
constexpr size_t WS_GG = WS_XR + al256((size_t)M * LW * 2);
constexpr size_t WS_Q = WS_GG + al256((size_t)M * LW * 2);
constexpr size_t WS_QI = WS_Q + al256((size_t)M * LW * 2);
constexpr size_t WS_ACUM = WS_QI + al256((size_t)M * LW * 2);
constexpr size_t WS_BCUM = WS_ACUM + al256((size_t)M * LW * 4);
constexpr size_t WS_R1_END = WS_BCUM + al256((size_t)M * LW * 4);
constexpr size_t WS_H = WS_R1;
static_assert(WS_H + (size_t)M * DFF * 2 <= WS_R1_END, "H overlay fits");
constexpr size_t WS_CANDG = WS_ACUM;
static_assert(WS_CANDG + (size_t)M * 1024 * 4 <= WS_R1_END, "candidate lists fit");
constexpr size_t WS_SEL = WS_R1_END;
constexpr size_t WS_NSEL = WS_SEL + al256((size_t)M * 256 * 2);
constexpr size_t WS_END = WS_NSEL + al256((size_t)M * 4);

#ifndef DUPMASK
#define DUPMASK 0
#endif
#define DUP(k) ((DUPMASK >> (k)) & 1)
#ifndef USE_CG_SYNC
#define USE_CG_SYNC 0
#endif
constexpr int CW_QUEUE = 2048;
constexpr int CW_BAR = 4096;
constexpr int LDSCTL_OFF = 131072 + 1024;
#ifndef WGM_IN
#define WGM_IN 4
#endif
#ifndef WGM_OUT
#define WGM_OUT 2
#endif
#ifndef WGM_FI
#define WGM_FI 4
#endif
#ifndef WGM_FO
#define WGM_FO 2
#endif
#ifndef STG_IN
#define STG_IN 0
#endif
#ifndef STG_OUT
#define STG_OUT 0
#endif
#ifndef STG_FI
#define STG_FI 0
#endif
#ifndef STG_FO
#define STG_FO 0
#endif
#ifndef GEMM_SP2
#define GEMM_SP2 true
#endif
#ifndef EPI_DUP_MASK
#define EPI_DUP_MASK 0
#endif
#ifndef FORCE_FALLBACK
#define FORCE_FALLBACK 0
#endif
#ifndef FORCE_SAFE_MODE
#define FORCE_SAFE_MODE 0
#endif
#ifndef TSEG
#define TSEG 0
#endif
#define TIC(id) unsigned long long tic_##id = (TSEG == (id)) ? __builtin_amdgcn_s_memrealtime() : 0ull
#define TOC(id) do { if (TSEG == (id) && F.bid == 0 && F.wave == 0) { const unsigned d_ = (unsigned)(__builtin_amdgcn_s_memrealtime() - tic_##id); if (F.lane == 0) { LAS unsigned* a_ = (LAS unsigned*)(F.lds + LDSCTL_OFF + 128); *a_ += d_; } } } while (0)
constexpr int LDS_BYTES = 147456;

#define LAS __attribute__((address_space(3)))
typedef unsigned short bf16;
typedef float f32x4 __attribute__((ext_vector_type(4)));
typedef float f32x2 __attribute__((ext_vector_type(2)));
typedef unsigned u32x4 __attribute__((ext_vector_type(4)));
typedef unsigned u32x2 __attribute__((ext_vector_type(2)));
typedef short bf16x8 __attribute__((ext_vector_type(8)));

__device__ __forceinline__ unsigned pk2(float lo, float hi) { unsigned r; asm("v_cvt_pk_bf16_f32 %0, %1, %2" : "=v"(r) : "v"(lo), "v"(hi)); return r; }
__device__ __forceinline__ unsigned f2bf(float f) { return pk2(f, 0.f) & 0xffffu; }
__device__ __forceinline__ float bf2f(unsigned b) { return __builtin_bit_cast(float, b << 16); }
__device__ __forceinline__ float bflo(unsigned w) { return __builtin_bit_cast(float, w << 16); }
__device__ __forceinline__ float bfhi(unsigned w) { return __builtin_bit_cast(float, w & 0xffff0000u); }
__device__ __forceinline__ void store_bf16x8(bf16* p, f32x4 lo, f32x4 hi) {
    u32x4 w; w.x = pg8::cvt_pk_bf16(lo[0], lo[1]); w.y = pg8::cvt_pk_bf16(lo[2], lo[3]); w.z = pg8::cvt_pk_bf16(hi[0], hi[1]); w.w = pg8::cvt_pk_bf16(hi[2], hi[3]);
    *(u32x4*)p = w;
}
typedef unsigned char fp8;
__device__ __forceinline__ unsigned pk4_fp8(float a, float b, float c, float d) { int w = __builtin_amdgcn_cvt_pk_fp8_f32(a, b, 0, false); w = __builtin_amdgcn_cvt_pk_fp8_f32(c, d, w, true); return (unsigned)w; }
__device__ __forceinline__ void store_bf16_lines(bf16* prow_c0  , size_t rowstride, f32x4 a0, f32x4 a1, f32x4 b0, f32x4 b1, bool lo8) {
    u32x4 p0, p1; p0.x = pg8::cvt_pk_bf16(a0[0], a0[1]); p0.y = pg8::cvt_pk_bf16(a0[2], a0[3]); p0.z = pg8::cvt_pk_bf16(a1[0], a1[1]); p0.w = pg8::cvt_pk_bf16(a1[2], a1[3]);
    p1.x = pg8::cvt_pk_bf16(b0[0], b0[1]); p1.y = pg8::cvt_pk_bf16(b0[2], b0[3]); p1.z = pg8::cvt_pk_bf16(b1[0], b1[1]); p1.w = pg8::cvt_pk_bf16(b1[2], b1[3]);
    u32x4 rcv, v1, v2;
#pragma unroll
    for (int j = 0; j < 4; ++j) { const unsigned snd = lo8 ? p1[j] : p0[j];
        rcv[j] = (unsigned)__builtin_amdgcn_update_dpp(0, (int)snd, 0x128  , 0xf, 0xf, false);
        v1[j] = lo8 ? p0[j] : rcv[j]; v2[j] = lo8 ? rcv[j] : p1[j]; }
    bf16* q = lo8 ? prow_c0 : prow_c0 - 8 * rowstride + 32;
    *(u32x4*)q = v1; *(u32x4*)(q + 8 * rowstride) = v2;
}
__device__ __forceinline__ size_t ki_tiled(int k, int d) { return (size_t)(k >> 4) * 1024 + (size_t)(((d >> 3) * 16 + (k & 15)) * 8 + (d & 7)); }
__device__ __forceinline__ void store_fp8x8(fp8* p, f32x4 lo, f32x4 hi) { u32x2 w; w.x = pk4_fp8(lo[0], lo[1], lo[2], lo[3]); w.y = pk4_fp8(hi[0], hi[1], hi[2], hi[3]); *(u32x2*)p = w; }
__device__ __forceinline__ u32x2 fp8x4_bf16x4(unsigned w) {
    const f32x2 a = __builtin_amdgcn_cvt_pk_f32_fp8((int)w, false); const f32x2 b = __builtin_amdgcn_cvt_pk_f32_fp8((int)w, true);
    const float a0 = a.x, a1 = a.y, b0 = b.x, b1 = b.y;
    u32x2 o; o.x = __builtin_amdgcn_perm(__float_as_uint(a1), __float_as_uint(a0), 0x07060302u); o.y = __builtin_amdgcn_perm(__float_as_uint(b1), __float_as_uint(b0), 0x07060302u);
    return o;
}
__device__ __forceinline__ float gelu_tanh(float x) {
    const float u = 0.7978845608028654f * (x + 0.044715f * x * x * x);
    const float e = __expf(2.0f * u);
    const float th = 1.0f - 2.0f * __builtin_amdgcn_rcpf(e + 1.0f);
    return 0.5f * x * (1.0f + th);
}
__device__ __forceinline__ float sigmoidf_(float x) { return __builtin_amdgcn_rcpf(1.0f + __expf(-x)); }

#define XB_TMO      128
#define XB_XCNT(j)  (256  + 64 * (j))
#define XB_XSUB(j)  (1280 + 64 * (j))
#define XB_XGEN(j)  (2304 + 64 * (j))
#define XB_TOP      3328
#define XB_TOPGEN   3392
#define XCD_BAR_WORDS 3456
#define XB_SPIN_CAP (1u << 18)

__device__ __forceinline__ unsigned xb_ld(unsigned* p)              { return __hip_atomic_load(p, __ATOMIC_RELAXED, __HIP_MEMORY_SCOPE_AGENT); }
__device__ __forceinline__ unsigned xb_add(unsigned* p, unsigned v) { return __hip_atomic_fetch_add(p, v, __ATOMIC_RELAXED, __HIP_MEMORY_SCOPE_AGENT); }
__device__ __forceinline__ unsigned xb_xcc_id() { return (unsigned)__builtin_amdgcn_s_getreg((3 << 11) | 20) & 0xFu; }
#define XB_SPIN(cond, bar) do { unsigned _sp = 0; while (cond) { __builtin_amdgcn_s_sleep(1); \
    if ((++_sp & 255u) == 0u) { if (xb_ld(&(bar)[XB_TMO])) break; if (_sp > XB_SPIN_CAP) { atomicAdd(&(bar)[XB_TMO], 1u); break; } } } } while (0)

struct XcdBarrier {
    unsigned* bar; unsigned x;
    volatile LAS unsigned* st;
};

__device__ __forceinline__ XcdBarrier xcd_barrier_post(unsigned* bar, volatile LAS unsigned* st) {
    XcdBarrier b; b.bar = bar; b.x = xb_xcc_id(); b.st = st;
    if (threadIdx.x == 0) (void)xb_add(&bar[XB_XCNT(b.x)], 1u);
    return b;
}
__device__ __forceinline__ void xcd_barrier_complete(unsigned* bar, unsigned x, unsigned& nloc, unsigned& nx) {
    const unsigned G = gridDim.x * gridDim.y * gridDim.z;
    unsigned sum, cnt, mine, sp = 0u;
    for (;;) {
        sum = 0u; cnt = 0u; mine = 0u;
#pragma unroll
        for (unsigned j = 0; j < 16; ++j) { const unsigned c = xb_ld(&bar[XB_XCNT(j)]); sum += c; cnt += (c > 0u) ? 1u : 0u; mine = (j == x) ? c : mine; }
        if (sum == G) break;
        __builtin_amdgcn_s_sleep(1);
        if ((++sp & 255u) == 0u) { if (xb_ld(&bar[XB_TMO])) break; if (sp > XB_SPIN_CAP) { atomicAdd(&bar[XB_TMO], 1u); break; } }
    }
    nloc = mine > 0u ? mine : 1u; nx = cnt > 0u ? cnt : 1u;
}

__device__ __forceinline__ void xcd_barrier(const XcdBarrier& b) {
    asm volatile("s_waitcnt vmcnt(0)" ::: "memory");
    __syncthreads();
    if (threadIdx.x == 0) {
        unsigned* bar = b.bar;
        __builtin_amdgcn_s_waitcnt(0);
        unsigned nloc = b.st[0], nx = b.st[1];
        if (nloc == 0u) { xcd_barrier_complete(bar, b.x, nloc, nx); b.st[0] = nloc; b.st[1] = nx; }
        const unsigned old = xb_add(&bar[XB_XSUB(b.x)], 1u);
        const unsigned gen = old / nloc;
        if (old + 1u == (gen + 1u) * nloc) {
            __builtin_amdgcn_fence(__ATOMIC_RELEASE, "agent");
            asm volatile("s_waitcnt vmcnt(0)" ::: "memory");
            const unsigned og = xb_add(&bar[XB_TOP], 1u);
            const unsigned tg = og / nx;
            if (og + 1u == (tg + 1u) * nx) xb_add(&bar[XB_TOPGEN], 1u);
            else XB_SPIN(xb_ld(&bar[XB_TOPGEN]) == tg, bar);
            __builtin_amdgcn_fence(__ATOMIC_ACQUIRE, "agent");
            xb_add(&bar[XB_XGEN(b.x)], 1u);
            asm volatile("s_waitcnt vmcnt(0)" ::: "memory");
        } else {
            XB_SPIN(xb_ld(&bar[XB_XGEN(b.x)]) == gen, bar);
            __builtin_amdgcn_fence(__ATOMIC_ACQUIRE, "agent");
            asm volatile("s_waitcnt vmcnt(0)" ::: "memory");
        }
    }
    __syncthreads();
}
struct EpiInProj {
    static constexpr bool PERM = false, AFTER_DRAIN = false, DUPE = (EPI_DUP_MASK >> 0) & 1;
    const float* rstd; const float* rcos; const float* rsin; const float* gq; const float* gk;
    bf16* XR; bf16* GG; bf16* Q; bf16* QI; fp8* KB; fp8* VB; bf16* KIB; fp8* KS; fp8* VS; bf16* KIS; float* WI; float* out;

    template <bool NORM> __device__ __forceinline__ void head_rope(f32x4 (&v)[2][2], const float* g, int pos, int fq) const {
        if (NORM) {
            float ss = 0.f;
#pragma unroll
            for (int bj = 0; bj < 2; ++bj)
#pragma unroll
                for (int n = 0; n < 2; ++n) ss += (v[bj][n][0] * v[bj][n][0] + v[bj][n][1] * v[bj][n][1]) + (v[bj][n][2] * v[bj][n][2] + v[bj][n][3] * v[bj][n][3]);
            ss += __shfl_xor(ss, 16); ss += __shfl_xor(ss, 32);
            const float inv = rsqrtf(ss * (1.0f / 64.0f) + EPS);
#pragma unroll
            for (int bj = 0; bj < 2; ++bj)
#pragma unroll
                for (int n = 0; n < 2; ++n) { const f32x4 g4 = *(const f32x4*)(g + 32 * bj + 8 * fq + 4 * n); v[bj][n] = v[bj][n] * inv * g4; }
        }
#pragma unroll
        for (int n = 0; n < 2; ++n) {
            const f32x4 c4 = *(const f32x4*)(rcos + pos * 32 + 8 * fq + 4 * n), s4 = *(const f32x4*)(rsin + pos * 32 + 8 * fq + 4 * n);
            const f32x4 x1 = v[0][n], x2 = v[1][n];
            v[0][n] = x1 * c4 - x2 * s4; v[1][n] = x2 * c4 + x1 * s4;
        }
    }
    __device__ __forceinline__ void operator()(const f32x4 (&acc)[2][2][4][2], const pg8::Unit& u, int wr, int wc, int fr, int fq) const {
        const int pn = u.pn;
#pragma unroll
        for (int ai = 0; ai < 2; ++ai) {
            const int rbase = u.pm * 256 + ai * 128;
            if (rbase >= MR) continue;
            const bool samp = rbase >= MP;
#pragma unroll
            for (int m = 0; m < 4; ++m) {
                const int r = rbase + wr * 64 + m * 16 + fr;
                int sb, t, pos;
                if (!samp) { sb = r >> 13; t = r & 8191; pos = t; } else { const int rs = r - MP; sb = rs >> 4; t = rs & 15; pos = PAST + t; }
                const float rsd = rstd[r];
                f32x4 v[2][2];
#pragma unroll
                for (int bj = 0; bj < 2; ++bj)
#pragma unroll
                    for (int n = 0; n < 2; ++n) v[bj][n] = acc[ai][bj][m][n] * rsd;
                if (pn < 2) {
#pragma unroll
                    for (int bj = 0; bj < 2; ++bj) {
                        const int c = 256 * pn + 64 * wc + 32 * bj + 8 * fq;
                        if (bj == 0) store_bf16_lines(XR + (size_t)r * LW + c, LW, v[0][0], v[0][1], v[1][0], v[1][1], fr < 8);
                        const int tl = samp ? DT - 3 : SEQ - 3;
                        if (t >= tl) {
                            float* o = samp ? out + O_CS + ((size_t)(sb * 3 + (t - tl))) * LW + c : out + O_CP + ((size_t)(sb * 3 + (t - tl))) * LW + c;
                            *(f32x4*)o = v[bj][0]; *(f32x4*)(o + 4) = v[bj][1];
                        }
                    }
                } else if (pn < 4) {
#pragma unroll
                    for (int bj = 0; bj < 2; ++bj)
#pragma unroll
                        for (int n = 0; n < 2; ++n)
#pragma unroll
                            for (int j = 0; j < 4; ++j) v[bj][n][j] = gelu_tanh(v[bj][n][j]);
                    store_bf16_lines(GG + (size_t)r * LW + 256 * (pn - 2) + 64 * wc + 8 * fq, LW, v[0][0], v[0][1], v[1][0], v[1][1], fr < 8);
                } else if (pn < 6) {
                    head_rope<true>(v, gq, pos, fq);
                    const int head = 4 * (pn - 4) + wc;
                    store_bf16_lines(Q + (size_t)r * 512 + head * 64 + 8 * fq, 512, v[0][0], v[0][1], v[1][0], v[1][1], fr < 8);
                } else if (pn == 6) {
                    if (wc < 2) head_rope<true>(v, gk, pos, fq);
                    const int hh = wc & 1;
                    float* of; fp8* ob;
                    if (wc < 2) { of = samp ? out + O_KS + (size_t)(r - MP) * KVW : out + O_KP + (size_t)r * KVW; ob = samp ? KS + ((size_t)sb * SKEYS + PAST + t) * KVW : KB + (size_t)r * KVW; }
                    else        { of = samp ? out + O_VS + (size_t)(r - MP) * KVW : out + O_VP + (size_t)r * KVW; ob = samp ? VS + ((size_t)sb * SKEYS + PAST + t) * KVW : VB + (size_t)r * KVW; }
#pragma unroll
                    for (int bj = 0; bj < 2; ++bj) {
                        const int c = hh * 64 + 32 * bj + 8 * fq;
                        *(f32x4*)(of + c) = v[bj][0]; *(f32x4*)(of + c + 4) = v[bj][1];
                        store_fp8x8(ob + c, v[bj][0], v[bj][1]);
                    }
                } else if (pn < 9) {
                    head_rope<false>(v, nullptr, pos, fq);
                    const int head = 4 * (pn - 7) + wc;
                    store_bf16_lines(QI + (size_t)r * 512 + head * 64 + 8 * fq, 512, v[0][0], v[0][1], v[1][0], v[1][1], fr < 8);
                } else {
                    if (wc == 0) {
                        head_rope<false>(v, nullptr, pos, fq);
                        float* of = samp ? out + O_KIS + (size_t)(r - MP) * 64 : out + O_KIP + (size_t)r * 64;
                        bf16* ob = samp ? KIS + (size_t)sb * SKEYS * 64 : KIB + (size_t)sb * SEQ * 64; const int kk = samp ? PAST + t : t;
#pragma unroll
                        for (int bj = 0; bj < 2; ++bj) {
                            const int c = 32 * bj + 8 * fq;
                            *(f32x4*)(of + c) = v[bj][0]; *(f32x4*)(of + c + 4) = v[bj][1];
                            store_bf16x8(ob + ki_tiled(kk, c), v[bj][0], v[bj][1]);
                        }
                    } else if (wc == 1) {
                        if (fq == 0) { *(f32x4*)(WI + (size_t)r * 8) = v[0][0] * WI_SCALE; *(f32x4*)(WI + (size_t)r * 8 + 4) = v[0][1] * WI_SCALE; }
                    }
                }
            }
        }
    }
};

struct EpiOutProj {
    static constexpr bool PERM = false, AFTER_DRAIN = false, DUPE = false;
    const float* xp; const float* xs; float* out; bf16* XB2; float* ssq;
    __device__ __forceinline__ void operator()(const f32x4 (&acc)[2][2][4][2], const pg8::Unit& u, int wr, int wc, int fr, int fq) const {
        const int col0 = u.pn * 256 + wc * 32 + 4 * fq;
#pragma unroll
        for (int ai = 0; ai < 2; ++ai) {
            const int rbase = u.pm * 256 + ai * 128;
            if (rbase >= MR) continue;
            const bool samp = rbase >= MP;
#pragma unroll
            for (int m = 0; m < 4; ++m) {
                const int r = rbase + wr * 64 + m * 16 + fr;
                const float* xrow = samp ? xs + (size_t)(r - MP) * D : xp + (size_t)r * D;
                float* yrow = samp ? out + O_YS + (size_t)(r - MP) * D : out + O_YP + (size_t)r * D;
                float ss = 0.f;
#pragma unroll
                for (int bj = 0; bj < 2; ++bj)
#pragma unroll
                    for (int n = 0; n < 2; ++n) {
                        const int c = col0 + bj * 128 + n * 16;
                        const f32x4 y = *(const f32x4*)(xrow + c) + acc[ai][bj][m][n];
                        if (samp) *(f32x4*)(yrow + c) = y;
                        ss += (y[0] * y[0] + y[1] * y[1]) + (y[2] * y[2] + y[3] * y[3]);
                        u32x2 w; w.x = pg8::cvt_pk_bf16(y[0], y[1]); w.y = pg8::cvt_pk_bf16(y[2], y[3]);
                        *(u32x2*)(XB2 + (size_t)r * D + c) = w;
                    }
                ss += __shfl_xor(ss, 16); ss += __shfl_xor(ss, 32);
                if (fq == 0) atomicAdd(ssq + r, ss);
            }
        }
    }
};

struct EpiFfnIn {
    static constexpr bool PERM = false, AFTER_DRAIN = false, DUPE = (EPI_DUP_MASK >> 2) & 1;
    const float* ssq; bf16* H;
    __device__ __forceinline__ void operator()(const f32x4 (&acc)[2][2][4][2], const pg8::Unit& u, int wr, int wc, int fr, int fq) const {
        const int c = 128 * u.pn + 32 * wc + 8 * fq;
#pragma unroll
        for (int ai = 0; ai < 2; ++ai) {
            const int rbase = u.pm * 256 + ai * 128;
            if (rbase >= MR) continue;
#pragma unroll
            for (int m = 0; m < 4; ++m) {
                const int r = rbase + wr * 64 + m * 16 + fr;
                const float rs2 = rsqrtf(ssq[r] * (1.0f / 1024.0f) + EPS);
                f32x4 h[2];
#pragma unroll
                for (int n = 0; n < 2; ++n) {
                    const f32x4 g = acc[ai][0][m][n] * rs2, up = acc[ai][1][m][n] * rs2;
#pragma unroll
                    for (int j = 0; j < 4; ++j) h[n][j] = g[j] * sigmoidf_(g[j]) * up[j];
                }
                store_bf16x8(H + (size_t)r * DFF + c, h[0], h[1]);
            }
        }
    }
};

struct EpiFfnOut {
    static constexpr bool PERM = false, AFTER_DRAIN = false, DUPE = (EPI_DUP_MASK >> 3) & 1;
    float* out; const bf16* XB2;
    __device__ __forceinline__ void operator()(const f32x4 (&acc)[2][2][4][2], const pg8::Unit& u, int wr, int wc, int fr, int fq) const {
        const int col0 = u.pn * 256 + wc * 32 + 4 * fq;
        const bool lo8 = fr < 8;
#pragma unroll
        for (int ai = 0; ai < 2; ++ai) {
            const int rbase = u.pm * 256 + ai * 128;
            if (rbase >= MP) continue;
#pragma unroll
            for (int m = 0; m < 4; ++m) {
                const int r = rbase + wr * 64 + m * 16 + fr;
                float* ylo = out + O_YP + (size_t)(r - (lo8 ? 0 : 8)) * D + (lo8 ? 0 : 16);
#pragma unroll
                for (int bj = 0; bj < 2; ++bj) {
                    f32x4 y[2];
#pragma unroll
                    for (int n = 0; n < 2; ++n) { const int c = col0 + bj * 128 + n * 16; const u32x2 xw = *(const u32x2*)(XB2 + (size_t)r * D + c);
                        const f32x4 x1 = {bflo(xw.x), bfhi(xw.x), bflo(xw.y), bfhi(xw.y)}; y[n] = x1 + acc[ai][bj][m][n]; }
                    f32x4 rcv;
#pragma unroll
                    for (int j = 0; j < 4; ++j) { const float snd = lo8 ? y[1][j] : y[0][j];
                        rcv[j] = __builtin_bit_cast(float, __builtin_amdgcn_update_dpp(0, __builtin_bit_cast(int, snd), 0x128  , 0xf, 0xf, false)); }
                    f32x4 v1, v2;
#pragma unroll
                    for (int j = 0; j < 4; ++j) { v1[j] = lo8 ? y[0][j] : rcv[j]; v2[j] = lo8 ? rcv[j] : y[1][j]; }
                    float* q_ = ylo + col0 + bj * 128;
                    *(f32x4*)q_ = v1; *(f32x4*)(q_ + (size_t)8 * D) = v2;
                }
            }
        }
    }
};

struct Params {
    const float* in[22];
    float* out;
    unsigned char* ws;
    double invf[32];
    int ph_lo, ph_hi;
};
enum { I_XP = 0, I_XS, I_CK, I_CV, I_CKI, I_SH, I_SC, I_NM, I_WIN, I_CW, I_CB, I_WRG, I_BRG, I_WIG, I_BIG, I_LAM, I_QN, I_KN, I_WOUT, I_NF, I_WFI, I_WFO };

struct Frame { LAS unsigned char* lds; int tid, lane, wave, G, bid; };

template <int NB, int KSTEPS, class BRow, class Epi>
__device__ __forceinline__ void skinny_gemm(Frame& F, const bf16* A, int lda, const bf16* Bt, int K, int nct, BRow brow, Epi epi) {
    const int lane = F.lane, qc = lane & 15, kq = lane >> 4, w = F.wave;
    LAS f32x4* red = (LAS f32x4*)F.lds;
    for (int item = F.bid; item < 4 * nct; item += F.G) {
        const int rb = item & 3, ct = item >> 2;
        const bf16* a0 = A + (size_t)(rb * 32 + qc) * lda + 8 * kq + w * (KSTEPS * 32); const bf16* a1 = a0 + (size_t)16 * lda;
        const bf16* bp[NB];
#pragma unroll
        for (int nb = 0; nb < NB; ++nb) bp[nb] = Bt + (size_t)brow(ct, nb, qc) * K + 8 * kq + w * (KSTEPS * 32);
        f32x4 acc[2][NB];
#pragma unroll
        for (int m = 0; m < 2; ++m)
#pragma unroll
            for (int nb = 0; nb < NB; ++nb) acc[m][nb] = (f32x4){0.f, 0.f, 0.f, 0.f};
#pragma unroll
        for (int ks = 0; ks < KSTEPS; ++ks) {
            const bf16x8 fa0 = *(const bf16x8*)(a0 + 32 * ks), fa1 = *(const bf16x8*)(a1 + 32 * ks);
#pragma unroll
            for (int nb = 0; nb < NB; ++nb) {
                const bf16x8 fb = *(const bf16x8*)(bp[nb] + 32 * ks);
                acc[0][nb] = __builtin_amdgcn_mfma_f32_16x16x32_bf16(fb, fa0, acc[0][nb], 0, 0, 0);
                acc[1][nb] = __builtin_amdgcn_mfma_f32_16x16x32_bf16(fb, fa1, acc[1][nb], 0, 0, 0);
            }
        }
#pragma unroll
        for (int m = 0; m < 2; ++m)
#pragma unroll
            for (int nb = 0; nb < NB; ++nb) red[(w * 2 * NB + m * NB + nb) * 64 + lane] = acc[m][nb];
        __syncthreads();
        if (w < 2) {
            f32x4 s[NB];
#pragma unroll
            for (int nb = 0; nb < NB; ++nb) { s[nb] = red[(w * NB + nb) * 64 + lane];
#pragma unroll
                for (int w2 = 1; w2 < 8; ++w2) s[nb] += red[(w2 * 2 * NB + w * NB + nb) * 64 + lane]; }
            epi(s, rb * 32 + w * 16 + qc, 16 * ct + 4 * kq, kq);
        }
        __syncthreads();
    }
}

__device__ __forceinline__ float wave_sum(float v) {
#pragma unroll
    for (int o = 1; o < 64; o <<= 1) v += __shfl_xor(v, o);
    return v;
}

__device__ __forceinline__ void transpose_item(const float* W, int K, int N, int nvalid, const float* gain, bf16* WT, int k0, int row0, int lcol0, bool perm, LAS float* scr, int lane) {
    const int c4 = (lane & 7) * 4, col = lcol0 + c4; const bool ok = col < nvalid;
    f32x4 v[8];
#pragma unroll
    for (int i = 0; i < 8; ++i) { const int kk = (lane >> 3) + 8 * i; v[i] = ok ? *(const f32x4*)(W + (size_t)(k0 + kk) * N + col) : (f32x4){0.f, 0.f, 0.f, 0.f}; }
#pragma unroll
    for (int i = 0; i < 8; ++i) { const int kk = (lane >> 3) + 8 * i; const float g = gain ? gain[k0 + kk] : 1.0f; *(LAS f32x4*)(scr + kk * 36 + c4) = v[i] * g; }
    asm volatile("s_waitcnt lgkmcnt(0)" ::: "memory");
    const int c = lane & 7;
#pragma unroll
    for (int j = 0; j < 4; ++j) {
        const int n = (lane >> 3) + 8 * j, src = perm ? pg8::perm32(n) : n;
        const LAS float* s = scr + (8 * c) * 36 + src;
        u32x4 o; o.x = pk2(s[0 * 36], s[1 * 36]); o.y = pk2(s[2 * 36], s[3 * 36]); o.z = pk2(s[4 * 36], s[5 * 36]); o.w = pk2(s[6 * 36], s[7 * 36]);
        *(u32x4*)(WT + (size_t)(row0 + n) * K + k0 + 8 * c) = o;
    }
    asm volatile("s_waitcnt lgkmcnt(0)" ::: "memory");
}

__device__ __forceinline__ void phase0(const Params& p, Frame& F) {
    unsigned char* ws = p.ws;
    LAS float* scr = (LAS float*)(F.lds + F.wave * 16384);
    const int gw = F.bid * 8 + F.wave, NGW = F.G * 8;
    TIC(50);
    constexpr int I_IN = 16 * (NIN / 32), I_OUT = 16 * (D / 32), I_FI = 16 * (2 * DFF / 32), I_FO = (DFF / 64) * (D / 32);
    constexpr int NITEMS = I_IN + I_OUT + I_FI + I_FO;
    for (int it = gw; it < NITEMS; it += NGW) {
        int r = it;
        if (r < I_IN) { const int kb = r / (NIN / 32), g = r % (NIN / 32), pn = g >> 3, sub = g & 7, bj = sub >> 2, wc = sub & 3;
            transpose_item(p.in[I_WIN], D, DIN, DIN, p.in[I_NM], (bf16*)(ws + WS_WIN), 64 * kb, 32 * g, 256 * pn + 64 * wc + 32 * bj, true, scr, F.lane); continue; }
        r -= I_IN;
        if (r < I_OUT) { const int kb = r / (D / 32), g = r % (D / 32);
            transpose_item(p.in[I_WOUT], D, D, D, nullptr, (bf16*)(ws + WS_WOUT), 64 * kb, 32 * g, 32 * g, false, scr, F.lane); continue; }
        r -= I_OUT;
        if (r < I_FI) { const int kb = r / (2 * DFF / 32), g = r % (2 * DFF / 32), pn = g >> 3, sub = g & 7, bj = sub >> 2, wc = sub & 3;
            transpose_item(p.in[I_WFI], D, 2 * DFF, 2 * DFF, p.in[I_NF], (bf16*)(ws + WS_WFI), 64 * kb, 32 * g, (bj ? DFF : 0) + 128 * pn + 32 * wc, true, scr, F.lane); continue; }
        r -= I_FI;
        { const int kb = r / (D / 32), g = r % (D / 32);
            transpose_item(p.in[I_WFO], DFF, D, D, nullptr, (bf16*)(ws + WS_WFO), 64 * kb, 32 * g, 32 * g, false, scr, F.lane); }
    }
    TOC(50);
    TIC(51);
    {
        bf16* XB = (bf16*)(ws + WS_XB); float* rstd = (float*)(ws + WS_RSTD);
        for (int m0 = gw; m0 < M; m0 += 4 * NGW) {
            f32x4 v[4][4];
#pragma unroll
            for (int rr = 0; rr < 4; ++rr) {
                const int m = m0 + rr * NGW;
                const bool real = m < MR;
                const float* xrow = (m < MP) ? p.in[I_XP] + (size_t)m * D : p.in[I_XS] + (size_t)((real ? m : MP) - MP) * D;
                const f32x4* xr = (const f32x4*)xrow + F.lane;
#pragma unroll
                for (int j = 0; j < 4; ++j) v[rr][j] = real ? xr[64 * j] : (f32x4){0.f, 0.f, 0.f, 0.f};
            }
#pragma unroll
            for (int rr = 0; rr < 4; ++rr) {
                const int m = m0 + rr * NGW;
                if (m >= M) continue;
                float s = 0.f;
#pragma unroll
                for (int j = 0; j < 4; ++j) s += (v[rr][j][0] * v[rr][j][0] + v[rr][j][1] * v[rr][j][1]) + (v[rr][j][2] * v[rr][j][2] + v[rr][j][3] * v[rr][j][3]);
                s = wave_sum(s);
                if (F.lane == 0) rstd[m] = (m < MR) ? rsqrtf(s * (1.0f / D) + EPS) : 0.f;
                unsigned long long* o8 = (unsigned long long*)(XB + (size_t)m * D) + F.lane;
#pragma unroll
                for (int j = 0; j < 4; ++j) o8[64 * j] = (unsigned long long)pk2(v[rr][j][0], v[rr][j][1]) | ((unsigned long long)pk2(v[rr][j][2], v[rr][j][3]) << 32);
            }
        }
    }
    TOC(51);
    TIC(52);
    const size_t gt = (size_t)F.bid * 512 + F.tid, GS = (size_t)F.G * 512;
    {
        fp8* KS = (fp8*)(ws + WS_KS); fp8* VS = (fp8*)(ws + WS_VS); bf16* KIS = (bf16*)(ws + WS_KIS);
        constexpr size_t NKV8 = (size_t)DB * PAST * KVW / 8, NKI8 = (size_t)DB * PAST * 64 / 8;
        for (size_t i = gt; i < 2 * NKV8 + NKI8; i += GS) {
            if (i < 2 * NKV8) {
                const bool isv = i >= NKV8; const size_t e = (isv ? i - NKV8 : i) * 8, b = e / ((size_t)PAST * KVW), rem = e % ((size_t)PAST * KVW);
                const float* src = (isv ? p.in[I_CV] : p.in[I_CK]) + e; fp8* dst = (isv ? VS : KS) + b * SKEYS * KVW + rem;
                store_fp8x8(dst, *(const f32x4*)src, *(const f32x4*)(src + 4));
            } else {
                const size_t e = (i - 2 * NKV8) * 8, b = e / ((size_t)PAST * 64), rem = e % ((size_t)PAST * 64);
                const float* src = p.in[I_CKI] + e;
                store_bf16x8(KIS + b * SKEYS * 64 + ki_tiled((int)(rem >> 6), (int)(rem & 63)), *(const f32x4*)src, *(const f32x4*)(src + 4));
            }
        }
    }
    {
        float* rc = (float*)(ws + WS_RCOS); float* rsn = (float*)(ws + WS_RSIN);
        for (size_t i = gt; i < (size_t)8192 * 32; i += GS) {
            const int pos = (int)(i >> 5), fi = (int)(i & 31);
            const double ang = (double)pos * p.invf[fi];
            const double kq = rint(ang * 0.63661977236758134308);
            double r = fma(-kq, 1.57079632679489655800e+00, ang); r = fma(-kq, 6.12323399573676603587e-17, r);
            const double r2 = r * r;
            double sn = -1.0 / 1307674368000.0; sn = sn * r2 + 1.0 / 6227020800.0; sn = sn * r2 - 1.0 / 39916800.0; sn = sn * r2 + 1.0 / 362880.0; sn = sn * r2 - 1.0 / 5040.0; sn = sn * r2 + 1.0 / 120.0; sn = sn * r2 - 1.0 / 6.0; sn = sn * r2 + 1.0; sn *= r;
            double cs = 1.0 / 20922789888000.0; cs = cs * r2 - 1.0 / 87178291200.0; cs = cs * r2 + 1.0 / 479001600.0; cs = cs * r2 - 1.0 / 3628800.0; cs = cs * r2 + 1.0 / 40320.0; cs = cs * r2 - 1.0 / 720.0; cs = cs * r2 + 1.0 / 24.0; cs = cs * r2 - 0.5; cs = cs * r2 + 1.0;
            const int q = (int)((long long)kq & 3);
            const double sv = (q == 0) ? sn : (q == 1) ? cs : (q == 2) ? -sn : -cs;
            const double cv = (q == 0) ? cs : (q == 1) ? -sn : (q == 2) ? -cs : sn;
            rc[i] = (float)cv; rsn[i] = (float)sv;
        }
    }
    {
        float* ssq = (float*)(ws + WS_SSQ);
        for (size_t i = gt; i < (size_t)M; i += GS) ssq[i] = 0.f;
        float* sp = (float*)(ws + WS_SP);
        for (size_t i = gt; i < 512; i += GS) sp[i] = log1pf(__expf(-p.in[I_LAM][i]));
        bf16* WG = (bf16*)(ws + WS_WG);
        for (size_t i = gt; i < (size_t)2 * 8 * 64 * 64; i += GS) {
            const int ii = (int)(i & 63), j = (int)((i >> 6) & 63), nb = (int)((i >> 12) & 7), gsel = (int)(i >> 15);
            const float* W = gsel ? p.in[I_WIG] : p.in[I_WRG];
            WG[i] = (bf16)f2bf(W[(nb * 64 + ii) * 64 + j]);
        }
    }
    TOC(52);
}

constexpr int LRU_WLDS = 16384;
template <int PASS> __device__ __forceinline__ void lru_unit(const Params& p, Frame& F, int sbi  , int nb, int sg) {
    unsigned char* ws = p.ws;
    const bool samp = sbi >= NB; const int b = samp ? sbi - NB : sbi;
    const int T = samp ? DT : 128, t0 = samp ? 0 : sg * 128;
    const size_t r0 = samp ? (size_t)MP + b * DT : (size_t)b * SEQ + t0;
    const int lane = F.lane, qc = lane & 15, kq = lane >> 4, ch = nb * 64 + lane;
    LAS unsigned char* wl = F.lds + F.wave * LRU_WLDS;
    LAS bf16* xcb = (LAS bf16*)wl; LAS float* xcf = (LAS float*)(wl + 2304); LAS float* av = (LAS float*)(wl + 2304 + 4096); LAS float* bv = (LAS float*)(wl + 2304 + 8192);
    const bf16* XR = (const bf16*)(ws + WS_XR) + r0 * LW + ch;
    const float cb = p.in[I_CB][ch], w0 = p.in[I_CW][ch], w1 = p.in[I_CW][LW + ch], w2 = p.in[I_CW][2 * LW + ch], w3 = p.in[I_CW][3 * LW + ch];
    float x1, x2, x3;
    if (t0 > 0) { x1 = bf2f(XR[-3 * LW]); x2 = bf2f(XR[-2 * LW]); x3 = bf2f(XR[-1 * LW]); }
    else if (samp) { const float* sc = p.in[I_SC] + (size_t)b * 3 * LW + ch; x1 = sc[0]; x2 = sc[LW]; x3 = sc[2 * LW]; }
    else { x1 = 0.f; x2 = 0.f; x3 = 0.f; }
    const bf16* GG = (const bf16*)(ws + WS_GG) + r0 * LW + ch; bf16* YC = (bf16*)(ws + WS_YC) + r0 * D + ch;
    unsigned short xn[16], gn2[16];
#pragma unroll
    for (int k = 0; k < 16; ++k) { xn[k] = XR[(size_t)k * LW]; gn2[k] = (PASS == 1) ? GG[(size_t)k * LW] : (unsigned short)0; }
    float Ac = 1.f, h = 0.f;
    if (PASS == 1) {
        h = samp ? p.in[I_SH][b * LW + ch] : 0.f;
        const f32x2* AGG = (const f32x2*)(ws + WS_AGG) + (size_t)sbi * 64 * LW + ch;
        f32x2 gn[8];
#pragma unroll
        for (int j = 0; j < 8; ++j) gn[j] = AGG[(size_t)(j < sg ? j : 0) * LW];
        for (int s0 = 0; s0 < sg; s0 += 8) {
            f32x2 g[8];
#pragma unroll
            for (int j = 0; j < 8; ++j) g[j] = gn[j];
            if (s0 + 8 < sg) {
#pragma unroll
                for (int j = 0; j < 8; ++j) gn[j] = AGG[(size_t)(s0 + 8 + j < sg ? s0 + 8 + j : 0) * LW];
            }
#pragma unroll
            for (int j = 0; j < 8; ++j) h = (s0 + j < sg) ? g[j].x * h + g[j].y : h;
        }
    }
    asm volatile("" ::: "memory");
    const bf16* WG = (const bf16*)(ws + WS_WG); const float* sp = (const float*)(ws + WS_SP);
    bf16x8 Wr[4][2], Wi[4][2]; float brg[4], big[4], spv[4];
#pragma unroll
    for (int jt = 0; jt < 4; ++jt) {
        const int j = 16 * jt + qc;
        const bf16* wr_ = WG + ((size_t)(0 * 8 + nb) * 64 + j) * 64 + 8 * kq; const bf16* wi_ = WG + ((size_t)(1 * 8 + nb) * 64 + j) * 64 + 8 * kq;
        Wr[jt][0] = *(const bf16x8*)wr_; Wr[jt][1] = *(const bf16x8*)(wr_ + 32); Wi[jt][0] = *(const bf16x8*)wi_; Wi[jt][1] = *(const bf16x8*)(wi_ + 32);
        brg[jt] = p.in[I_BRG][nb * 64 + j]; big[jt] = p.in[I_BIG][nb * 64 + j]; spv[jt] = sp[nb * 64 + j];
    }
    for (int st = 0; st < T; st += 16) {
        float xv[16], gg[16];
#pragma unroll
        for (int k = 0; k < 16; ++k) { xv[k] = bf2f(xn[k]); if (PASS == 1) gg[k] = bf2f(gn2[k]); }
        if (st + 16 < T) {
#pragma unroll
            for (int k = 0; k < 16; ++k) { xn[k] = XR[(size_t)(st + 16 + k) * LW]; if (PASS == 1) gn2[k] = GG[(size_t)(st + 16 + k) * LW]; }
        }
#pragma unroll
        for (int k = 0; k < 16; ++k) {
            const float xc = cb + w0 * x1 + w1 * x2 + w2 * x3 + w3 * xv[k];
            x1 = x2; x2 = x3; x3 = xv[k];
            xcf[k * 64 + lane] = xc; xcb[k * 72 + lane] = (bf16)f2bf(xc);
        }
        asm volatile("s_waitcnt lgkmcnt(0)" ::: "memory");
        const bf16x8 A0 = *(const LAS bf16x8*)(xcb + qc * 72 + 8 * kq), A1 = *(const LAS bf16x8*)(xcb + qc * 72 + 32 + 8 * kq);
#pragma unroll
        for (int jt = 0; jt < 4; ++jt) {
            const int j = 16 * jt + qc;
            f32x4 ar = {0.f, 0.f, 0.f, 0.f}, ai = {0.f, 0.f, 0.f, 0.f};
            ar = __builtin_amdgcn_mfma_f32_16x16x32_bf16(A0, Wr[jt][0], ar, 0, 0, 0); ar = __builtin_amdgcn_mfma_f32_16x16x32_bf16(A1, Wr[jt][1], ar, 0, 0, 0);
            ai = __builtin_amdgcn_mfma_f32_16x16x32_bf16(A0, Wi[jt][0], ai, 0, 0, 0); ai = __builtin_amdgcn_mfma_f32_16x16x32_bf16(A1, Wi[jt][1], ai, 0, 0, 0);
#pragma unroll
            for (int ii = 0; ii < 4; ++ii) {
                const int t = 4 * kq + ii;
                const float rg = sigmoidf_(ar[ii] + brg[jt]), ig = sigmoidf_(ai[ii] + big[jt]);
                const float a = __expf(-8.0f * rg * spv[jt]);
                float mult = sqrtf(fmaxf(1.0f - a * a, 0.f));
                if (!samp && (t0 + st + t) == 0) mult = 1.0f;
                av[t * 64 + j] = a; bv[t * 64 + j] = mult * ig * xcf[t * 64 + j];
            }
        }
        asm volatile("s_waitcnt lgkmcnt(0)" ::: "memory");
#pragma unroll
        for (int k = 0; k < 16; ++k) {
            const float a = av[k * 64 + lane], bb = bv[k * 64 + lane];
            h = a * h + bb;
            if (PASS == 0) Ac *= a;
            else YC[(size_t)(st + k) * D] = (bf16)f2bf(h * gg[k]);
        }
        asm volatile("s_waitcnt lgkmcnt(0)" ::: "memory");
    }
    if (PASS == 0) ((f32x2*)(ws + WS_AGG))[((size_t)sbi * 64 + sg) * LW + ch] = (f32x2){Ac, h};
    else { if (samp) p.out[O_HS + b * LW + ch] = h; else if (sg == 63) p.out[O_HP + b * LW + ch] = h; }
}
template <int PASS> __device__ __forceinline__ void lru_phase(const Params& p, Frame& F) {
    for (int u = F.bid * 8 + F.wave; u < 2048 + 64; u += F.G * 8) {
        if (u < 2048) lru_unit<PASS>(p, F, u >> 9, u & 7, (u >> 3) & 63);
        else lru_unit<PASS>(p, F, NB + ((u - 2048) >> 3), (u - 2048) & 7, 0);
    }
}

constexpr int A_CAND = 0, A_CNT = 131072, A_THR = 131072 + 128, A_FLAG = 131072 + 256, A_CNT0 = 131072 + 384, A_HBAR = 131072 + 512, A_TICK = 131072 + 576, CAP = 1024;
constexpr int VPITCH = 288;
extern "C" __device__ unsigned __ockl_wfred_max_u32(unsigned);
extern "C" __device__ unsigned __ockl_wfred_min_u32(unsigned);
typedef short v4i16_t __attribute__((ext_vector_type(4)));
typedef int v2i32_t __attribute__((ext_vector_type(2)));
constexpr int KV8P = 144;

__device__ __forceinline__ unsigned pack_key(float s, int key) {
    unsigned u = __float_as_uint(s);
    u = (u & 0x80000000u) ? ~u : (u | 0x80000000u);
    return (u & 0xFFFFE000u) | (unsigned)(8191 - key);
}
extern "C" __device__ unsigned __ockl_wfred_add_u32(unsigned);
extern "C" __device__ unsigned __ockl_wfscan_add_u32(unsigned, bool);
struct SelRes { unsigned thr; int cnt; };
template <int ROWS> __device__ __forceinline__ SelRes select_rank_rows(LAS unsigned* cq, int n, int rlo, int rhi, int lane) {
    unsigned e[ROWS]; unsigned mx = 0u, mn = 0xFFFFFFFFu;
#pragma unroll
    for (int i = 0; i < ROWS; ++i) { const int idx = i * 64 + lane; const unsigned x = cq[idx]; const bool v = idx < n; e[i] = v ? x : 0u; mx = e[i] > mx ? e[i] : mx; const unsigned y = v ? x : 0xFFFFFFFFu; mn = y < mn ? y : mn; }
    unsigned lo = (unsigned)__builtin_amdgcn_readfirstlane((int)__ockl_wfred_min_u32(mn));
    unsigned hi = (unsigned)__builtin_amdgcn_readfirstlane((int)__ockl_wfred_max_u32(mx)); hi = hi == 0xFFFFFFFFu ? hi : hi + 1u;
    int clo = n;
    for (int it = 0; it < 40 && clo > rhi; ++it) {
        const unsigned piv = lo + ((hi - lo) >> 1);
        unsigned long long mk[ROWS];
#pragma unroll
        for (int i = 0; i < ROWS; ++i) mk[i] = __ballot(e[i] >= piv);
#pragma unroll
        for (int i = 0; i < ROWS; ++i) asm volatile("" : "+s"(mk[i]));
        int c = 0;
#pragma unroll
        for (int i = 0; i < ROWS; ++i) c += __popcll(mk[i]);
        if (c >= rlo) { lo = piv; clo = c; } else hi = piv;
    }
    unsigned cl = 0u;
#pragma unroll
    for (int i = 0; i < ROWS; ++i) cl += (e[i] >= lo) ? 1u : 0u;
    unsigned pos = __ockl_wfscan_add_u32(cl, false);
#pragma unroll
    for (int i = 0; i < ROWS; ++i) { const bool k = e[i] >= lo; if (k) cq[pos] = e[i]; pos += k ? 1u : 0u; }
    SelRes r; r.thr = lo; r.cnt = clo; return r;
}
__device__ __forceinline__ SelRes select_rank(LAS unsigned* cq, int n, int rlo, int rhi, int lane) {
    if (n <= 768) return select_rank_rows<12>(cq, n, rlo, rhi, lane);
    return select_rank_rows<16>(cq, n, rlo, rhi, lane);
}

__device__ __forceinline__ void half_barrier(LAS unsigned* hb, int lane) {
    asm volatile("s_waitcnt vmcnt(0) lgkmcnt(0)" ::: "memory");
    if (lane == 0) {
        const unsigned gen = __hip_atomic_load(hb + 1, __ATOMIC_RELAXED, __HIP_MEMORY_SCOPE_WORKGROUP);
        const unsigned old = __hip_atomic_fetch_add(hb, 1u, __ATOMIC_RELAXED, __HIP_MEMORY_SCOPE_WORKGROUP);
        if (old == 3u) { __hip_atomic_store(hb, 0u, __ATOMIC_RELAXED, __HIP_MEMORY_SCOPE_WORKGROUP); __hip_atomic_store(hb + 1, gen + 1u, __ATOMIC_RELAXED, __HIP_MEMORY_SCOPE_WORKGROUP); }
        else { while (__hip_atomic_load(hb + 1, __ATOMIC_RELAXED, __HIP_MEMORY_SCOPE_WORKGROUP) == gen) __builtin_amdgcn_s_sleep(1); }
    }
    asm volatile("s_waitcnt lgkmcnt(0)" ::: "memory");
}
__device__ __forceinline__ void select_unit(const Params& p, Frame& F, size_t q0row, int L, const bf16* KI) {
    unsigned char* ws = p.ws;
    const bf16* QI = (const bf16*)(ws + WS_QI); const float* WI = (const float*)(ws + WS_WI);
    const int lane = F.lane, half = F.wave >> 2, wid = F.wave & 3, htid = F.tid & 255, qc = lane & 15, kq = lane >> 4;
    LAS unsigned* cand = (LAS unsigned*)(F.lds + A_CAND + half * 65536); LAS unsigned* cntp = (LAS unsigned*)(F.lds + A_CNT + half * 64); LAS unsigned* thrp = (LAS unsigned*)(F.lds + A_THR + half * 64);
    LAS unsigned* flagp = (LAS unsigned*)(F.lds + A_FLAG + half * 16); LAS unsigned* hb = (LAS unsigned*)(F.lds + A_HBAR + half * 16);
    constexpr int nq = 16;
    constexpr int nslots = 4; const int slot = wid;
    const int ql = qc;
    TIC(1);
    bf16x8 Bq[9][2]; float sg_[8];
    {
        const size_t qrow = q0row + ql;
        float lin[2][8];
#pragma unroll
        for (int s = 0; s < 2; ++s)
#pragma unroll
            for (int j = 0; j < 8; ++j) lin[s][j] = 0.f;
#pragma unroll
        for (int h = 0; h < 8; ++h) {
            const float w0 = WI[qrow * 8 + h], w = 0.5f * w0;
            sg_[h] = (w0 < 0.f) ? -1.f : 1.f;
#pragma unroll
            for (int s = 0; s < 2; ++s) {
                const u32x4 raw = *(const u32x4*)(QI + qrow * 512 + h * 64 + 32 * s + 8 * kq);
                u32x4 o; o.x = pk2(bflo(raw.x) * w, bfhi(raw.x) * w); o.y = pk2(bflo(raw.y) * w, bfhi(raw.y) * w); o.z = pk2(bflo(raw.z) * w, bfhi(raw.z) * w); o.w = pk2(bflo(raw.w) * w, bfhi(raw.w) * w);
                Bq[h][s] = __builtin_bit_cast(bf16x8, o);
                lin[s][0] += bflo(o.x); lin[s][1] += bfhi(o.x); lin[s][2] += bflo(o.y); lin[s][3] += bfhi(o.y); lin[s][4] += bflo(o.z); lin[s][5] += bfhi(o.z); lin[s][6] += bflo(o.w); lin[s][7] += bfhi(o.w);
            }
        }
#pragma unroll
        for (int s = 0; s < 2; ++s) { u32x4 o; o.x = pk2(lin[s][0], lin[s][1]); o.y = pk2(lin[s][2], lin[s][3]); o.z = pk2(lin[s][4], lin[s][5]); o.w = pk2(lin[s][6], lin[s][7]); Bq[8][s] = __builtin_bit_cast(bf16x8, o); }
    }
    half_barrier(hb, lane);
    TOC(1);
    TIC(2);
    for (int arep_ = 0; arep_ <= DUP(8); ++arep_) {
    const int NG = (L + 63) >> 6; const bool tail = (L & 63) != 0;
    LAS unsigned* cnt0 = (LAS unsigned*)(F.lds + A_CNT0 + half * 64);
    int rk = (600 * 1024) / L; rk = rk < 48 ? 48 : (rk > 256 ? 256 : rk);
#if FORCE_FALLBACK
    rk = 8;
#endif
#if FORCE_SAFE_MODE
    const int mode0 = 1;
#else
    const int mode0 = 0;
#endif
    bf16x8 An[4][2];
#define LOAD_A(DST, G, T0, T1) do { int g_ = (G); g_ = g_ < NG ? g_ : NG - 1; _Pragma("unroll") for (int tl = T0; tl < T1; ++tl) { int tt_ = g_ * 4 + tl; tt_ = tt_ < (L >> 4) ? tt_ : (L >> 4) - 1; \
        const bf16* kt_ = KI + (size_t)tt_ * 1024 + lane * 8;                \
        DST[tl - T0][0] = *(const bf16x8*)kt_; DST[tl - T0][1] = *(const bf16x8*)(kt_ + 512); } } while (0)
#define LOAD_AN(G) LOAD_A(An, G, 0, 4)
    for (int mode = mode0; mode < 2; ++mode) {
    bool redo = false;
    if (htid < 16) { cntp[htid] = 0u; thrp[htid] = 0u; cnt0[htid] = 0u; }
    if (htid == 32) flagp[1] = 0u;
    int g0 = 0, KG = 16;
    LOAD_AN(slot);
    while (g0 < NG) {
        const int gend = (g0 + KG < NG) ? g0 + KG : NG;
        if (htid == 32) flagp[0] = 0u;
        half_barrier(hb, lane);
        const unsigned thr = thrp[ql];
        LAS unsigned* cq = cand + ql * CAP;
        TIC(3);
        for (int g = g0 + slot; g < gend; g += nslots) {
            TIC(7);
            bf16x8 Ac[4][2];
#pragma unroll
            for (int tl = 0; tl < 4; ++tl) { Ac[tl][0] = An[tl][0]; Ac[tl][1] = An[tl][1]; }
            { const int gn = g + nslots; LOAD_AN(gn < gend ? gn : gend + slot); }
            unsigned pk[16];
#define TILE(TL, A0_, A1_) do { f32x4 a_[9]; \
                _Pragma("unroll") for (int h = 0; h < 9; ++h) { f32x4 z_ = {0.f, 0.f, 0.f, 0.f}; \
                    z_ = __builtin_amdgcn_mfma_f32_16x16x32_bf16(A0_, Bq[h][0], z_, 0, 0, 0); a_[h] = __builtin_amdgcn_mfma_f32_16x16x32_bf16(A1_, Bq[h][1], z_, 0, 0, 0); } \
                  \
                  \
                asm volatile("s_nop 11" : "+v"(a_[0]), "+v"(a_[1]), "+v"(a_[2]), "+v"(a_[3]), "+v"(a_[4]), "+v"(a_[5]), "+v"(a_[6]), "+v"(a_[7]), "+v"(a_[8])); \
                f32x4 s0 = a_[8]; \
                _Pragma("unroll") for (int h = 0; h < 8; ++h) { _Pragma("unroll") for (int i = 0; i < 4; ++i) asm("v_fma_f32 %0, |%1|, %2, %0" : "+v"(s0[i]) : "v"(a_[h][i]), "v"(sg_[h])); } \
                _Pragma("unroll") for (int i = 0; i < 4; ++i) pk[(TL) * 4 + i] = pack_key(s0[i], g * 64 + (TL) * 16 + 4 * kq + i); } while (0)
            __builtin_amdgcn_sched_barrier(0);
            TILE(0, Ac[0][0], Ac[0][1]); TILE(1, Ac[1][0], Ac[1][1]); TILE(2, Ac[2][0], Ac[2][1]); TILE(3, Ac[3][0], Ac[3][1]);
#undef TILE
            if (tail && g == NG - 1) {
                int vt = L - g * 64 - 4 * kq; asm volatile("" : "+v"(vt));
#pragma unroll
                for (int j = 0; j < 16; ++j) pk[j] = ((j >> 2) * 16 + (j & 3) < vt) ? pk[j] : 0u;
            }
            TOC(7);
            TIC(8);
            int n = 0;
#pragma unroll
            for (int j = 0; j < 16; ++j) n += (pk[j] > thr) ? 1 : 0;
            if (n) {
                unsigned base = __hip_atomic_fetch_add(cntp + ql, (unsigned)n, __ATOMIC_RELAXED, __HIP_MEMORY_SCOPE_WORKGROUP);
                if (base + (unsigned)n > (unsigned)CAP) flagp[0] = 1u;
                else {
#pragma unroll
                    for (int j = 0; j < 16; ++j) if (pk[j] > thr) cq[base++] = pk[j];
                }
            }
            TOC(8);
        }
        TOC(3);
        TIC(4);
        half_barrier(hb, lane);
        TOC(4);
        TIC(5);
        const bool ovf = flagp[0] != 0u;
        if (ovf && mode == 0) { redo = true; break; }
        if (ovf) { if (htid < 16) cntp[htid] = cnt0[htid]; half_barrier(hb, lane); }
        const bool last = !ovf && gend == NG;
        if (!last) {
            const int plim = ovf ? 256 : (mode == 0 ? rk + (rk >> 2) : 512), rlo = mode == 0 ? rk : 256, rhi = mode == 0 ? rk + (rk >> 2) : 256;
#pragma unroll 1
            for (int i2 = 0; i2 < 4; ++i2) {
                const int qq = wid * 4 + i2;
                if (qq < nq) {
                    int n = __builtin_amdgcn_readfirstlane((int)cntp[qq]);
                    if (n > plim) { const SelRes r = select_rank(cand + qq * CAP, n, rlo, rhi, lane); n = r.cnt; if (lane == 0) { cntp[qq] = (unsigned)n; thrp[qq] = r.thr; } }
                    if (lane == 0) cnt0[qq] = (unsigned)n;
                }
            }
        }
        TOC(5);
        if (ovf) { KG = (KG >> 1) > nslots ? (KG >> 1) : nslots; LOAD_AN(g0 + slot); }
        else { g0 = gend; KG = mode == 0 ? NG : ((KG * 2 < 32) ? KG * 2 : 32); }
    }
    if (!redo && mode == 0 && L > 1024) {
        if (lane < 4) { const int qq = wid * 4 + lane; if (qq < nq && cntp[qq] < 256u) flagp[1] = 1u; }
        half_barrier(hb, lane);
        redo = flagp[1] != 0u;
    }
    half_barrier(hb, lane);
    if (!redo) break;
    }
    TOC(2);
#undef LOAD_AN
#undef LOAD_A
    }
    TIC(6);
    {
        int lane_b = lane; asm volatile("" : "+v"(lane_b));
        unsigned short* SEL = (unsigned short*)(ws + WS_SEL); int* NSEL = (int*)(ws + WS_NSEL);
#pragma unroll 1
        for (int i2 = 0; i2 < 4; ++i2) {
            const int qq = wid * 4 + i2;
            if (qq >= nq) continue;
            int n = __builtin_amdgcn_readfirstlane((int)cntp[qq]);
            if (n > 256) { select_rank(cand + qq * CAP, n, 256, 256, lane_b); n = 256; }
            asm volatile("s_waitcnt lgkmcnt(0)" ::: "memory");
            const LAS unsigned* cq = cand + qq * CAP;
            const size_t row = q0row + qq;
            u32x2 w;
            { const int k = 4 * lane_b; const unsigned e0 = k < n ? cq[k] : 8191u, e1 = k + 1 < n ? cq[k + 1] : 8191u, e2 = k + 2 < n ? cq[k + 2] : 8191u, e3 = k + 3 < n ? cq[k + 3] : 8191u;
              w.x = (8191u - (e0 & 8191u)) | ((8191u - (e1 & 8191u)) << 16); w.y = (8191u - (e2 & 8191u)) | ((8191u - (e3 & 8191u)) << 16); }
            *(u32x2*)(SEL + row * 256 + 4 * lane_b) = w;
            if (lane_b == 0) NSEL[row] = n;
        }
    }
    half_barrier(hb, lane);
    TOC(6);
}

__device__ __forceinline__ void attend_query(const Params& p, Frame& F, size_t qrow, const fp8* Kb, const fp8* Vb) {
    unsigned char* ws = p.ws;
    const bf16* Qb = (const bf16*)(ws + WS_Q); bf16* YC = (bf16*)(ws + WS_YC);
    const int lane_b = F.lane, qc_b = lane_b & 15, kq_b = lane_b >> 4, wid = F.wave;
    const int wb = wid * LRU_WLDS;
    LAS unsigned short* ix = (LAS unsigned short*)(F.lds + wb);
    LAS unsigned char* vst = F.lds + wb + 512;
    const int n = __builtin_amdgcn_readfirstlane(((const int*)(ws + WS_NSEL))[qrow]);
    *(LAS u32x2*)(ix + 4 * lane_b) = __builtin_nontemporal_load((const u32x2*)((const unsigned short*)(ws + WS_SEL) + qrow * 256 + 4 * lane_b));
    asm volatile("s_waitcnt lgkmcnt(0)" ::: "memory");
    const int h = lane_b & 15;
    long Bh8[4];
#pragma unroll
    for (int s = 0; s < 4; ++s) {
        const bool v = (h < 8) && ((h >> 2) == (kq_b >> 1));
        u32x4 raw = {0u, 0u, 0u, 0u};
        if (v) raw = __builtin_nontemporal_load((const u32x4*)(Qb + qrow * 512 + h * 64 + 32 * (kq_b & 1) + 8 * s));
        const unsigned lo = pk4_fp8(bflo(raw.x), bfhi(raw.x), bflo(raw.y), bfhi(raw.y)), hi = pk4_fp8(bflo(raw.z), bfhi(raw.z), bflo(raw.w), bfhi(raw.w));
        Bh8[s] = (long)(((unsigned long long)hi << 32) | lo);
    }
    float sc[64];
    u32x4 Kn[4][2];
#pragma unroll
    for (int t4 = 0; t4 < 4; ++t4) { const fp8* kr = Kb + (size_t)ix[t4 * 16 + qc_b] * KVW + 32 * kq_b; Kn[t4][0] = *(const u32x4*)kr; Kn[t4][1] = *(const u32x4*)(kr + 16); }
#pragma unroll
    for (int g4 = 0; g4 < 4; ++g4) {
        u32x4 Ka[4][2];
#pragma unroll
        for (int t4 = 0; t4 < 4; ++t4) { Ka[t4][0] = Kn[t4][0]; Ka[t4][1] = Kn[t4][1]; }
        if (g4 < 3) {
#pragma unroll
            for (int t4 = 0; t4 < 4; ++t4) { const fp8* kr = Kb + (size_t)ix[(g4 + 1) * 64 + t4 * 16 + qc_b] * KVW + 32 * kq_b; Kn[t4][0] = *(const u32x4*)kr; Kn[t4][1] = *(const u32x4*)(kr + 16); }
        }
#pragma unroll
        for (int t4 = 0; t4 < 4; ++t4) {
            f32x4 acc = {0.f, 0.f, 0.f, 0.f};
#pragma unroll
            for (int s = 0; s < 4; ++s) {
                const u32x4 kw = Ka[t4][s >> 1];
                const long a8 = (long)(((unsigned long long)((s & 1) ? kw.w : kw.y) << 32) | ((s & 1) ? kw.z : kw.x));
                acc = __builtin_amdgcn_mfma_f32_16x16x32_fp8_fp8(a8, Bh8[s], acc, 0, 0, 0);
            }
#pragma unroll
            for (int ii = 0; ii < 4; ++ii) { const int key = (g4 * 4 + t4) * 16 + 4 * kq_b + ii; sc[(g4 * 4 + t4) * 4 + ii] = key < n ? acc[ii] * 0.125f : -INFINITY; }
        }
        __builtin_amdgcn_sched_barrier(0);
    }
    float mx = sc[0];
#pragma unroll
    for (int j = 1; j < 64; ++j) mx = fmaxf(mx, sc[j]);
    mx = fmaxf(mx, __shfl_xor(mx, 16)); mx = fmaxf(mx, __shfl_xor(mx, 32));
    float sum = 0.f;
#pragma unroll
    for (int j = 0; j < 64; ++j) { sc[j] = __expf(sc[j] - mx); sum += sc[j]; }
    sum += __shfl_xor(sum, 16); sum += __shfl_xor(sum, 32);
    const float rl = 1.0f / sum;
    long pb8[8];
#pragma unroll
    for (int b = 0; b < 8; ++b) { const unsigned lo = pk4_fp8(sc[b * 8 + 0], sc[b * 8 + 1], sc[b * 8 + 2], sc[b * 8 + 3]), hi = pk4_fp8(sc[b * 8 + 4], sc[b * 8 + 5], sc[b * 8 + 6], sc[b * 8 + 7]);
        pb8[b] = (long)(((unsigned long long)hi << 32) | lo); }
    f32x4 oacc[8];
#pragma unroll
    for (int dt = 0; dt < 8; ++dt) oacc[dt] = (f32x4){0.f, 0.f, 0.f, 0.f};
    u32x4 vr[4], vr2[4];
    const int vrow = lane_b >> 3, vch = lane_b & 7;
#pragma unroll
    for (int i = 0; i < 4; ++i) { vr[i] = *(const u32x4*)(Vb + (size_t)ix[8 * i + vrow] * KVW + vch * 16); vr2[i] = *(const u32x4*)(Vb + (size_t)ix[32 + 8 * i + vrow] * KVW + vch * 16); }
    const int tq = qc_b >> 1, trow = (tq < 4) ? 4 * kq_b + tq : 16 + 4 * kq_b + (tq - 4);
    const LAS unsigned char* trb = vst + trow * KV8P + (qc_b & 1) * 8;
#pragma unroll
    for (int b = 0; b < 8; ++b) {
#pragma unroll
        for (int i = 0; i < 4; ++i) *(LAS u32x4*)(vst + (8 * i + vrow) * KV8P + vch * 16) = vr[i];
#pragma unroll
        for (int i = 0; i < 4; ++i) vr[i] = vr2[i];
        if (b < 6) {
#pragma unroll
            for (int i = 0; i < 4; ++i) vr2[i] = *(const u32x4*)(Vb + (size_t)ix[32 * (b + 2) + 8 * i + vrow] * KVW + vch * 16);
        }
        asm volatile("s_waitcnt lgkmcnt(0)" ::: "memory");
#pragma unroll
        for (int dt = 0; dt < 8; ++dt) {
            const v2i32_t t8 = __builtin_amdgcn_ds_read_tr8_b64_v2i32((LAS v2i32_t*)(trb + dt * 16));
            const long Av = (long)(((unsigned long long)(unsigned)t8[1] << 32) | (unsigned)t8[0]);
            oacc[dt] = __builtin_amdgcn_mfma_f32_16x16x32_fp8_fp8(Av, pb8[b], oacc[dt], 0, 0, 0);
        }
        asm volatile("s_waitcnt lgkmcnt(0)" ::: "memory");
        __builtin_amdgcn_sched_barrier(0);
    }
    if (h < 4) {
#pragma unroll
        for (int dd = 0; dd < 4; ++dd) { const f32x4 o = oacc[dd] * rl; u32x2 w; w.x = pk2(o[0], o[1]); w.y = pk2(o[2], o[3]); __builtin_nontemporal_store(w, (u32x2*)(YC + qrow * D + 512 + h * 64 + dd * 16 + 4 * kq_b)); }
    } else if (h < 8) {
#pragma unroll
        for (int dd = 0; dd < 4; ++dd) { const f32x4 o = oacc[4 + dd] * rl; u32x2 w; w.x = pk2(o[0], o[1]); w.y = pk2(o[2], o[3]); __builtin_nontemporal_store(w, (u32x2*)(YC + qrow * D + 512 + h * 64 + dd * 16 + 4 * kq_b)); }
    }
}

__device__ __forceinline__ void phase3(const Params& p, Frame& F) {
    unsigned char* ws = p.ws;
    TIC(9);
    TOC(9);
    {
        const int half = F.wave >> 2, htid = F.tid & 255;
        LAS unsigned* hb = (LAS unsigned*)(F.lds + A_HBAR + half * 16); LAS int* tick = (LAS int*)(F.lds + A_TICK + half * 16);
        if (htid == 0) { hb[0] = 0u; hb[1] = 0u; }
        __syncthreads();
        if (half == 1) {
            for (int u = F.bid * 4 + (F.wave & 3); u < 2048 + 64; u += F.G * 4) {
                if (u < 2048) lru_unit<0>(p, F, u >> 9, u & 7, (u >> 3) & 63);
                else lru_unit<0>(p, F, NB + ((u - 2048) >> 3), (u - 2048) & 7, 0);
            }
            half_barrier(hb, F.lane);
        }
        unsigned* ctr = (unsigned*)(ws + WS_CTL) + CW_QUEUE;
        for (int q = 2 * F.bid + half;;) {
            if (q >= 2048 + DB) break;
            unsigned tn = 0u;
            if (htid == 0) tn = __hip_atomic_fetch_add(ctr, 1u, __ATOMIC_RELAXED, __HIP_MEMORY_SCOPE_AGENT);
            size_t q0row; int L; const bf16* KI;
            const bool is_s = q >= 1024 && q < 1024 + DB;
            if (!is_s) {
                const int u = q < 1024 ? q : q - DB, chunk = 127 - (u >> 4), b = (u & 15) >> 2, quarter = u & 3;
                q0row = (size_t)b * SEQ + chunk * 64 + quarter * 16; L = 64 * (chunk + 1);
                KI = (const bf16*)(ws + WS_KIB) + (size_t)b * SEQ * 64;
            } else {
                const int s = q - 1024;
                q0row = (size_t)MP + s * DT; L = SKEYS;
                KI = (const bf16*)(ws + WS_KIS) + (size_t)s * SKEYS * 64;
            }
            select_unit(p, F, q0row, L, KI);
            if (htid == 0) *tick = (int)(2 * F.G + tn);
            half_barrier(hb, F.lane);
            q = *tick;
            half_barrier(hb, F.lane);
        }
    }
}

__device__ __forceinline__ void phase4(const Params& p, Frame& F) {
    unsigned char* ws = p.ws;
    TIC(10);
    if (F.wave < 4) {
        for (int u = F.bid * 4 + F.wave; u < 2048 + 64; u += F.G * 4) {
            if (u < 2048) lru_unit<1>(p, F, u >> 9, u & 7, (u >> 3) & 63);
            else lru_unit<1>(p, F, NB + ((u - 2048) >> 3), (u - 2048) & 7, 0);
        }
    }
    TOC(10);
    const bool aff = (F.G & 7) == 0;
    const int x = F.bid & 7, b = aff ? (x >> 1) : (F.bid & 3);
    const int nwv = aff ? (F.G >> 2) * 8 : ((F.G + 3 - (F.bid & 3)) / 4) * 8;
    const int wv = aff ? ((F.bid >> 3) * 2 + (x & 1)) * 8 + F.wave : (F.bid >> 2) * 8 + F.wave;
    unsigned* ctr = (unsigned*)(ws + WS_CTL) + CW_QUEUE + 64 * (1 + b);
    const fp8* Kb = (const fp8*)(ws + WS_KB) + (size_t)b * SEQ * KVW; const fp8* Vb = (const fp8*)(ws + WS_VB) + (size_t)b * SEQ * KVW;
    for (int q = wv;;) {
        if (q >= SEQ + 2 * DT) break;
        if (q < SEQ) attend_query(p, F, (size_t)b * SEQ + q, Kb, Vb);
        else { const int qs = q - SEQ, s = 2 * b + (qs >> 4);
            attend_query(p, F, (size_t)MP + s * DT + (qs & 15), (const fp8*)(ws + WS_KS) + (size_t)s * SKEYS * KVW, (const fp8*)(ws + WS_VS) + (size_t)s * SKEYS * KVW); }
        unsigned t = 0u;
        if (F.lane == 0) t = __hip_atomic_fetch_add(ctr, 1u, __ATOMIC_RELAXED, __HIP_MEMORY_SCOPE_AGENT);
        q = nwv + __builtin_amdgcn_readfirstlane((int)t);
    }
}

__global__ void __launch_bounds__(512, 2) fwd_kernel(Params p) {
    extern __shared__ __attribute__((aligned(16))) unsigned char lds_raw[];
    Frame F; F.lds = (LAS unsigned char*)lds_raw; F.tid = threadIdx.x; F.lane = F.tid & 63; F.wave = __builtin_amdgcn_readfirstlane(F.tid >> 6); F.G = gridDim.x; F.bid = blockIdx.x;
    unsigned char* ws = p.ws;
    const int lo = p.ph_lo, hi = p.ph_hi;
#if !USE_CG_SYNC
    if (F.tid < 64) ((LAS unsigned*)(F.lds + LDSCTL_OFF))[F.tid] = 0u;
    __syncthreads();
    XcdBarrier xbar = xcd_barrier_post((unsigned*)(ws + WS_CTL) + CW_BAR, (volatile LAS unsigned*)(F.lds + LDSCTL_OFF));
#endif
#define STAGGER(US) do { if ((US) > 0 && ((F.bid >> 6) & 1)) { const unsigned long long t0_ = __builtin_amdgcn_s_memrealtime(); while (__builtin_amdgcn_s_memrealtime() - t0_ < (unsigned long long)(100 * (US))) __builtin_amdgcn_s_sleep(8); } } while (0)
#define IN(k) (lo <= (k) && (k) < hi)
#ifndef SKIPMASK
#define SKIPMASK 0
#endif
#define SKIP(k) ((SKIPMASK >> (k)) & 1)
#define REPS(k) for (int rep_ = 0; rep_ <= DUP(k); ++rep_, (rep_ <= DUP(k) ? GSYNC() : (void)0))
#if USE_CG_SYNC
#define GSYNC() cg::this_grid().sync()
#else
#define GSYNC() xcd_barrier(xbar)
#endif
#define SEAM(k) do { if (IN(k) && IN((k) + 1)) { GSYNC(); } } while (0)
    { TIC(20); if (IN(0) && !SKIP(0)) REPS(0) phase0(p, F); TOC(20); }
    { TIC(40); SEAM(0); TOC(40); }
    if (IN(1) && !SKIP(1)) REPS(1) {
        pg8::Gemm g{(const pg8::bf16_t*)(ws + WS_XB), (const pg8::bf16_t*)(ws + WS_WIN), MP, NIN, D};
        pg8::StaticOrder S; S.init(MP, NIN, F.G, F.bid, WGM_IN);
        EpiInProj E{(const float*)(ws + WS_RSTD), (const float*)(ws + WS_RCOS), (const float*)(ws + WS_RSIN), p.in[I_QN], p.in[I_KN],
                    (bf16*)(ws + WS_XR), (bf16*)(ws + WS_GG), (bf16*)(ws + WS_Q), (bf16*)(ws + WS_QI), (fp8*)(ws + WS_KB), (fp8*)(ws + WS_VB), (bf16*)(ws + WS_KIB),
                    (fp8*)(ws + WS_KS), (fp8*)(ws + WS_VS), (bf16*)(ws + WS_KIS), (float*)(ws + WS_WI), p.out};
        STAGGER(STG_IN);
        { TIC(21); pg8::gemm_phase<EpiInProj, pg8::StaticOrder, true, GEMM_SP2>(F.lds, g, S, E); TOC(21); }
        TIC(31);
        {
            const float* rstd = E.rstd + MP; const float* rcos = E.rcos; const float* rsin = E.rsin; const float* gq = E.gq; const float* gk = E.gk; float* out = p.out;
            bf16* XR = E.XR + (size_t)MP * LW; bf16* GG = E.GG + (size_t)MP * LW; bf16* Q = E.Q + (size_t)MP * 512; bf16* QI = E.QI + (size_t)MP * 512;
            fp8* KS = E.KS; fp8* VS = E.VS; bf16* KIS = E.KIS; float* WI = E.WI + (size_t)MP * 8;
            skinny_gemm<4, 4>(F, (const bf16*)(ws + WS_XB) + (size_t)MP * D, D, (const bf16*)(ws + WS_WIN), D, 38,
                [](int hb_, int nb, int r) { const int c = 64 * hb_ + 16 * nb + r, pn = c >> 8, wc = (c >> 6) & 3, bj = (c >> 5) & 1, w32 = c & 31, fq = w32 >> 3, n = (w32 >> 2) & 1, j = w32 & 3;
                                             return 256 * pn + 128 * bj + 32 * wc + 16 * n + 4 * fq + j; },
                [=](const f32x4 (&acc)[4], int r, int c0, int kq) {
                    const int hbk = c0 >> 4, sb = r >> 4, t = r & 15, pos = PAST + t;
                    const float rsd = rstd[r];
                    f32x4 v[4];
#pragma unroll
                    for (int nb = 0; nb < 4; ++nb) v[nb] = acc[nb] * rsd;
                    const bool norm = (hbk >= 16 && hbk < 26), rope = norm || (hbk >= 28 && hbk < 37);
                    if (norm) {
                        float ss = 0.f;
#pragma unroll
                        for (int nb = 0; nb < 4; ++nb) ss += (v[nb][0] * v[nb][0] + v[nb][1] * v[nb][1]) + (v[nb][2] * v[nb][2] + v[nb][3] * v[nb][3]);
                        ss += __shfl_xor(ss, 16); ss += __shfl_xor(ss, 32);
                        const float inv = rsqrtf(ss * (1.0f / 64.0f) + EPS); const float* g = hbk < 24 ? gq : gk;
#pragma unroll
                        for (int nb = 0; nb < 4; ++nb) v[nb] = v[nb] * inv * *(const f32x4*)(g + 16 * nb + 4 * kq);
                    }
                    if (rope) {
#pragma unroll
                        for (int nb = 0; nb < 2; ++nb) {
                            const f32x4 c4 = *(const f32x4*)(rcos + pos * 32 + 16 * nb + 4 * kq), s4 = *(const f32x4*)(rsin + pos * 32 + 16 * nb + 4 * kq);
                            const f32x4 x1 = v[nb], x2 = v[nb + 2];
                            v[nb] = x1 * c4 - x2 * s4; v[nb + 2] = x2 * c4 + x1 * s4;
                        }
                    }
#pragma unroll
                    for (int nb = 0; nb < 4; ++nb) {
                        const int d = 16 * nb + 4 * kq; const f32x4 x = v[nb];
                        u32x2 wb; wb.x = pg8::cvt_pk_bf16(x[0], x[1]); wb.y = pg8::cvt_pk_bf16(x[2], x[3]);
                        if (hbk < 8) {
                            const int c = 64 * hbk + d; *(u32x2*)(XR + (size_t)r * LW + c) = wb;
                            if (t >= DT - 3) *(f32x4*)(out + O_CS + ((size_t)(sb * 3 + (t - (DT - 3)))) * LW + c) = x;
                        } else if (hbk < 16) {
                            f32x4 gl; gl[0] = gelu_tanh(x[0]); gl[1] = gelu_tanh(x[1]); gl[2] = gelu_tanh(x[2]); gl[3] = gelu_tanh(x[3]);
                            u32x2 wg; wg.x = pg8::cvt_pk_bf16(gl[0], gl[1]); wg.y = pg8::cvt_pk_bf16(gl[2], gl[3]);
                            *(u32x2*)(GG + (size_t)r * LW + 64 * (hbk - 8) + d) = wg;
                        } else if (hbk < 24) { *(u32x2*)(Q + (size_t)r * 512 + 64 * (hbk - 16) + d) = wb;
                        } else if (hbk < 28) {
                            const int kvh = hbk & 1; const bool isk = hbk < 26;
                            *(f32x4*)(out + (isk ? O_KS : O_VS) + (size_t)r * KVW + kvh * 64 + d) = x;
                            *(unsigned*)((isk ? KS : VS) + ((size_t)sb * SKEYS + PAST + t) * KVW + kvh * 64 + d) = pk4_fp8(x[0], x[1], x[2], x[3]);
                        } else if (hbk < 36) { *(u32x2*)(QI + (size_t)r * 512 + 64 * (hbk - 28) + d) = wb;
                        } else if (hbk == 36) {
                            *(f32x4*)(out + O_KIS + (size_t)r * 64 + d) = x;
                            *(u32x2*)(KIS + (size_t)sb * SKEYS * 64 + ki_tiled(PAST + t, d)) = wb;
                        } else if (d < 8) { *(f32x4*)(WI + (size_t)r * 8 + d) = x * WI_SCALE; }
                    }
                });
        }
        TOC(31);
    }
    { TIC(41); SEAM(1); TOC(41); }
    { TIC(23); if (IN(2) && !SKIP(2)) REPS(2) phase3(p, F); TOC(23); }
    { TIC(43); SEAM(2); TOC(43); }
    { TIC(24); if (IN(3) && !SKIP(3)) REPS(3) phase4(p, F); TOC(24); }
    { TIC(44); SEAM(3); TOC(44); }
    if (IN(4) && !SKIP(4)) REPS(4) {
        pg8::Gemm g{(const pg8::bf16_t*)(ws + WS_YC), (const pg8::bf16_t*)(ws + WS_WOUT), MP, D, D};
        pg8::StaticOrder S; S.init(MP, D, F.G, F.bid, WGM_OUT);
        EpiOutProj E{p.in[I_XP], p.in[I_XS], p.out, (bf16*)(ws + WS_XB), (rep_ < DUP(4)) ? (float*)(ws + WS_CTL + 65536) : (float*)(ws + WS_SSQ)};
        STAGGER(STG_OUT);
        { TIC(25); pg8::gemm_phase<EpiOutProj, pg8::StaticOrder, true, GEMM_SP2>(F.lds, g, S, E); TOC(25); }
        TIC(35);
        {
            const float* xs = p.in[I_XS]; float* ys = p.out + O_YS; bf16* XB2 = (bf16*)(ws + WS_XB) + (size_t)MP * D; float* ssq = E.ssq + MP;
            skinny_gemm<1, 4>(F, (const bf16*)(ws + WS_YC) + (size_t)MP * D, D, (const bf16*)(ws + WS_WOUT), D, D / 16,
                [](int ct, int, int r) { return 16 * ct + r; },
                [=](const f32x4 (&acc)[1], int r, int c0, int) {
                    const f32x4 y = *(const f32x4*)(xs + (size_t)r * D + c0) + acc[0];
                    *(f32x4*)(ys + (size_t)r * D + c0) = y;
                    u32x2 w; w.x = pg8::cvt_pk_bf16(y[0], y[1]); w.y = pg8::cvt_pk_bf16(y[2], y[3]); *(u32x2*)(XB2 + (size_t)r * D + c0) = w;
                    float ss = (y[0] * y[0] + y[1] * y[1]) + (y[2] * y[2] + y[3] * y[3]);
                    ss += __shfl_xor(ss, 16); ss += __shfl_xor(ss, 32);
                    if ((threadIdx.x & 48) == 0) atomicAdd(ssq + r, ss);
                });
        }
        TOC(35);
    }
    { TIC(45); SEAM(4); TOC(45); }
    if (IN(5) && !SKIP(5)) REPS(5) {
        pg8::Gemm g{(const pg8::bf16_t*)(ws + WS_XB), (const pg8::bf16_t*)(ws + WS_WFI), MP, 2 * DFF, D};
        pg8::StaticOrder S; S.init(MP, 2 * DFF, F.G, F.bid, WGM_FI);
        EpiFfnIn E{(const float*)(ws + WS_SSQ), (bf16*)(ws + WS_H)};
        STAGGER(STG_FI);
        { TIC(26); pg8::gemm_phase<EpiFfnIn, pg8::StaticOrder, true, GEMM_SP2>(F.lds, g, S, E); TOC(26); }
        TIC(36);
        {
            const float* ssq = (const float*)(ws + WS_SSQ) + MP; bf16* H = (bf16*)(ws + WS_H) + (size_t)MP * DFF;
            skinny_gemm<8, 4>(F, (const bf16*)(ws + WS_XB) + (size_t)MP * D, D, (const bf16*)(ws + WS_WFI), D, DFF / 64,
                [](int ct, int nb, int r) { const int c = 16 * (ct + (DFF / 64) * (nb >> 1)) + r, pn = c >> 7, wc = (c >> 5) & 3, w32 = c & 31, fq = w32 >> 3, n = (w32 >> 2) & 1, j = w32 & 3; return 256 * pn + 128 * (nb & 1) + 32 * wc + 16 * n + 4 * fq + j; },
                [=](const f32x4 (&acc)[8], int r, int c0, int) {
                    const float rs2 = rsqrtf(ssq[r] * (1.0f / 1024.0f) + EPS);
#pragma unroll
                    for (int t = 0; t < 4; ++t) {
                        const f32x4 g = acc[2 * t] * rs2, up = acc[2 * t + 1] * rs2; f32x4 h;
#pragma unroll
                        for (int j = 0; j < 4; ++j) h[j] = g[j] * sigmoidf_(g[j]) * up[j];
                        u32x2 w; w.x = pg8::cvt_pk_bf16(h[0], h[1]); w.y = pg8::cvt_pk_bf16(h[2], h[3]); *(u32x2*)(H + (size_t)r * DFF + c0 + t * (DFF / 4)) = w;
                    }
                });
        }
        TOC(36);
    }
    { TIC(46); SEAM(5); TOC(46); }
    if (IN(6) && !SKIP(6)) {
        pg8::Gemm g{(const pg8::bf16_t*)(ws + WS_H), (const pg8::bf16_t*)(ws + WS_WFO), MP, D, DFF};
        pg8::StaticOrder S; S.init(MP, D, F.G, F.bid, WGM_FO);
        EpiFfnOut E{p.out, (const bf16*)(ws + WS_XB)};
        STAGGER(STG_FO);
        { TIC(27); pg8::gemm_phase<EpiFfnOut, pg8::StaticOrder, true, GEMM_SP2>(F.lds, g, S, E); TOC(27); }
        TIC(37);
        {
            float* ys = p.out + O_YS;
            skinny_gemm<1, 11>(F, (const bf16*)(ws + WS_H) + (size_t)MP * DFF, DFF, (const bf16*)(ws + WS_WFO), DFF, D / 16,
                [](int ct, int, int r) { return 16 * ct + r; },
                [=](const f32x4 (&acc)[1], int r, int c0, int) { float* y = ys + (size_t)r * D + c0; *(f32x4*)y = *(const f32x4*)y + acc[0]; });
        }
        TOC(37);
    }
    if (TSEG && F.bid == 0 && F.tid == 0) { const unsigned acc_ = *(LAS unsigned*)(F.lds + LDSCTL_OFF + 128); const unsigned long long t0_ = __builtin_amdgcn_s_memrealtime(); while ((unsigned)(__builtin_amdgcn_s_memrealtime() - t0_) < acc_) __builtin_amdgcn_s_sleep(8); }
#undef IN
#undef SEAM
}

#ifndef N_LAUNCHES
#define N_LAUNCHES 1
#endif
constexpr int NPHASE = 7;
extern "C" void kernel_launch(void* const* d_in, const int* in_sizes, int n_in, void* d_out, int out_size, void* d_ws, size_t ws_size, hipStream_t stream) {
    static int grid = 0;
    if (grid == 0) {
        if (n_in != 22 || out_size != (int)O_END || ws_size < WS_END) { fprintf(stderr, "kernel_launch: unexpected shapes: n_in %d out %d ws %zu (need %zu)\n", n_in, out_size, ws_size, (size_t)WS_END); grid = -1; return; }
        int dev = 0, cus = 0, per_cu = 0;
        if (hipGetDevice(&dev) != hipSuccess || hipDeviceGetAttribute(&cus, hipDeviceAttributeMultiprocessorCount, dev) != hipSuccess) { grid = -1; return; }
        if (hipFuncSetAttribute((const void*)fwd_kernel, hipFuncAttributeMaxDynamicSharedMemorySize, LDS_BYTES) != hipSuccess) { fprintf(stderr, "kernel_launch: hipFuncSetAttribute failed\n"); grid = -1; return; }
        if (hipOccupancyMaxActiveBlocksPerMultiprocessor(&per_cu, (const void*)fwd_kernel, 512, LDS_BYTES) != hipSuccess || per_cu < 1) { fprintf(stderr, "kernel_launch: occupancy query says %d blocks/CU\n", per_cu); per_cu = 1; }
        (void)hipGetLastError();
        grid = cus;
    }
    if (grid < 0) return;
    if (!USE_CG_SYNC) { if (hipMemsetAsync((char*)d_ws + WS_CTL, 0, 65536, stream) != hipSuccess) { fprintf(stderr, "kernel_launch: memset failed\n"); return; } }
    Params p{};
    for (int i = 0; i < 22; ++i) p.in[i] = (const float*)d_in[i];
    p.out = (float*)d_out; p.ws = (unsigned char*)d_ws;
    for (int i = 0; i < 32; ++i) p.invf[i] = pow(10000.0, -(double)i / 32.0);
    if (N_LAUNCHES == 1) {
        p.ph_lo = 0; p.ph_hi = NPHASE;
        void* args[] = {&p};
        hipError_t e = hipLaunchCooperativeKernel((const void*)fwd_kernel, dim3(grid), dim3(512), args, LDS_BYTES, stream);
        if (e != hipSuccess) fprintf(stderr, "kernel_launch: cooperative launch failed: %s (grid %d)\n", hipGetErrorString(e), grid);
    } else {
        for (int k = 0; k < NPHASE; ++k) { p.ph_lo = k; p.ph_hi = k + 1; hipLaunchKernelGGL(fwd_kernel, dim3(grid), dim3(512), LDS_BYTES, stream, p); }
    }
}
```
